# Optimizing an MI355X kernel written in HIP

```python
import math
import jax, jax.numpy as jnp
from jax import lax
import numpy as np

D_MODEL = 1024
BATCH = 4
SEQ = 8192
DEPTH = 2

PLE_DIM = 256
N_EVEN = (DEPTH + 1) // 2
N_ODD = DEPTH // 2

DA_HEADS = 4
DA_HEAD_DIM = 64
DA_V_DIM = 2 * DA_HEAD_DIM
DA_QK_WIDTH = DA_HEADS * 2 * DA_HEAD_DIM
DA_WIDTH = DA_HEADS * DA_V_DIM

HG_HEADS = 4
HG_KDIM = 128
HG_VDIM = 128
HG_KWIDTH = HG_HEADS * HG_KDIM
HG_WIDTH = HG_HEADS * HG_VDIM
HG_CHUNK = 64

DL_HEADS = 16
DL_HEAD_DIM = D_MODEL // DL_HEADS
DL_PAIRS = ((128, 1), (512, 4), (2048, 16))

FFN_DIM = 4 * D_MODEL
ROPE_THETA = 500000.0
ROT_DIM = 64 // 4
ALPHA = (2 * DEPTH) ** 0.25
BETA = (8 * DEPTH) ** -0.25
LN_EPS = 1e-5
Q_BLOCK = 128

kernel_name = "hybrid_diffattn_hgrn2_dilated_deepnorm"


def layer_norm(x, g, b):
    xf = x.astype(jnp.float32)
    mu = jnp.mean(xf, -1, keepdims=True)
    var = jnp.mean(jnp.square(xf - mu), -1, keepdims=True)
    return ((xf - mu) * lax.rsqrt(var + LN_EPS) * g + b).astype(x.dtype)


def rms_norm(x, g):
    xf = x.astype(jnp.float32)
    return (xf * lax.rsqrt(jnp.mean(xf * xf, -1, keepdims=True) + LN_EPS) * g).astype(x.dtype)


def rope_tables(seq):
    inv = ROPE_THETA ** (-jnp.arange(0, ROT_DIM, 2, dtype=jnp.float32) / ROT_DIM)
    ang = jnp.arange(seq, dtype=jnp.float32)[:, None] * inv[None, :]
    return jnp.cos(ang), jnp.sin(ang)


def partial_rope(x, cos, sin):
    half = ROT_DIM // 2
    x1, x2, xp = x[..., :half], x[..., half:ROT_DIM], x[..., ROT_DIM:]
    c, s = cos.astype(x.dtype), sin.astype(x.dtype)
    return jnp.concatenate([x1 * c - x2 * s, x1 * s + x2 * c, xp], axis=-1)


def diff_attention(qa, ka, va, lam_params, sub_g, lam_init, cos, sin):
    B, S = qa.shape[:2]
    q = partial_rope(qa.transpose(0, 2, 3, 1, 4), cos, sin) * (DA_HEAD_DIM ** -0.5)
    k = partial_rope(ka.transpose(0, 2, 3, 1, 4), cos, sin)
    v = va.transpose(0, 2, 1, 3)
    lp = lam_params.astype(jnp.float32)
    lam = jnp.exp(jnp.sum(lp[0] * lp[1])) - jnp.exp(jnp.sum(lp[2] * lp[3])) + lam_init
    nb = S // Q_BLOCK
    qb = q.reshape(B, DA_HEADS, 2, nb, Q_BLOCK, DA_HEAD_DIM).transpose(3, 0, 1, 2, 4, 5)
    kpos = jnp.arange(S)

    def block(args):
        qi, i = args
        s = jnp.einsum('bhcqd,bhckd->bhcqk', qi, k).astype(jnp.float32)
        qpos = i * Q_BLOCK + jnp.arange(Q_BLOCK)
        s = jnp.where(kpos[None, :] <= qpos[:, None], s, -jnp.inf)
        pr = jax.nn.softmax(s, axis=-1)
        a = pr[:, :, 0] - lam * pr[:, :, 1]
        return jnp.einsum('bhqk,bhkd->bhqd', a.astype(v.dtype), v)

    o = lax.map(block, (qb, jnp.arange(nb)))
    o = o.transpose(1, 2, 0, 3, 4).reshape(B, DA_HEADS, S, DA_V_DIM)
    o = rms_norm(o, sub_g) * (1.0 - lam_init)
    return o.transpose(0, 2, 1, 3).reshape(B, S, DA_WIDTH)


def hgrn2(hq, hf, hi, hg, lb, out_g):
    B, S, H, dk = hq.shape
    dv = hi.shape[-1]
    f32 = jnp.float32
    q = jax.nn.silu(hq.astype(f32))
    f = lb + (1.0 - lb) * jax.nn.sigmoid(hf.astype(f32))
    kk = 1.0 - f
    logf = jnp.log(f)
    C = HG_CHUNK
    n = S // C

    def chunks(t):
        return t.reshape(B, n, C, H, t.shape[-1]).transpose(1, 0, 3, 2, 4)

    qc, kc, lc, vc = chunks(q), chunks(kk), chunks(logf), chunks(hi.astype(f32))
    b = jnp.cumsum(lc, axis=-2)
    b_last = b[..., C - 1:C, :]
    b_mid = b[..., C // 2 - 1:C // 2, :]
    a = jnp.einsum('nbhtk,nbhsk->nbhts', qc * jnp.exp(b - b_mid), kc * jnp.exp(b_mid - b))
    a = jnp.where(jnp.tril(jnp.ones((C, C), bool)), a, 0.0)
    o_intra = jnp.einsum('nbhts,nbhsv->nbhtv', a, vc)
    q_out = qc * jnp.exp(b)
    k_st = kc * jnp.exp(b_last - b)
    decay = jnp.exp(b_last[..., 0, :])

    def step(state, xs):
        qo, ks, vv, dc = xs
        o_inter = jnp.einsum('bhtk,bhkv->bhtv', qo, state)
        state = dc[..., None] * state + jnp.einsum('bhsk,bhsv->bhkv', ks, vv)
        return state, o_inter

    s0 = jnp.zeros((B, H, dk, dv), f32)
    _, o_inter = lax.scan(step, s0, (q_out, k_st, vc, decay))
    o = (o_intra + o_inter).transpose(1, 0, 3, 2, 4).reshape(B, S, H, dv)
    o = rms_norm(o, out_g) * jax.nn.silu(hg.astype(f32))
    return o.reshape(B, S, H * dv).astype(hi.dtype)


def even_mixer(x, w_in, w_out, lam_params, sub_g, lb, hg_g, lam_init, cos, sin):
    B, S, _ = x.shape
    h = x @ w_in
    sizes = (DA_QK_WIDTH, DA_QK_WIDTH, DA_WIDTH, HG_KWIDTH, HG_KWIDTH, HG_WIDTH, HG_WIDTH)
    cuts = [sum(sizes[:i + 1]) for i in range(len(sizes) - 1)]
    qa, ka, va, hq, hf, hi, hg = jnp.split(h, cuts, axis=-1)
    o_a = diff_attention(qa.reshape(B, S, DA_HEADS, 2, DA_HEAD_DIM),
                         ka.reshape(B, S, DA_HEADS, 2, DA_HEAD_DIM),
                         va.reshape(B, S, DA_HEADS, DA_V_DIM),
                         lam_params, sub_g, lam_init, cos, sin)
    o_b = hgrn2(hq.reshape(B, S, HG_HEADS, HG_KDIM), hf.reshape(B, S, HG_HEADS, HG_KDIM),
                hi.reshape(B, S, HG_HEADS, HG_VDIM), hg.reshape(B, S, HG_HEADS, HG_VDIM),
                lb.reshape(HG_HEADS, HG_KDIM), hg_g)
    return jnp.concatenate([o_a.astype(x.dtype), o_b.astype(x.dtype)], axis=-1) @ w_out


def dilated_branch(q, k, v, dil, span):
    B, H, S, hd = q.shape
    L = S // dil

    def to_res(t):
        return t.reshape(B, H, L, dil, hd).transpose(0, 1, 3, 2, 4)

    blk = span
    nb = -(-L // blk)
    pad = nb * blk - L

    def padl(t, front):
        return jnp.pad(t, ((0, 0), (0, 0), (0, 0), (front, pad), (0, 0)))

    qp = padl(to_res(q), 0).reshape(B, H, dil, nb, blk, hd)
    kp = padl(to_res(k), blk).reshape(B, H, dil, nb + 1, blk, hd)
    vp = padl(to_res(v), blk).reshape(B, H, dil, nb + 1, blk, hd)
    kw = jnp.concatenate([kp[:, :, :, :-1], kp[:, :, :, 1:]], axis=-2)
    vw = jnp.concatenate([vp[:, :, :, :-1], vp[:, :, :, 1:]], axis=-2)
    s = jnp.einsum('bhrnqd,bhrnkd->bhrnqk', qp, kw).astype(jnp.float32)
    a_idx = jnp.arange(blk)[:, None]
    c_idx = jnp.arange(2 * blk)[None, :]
    dist = blk + a_idx - c_idx
    key_idx = (jnp.arange(nb)[:, None, None] - 1) * blk + c_idx[None]
    valid = (dist >= 0)[None] & (dist <= span)[None] & (key_idx >= 0)
    s = jnp.where(valid, s, -jnp.inf)
    m = jnp.max(s, axis=-1, keepdims=True)
    e = jnp.exp(s - m)
    den = jnp.sum(e, axis=-1)
    o = jnp.einsum('bhrnqk,bhrnkd->bhrnqd', e.astype(v.dtype), vw) / den[..., None].astype(v.dtype)
    lse = m[..., 0] + jnp.log(den)
    o = o.reshape(B, H, dil, nb * blk, hd)[:, :, :, :L].transpose(0, 1, 3, 2, 4).reshape(B, H, S, hd)
    lse = lse.reshape(B, H, dil, nb * blk)[..., :L].transpose(0, 1, 3, 2).reshape(B, H, S)
    return o, lse


def odd_mixer(x, w_in, w_out, cos, sin):
    B, S, D = x.shape
    q, k, v = jnp.split(x @ w_in, 3, axis=-1)

    def heads(t):
        return t.reshape(B, S, DL_HEADS, DL_HEAD_DIM).transpose(0, 2, 1, 3)

    q = partial_rope(heads(q), cos, sin) * (DL_HEAD_DIM ** -0.5)
    k = partial_rope(heads(k), cos, sin)
    v = heads(v)
    outs, lses = [], []
    for (w, d) in DL_PAIRS:
        o, lse = dilated_branch(q, k, v, d, w // d)
        outs.append(o)
        lses.append(lse)
    wts = jax.nn.softmax(jnp.stack(lses, axis=0), axis=0)
    o = jnp.einsum('gbhs,gbhsd->bhsd', wts.astype(v.dtype), jnp.stack(outs, axis=0))
    return o.transpose(0, 2, 1, 3).reshape(B, S, D) @ w_out


def setup_inputs(seed: int = 0) -> dict:
    key = jax.random.key(seed)
    ks = jax.random.split(key, 20)
    f32 = jnp.float32

    def nrm(k, shape, s):
        return jax.random.normal(k, shape, f32) * s

    def gain(k, shape):
        return 1.0 + 0.02 * jax.random.normal(k, shape, f32)

    even_in = 2 * DA_QK_WIDTH + DA_WIDTH + 2 * HG_KWIDTH + 2 * HG_WIDTH
    return {
        "x": nrm(ks[0], (BATCH, SEQ, D_MODEL), 1.0),
        "p": nrm(ks[1], (DEPTH, BATCH, SEQ, PLE_DIM), 1.0),
        "ev_w_in": nrm(ks[2], (N_EVEN, D_MODEL, even_in), D_MODEL ** -0.5),
        "ev_w_out": nrm(ks[3], (N_EVEN, DA_WIDTH + HG_WIDTH, D_MODEL), BETA * (DA_WIDTH + HG_WIDTH) ** -0.5),
        "da_lambda": nrm(ks[4], (N_EVEN, 4, DA_HEAD_DIM), 0.1),
        "da_subln_g": gain(ks[5], (N_EVEN, DA_V_DIM)),
        "hg_lb_logits": nrm(ks[6], (N_EVEN + 1, HG_KWIDTH), 0.1),
        "hg_norm_g": gain(ks[7], (N_EVEN, HG_VDIM)),
        "od_w_in": nrm(ks[8], (N_ODD, D_MODEL, 3 * D_MODEL), D_MODEL ** -0.5),
        "od_w_out": nrm(ks[9], (N_ODD, D_MODEL, D_MODEL), BETA * D_MODEL ** -0.5),
        "ln1_g": gain(ks[10], (DEPTH, D_MODEL)),
        "ln1_b": nrm(ks[11], (DEPTH, D_MODEL), 0.02),
        "ffn_w1": nrm(ks[12], (DEPTH, D_MODEL, FFN_DIM), D_MODEL ** -0.5),
        "ffn_w2": nrm(ks[13], (DEPTH, FFN_DIM, D_MODEL), BETA * FFN_DIM ** -0.5),
        "ln2_g": gain(ks[14], (DEPTH, D_MODEL)),
        "ln2_b": nrm(ks[15], (DEPTH, D_MODEL), 0.02),
        "ple_w_proj": nrm(ks[16], (DEPTH, PLE_DIM, D_MODEL), PLE_DIM ** -0.5),
        "ple_w_gate": nrm(ks[17], (DEPTH, D_MODEL, D_MODEL), D_MODEL ** -0.5),
        "ple_norm_g": gain(ks[18], (DEPTH, D_MODEL)),
    }


def reference(x, p, ev_w_in, ev_w_out, da_lambda, da_subln_g, hg_lb_logits, hg_norm_g,
              od_w_in, od_w_out, ln1_g, ln1_b, ffn_w1, ffn_w2, ln2_g, ln2_b,
              ple_w_proj, ple_w_gate, ple_norm_g):
    S = x.shape[1]
    cos, sin = rope_tables(S)
    lb_all = jnp.cumsum(jax.nn.softmax(hg_lb_logits.astype(jnp.float32), axis=0), axis=0)
    for l in range(DEPTH):
        j = l // 2
        if l % 2 == 0:
            lam_init = 0.8 - 0.6 * math.exp(-0.3 * l)
            mix = even_mixer(x, ev_w_in[j], ev_w_out[j], da_lambda[j], da_subln_g[j],
                             lb_all[j], hg_norm_g[j], lam_init, cos, sin)
        else:
            mix = odd_mixer(x, od_w_in[j], od_w_out[j], cos, sin)
        x = layer_norm(ALPHA * x + mix, ln1_g[l], ln1_b[l])
        hdn = jnp.square(jax.nn.relu(x @ ffn_w1[l]))
        x = layer_norm(ALPHA * x + hdn @ ffn_w2[l], ln2_g[l], ln2_b[l])
        e = rms_norm(p[l] @ ple_w_proj[l], ple_norm_g[l])
        x = x + jax.nn.sigmoid(x @ ple_w_gate[l]) * e
    return x
```

```cpp
#include <hip/hip_runtime.h>
#include <hip/hip_cooperative_groups.h>
#include <cstdio>
#include <cstdint>
namespace cg = cooperative_groups;
namespace pg8 {
#define PG8_LAS __attribute__((address_space(3)))
typedef unsigned short bf16_t;
typedef short bf16x8 __attribute__((ext_vector_type(8)));
typedef float f32x4 __attribute__((ext_vector_type(4)));
typedef unsigned u32x4 __attribute__((ext_vector_type(4)));
constexpr int BM = 256, BK = 64, HALF = 128, HTB = HALF * BK * 2  , STAGE_BYTES = 8 * HTB, NXCD = 8, WGM = 8;

__host__ __device__ __forceinline__ int lds_byte(int r, int c) { const int st = (r >> 4) * 2 + (c >> 5), rr = r & 15, cc = c & 31, ob = rr * 64 + cc * 2; return st * 1024 + (ob ^ (((ob >> 9) & 1) << 5)); }
__host__ __device__ __forceinline__ void stage_rc(int b, int& R, int& C) { const int st = b / 1024, sb = b % 1024, swz = sb ^ (((sb >> 9) & 1) << 5); R = (st >> 1) * 16 + swz / 64; C = (st & 1) * 32 + (swz % 64) / 2; }
__host__ __device__ __forceinline__ int perm32(int rho) { const int n = rho >> 4, i = rho & 15; return 8 * (i >> 2) + 4 * n + (i & 3); }

struct Unit { int pm, pn; };
struct Gemm { const bf16_t* A; const bf16_t* Bt; int M, N, K; };

struct StaticOrder {
    int nM, nN, nwg, G, c;
    __host__ __device__ void init(int M, int N, int G_, int c_) { nM = M / BM; nN = N / BM; nwg = nM * nN; G = G_; c = c_; }
    __host__ __device__ bool next(int i, Unit& u) const {
        const long L = (long)i * G + c; if (L >= nwg) return false;
        int wgid = (int)L; { const int q = nwg / NXCD, r = nwg % NXCD, xcd = wgid % NXCD, off = wgid / NXCD; wgid = (xcd < r ? xcd * (q + 1) : r * (q + 1) + (xcd - r) * q) + off; }
        const int nig = WGM * nN, gid = wgid / nig, fm = gid * WGM, gsz = (nM - fm) < WGM ? (nM - fm) : WGM;
        u.pm = fm + ((wgid % nig) % gsz); u.pn = (wgid % nig) / gsz; return true;
    }
    __device__ __forceinline__ void a_ready(const Unit&) const {}
    __device__ __forceinline__ void done(const Unit&) const {}
};

__device__ __forceinline__ unsigned cvt_pk_bf16(float lo, float hi) { unsigned r; asm volatile("v_cvt_pk_bf16_f32 %0, %1, %2" : "=v"(r) : "v"(lo), "v"(hi)); return r; }
typedef float f32x2 __attribute__((ext_vector_type(2)));
template <class Epi, class Sched, bool ALIGN_EPI = false, bool SP2 = false>
__device__ __forceinline__ void gemm_phase(PG8_LAS unsigned char* lds, const Gemm g, const Sched& S, const Epi& E, const int tid_in) {
    const int tid = tid_in, wid = __builtin_amdgcn_readfirstlane(tid >> 6), lane = tid & 63, wr = wid >> 2, wc = wid & 3, fr = lane & 15, fq = lane >> 4;
    const int K = g.K, nt = K / BK;
    unsigned voffA[2], voffB[2];
#pragma unroll
    for (int i = 0; i < 2; ++i) { int R, C; stage_rc(tid * 16 + i * 8192, R, C); const int Rb = Epi::PERM ? ((R & ~31) + perm32(R & 31)) : R;
        voffA[i] = (unsigned)(R * K + C) * 2u; voffB[i] = (unsigned)(Rb * K + C) * 2u; }
    const size_t kstep = (size_t)(BK * 2);
    const size_t hstep = (size_t)HALF * K * 2;
    const size_t tstep = 2 * hstep;
    const unsigned ldsw = (unsigned)wid * 1024u;
    const int aoff = lds_byte(wr * 64 + fr, fq * 8), boff = lds_byte(wc * 32 + fr, fq * 8);
#define PG8_SA(b, h) (((b) * 2 + (h)) * HTB)
#define PG8_SB(b, h) ((4 + (b) * 2 + (h)) * HTB)
#define PG8_STAGE(bufoff, gbase, voff) do { _Pragma("unroll") for (int _i = 0; _i < 2; ++_i) \
        __builtin_amdgcn_global_load_lds((const unsigned*)((const char*)(gbase) + (voff)[_i]), (PG8_LAS unsigned*)(lds + (bufoff) + ldsw + _i * 8192), 16, 0, 0); } while (0)
#define PG8_LDA(dst, b, h) do { _Pragma("unroll") for (int m = 0; m < 4; ++m) _Pragma("unroll") for (int k = 0; k < 2; ++k) dst[m][k] = *(const PG8_LAS bf16x8*)(lds + PG8_SA(b, h) + aoff + m * 2048 + k * 1024); } while (0)
#define PG8_LDB(dst, b, h) do { _Pragma("unroll") for (int n = 0; n < 2; ++n) _Pragma("unroll") for (int k = 0; k < 2; ++k) dst[n][k] = *(const PG8_LAS bf16x8*)(lds + PG8_SB(b, h) + boff + n * 2048 + k * 1024); } while (0)
#define PG8_MMA(ai, bj, At, Bt) do { __builtin_amdgcn_s_setprio(1); _Pragma("unroll") for (int m = 0; m < 4; ++m) _Pragma("unroll") for (int n = 0; n < 2; ++n) _Pragma("unroll") for (int k = 0; k < 2; ++k) \
        acc[ai][bj][m][n] = __builtin_amdgcn_mfma_f32_16x16x32_bf16(Bt[n][k], At[m][k], acc[ai][bj][m][n], 0, 0, 0); __builtin_amdgcn_s_setprio(0); } while (0)
#define PG8_WAIT_V(n) asm volatile("s_waitcnt vmcnt(" #n ")" ::: "memory")
#define PG8_WAIT_L(n) asm volatile("s_waitcnt lgkmcnt(" #n ")" ::: "memory")
#define PG8_BAR __builtin_amdgcn_s_barrier()
#define PG8_SCHED __builtin_amdgcn_sched_barrier(0)
    Unit cur, nxt; int ui = 0;
    if (!S.next(0, cur)) return;
    f32x4 acc[2][2][4][2];
#pragma unroll
    for (int a = 0; a < 2; ++a)
#pragma unroll
        for (int b = 0; b < 2; ++b)
#pragma unroll
            for (int m = 0; m < 4; ++m)
#pragma unroll
                for (int n = 0; n < 2; ++n) acc[a][b][m][n] = (f32x4){0.f, 0.f, 0.f, 0.f};
    bf16x8 At[4][2], B0[2][2], B1[2][2];
    const char* cA = (const char*)g.A + (size_t)cur.pm * tstep; const char* cB = (const char*)g.Bt + (size_t)cur.pn * tstep;
    S.a_ready(cur);
    if constexpr (SP2) {
        PG8_STAGE(PG8_SB(0, 0), cB, voffB); PG8_STAGE(PG8_SB(0, 1), cB + hstep, voffB); PG8_STAGE(PG8_SA(0, 0), cA, voffA); PG8_STAGE(PG8_SA(0, 1), cA + hstep, voffA);
        if (wr == 1) PG8_BAR;
        PG8_WAIT_V(2); PG8_BAR;
        PG8_STAGE(PG8_SB(1, 0), cB + kstep, voffB); PG8_STAGE(PG8_SA(1, 0), cA + kstep, voffA); PG8_STAGE(PG8_SB(1, 1), cB + hstep + kstep, voffB);
        PG8_WAIT_V(6); PG8_BAR;
    } else {
        PG8_STAGE(PG8_SB(0, 0), cB, voffB); PG8_STAGE(PG8_SA(0, 0), cA, voffA); PG8_STAGE(PG8_SB(0, 1), cB + hstep, voffB); PG8_STAGE(PG8_SA(0, 1), cA + hstep, voffA);
        if (wr == 1) PG8_BAR;
        PG8_WAIT_V(4); PG8_BAR;
        PG8_STAGE(PG8_SB(1, 0), cB + kstep, voffB); PG8_STAGE(PG8_SA(1, 0), cA + kstep, voffA); PG8_STAGE(PG8_SB(1, 1), cB + hstep + kstep, voffB);
        PG8_WAIT_V(6); PG8_BAR;
    }
    for (;;) {
        const bool has_next = S.next(ui + 1, nxt);
        const char* nA = has_next ? (const char*)g.A + (size_t)nxt.pm * tstep : cA; const char* nB = has_next ? (const char*)g.Bt + (size_t)nxt.pn * tstep : cB;
        for (int t = 0; t < nt; t += 2) {
            const bool last = (t == nt - 2);
            const char* a1 = cA + (size_t)(t + 1) * kstep;
            const char* a2 = last ? nA : cA + (size_t)(t + 2) * kstep; const char* b2 = last ? nB : cB + (size_t)(t + 2) * kstep;
            const char* a3 = a2 + kstep; const char* b3 = b2 + kstep;
            if (last && has_next) S.a_ready(nxt);
            if constexpr (SP2) {
            PG8_LDB(B0, 0, 0); PG8_LDB(B1, 0, 1); PG8_SCHED; PG8_LDA(At, 0, 0); PG8_STAGE(PG8_SA(1, 1), a1 + hstep, voffA);
            PG8_WAIT_V(8); PG8_WAIT_L(0); PG8_BAR; PG8_MMA(0, 0, At, B0); PG8_MMA(0, 1, At, B1); PG8_BAR; PG8_SCHED;
            PG8_LDA(At, 0, 1); PG8_STAGE(PG8_SB(0, 0), b2, voffB); PG8_STAGE(PG8_SB(0, 1), b2 + hstep, voffB); PG8_STAGE(PG8_SA(0, 0), a2, voffA);
            PG8_WAIT_V(8); PG8_WAIT_L(0); PG8_BAR; PG8_MMA(1, 0, At, B0); PG8_MMA(1, 1, At, B1); PG8_BAR; PG8_SCHED;
            PG8_LDB(B0, 1, 0); PG8_LDB(B1, 1, 1); PG8_SCHED; PG8_LDA(At, 1, 0); PG8_STAGE(PG8_SA(0, 1), a2 + hstep, voffA);
            PG8_WAIT_V(8); PG8_WAIT_L(0); PG8_BAR; PG8_MMA(0, 0, At, B0); PG8_MMA(0, 1, At, B1); PG8_BAR; PG8_SCHED;
            PG8_LDA(At, 1, 1); PG8_STAGE(PG8_SB(1, 0), b3, voffB); PG8_STAGE(PG8_SB(1, 1), b3 + hstep, voffB); PG8_STAGE(PG8_SA(1, 0), a3, voffA);
            PG8_WAIT_V(8); PG8_WAIT_L(0); PG8_BAR; PG8_MMA(1, 0, At, B0); PG8_MMA(1, 1, At, B1); PG8_BAR; PG8_SCHED;
            } else {
            PG8_LDB(B0, 0, 0); PG8_SCHED; PG8_LDA(At, 0, 0); PG8_STAGE(PG8_SA(1, 1), a1 + hstep, voffA);
            PG8_WAIT_L(8); PG8_BAR; PG8_WAIT_L(0); PG8_MMA(0, 0, At, B0); PG8_BAR; PG8_SCHED;
            PG8_LDB(B1, 0, 1); PG8_STAGE(PG8_SB(0, 0), b2, voffB);
            PG8_BAR; PG8_WAIT_L(0); PG8_MMA(0, 1, At, B1); PG8_BAR;
            PG8_LDA(At, 0, 1); PG8_STAGE(PG8_SA(0, 0), a2, voffA);
            PG8_BAR; PG8_WAIT_L(0); PG8_MMA(1, 0, At, B0); PG8_BAR; PG8_SCHED;
            PG8_STAGE(PG8_SB(0, 1), b2 + hstep, voffB);
            PG8_WAIT_V(6); PG8_BAR; PG8_MMA(1, 1, At, B1); PG8_BAR;
            PG8_LDB(B0, 1, 0); PG8_SCHED; PG8_LDA(At, 1, 0); PG8_STAGE(PG8_SA(0, 1), a2 + hstep, voffA);
            PG8_WAIT_L(8); PG8_BAR; PG8_WAIT_L(0); PG8_MMA(0, 0, At, B0); PG8_BAR; PG8_SCHED;
            PG8_LDB(B1, 1, 1); PG8_STAGE(PG8_SB(1, 0), b3, voffB);
            PG8_BAR; PG8_WAIT_L(0); PG8_MMA(0, 1, At, B1); PG8_BAR;
            PG8_LDA(At, 1, 1); PG8_STAGE(PG8_SA(1, 0), a3, voffA);
            PG8_BAR; PG8_WAIT_L(0); PG8_MMA(1, 0, At, B0); PG8_BAR; PG8_SCHED;
            PG8_STAGE(PG8_SB(1, 1), b3 + hstep, voffB);
            PG8_WAIT_V(6); PG8_BAR; PG8_MMA(1, 1, At, B1); PG8_BAR;
            }
        }
        if constexpr (ALIGN_EPI) { if (wr == 0) PG8_BAR; }
        if constexpr (!Epi::AFTER_DRAIN) { E(acc, cur, wr, wc, fr, fq); S.done(cur); }
        if (!has_next) break;
#pragma unroll
        for (int a = 0; a < 2; ++a)
#pragma unroll
            for (int b = 0; b < 2; ++b)
#pragma unroll
                for (int m = 0; m < 4; ++m)
#pragma unroll
                    for (int n = 0; n < 2; ++n) acc[a][b][m][n] = (f32x4){0.f, 0.f, 0.f, 0.f};
        cur = nxt; cA = nA; cB = nB; ++ui;
        if constexpr (ALIGN_EPI) { if (wr == 1) PG8_BAR; }
    }
    PG8_WAIT_V(0);
    if constexpr (!ALIGN_EPI) { if (wr == 0) PG8_BAR; }
    PG8_BAR;
    if constexpr (Epi::AFTER_DRAIN) { E.fused(acc, cur, wr, wc, fr, fq, lds, wid, lane); S.done(cur); }
#undef PG8_SA
#undef PG8_SB
#undef PG8_STAGE
#undef PG8_LDA
#undef PG8_LDB
#undef PG8_MMA
#undef PG8_WAIT_V
#undef PG8_WAIT_L
#undef PG8_BAR
#undef PG8_SCHED
}
}
namespace pg8 {
__device__ __forceinline__ float shx(float v, int m, int lane) { return __builtin_bit_cast(float, __builtin_amdgcn_ds_bpermute((lane ^ m) << 2, __builtin_bit_cast(int, v))); }
constexpr float QSCALE = 0.125f * 1.4426950408889634f;
struct EpiStore {
    static constexpr bool PERM = true, AFTER_DRAIN = false;
    bf16_t* O; int ldc; int act; int rope_cols; int scale_cols; const float* cs;
    __device__ __forceinline__ void operator()(f32x4 (&acc)[2][2][4][2], const Unit& u, int wr, int wc, int fr, int fq) const {
        { int ln_; asm volatile("v_mbcnt_lo_u32_b32 %0, -1, 0\n\tv_mbcnt_hi_u32_b32 %0, -1, %0" : "=v"(ln_)); fr = ln_ & 15; fq = ln_ >> 4; }
        const int row0 = u.pm * BM + wr * 64 + fr; const int colt = u.pn * BM;
        const int col0 = colt + wc * 32 + 8 * fq;
        if (colt < rope_cols && (wc & 1) == 0) {
            const float sgn = fq == 0 ? -1.f : 1.f; const int lane = fq * 16 + fr;
            const int fqc = fq & 1;
#pragma unroll
            for (int ai = 0; ai < 2; ++ai)
#pragma unroll
                for (int m = 0; m < 4; ++m) {
                    const int pos = (row0 + ai * HALF + m * 16) & 8191;
                    const float* cp = cs + pos * 8;
#pragma unroll
                    for (int n = 0; n < 2; ++n) {
                        const f32x4 cv = *(const f32x4*)(cp + 4 * n), sv = *(const f32x4*)(cp + 65536 + 4 * n);
#pragma unroll
                        for (int bj = 0; bj < 2; ++bj)
#pragma unroll
                            for (int e = 0; e < 4; ++e) {
                                const float v = acc[ai][bj][m][n][e]; const float pv = shx(v, 16, lane);
                                const float nv = v * cv[e] + sgn * pv * sv[e];
                                acc[ai][bj][m][n][e] = (fq < 2) ? nv : v;
                            }
                        asm volatile("" ::: "memory");
                    }
                }
            (void)fqc;
        }
        const float sc = (colt < scale_cols) ? QSCALE : 1.f;
#pragma unroll
        for (int ai = 0; ai < 2; ++ai)
#pragma unroll
            for (int m = 0; m < 4; ++m) { bf16_t* rowp = O + (size_t)(row0 + ai * HALF + m * 16) * ldc + col0;
#pragma unroll
                for (int bj = 0; bj < 2; ++bj) { f32x4 v0 = acc[ai][bj][m][0], v1 = acc[ai][bj][m][1];
                    if (act == 1) {
#pragma unroll
                        for (int e = 0; e < 4; ++e) { float a = fmaxf(v0[e], 0.f), b = fmaxf(v1[e], 0.f); v0[e] = a * a; v1[e] = b * b; } }
                    v0 = v0 * sc; v1 = v1 * sc; u32x4 w; w.x = cvt_pk_bf16(v0[0], v0[1]); w.y = cvt_pk_bf16(v0[2], v0[3]); w.z = cvt_pk_bf16(v1[0], v1[1]); w.w = cvt_pk_bf16(v1[2], v1[3]);
                    *(u32x4*)(rowp + bj * HALF) = w; } }
    }
};
struct EpiResid {
    static constexpr bool PERM = false, AFTER_DRAIN = false;
    const float* xin; float* out; float alpha;
    __device__ __forceinline__ void operator()(f32x4 (&acc)[2][2][4][2], const Unit& u, int wr, int wc, int fr, int fq) const {
        { int ln_; asm volatile("v_mbcnt_lo_u32_b32 %0, -1, 0\n\tv_mbcnt_hi_u32_b32 %0, -1, %0" : "=v"(ln_)); fr = ln_ & 15; fq = ln_ >> 4; }
        const int col0 = u.pn * BM + wc * 32 + 4 * fq;
#pragma unroll
        for (int ai = 0; ai < 2; ++ai)
#pragma unroll
            for (int m = 0; m < 4; ++m) { const size_t off = (size_t)(u.pm * BM + ai * HALF + wr * 64 + m * 16 + fr) * 1024 + col0;
#pragma unroll
                for (int bj = 0; bj < 2; ++bj)
#pragma unroll
                    for (int n = 0; n < 2; ++n) { const f32x4 xv = *(const f32x4*)(xin + off + bj * HALF + n * 16); *(f32x4*)(out + off + bj * HALF + n * 16) = xv * alpha + acc[ai][bj][m][n]; } }
    }
};
struct EpiE {
    static constexpr bool PERM = true, AFTER_DRAIN = false;
    bf16_t* O; float* rowss;
    __device__ __forceinline__ void operator()(f32x4 (&acc)[2][2][4][2], const Unit& u, int wr, int wc, int fr, int fq) const {
        { int ln_; asm volatile("v_mbcnt_lo_u32_b32 %0, -1, 0\n\tv_mbcnt_hi_u32_b32 %0, -1, %0" : "=v"(ln_)); fr = ln_ & 15; fq = ln_ >> 4; }
        const int row0 = u.pm * BM + wr * 64 + fr; const int col0 = u.pn * BM + wc * 32 + 8 * fq; const int lane = fq * 16 + fr;
#pragma unroll
        for (int ai = 0; ai < 2; ++ai)
#pragma unroll
            for (int m = 0; m < 4; ++m) { const int row = row0 + ai * HALF + m * 16; bf16_t* rowp = O + (size_t)row * 1024 + col0; float ss = 0.f;
#pragma unroll
                for (int bj = 0; bj < 2; ++bj) { const f32x4 v0 = acc[ai][bj][m][0], v1 = acc[ai][bj][m][1];
                    ss += (v0[0] * v0[0] + v0[1] * v0[1]) + (v0[2] * v0[2] + v0[3] * v0[3]) + (v1[0] * v1[0] + v1[1] * v1[1]) + (v1[2] * v1[2] + v1[3] * v1[3]);
                    u32x4 w; w.x = cvt_pk_bf16(v0[0], v0[1]); w.y = cvt_pk_bf16(v0[2], v0[3]); w.z = cvt_pk_bf16(v1[0], v1[1]); w.w = cvt_pk_bf16(v1[2], v1[3]);
                    *(u32x4*)(rowp + bj * HALF) = w; }
                ss += shx(ss, 16, lane); ss += shx(ss, 32, lane);
                if (fq == 0) atomicAdd(rowss + row, ss); }
    }
};
struct EpiGate {
    static constexpr bool PERM = false, AFTER_DRAIN = false;
    float* x; const bf16_t* E; const float* rowss; const float* g; bf16_t* xb;
    __device__ __forceinline__ void operator()(f32x4 (&acc)[2][2][4][2], const Unit& u, int wr, int wc, int fr, int fq) const {
        { int ln_; asm volatile("v_mbcnt_lo_u32_b32 %0, -1, 0\n\tv_mbcnt_hi_u32_b32 %0, -1, %0" : "=v"(ln_)); fr = ln_ & 15; fq = ln_ >> 4; }
        typedef unsigned u32x2v __attribute__((ext_vector_type(2)));
        const int col0 = u.pn * BM + wc * 32 + 4 * fq;
#pragma unroll
        for (int ai = 0; ai < 2; ++ai)
#pragma unroll
            for (int m = 0; m < 4; ++m) { const int row = u.pm * BM + ai * HALF + wr * 64 + m * 16 + fr; const size_t off = (size_t)row * 1024 + col0;
                const float rs = 1.0f / sqrtf(rowss[row] * (1.0f / 1024.0f) + 1e-5f);
#pragma unroll
                for (int bj = 0; bj < 2; ++bj)
#pragma unroll
                    for (int n = 0; n < 2; ++n) { const size_t o2 = off + bj * HALF + n * 16; const int c = col0 + bj * HALF + n * 16;
                        const f32x4 xv = *(const f32x4*)(x + o2); const f32x4 gv = *(const f32x4*)(g + c); const u32x2v ev = *(const u32x2v*)(E + o2);
                        const f32x4 a = acc[ai][bj][m][n]; f32x4 o;
                        const float e0 = __uint_as_float(ev.x << 16), e1 = __uint_as_float(ev.x & 0xffff0000u), e2 = __uint_as_float(ev.y << 16), e3 = __uint_as_float(ev.y & 0xffff0000u);
                        o[0] = xv[0] + e0 * rs * gv[0] / (1.f + __expf(-a[0])); o[1] = xv[1] + e1 * rs * gv[1] / (1.f + __expf(-a[1]));
                        o[2] = xv[2] + e2 * rs * gv[2] / (1.f + __expf(-a[2])); o[3] = xv[3] + e3 * rs * gv[3] / (1.f + __expf(-a[3]));
                        *(f32x4*)(x + o2) = o;
                        if (xb) { u32x2v w; w.x = cvt_pk_bf16(o[0], o[1]); w.y = cvt_pk_bf16(o[2], o[3]); *(u32x2v*)(xb + o2) = w; } } }
    }
};
}
#define PG8_SP2 true
#define PG8_ALIGN true
#include <hip/hip_bf16.h>
#include <cmath>
namespace attn_body {
using bf16=__hip_bfloat16;
using bf16x8=__attribute__((ext_vector_type(8)))short;
using s16x4=__attribute__((ext_vector_type(4)))short;
using f32x16=__attribute__((ext_vector_type(16)))float;
using u32x4=__attribute__((ext_vector_type(4)))unsigned;
constexpr int SEQ=8192,D=64,DM=3584,DMO=1024;
constexpr int NW=8,QBLK=32,QB=QBLK*NW,KVBLK=64,NQB=SEQ/QB;
constexpr int ATTN_PITCH=DM, ATTN_UNIT_ROWS=QB;
__device__ __forceinline__ int crow(int r,int hi){return (r&3)+8*(r>>2)+4*hi;}
#define SBAR() __builtin_amdgcn_sched_barrier(0)
__device__ __forceinline__ void cmask(f32x16&p0,f32x16&p1,int jb,int qrel,int hi){
  const float NEG=-INFINITY; int kb=64*jb+4*hi;
  #pragma unroll
  for(int r=0;r<16;++r){int kv=kb+(r&3)+8*(r>>2); if(kv>qrel)p0[r]=NEG; if(kv+32>qrel)p1[r]=NEG;}
}

constexpr int NSLOT=3, SLOTB=8192;
constexpr int LDS_K=0, LDS_V=NSLOT*SLOTB, LDS_WS=2*NSLOT*SLOTB, LDS_OST=LDS_WS+NW*64*4, LDS_BYTES=LDS_OST+NW*4096;
constexpr float C2=0.125f*1.4426950408889634f;
__device__ __forceinline__ void glds16(const void*gsrc,unsigned lds_dst){unsigned keep;
  asm volatile("s_mov_b32 %0, m0\n\ts_mov_b32 m0, %2\n\ts_nop 0\n\tglobal_load_lds_dwordx4 %1, off\n\ts_mov_b32 m0, %0":"=&s"(keep):"v"(gsrc),"s"(lds_dst):"memory");}
__device__ __forceinline__ float max3f(float a,float b,float c){float r;asm("v_max3_f32 %0, %1, %2, %3":"=v"(r):"v"(a),"v"(b),"v"(c));return r;}
__device__ __forceinline__ float max2f(float a,float b){float r;asm("v_max_f32_e32 %0, %1, %2":"=v"(r):"v"(a),"v"(b));return r;}
__device__ __forceinline__ float fadd_s(float a,float b){float r;asm("v_add_f32_e32 %0, %1, %2":"=v"(r):"v"(a),"v"(b));return r;}
__device__ __forceinline__ float fsub_s(float a,float b){float r;asm("v_sub_f32_e32 %0, %1, %2":"=v"(r):"v"(a),"v"(b));return r;}
typedef float f32x2_t __attribute__((ext_vector_type(2))); typedef __bf16 bf16x2_t __attribute__((ext_vector_type(2)));
__device__ __forceinline__ unsigned cvtpk_s(float lo,float hi){f32x2_t v={lo,hi};bf16x2_t b=__builtin_convertvector(v,bf16x2_t);return __builtin_bit_cast(unsigned,b);}
#define WAIT_BAR(N) asm volatile("s_waitcnt vmcnt(" #N ") lgkmcnt(0)\n\ts_barrier":::"memory")

__device__ __forceinline__ void qkt(f32x16&p0,f32x16&p1,const char*Kslot,const bf16x8*qr,const f32x16&negm,int r32,int hi){
  const char*kb=Kslot+hi*1024+r32*16;
  #pragma unroll
  for(int d0=0;d0<4;++d0){
    const bf16x8 b0=*reinterpret_cast<const bf16x8*>(kb+d0*2048);
    const bf16x8 b1=*reinterpret_cast<const bf16x8*>(kb+d0*2048+512);
    if(d0==0){p0=__builtin_amdgcn_mfma_f32_32x32x16_bf16(b0,qr[0],negm,0,0,0);p1=__builtin_amdgcn_mfma_f32_32x32x16_bf16(b1,qr[0],negm,0,0,0);}
    else{p0=__builtin_amdgcn_mfma_f32_32x32x16_bf16(b0,qr[d0],p0,0,0,0);p1=__builtin_amdgcn_mfma_f32_32x32x16_bf16(b1,qr[d0],p1,0,0,0);}}
}
typedef __attribute__((address_space(3))) const char* lds_cptr;
typedef short v4i16_t __attribute__((ext_vector_type(4)));
__device__ __forceinline__ void kload8(bf16x8*kf,lds_cptr kp){
  kf[0]=*(const __attribute__((address_space(3))) bf16x8*)(kp);      kf[1]=*(const __attribute__((address_space(3))) bf16x8*)(kp+512);
  kf[2]=*(const __attribute__((address_space(3))) bf16x8*)(kp+2048); kf[3]=*(const __attribute__((address_space(3))) bf16x8*)(kp+2560);
  kf[4]=*(const __attribute__((address_space(3))) bf16x8*)(kp+4096); kf[5]=*(const __attribute__((address_space(3))) bf16x8*)(kp+4608);
  kf[6]=*(const __attribute__((address_space(3))) bf16x8*)(kp+6144); kf[7]=*(const __attribute__((address_space(3))) bf16x8*)(kp+6656);
}
__device__ __forceinline__ void kload2(bf16x8*kf,lds_cptr kp,int j){ kf[2*j]=*(const __attribute__((address_space(3))) bf16x8*)(kp+j*2048); kf[2*j+1]=*(const __attribute__((address_space(3))) bf16x8*)(kp+j*2048+512); }
__device__ __forceinline__ s16x4 vtr(lds_cptr p){ return __builtin_bit_cast(s16x4,__builtin_amdgcn_ds_read_tr16_b64_v4i16((__attribute__((address_space(3))) v4i16_t*)p)); }
__device__ __forceinline__ float rowmax(const f32x16&p0,const f32x16&p1){
  float a=max3f(p0[0],p0[1],p1[0]),b=max3f(p0[2],p0[3],p1[1]);a=max3f(a,p1[2],p1[3]);
  #pragma unroll
  for(int r=4;r<16;r+=4){a=max3f(a,p0[r],p0[r+1]);b=max3f(b,p0[r+2],p0[r+3]);a=max3f(a,p1[r],p1[r+1]);b=max3f(b,p1[r+2],p1[r+3]);}
  const float m=max2f(a,b);
  auto rr=__builtin_amdgcn_permlane32_swap(__float_as_uint(m),__float_as_uint(m),false,false);
  return max2f(__uint_as_float(rr[0]),__uint_as_float(rr[1]));
}
__device__ __forceinline__ void pv(f32x16*o,int vb,bf16x8 pa0,bf16x8 pa1,bf16x8 pa2,bf16x8 pa3){
  #pragma unroll
  for(int d0=0;d0<2;++d0){s16x4 lo[4],hi[4];
    #pragma unroll
    for(int ks=0;ks<4;++ks){
      asm volatile("ds_read_b64_tr_b16 %0,%1 offset:%c2":"=&v"(lo[ks]):"v"(vb),"i"(d0*4096+ks*1024):"memory");
      asm volatile("ds_read_b64_tr_b16 %0,%1 offset:%c2":"=&v"(hi[ks]):"v"(vb),"i"(d0*4096+ks*1024+512):"memory");}
    asm volatile("s_waitcnt lgkmcnt(0)":::"memory");SBAR();
    #define PK(k) (bf16x8){lo[k][0],lo[k][1],lo[k][2],lo[k][3],hi[k][0],hi[k][1],hi[k][2],hi[k][3]}
    o[d0]=__builtin_amdgcn_mfma_f32_32x32x16_bf16(pa0,PK(0),o[d0],0,0,0);
    o[d0]=__builtin_amdgcn_mfma_f32_32x32x16_bf16(pa1,PK(1),o[d0],0,0,0);
    o[d0]=__builtin_amdgcn_mfma_f32_32x32x16_bf16(pa2,PK(2),o[d0],0,0,0);
    o[d0]=__builtin_amdgcn_mfma_f32_32x32x16_bf16(pa3,PK(3),o[d0],0,0,0);
    #undef PK
  }
}

#ifndef ATTN_STORE16
#define ATTN_STORE16(p,v) (*(u32x4*)(p)=(v))
#endif
template<int THRL> __device__ __forceinline__ void attn_unit(int b,int colq,int colk,int colv,int colo,int qb,const bf16*Q,const bf16*__restrict__ K,const bf16*__restrict__ V,bf16*O,char*shm,const int tid_in){
  const int tid=tid_in,lane=tid&63,r32=lane&31,hi=lane>>5; const int wid=__builtin_amdgcn_readfirstlane(tid>>6);
  const long rowbase=(long)b*SEQ; const int q0=qb*QB;
  const bf16*Qw=Q+(rowbase+q0+wid*QBLK)*DM+colq;
  const bf16*Kh=K+rowbase*DM+colk,*Vh=V+rowbase*DM+colv;
  const unsigned lds0=(unsigned)(uintptr_t)shm;
  float*wsf=(float*)(shm+LDS_WS)+wid*64;
  const bf16*ksrc=Kh+(long)lane*DM+wid*8;
  const bf16*vsrc=Vh+(long)(16*(wid&3)+(lane>>2))*DM+(wid>>2)*32+(lane&3)*8;
  const unsigned kdst=lds0+LDS_K+wid*1024, vdst=lds0+LDS_V+wid*1024;
  #define DMA_K(t,slot) glds16(ksrc+(long)(t)*KVBLK*DM,(unsigned)__builtin_amdgcn_readfirstlane(kdst+(slot)))
  #define DMA_V(t,slot) glds16(vsrc+(long)(t)*KVBLK*DM,(unsigned)__builtin_amdgcn_readfirstlane(vdst+(slot)))
  const int vb0=(int)(lds0+LDS_V)+((lane>>4)&1)*32+(lane&3)*8+(4*hi+((lane&15)>>2))*64;
  const char*Kbase=shm+LDS_K; bf16x8 kf[8];
  const lds_cptr shm3=(lds_cptr)shm; const lds_cptr kp0=shm3+LDS_K+hi*1024+r32*16; const lds_cptr vp0=shm3+LDS_V+((lane>>4)&1)*32+(lane&3)*8+(4*hi+((lane&15)>>2))*64;
  const int NT=(q0+QB)/KVBLK;
  DMA_K(0,0);DMA_V(0,0);DMA_K(1,SLOTB);
  bf16x8 qr[4];
  #pragma unroll
  for(int d0=0;d0<4;++d0)qr[d0]=*reinterpret_cast<const bf16x8*>(&Qw[(long)r32*DM+d0*16+hi*8]);
  float mhat=0.f,l_reg=0.f;f32x16 o[2];o[0]=f32x16{};o[1]=f32x16{};f32x16 negm=f32x16{};asm volatile("":"+v"(negm));
  const int qrel=wid*QBLK+r32;
  #define CMASK(P0,P1,t) do{int jb_=(t)-(NT-4); if(jb_>=0)cmask(P0,P1,jb_,qrel,hi);}while(0)
  bool resc=false;
  #define START(P0,P1) do{ const float rm=rowmax(P0,P1); resc=false; \
    { const float dl=rm; mhat=fadd_s(mhat,dl); \
      _Pragma("unroll") for(int r=0;r<16;++r){P0[r]=fsub_s(P0[r],dl);P1[r]=fsub_s(P1[r],dl);} \
      _Pragma("unroll") for(int r=0;r<16;++r)negm[r]=-mhat; asm volatile("":"+v"(negm)); } \
    _Pragma("unroll") for(int r=0;r<16;++r)P0[r]=__builtin_amdgcn_exp2f(P0[r]); }while(0)
  #define RESC() do{ if(resc){ asm volatile("s_waitcnt lgkmcnt(0)":::"memory"); \
      _Pragma("unroll") for(int d_=0;d_<2;++d_) _Pragma("unroll") for(int r=0;r<16;++r)o[d_][r]*=wsf[crow(r,hi)]; } }while(0)
  f32x16 pA0,pA1,pB0,pB1;
  int sl_prev=0,sl_cur=0,sl_next=SLOTB;
  #define ROT() do{sl_prev=sl_cur;sl_cur=sl_next;sl_next=(sl_next==(NSLOT-1)*SLOTB)?0:sl_next+SLOTB;}while(0)
  DMA_K(2,2*SLOTB);
  WAIT_BAR(3);
  qkt(pA0,pA1,Kbase,qr,negm,r32,hi);asm volatile("s_nop 15\n\ts_nop 7":"+v"(pA0),"+v"(pA1));CMASK(pA0,pA1,0);
  START(pA0,pA1);
  _Pragma("unroll") for(int r=0;r<16;++r)pA1[r]=__builtin_amdgcn_exp2f(pA1[r]);
  WAIT_BAR(0);
  DMA_K(3,0);DMA_V(1,SLOTB);
  ROT();
  kload8(kf,kp0+sl_cur);
  WAIT_BAR(2);
  s16x4 vlo[8],vhi[8]; u32x4 pw0,pw1,pw2,pw3;
  #define PKW(P,B) cvtpk_s(P[B],P[B+1])
  #define PAF(k) __builtin_bit_cast(bf16x8,pw##k)
  #define VFR(i) (bf16x8){vlo[i][0],vlo[i][1],vlo[i][2],vlo[i][3],vhi[i][0],vhi[i][1],vhi[i][2],vhi[i][3]}
  #define PIN(x) asm volatile("":"+v"(x))
  #define MX3(a,b,c) __builtin_fmaxf(__builtin_fmaxf((a),(b)),(c))
  #define GAPA(MF,A0,A1,A2,A3,W0,W1,PW) do{ MF; sacc+=A0; sacc+=A1; sacc+=A2; sacc+=A3; PIN(sacc); W0; W1; PIN(PW); SBAR(); }while(0)
  #define EX(v) __builtin_amdgcn_exp2f(v)
  #define GAPB(MF,X,B) do{ MF; X[B]=EX(X[B]); X[B+1]=EX(X[B+1]); X[B+2]=EX(X[B+2]); X[B+3]=EX(X[B+3]); PIN(X); SBAR(); }while(0)
  #define VRD(i) do{ vlo[i]=vtr(vp_+(((i)>>2)*4096+((i)&3)*1024)); vhi[i]=vtr(vp_+(((i)>>2)*4096+((i)&3)*1024+512)); }while(0)
  #define KRD(G,j) do{ if(G){ kload2(kf,kp0+sl_next,j); SBAR(); } }while(0)
  #define STEP(C0,C1,P0,P1,t,GK,GV,GL) do{ SBAR(); \
    const lds_cptr vp_=vp0+sl_prev; \
    VRD(0); SBAR(); float sacc=(P0[0]+P0[1]); \
    GAPA(C0=__builtin_amdgcn_mfma_f32_32x32x16_bf16(kf[0],qr[0],negm,0,0,0), P0[2],P0[3],P0[4],P0[5],     pw0[0]=PKW(P0,0), pw0[1]=PKW(P0,2), pw0); \
    VRD(4); SBAR(); GAPA(C1=__builtin_amdgcn_mfma_f32_32x32x16_bf16(kf[1],qr[0],negm,0,0,0), P0[6],P0[7],P0[8],P0[9],     pw0[2]=PKW(P0,4), pw0[3]=PKW(P0,6), pw0); \
    VRD(1); SBAR(); GAPA(C0=__builtin_amdgcn_mfma_f32_32x32x16_bf16(kf[2],qr[1],C0,0,0,0),   P0[10],P0[11],P0[12],P0[13], pw1[0]=PKW(P0,8), pw1[1]=PKW(P0,10), pw1); \
    VRD(5); SBAR(); GAPA(C1=__builtin_amdgcn_mfma_f32_32x32x16_bf16(kf[3],qr[1],C1,0,0,0),   P0[14],P0[15],P1[0],P1[1],   pw1[2]=PKW(P0,12),pw1[3]=PKW(P0,14), pw1); \
    VRD(2); SBAR(); GAPA(C0=__builtin_amdgcn_mfma_f32_32x32x16_bf16(kf[4],qr[2],C0,0,0,0),   P1[2],P1[3],P1[4],P1[5],     pw2[0]=PKW(P1,0), pw2[1]=PKW(P1,2), pw2); \
    VRD(6); SBAR(); GAPA(C1=__builtin_amdgcn_mfma_f32_32x32x16_bf16(kf[5],qr[2],C1,0,0,0),   P1[6],P1[7],P1[8],P1[9],     pw2[2]=PKW(P1,4), pw2[3]=PKW(P1,6), pw2); \
    VRD(3); SBAR(); GAPA(C0=__builtin_amdgcn_mfma_f32_32x32x16_bf16(kf[6],qr[3],C0,0,0,0),   P1[10],P1[11],P1[12],P1[13], pw3[0]=PKW(P1,8), pw3[1]=PKW(P1,10), pw3); \
    VRD(7); SBAR(); GAPA(C1=__builtin_amdgcn_mfma_f32_32x32x16_bf16(kf[7],qr[3],C1,0,0,0),   P1[14],P1[15],0.f,0.f,       pw3[2]=PKW(P1,12),pw3[3]=PKW(P1,14), pw3); \
    l_reg+=sacc; \
    if(GK){DMA_K((t)+3,sl_cur);} if(GV){DMA_V((t)+1,sl_next);} \
    CMASK(C0,C1,t); \
    { float a=MX3(C0[0],C0[1],C1[0]),b=MX3(C0[2],C0[3],C1[1]); a=MX3(a,C1[2],C1[3]); \
      _Pragma("unroll") for(int r=4;r<16;r+=4){a=MX3(a,C0[r],C0[r+1]);b=MX3(b,C0[r+2],C0[r+3]);a=MX3(a,C1[r],C1[r+1]);b=MX3(b,C1[r+2],C1[r+3]);} \
      float rm=__builtin_fmaxf(a,b); { auto rr=__builtin_amdgcn_permlane32_swap(__float_as_uint(rm),__float_as_uint(rm),false,false); rm=__builtin_fmaxf(__uint_as_float(rr[0]),__uint_as_float(rr[1])); } \
      resc=false; \
      if(__builtin_expect(__any(rm>(float)THRL),0)){ const float dl=__builtin_fmaxf(rm,0.f); mhat+=dl; \
        _Pragma("unroll") for(int r=0;r<16;++r){C0[r]-=dl;C1[r]-=dl;} \
        _Pragma("unroll") for(int r=0;r<16;++r)negm[r]=-mhat; asm volatile("":"+v"(negm)); \
        const float f=__builtin_amdgcn_exp2f(-dl); l_reg*=f; if(hi==0)wsf[r32]=f; resc=true; } } \
    SBAR(); \
    GAPB(o[0]=__builtin_amdgcn_mfma_f32_32x32x16_bf16(PAF(0),VFR(0),o[0],0,0,0), C0,0); \
    GAPB(o[1]=__builtin_amdgcn_mfma_f32_32x32x16_bf16(PAF(0),VFR(4),o[1],0,0,0), C0,4); \
    KRD(GL,0); GAPB(o[0]=__builtin_amdgcn_mfma_f32_32x32x16_bf16(PAF(1),VFR(1),o[0],0,0,0), C0,8); \
    KRD(GL,1); GAPB(o[1]=__builtin_amdgcn_mfma_f32_32x32x16_bf16(PAF(1),VFR(5),o[1],0,0,0), C0,12); \
    KRD(GL,2); GAPB(o[0]=__builtin_amdgcn_mfma_f32_32x32x16_bf16(PAF(2),VFR(2),o[0],0,0,0), C1,0); \
    KRD(GL,3); GAPB(o[1]=__builtin_amdgcn_mfma_f32_32x32x16_bf16(PAF(2),VFR(6),o[1],0,0,0), C1,4); \
    GAPB(o[0]=__builtin_amdgcn_mfma_f32_32x32x16_bf16(PAF(3),VFR(3),o[0],0,0,0), C1,8); \
    GAPB(o[1]=__builtin_amdgcn_mfma_f32_32x32x16_bf16(PAF(3),VFR(7),o[1],0,0,0), C1,12); \
    }while(0)
  int t=1;
  #undef CMASK
  #define CMASK(P0,P1,t) do{}while(0)
  for(;t+5<NT;t+=2){
    STEP(pB0,pB1,pA0,pA1,t,true,true,true);     WAIT_BAR(2); RESC(); ROT();
    STEP(pA0,pA1,pB0,pB1,t+1,true,true,true);   WAIT_BAR(2); RESC(); ROT();
  }
  #undef CMASK
  #define CMASK(P0,P1,t) do{int jb_=(t)-(NT-4); if(jb_>=0)cmask(P0,P1,jb_,qrel,hi);}while(0)
  #define ENDW(tt) do{ if((tt)+3<NT){WAIT_BAR(2);} else if((tt)+2<NT){WAIT_BAR(1);} else {WAIT_BAR(0);} }while(0)
  for(;t+1<NT;t+=2){
    STEP(pB0,pB1,pA0,pA1,t,(t+3<NT),(t+1<NT),(t+1<NT));       ENDW(t);   RESC(); ROT();
    STEP(pA0,pA1,pB0,pB1,t+1,(t+4<NT),(t+2<NT),(t+2<NT));     ENDW(t+1); RESC(); ROT();
  }
  STEP(pB0,pB1,pA0,pA1,NT-1,false,false,false); RESC();
  { float sacc=pB0[0]+pB0[1]; _Pragma("unroll") for(int r=2;r<16;++r)sacc+=pB0[r]; _Pragma("unroll") for(int r=0;r<16;++r)sacc+=pB1[r]; l_reg+=sacc;
    pw0=(u32x4){PKW(pB0,0),PKW(pB0,2),PKW(pB0,4),PKW(pB0,6)};pw1=(u32x4){PKW(pB0,8),PKW(pB0,10),PKW(pB0,12),PKW(pB0,14)};pw2=(u32x4){PKW(pB1,0),PKW(pB1,2),PKW(pB1,4),PKW(pB1,6)};pw3=(u32x4){PKW(pB1,8),PKW(pB1,10),PKW(pB1,12),PKW(pB1,14)};
    SBAR(); pv(o,vb0+sl_cur,PAF(0),PAF(1),PAF(2),PAF(3)); }
  #undef PKW
  #undef PAF
  #undef VFR
  #undef PIN
  #undef MX3
  #undef GAPA
  #undef GAPB
  #undef EX
  #undef VRD
  #undef KRD
  #undef STEP
  #undef ENDW
  {auto rr=__builtin_amdgcn_permlane32_swap(__float_as_uint(l_reg),__float_as_uint(l_reg),false,false);l_reg=__uint_as_float(rr[0])+__uint_as_float(rr[1]);}
  if(hi==0)wsf[32+r32]=l_reg;asm volatile("s_waitcnt lgkmcnt(0)":::"memory");
  float rli[16];
  #pragma unroll
  for(int r=0;r<16;++r)rli[r]=__builtin_amdgcn_rcpf(wsf[32+crow(r,hi)]);
  bf16*Ow=O+(rowbase+q0+wid*QBLK)*DMO+colo;
  { bf16*stg=(bf16*)(shm+LDS_OST)+wid*2048;
    #pragma unroll
    for(int r=0;r<16;++r){const int orow=crow(r,hi);
      #pragma unroll
      for(int d0=0;d0<2;++d0)stg[orow*64+d0*32+r32]=__float2bfloat16(o[d0][r]*rli[r]);}
    asm volatile("s_waitcnt lgkmcnt(0)":::"memory");
    #pragma unroll
    for(int i=0;i<4;++i){const int row=i*8+(lane>>3),ch=lane&7; const u32x4 v=*(const u32x4*)(stg+row*64+ch*8); ATTN_STORE16(Ow+(long)row*DMO+ch*8,v);} }
  asm volatile("s_waitcnt lgkmcnt(0)\n\ts_barrier":::"memory");
  #undef DMA_K
  #undef DMA_V
  #undef CMASK
  #undef START
  #undef RESC
  #undef ROT
}
constexpr int ATTN_LDS_BYTES=LDS_BYTES;
#undef SBAR
#undef WAIT_BAR
}
#define LAS __attribute__((address_space(3)))
typedef unsigned short u16;
typedef unsigned v4u __attribute__((ext_vector_type(4)));
typedef unsigned v2u __attribute__((ext_vector_type(2)));
typedef float f32x4 __attribute__((ext_vector_type(4)));
typedef short bf16x8 __attribute__((ext_vector_type(8)));
typedef short s16x4 __attribute__((ext_vector_type(4)));
typedef float f32x16 __attribute__((ext_vector_type(16)));
typedef float f32x2_t __attribute__((ext_vector_type(2)));
typedef __bf16 bf16x2_t __attribute__((ext_vector_type(2)));

constexpr int MTOK = 32768, SEQL = 8192, DMODEL = 1024, FFD = 4096, NIN0 = 3584, NIN1 = 3072, PLE = 256;
constexpr float LN_EPS = 1e-5f;
constexpr float ALPHA = 1.4142135623730951f;
constexpr size_t MiB = 1u << 20;
constexpr size_t WS_ROWSS = 0;
constexpr size_t WS_BAR = 256 * 1024;
constexpr size_t WS_MISC = 512 * 1024;
constexpr size_t WS_CS = 1 * MiB;
constexpr size_t WS_WIN0 = 2 * MiB, WS_WOUT0 = 9 * MiB, WS_WIN1 = 11 * MiB, WS_WOUT1 = 17 * MiB, WS_W1 = 19 * MiB  , WS_W2 = 35 * MiB  , WS_WP = 51 * MiB  , WS_WG = 52 * MiB  ;
constexpr size_t WS_LSE = 56 * MiB;
constexpr size_t WS_XB = 64 * MiB, WS_MIX = 128 * MiB, WS_HB = 192 * MiB, WS_AUX = 448 * MiB, WS_END = 512 * MiB;
constexpr size_t WS_HGS = 416 * MiB, WS_HGD = 432 * MiB;
constexpr size_t WS_OB1 = 384 * MiB;
constexpr int LDS_BYTES = 147456;

__device__ __forceinline__ unsigned f2bf(float f) { unsigned u = __builtin_bit_cast(unsigned, f); return (u + 0x7fffu + ((u >> 16) & 1u)) >> 16; }
__device__ __forceinline__ unsigned pk2(float lo, float hi) { f32x2_t v = {lo, hi}; bf16x2_t b = __builtin_convertvector(v, bf16x2_t); return __builtin_bit_cast(unsigned, b); }
__device__ __forceinline__ float bf2f(unsigned v) { return __uint_as_float(v << 16); }
__device__ __forceinline__ float bflo(unsigned w) { return __uint_as_float(w << 16); }
__device__ __forceinline__ float bfhi(unsigned w) { return __uint_as_float(w & 0xffff0000u); }
__device__ __forceinline__ float shx(float v, int m, int lane) { return __builtin_bit_cast(float, __builtin_amdgcn_ds_bpermute((lane ^ m) << 2, __builtin_bit_cast(int, v))); }
__device__ __forceinline__ float wave_sum(float v, int lane) {
#pragma unroll
    for (int o = 1; o < 64; o <<= 1) v += shx(v, o, lane);
    return v;
}
__device__ __forceinline__ int crow(int reg, int h) { return (reg & 3) + 8 * (reg >> 2) + 4 * h; }
#define MFMA32(a, b, c) __builtin_amdgcn_mfma_f32_32x32x16_bf16((a), (b), (c), 0, 0, 0)
__device__ __forceinline__ bf16x8 pack8(const f32x16& x, int base) {
    v4u p; p.x = pk2(x[base], x[base + 1]); p.y = pk2(x[base + 2], x[base + 3]); p.z = pk2(x[base + 4], x[base + 5]); p.w = pk2(x[base + 6], x[base + 7]);
    return __builtin_bit_cast(bf16x8, p);
}
typedef short v4i16_t __attribute__((ext_vector_type(4)));
__device__ __forceinline__ s16x4 trrd(LAS unsigned char* p) { return __builtin_bit_cast(s16x4, __builtin_amdgcn_ds_read_tr16_b64_v4i16((LAS v4i16_t*)p)); }
__device__ __forceinline__ bf16x8 trfrag(LAS unsigned char* img, int pitch, int row_lo, int hi_delta, int col0, int lane) {
    const int i16 = lane & 15, q = i16 >> 2, p = i16 & 3, g16 = (lane >> 4) & 1;
    LAS unsigned char* a = img + (row_lo + q) * pitch + (col0 + 16 * g16 + 4 * p) * 2;
    const s16x4 lo = trrd(a), hi = trrd(a + hi_delta * pitch);
    return (bf16x8){lo[0], lo[1], lo[2], lo[3], hi[0], hi[1], hi[2], hi[3]};
}

struct Args {
    const float *x, *p, *ev_w_in, *ev_w_out, *da_lambda, *da_subln_g, *hg_lb_logits, *hg_norm_g, *od_w_in, *od_w_out, *ln1_g, *ln1_b, *ffn_w1, *ffn_w2, *ln2_g, *ln2_b, *ple_w_proj, *ple_w_gate, *ple_norm_g;
    float* out; unsigned char* ws;
};

__device__ __forceinline__ void p0_transpose_item(const float* W, int K, int N, u16* WT, LAS float* scr, int item, int lane) {
    const int nblk = N / 32, kb = item / nblk, nb = item % nblk, k0 = 64 * kb, n0 = 32 * nb;
#pragma unroll 8
    for (int i = 0; i < 32; ++i) { const int kk = 2 * i + (lane >> 5); scr[kk * 33 + (lane & 31)] = W[(size_t)(k0 + kk) * N + n0 + (lane & 31)]; }
    asm volatile("s_waitcnt lgkmcnt(0)" ::: "memory");
    const int c = lane & 7;
#pragma unroll
    for (int j = 0; j < 4; ++j) { const int n = (lane >> 3) + 8 * j; const LAS float* s = scr + (8 * c) * 33 + n;
        v4u o; o.x = pk2(s[0 * 33], s[1 * 33]); o.y = pk2(s[2 * 33], s[3 * 33]); o.z = pk2(s[4 * 33], s[5 * 33]); o.w = pk2(s[6 * 33], s[7 * 33]);
        *(v4u*)(WT + (size_t)(n0 + n) * K + k0 + 8 * c) = o; }
    asm volatile("s_waitcnt lgkmcnt(0)" ::: "memory");
}
__device__ __forceinline__ void prologue(const Args& A, LAS unsigned char* lds, int gw, int NGW, int wave, int lane) {
    unsigned char* ws = A.ws;
    LAS float* scr = (LAS float*)(lds + wave * 16384);
    const int cnt[12] = {(1024 / 64) * (NIN0 / 32), 512, (1024 / 64) * (NIN1 / 32), 512, 2048, 2048, 2048, 2048, 128, 128, 512, 512};
    int total = 0;
#pragma unroll
    for (int i = 0; i < 12; ++i) total += cnt[i];
    for (int it = gw; it < total; it += NGW) {
        int r = it;
        if (r < cnt[0]) { p0_transpose_item(A.ev_w_in, 1024, NIN0, (u16*)(ws + WS_WIN0), scr, r, lane); continue; } r -= cnt[0];
        if (r < cnt[1]) { p0_transpose_item(A.ev_w_out, 1024, 1024, (u16*)(ws + WS_WOUT0), scr, r, lane); continue; } r -= cnt[1];
        if (r < cnt[2]) { p0_transpose_item(A.od_w_in, 1024, NIN1, (u16*)(ws + WS_WIN1), scr, r, lane); continue; } r -= cnt[2];
        if (r < cnt[3]) { p0_transpose_item(A.od_w_out, 1024, 1024, (u16*)(ws + WS_WOUT1), scr, r, lane); continue; } r -= cnt[3];
        if (r < 4096) { const int l = r >> 11; p0_transpose_item(A.ffn_w1 + (size_t)l * 1024 * 4096, 1024, 4096, (u16*)(ws + WS_W1 + l * 8 * MiB), scr, r & 2047, lane); continue; } r -= 4096;
        if (r < 4096) { const int l = r >> 11; p0_transpose_item(A.ffn_w2 + (size_t)l * 1024 * 4096, 4096, 1024, (u16*)(ws + WS_W2 + l * 8 * MiB), scr, r & 2047, lane); continue; } r -= 4096;
        if (r < 256) { const int l = r >> 7; p0_transpose_item(A.ple_w_proj + (size_t)l * 256 * 1024, 256, 1024, (u16*)(ws + WS_WP + l * (MiB / 2)), scr, r & 127, lane); continue; } r -= 256;
        { const int l = r >> 9; p0_transpose_item(A.ple_w_gate + (size_t)l * 1024 * 1024, 1024, 1024, (u16*)(ws + WS_WG + l * 2 * MiB), scr, r & 511, lane); }
    }
    u16* XB = (u16*)(ws + WS_XB);
    for (int m = gw; m < MTOK; m += NGW) {
        const f32x4* xr = (const f32x4*)(A.x + (size_t)m * 1024) + lane; v2u* o = (v2u*)(XB + (size_t)m * 1024) + lane;
#pragma unroll
        for (int j = 0; j < 4; ++j) { const f32x4 v = xr[64 * j]; v2u w; w.x = pk2(v[0], v[1]); w.y = pk2(v[2], v[3]); o[64 * j] = w; }
    }
    float* cs = (float*)(ws + WS_CS);
    for (int idx = gw * 64 + lane; idx < 65536; idx += NGW * 64) {
        const int pos = idx >> 3, e = idx & 7;
        double iv = 1.0;
#pragma unroll 1
        for (int k = 0; k < e; ++k) iv *= 0.19392274474868576;
        const float inv = (float)iv;
        const float angf = (float)pos * inv;
        double a = (double)angf; const double twopi = 6.283185307179586476925;
        const double kq = __builtin_rint(a / twopi); a -= kq * twopi;
        const double a2 = a * a; double sn = 0.0, cn = 0.0;
        double ts = a, tc = 1.0;
#pragma unroll 1
        for (int n = 0; n < 16; ++n) { cn += tc; sn += ts; tc *= -a2 / (double)((2 * n + 1) * (2 * n + 2)); ts *= -a2 / (double)((2 * n + 2) * (2 * n + 3)); }
        cs[idx] = (float)cn; cs[65536 + idx] = (float)sn;
    }
    float* misc = (float*)(ws + WS_MISC);
    for (int i = gw * 64 + lane; i < 512; i += NGW * 64) { const float l0 = A.hg_lb_logits[i], l1 = A.hg_lb_logits[512 + i]; misc[i] = 1.f / (1.f + __expf(l1 - l0)); }
}

__device__ __forceinline__ void ln_rows(float* X, u16* XBo, const float* g, const float* bta, float* rowss, const float* prow, u16* PBo, int gw, int NGW, int lane) {
    for (int m = gw; m < MTOK; m += NGW) {
        f32x4* xr = (f32x4*)(X + (size_t)m * 1024) + lane;
        f32x4 v[4]; float s = 0.f;
#pragma unroll
        for (int j = 0; j < 4; ++j) { v[j] = xr[64 * j]; s += (v[j][0] + v[j][1]) + (v[j][2] + v[j][3]); }
        const float mean = wave_sum(s, lane) * (1.f / 1024.f); float s2 = 0.f;
#pragma unroll
        for (int j = 0; j < 4; ++j) { v[j] = v[j] - mean; s2 += (v[j][0] * v[j][0] + v[j][1] * v[j][1]) + (v[j][2] * v[j][2] + v[j][3] * v[j][3]); }
        const float rstd = 1.f / sqrtf(wave_sum(s2, lane) * (1.f / 1024.f) + LN_EPS);
        v2u* o8 = (v2u*)(XBo + (size_t)m * 1024) + lane;
#pragma unroll
        for (int j = 0; j < 4; ++j) { const f32x4 gv = ((const f32x4*)g)[lane + 64 * j], bv = ((const f32x4*)bta)[lane + 64 * j];
            const f32x4 o = v[j] * rstd * gv + bv; xr[64 * j] = o; v2u w; w.x = pk2(o[0], o[1]); w.y = pk2(o[2], o[3]); o8[64 * j] = w; }
        if (rowss && lane == 0) rowss[m] = 0.f;
        if (prow) { const f32x4 pv = ((const f32x4*)(prow + (size_t)m * 256))[lane]; v2u w; w.x = pk2(pv[0], pv[1]); w.y = pk2(pv[2], pv[3]); ((v2u*)(PBo + (size_t)m * 256))[lane] = w; }
    }
}
__device__ __forceinline__ void diff_combine(const u16* AUX, u16* MIX, const float* lam_p, const float* subg, int gw, int NGW, int lane) {
    const float s01 = wave_sum(lam_p[lane] * lam_p[64 + lane], lane), s23 = wave_sum(lam_p[128 + lane] * lam_p[192 + lane], lane);
    const float lam = __expf(s01) - __expf(s23) + 0.2f;
    const int h = lane >> 4, d0 = (lane & 15) * 8;
    float gv[8];
#pragma unroll
    for (int e = 0; e < 8; ++e) gv[e] = subg[d0 + e] * 0.8f;
    for (int m = gw; m < MTOK; m += NGW) {
        const v4u a0 = *(const v4u*)(AUX + (size_t)m * 1024 + h * 256 + d0), a1 = *(const v4u*)(AUX + (size_t)m * 1024 + h * 256 + 128 + d0);
        float o[8];
        o[0] = bflo(a0.x) - lam * bflo(a1.x); o[1] = bfhi(a0.x) - lam * bfhi(a1.x); o[2] = bflo(a0.y) - lam * bflo(a1.y); o[3] = bfhi(a0.y) - lam * bfhi(a1.y);
        o[4] = bflo(a0.z) - lam * bflo(a1.z); o[5] = bfhi(a0.z) - lam * bfhi(a1.z); o[6] = bflo(a0.w) - lam * bflo(a1.w); o[7] = bfhi(a0.w) - lam * bfhi(a1.w);
        float ss = 0.f;
#pragma unroll
        for (int e = 0; e < 8; ++e) ss += o[e] * o[e];
        ss += shx(ss, 1, lane); ss += shx(ss, 2, lane); ss += shx(ss, 4, lane); ss += shx(ss, 8, lane);
        const float rs = 1.f / sqrtf(ss * (1.f / 128.f) + LN_EPS);
        v4u w; w.x = pk2(o[0] * rs * gv[0], o[1] * rs * gv[1]); w.y = pk2(o[2] * rs * gv[2], o[3] * rs * gv[3]); w.z = pk2(o[4] * rs * gv[4], o[5] * rs * gv[5]); w.w = pk2(o[6] * rs * gv[6], o[7] * rs * gv[7]);
        *(v4u*)(MIX + (size_t)m * 1024 + h * 128 + d0) = w;
    }
}
namespace hg {
constexpr int P_QA = 272, P_QO = 264, P_TR = 320;
constexpr int O_QA = 0, O_KA = O_QA + 64 * P_QA, O_QO = O_KA + 64 * P_QA, O_KST = O_QO + 64 * P_QO, O_V = O_KST + 64 * P_TR, O_OST = O_V + 64 * P_TR, O_TOT = O_OST + 64 * 132 * 4, O_DEC = O_TOT + 2048, O_END = O_DEC + 512;
static_assert(O_END <= 131072, "hgrn lds");
template <bool OUT>
__device__ __forceinline__ void item(LAS unsigned char* L, const u16* __restrict__ H, int it, const float* __restrict__ lbv, float* Send, float* Drun, const float* __restrict__ outg, u16* MIX, const int tid) {
    const int  lane = tid & 63, w = __builtin_amdgcn_readfirstlane(tid >> 6), r = lane & 31, h = lane >> 5;
    const int tt = w & 1, vt = w >> 1;
    const int bh = it >> 4, run = it & 15, b = bh >> 2, hh = bh & 3;
    const int kd = tid & 127, seg = tid >> 7;
    const size_t row0 = (size_t)b * 8192 + (size_t)run * 512;
    const float lb = lbv[hh * 128 + kd];
    LAS float* TOT = (LAS float*)(L + O_TOT); LAS float* DEC = (LAS float*)(L + O_DEC); LAS float* OST = (LAS float*)(L + O_OST);
    f32x16 S[4];
#pragma unroll
    for (int k = 0; k < 4; ++k) S[k] = f32x16{};
    if (OUT) {
        for (int rp = 0; rp < run; ++rp) { const int ip = bh * 16 + rp;
#pragma unroll
            for (int k = 0; k < 4; ++k)
#pragma unroll
                for (int i = 0; i < 16; ++i) S[k][i] = Drun[ip * 128 + 32 * k + crow(i, h)] * S[k][i] + Send[((((size_t)ip * 4 + vt) * 4 + k) * 16 + i) * 64 + lane];
        }
    }
    float bsum = 0.f;
    for (int ch = 0; ch < 8; ++ch) {
        const size_t rowc = row0 + ch * 64;
        float fg[16], cs[16], hq[16];
#pragma unroll
        for (int i = 0; i < 16; ++i) { const u16* p = H + (rowc + seg * 16 + i) * NIN0 + hh * 128 + kd; fg[i] = bf2f(p[2048]); if (OUT) hq[i] = bf2f(p[1536]); }
#pragma unroll
        for (int n = 0; n < 2; ++n) { const int id = tid + 512 * n, t = id >> 4, c = id & 15;
            const v4u v = *(const v4u*)(H + (rowc + t) * NIN0 + 2560 + hh * 128 + c * 8); *(LAS v4u*)(L + O_V + t * P_TR + c * 16) = v; }
        float runs = 0.f;
#pragma unroll
        for (int i = 0; i < 16; ++i) { const float sg = 1.f / (1.f + __expf(-fg[i])); const float f = lb + (1.f - lb) * sg; fg[i] = (1.f - lb) * (1.f - sg); runs += __logf(f); cs[i] = runs; }
        TOT[seg * 128 + kd] = runs;
        __syncthreads();
        const float t0 = TOT[kd], t1 = TOT[128 + kd], t2 = TOT[256 + kd], t3 = TOT[384 + kd];
        const float off = (seg > 0 ? t0 : 0.f) + (seg > 1 ? t1 : 0.f) + (seg > 2 ? t2 : 0.f);
        const float bmid = t0 + t1, blast = (t0 + t1) + (t2 + t3);
        const float elm = __expf(blast - bmid), em = __expf(bmid);
#pragma unroll
        for (int i = 0; i < 16; ++i) {
            const int t = seg * 16 + i; const float bi = off + cs[i];
            const float e1 = __expf(bi - bmid), e2 = __expf(bmid - bi); const float kk = fg[i];
            *(LAS u16*)(L + O_KST + t * P_TR + kd * 2) = (u16)f2bf(kk * e2 * elm);
            if (OUT) { const float q = hq[i] / (1.f + __expf(-hq[i]));
                *(LAS u16*)(L + O_QA + t * P_QA + kd * 2) = (u16)f2bf(q * e1);
                *(LAS u16*)(L + O_KA + t * P_QA + kd * 2) = (u16)f2bf(kk * e2);
                *(LAS u16*)(L + O_QO + t * P_QO + kd * 2) = (u16)f2bf(q * e1 * em); }
        }
        if (seg == 0) { DEC[kd] = __expf(blast); bsum += blast; }
        __syncthreads();
        if (OUT) {
            f32x16 acc = f32x16{};
            for (int st = 0; st <= tt; ++st) {
                f32x16 X = f32x16{};
#pragma unroll
                for (int ks = 0; ks < 8; ++ks) { const bf16x8 a = *(LAS bf16x8*)(L + O_KA + (32 * st + r) * P_QA + (16 * ks + 8 * h) * 2); const bf16x8 bq = *(LAS bf16x8*)(L + O_QA + (32 * tt + r) * P_QA + (16 * ks + 8 * h) * 2); X = MFMA32(a, bq, X); }
                if (st == tt) {
#pragma unroll
                    for (int i = 0; i < 16; ++i) if (crow(i, h) > r) X[i] = 0.f; }
#pragma unroll
                for (int s2 = 0; s2 < 2; ++s2) { const bf16x8 pa = pack8(X, 8 * s2); const bf16x8 vf = trfrag(L + O_V, P_TR, 32 * st + 16 * s2 + 4 * h, 8, 32 * vt, lane); acc = MFMA32(pa, vf, acc); }
            }
#pragma unroll
            for (int k = 0; k < 4; ++k)
#pragma unroll
                for (int s2 = 0; s2 < 2; ++s2) {
                    LAS unsigned char* qp = L + O_QO + (32 * tt + r) * P_QO + (32 * k + 16 * s2 + 4 * h) * 2;
                    const s16x4 lo = *(LAS s16x4*)qp, hi = *(LAS s16x4*)(qp + 16);
                    const bf16x8 a2 = (bf16x8){lo[0], lo[1], lo[2], lo[3], hi[0], hi[1], hi[2], hi[3]};
                    acc = MFMA32(a2, pack8(S[k], 8 * s2), acc); }
#pragma unroll
            for (int i = 0; i < 16; ++i) OST[(32 * tt + crow(i, h)) * 132 + 32 * vt + r] = acc[i];
        }
#pragma unroll
        for (int k = 0; k < 4; ++k) {
#pragma unroll
            for (int i = 0; i < 16; ++i) S[k][i] *= DEC[32 * k + crow(i, h)];
#pragma unroll
            for (int ks = 0; ks < 4; ++ks) { const bf16x8 a = trfrag(L + O_KST, P_TR, 16 * ks + 8 * h, 4, 32 * k, lane); const bf16x8 bv = trfrag(L + O_V, P_TR, 16 * ks + 8 * h, 4, 32 * vt, lane); S[k] = MFMA32(a, bv, S[k]); }
        }
        __syncthreads();
        if (OUT) {
            const int t = tid >> 3, c8 = tid & 7; float o[16]; float ss = 0.f;
#pragma unroll
            for (int j = 0; j < 4; ++j) { const f32x4 v = *(LAS f32x4*)(OST + t * 132 + c8 * 16 + 4 * j); o[4 * j] = v[0]; o[4 * j + 1] = v[1]; o[4 * j + 2] = v[2]; o[4 * j + 3] = v[3]; ss += (v[0] * v[0] + v[1] * v[1]) + (v[2] * v[2] + v[3] * v[3]); }
            ss += shx(ss, 1, lane); ss += shx(ss, 2, lane); ss += shx(ss, 4, lane);
            const float rs = 1.f / sqrtf(ss * (1.f / 128.f) + LN_EPS);
            const u16* gp = H + (rowc + t) * NIN0 + 3072 + hh * 128 + c8 * 16; u16* op = MIX + (rowc + t) * 1024 + 512 + hh * 128 + c8 * 16;
#pragma unroll
            for (int j = 0; j < 2; ++j) { const v4u gvv = *(const v4u*)(gp + 8 * j); const unsigned gw_[4] = {gvv.x, gvv.y, gvv.z, gvv.w}; unsigned ow[4];
#pragma unroll
                for (int e = 0; e < 4; ++e) { const float g0 = bflo(gw_[e]), g1 = bfhi(gw_[e]); const int c = 8 * j + 2 * e;
                    const float y0 = o[c] * rs * outg[c8 * 16 + c] * (g0 / (1.f + __expf(-g0))), y1 = o[c + 1] * rs * outg[c8 * 16 + c + 1] * (g1 / (1.f + __expf(-g1)));
                    ow[e] = pk2(y0, y1); }
                *(v4u*)(op + 8 * j) = (v4u){ow[0], ow[1], ow[2], ow[3]}; }
        }
    }
    if (!OUT) {
        if (tt == 0) {
#pragma unroll
            for (int k = 0; k < 4; ++k)
#pragma unroll
                for (int i = 0; i < 16; ++i) Send[((((size_t)it * 4 + vt) * 4 + k) * 16 + i) * 64 + lane] = S[k][i]; }
        if (seg == 0) Drun[it * 128 + kd] = __expf(bsum);
    }
}
}

__device__ __forceinline__ void dil_task(LAS unsigned char* Lw, const u16* __restrict__ QKV, int task, u16* OBg0, u16* OBg1, u16* OBg2, float* LSE, int lane) {
    const int r = lane & 31, h = lane >> 5;
    const int bh = task / 768, rem = task - bh * 768, g = rem >> 8, j = rem & 255;
    const int sh = 2 * g, res = j >> (8 - sh), qt = j & ((256 >> sh) - 1);
    const int b = bh >> 4, hd = bh & 15;
    const size_t rowb = (size_t)b * 8192;
    const int qpos = res + ((32 * qt + r) << sh);
    const u16* qp = QKV + (rowb + qpos) * NIN1 + hd * 64;
    bf16x8 qf[4];
#pragma unroll
    for (int ks = 0; ks < 4; ++ks) qf[ks] = *(const bf16x8*)(qp + 16 * ks + 8 * h);
    f32x16 X[5];
#pragma unroll
    for (int kb = 0; kb < 5; ++kb) {
        int ki = 32 * qt - 128 + 32 * kb + r; ki = ki < 0 ? 0 : ki;
        const u16* kp = QKV + (rowb + res + (ki << sh)) * NIN1 + 1024 + hd * 64;
        X[kb] = f32x16{};
#pragma unroll
        for (int ks = 0; ks < 4; ++ks) { const bf16x8 kf = *(const bf16x8*)(kp + 16 * ks + 8 * h); X[kb] = MFMA32(kf, qf[ks], X[kb]); }
    }
    float m = -INFINITY;
#pragma unroll
    for (int kb = 0; kb < 5; ++kb)
#pragma unroll
        for (int i = 0; i < 16; ++i) { const int c = crow(i, h); bool valid = (32 * qt - 128 + 32 * kb + c) >= 0;
            if (kb == 0) valid = valid && (c >= r);
            if (kb == 4) valid = valid && (c <= r);
            X[kb][i] = valid ? X[kb][i] : -INFINITY; m = fmaxf(m, X[kb][i]); }
    m = fmaxf(m, shx(m, 32, lane));
    float l = 0.f;
#pragma unroll
    for (int kb = 0; kb < 5; ++kb)
#pragma unroll
        for (int i = 0; i < 16; ++i) { X[kb][i] = __builtin_amdgcn_exp2f(X[kb][i] - m); l += X[kb][i]; }
    l += shx(l, 32, lane);
    f32x16 y[2]; y[0] = f32x16{}; y[1] = f32x16{};
#pragma unroll
    for (int kb = 0; kb < 5; ++kb) {
#pragma unroll
        for (int n = 0; n < 4; ++n) { const int id = lane + 64 * n, key = id >> 3, c = id & 7; int ki = 32 * qt - 128 + 32 * kb + key; ki = ki < 0 ? 0 : ki;
            const v4u v = *(const v4u*)(QKV + (rowb + res + (ki << sh)) * NIN1 + 2048 + hd * 64 + c * 8); *(LAS v4u*)(Lw + key * 192 + c * 16) = v; }
#pragma unroll
        for (int s2 = 0; s2 < 2; ++s2) { const bf16x8 pb = pack8(X[kb], 8 * s2);
#pragma unroll
            for (int dt = 0; dt < 2; ++dt) { const bf16x8 a = trfrag(Lw, 192, 16 * s2 + 4 * h, 8, 32 * dt, lane); y[dt] = MFMA32(a, pb, y[dt]); } }
    }
    const float inv = 1.f / l;
    u16* ob = (g == 0 ? OBg0 : g == 1 ? OBg1 : OBg2) + (rowb + qpos) * 1024 + hd * 64;
#pragma unroll
    for (int dt = 0; dt < 2; ++dt)
#pragma unroll
        for (int gq = 0; gq < 4; ++gq) { v2u w; w.x = pk2(y[dt][4 * gq] * inv, y[dt][4 * gq + 1] * inv); w.y = pk2(y[dt][4 * gq + 2] * inv, y[dt][4 * gq + 3] * inv); *(v2u*)(ob + 32 * dt + 8 * gq + 4 * h) = w; }
    if (h == 0) LSE[((size_t)g * MTOK + rowb + qpos) * 16 + hd] = (m + __log2f(l)) * 0.6931471805599453f;
}
__device__ __forceinline__ void dil_merge(const u16* OB0, const u16* OB1, const u16* OB2, const float* LSE, u16* MIX, int gw, int NGW, int lane) {
    const int hd = lane >> 2, dq = (lane & 3) * 16;
    for (int m = gw; m < MTOK; m += NGW) {
        const float l0 = LSE[((size_t)m) * 16 + hd], l1 = LSE[((size_t)MTOK + m) * 16 + hd], l2 = LSE[((size_t)2 * MTOK + m) * 16 + hd];
        const float mx = fmaxf(l0, fmaxf(l1, l2)); float w0 = __expf(l0 - mx), w1 = __expf(l1 - mx), w2 = __expf(l2 - mx); const float iz = 1.f / (w0 + w1 + w2); w0 *= iz; w1 *= iz; w2 *= iz;
        const size_t off = (size_t)m * 1024 + hd * 64 + dq;
#pragma unroll
        for (int j = 0; j < 2; ++j) { const v4u a = *(const v4u*)(OB0 + off + 8 * j), bq = *(const v4u*)(OB1 + off + 8 * j), c = *(const v4u*)(OB2 + off + 8 * j);
            const unsigned aw[4] = {a.x, a.y, a.z, a.w}, bw[4] = {bq.x, bq.y, bq.z, bq.w}, cw[4] = {c.x, c.y, c.z, c.w}; unsigned ow[4];
#pragma unroll
            for (int e = 0; e < 4; ++e) ow[e] = pk2(w0 * bflo(aw[e]) + w1 * bflo(bw[e]) + w2 * bflo(cw[e]), w0 * bfhi(aw[e]) + w1 * bfhi(bw[e]) + w2 * bfhi(cw[e]));
            *(v4u*)(MIX + off + 8 * j) = (v4u){ow[0], ow[1], ow[2], ow[3]}; }
    }
}
#ifndef PH_LO
#define PH_LO 0
#endif
#ifndef PH_HI
#define PH_HI 100
#endif
__device__ __forceinline__ int fresh_lane() { int l; asm volatile("v_mbcnt_lo_u32_b32 %0, -1, 0\n\tv_mbcnt_hi_u32_b32 %0, -1, %0" : "=v"(l)); return l; }
__device__ __forceinline__ void grid_bar(unsigned* bar, unsigned target, int wave0) {
    asm volatile("s_waitcnt vmcnt(0) lgkmcnt(0)" ::: "memory");
    __syncthreads();
    if (wave0 == 0) {
        const int ln = fresh_lane();
        if (ln == 0) {
            __builtin_amdgcn_fence(__ATOMIC_RELEASE, "agent");
            asm volatile("s_waitcnt vmcnt(0)" ::: "memory");
            __hip_atomic_fetch_add(bar, 1u, __ATOMIC_RELAXED, __HIP_MEMORY_SCOPE_AGENT);
            while (__hip_atomic_load(bar, __ATOMIC_RELAXED, __HIP_MEMORY_SCOPE_AGENT) < target) __builtin_amdgcn_s_sleep(2);
            __builtin_amdgcn_fence(__ATOMIC_ACQUIRE, "agent");
            asm volatile("s_waitcnt vmcnt(0)" ::: "memory");
        }
    }
    __syncthreads();
}
template <class Epi>
__device__ __forceinline__ void run_gemm(LAS unsigned char* lds, const u16* A, const u16* Bt, int N, int K, const Epi& E, int tid) {
    asm volatile("" : "+v"(tid));
    pg8::Gemm g{A, Bt, MTOK, N, K}; pg8::StaticOrder S; S.init(MTOK, N, (int)gridDim.x, (int)blockIdx.x);
    pg8::gemm_phase<Epi, pg8::StaticOrder, PG8_ALIGN, PG8_SP2>(lds, g, S, E, tid);
}
__global__ void __launch_bounds__(512, 2) fwd_kernel(Args A) {
    extern __shared__ __attribute__((aligned(16))) unsigned char lds_raw[];
    LAS unsigned char* lds = (LAS unsigned char*)lds_raw;
    cg::grid_group grid = cg::this_grid();
    const int wave0 = __builtin_amdgcn_readfirstlane((int)threadIdx.x >> 6);
#define tid0 (wave0 * 64 + fresh_lane())
    const int G = gridDim.x, bx = blockIdx.x;
    const int vcu = (G % 8 == 0) ? (bx % 8) * (G / 8) + bx / 8 : bx;
    const int NGW = G * 8;
#define PHASE_IDS() int tid = tid0; asm volatile("" : "+v"(tid)); const int lane = tid & 63, wave = __builtin_amdgcn_readfirstlane(tid >> 6), gw = bx * 8 + wave; (void)lane; (void)gw;
    unsigned char* ws = A.ws;
    float* rowss = (float*)(ws + WS_ROWSS); const float* lbv = (const float*)(ws + WS_MISC); const float* cs = (const float*)(ws + WS_CS);
    u16* XB = (u16*)(ws + WS_XB); u16* MIX = (u16*)(ws + WS_MIX); u16* HB = (u16*)(ws + WS_HB); u16* AUX = (u16*)(ws + WS_AUX);
    float* HGS = (float*)(ws + WS_HGS); float* HGD = (float*)(ws + WS_HGD); float* LSE = (float*)(ws + WS_LSE); u16* OB1 = (u16*)(ws + WS_OB1);
    float* X = A.out;
    unsigned* barw = (unsigned*)(ws + WS_BAR); unsigned nbar = 0;
#define GSYNC() do { ++nbar; grid_bar(barw, nbar * (unsigned)G, wave0); } while (0)

    { PHASE_IDS(); prologue(A, lds, gw, NGW, wave, lane); }
    grid.sync();

    for (int l = 0; l < 2; ++l) {
        const u16* Ain = (l == 0) ? XB : AUX;
        if (l == 0) {
            { pg8::EpiStore E{HB, NIN0, 0, 1024, 512, cs}; run_gemm(lds, Ain, (const u16*)(ws + WS_WIN0), NIN0, 1024, E, tid0); }
            GSYNC();
#ifndef NO_HGA
            for (int it = vcu; it < 256; it += G) { PHASE_IDS(); hg::item<false>(lds, HB, it, lbv, HGS, HGD, nullptr, nullptr, tid); }
#endif
            __syncthreads();
            for (int i = 0; i < 2048; ++i) {
                int tidA = tid0; asm volatile("" : "+v"(tidA));
                int pair, qb;
                if (G == 256) { if (i >= 8) break; const int s = vcu & 3, k = 7 - i; pair = vcu >> 2; qb = 4 * k + ((k & 1) ? 3 - s : s); }
                else { const int u = vcu + i * G; if (u >= 2048) break; pair = u >> 5; qb = 31 - (u & 31); }
                const int b = pair >> 4, vh = pair & 15, hh = vh >> 2, c = (vh >> 1) & 1, half = vh & 1;
#ifndef NO_ATTN
                attn_body::attn_unit<8>(b, (2 * hh + c) * 64, 512 + (2 * hh + c) * 64, 1024 + hh * 128 + half * 64, vh * 64, qb,
                                        (const attn_body::bf16*)HB, (const attn_body::bf16*)HB, (const attn_body::bf16*)HB, (attn_body::bf16*)AUX, (char*)lds_raw, tidA);
#endif
            }
            GSYNC();
#ifndef NO_HGC
            for (int it = vcu; it < 256; it += G) { PHASE_IDS(); hg::item<true>(lds, HB, it, lbv, HGS, HGD, A.hg_norm_g, MIX, tid); }
#endif
            { PHASE_IDS(); diff_combine(AUX, MIX, A.da_lambda, A.da_subln_g, gw, NGW, lane); }
            GSYNC();
        } else {
            { pg8::EpiStore E{HB, NIN1, 0, 2048, 1024, cs}; run_gemm(lds, Ain, (const u16*)(ws + WS_WIN1), NIN1, 1024, E, tid0); }
            GSYNC();
#ifndef NO_DIL
            { PHASE_IDS(); for (int t = gw; t < 64 * 768; t += NGW) dil_task(lds + wave * 6144, HB, t, AUX, OB1, XB, LSE, lane); }
#endif
            GSYNC();
            { PHASE_IDS(); dil_merge(AUX, OB1, XB, LSE, MIX, gw, NGW, lane); }
            GSYNC();
        }
        { pg8::EpiResid E{l == 0 ? A.x : X, X, ALPHA}; run_gemm(lds, MIX, (const u16*)(ws + (l == 0 ? WS_WOUT0 : WS_WOUT1)), 1024, 1024, E, tid0); }
        GSYNC();
        { PHASE_IDS(); ln_rows(X, XB, A.ln1_g + l * 1024, A.ln1_b + l * 1024, rowss, A.p + (size_t)l * MTOK * PLE, AUX, gw, NGW, lane); }
        GSYNC();
        { pg8::EpiStore E{HB, FFD, 1, 0, 0, cs}; run_gemm(lds, XB, (const u16*)(ws + WS_W1 + l * 8 * MiB), FFD, 1024, E, tid0); }
        { pg8::EpiE E{MIX, rowss}; run_gemm(lds, AUX, (const u16*)(ws + WS_WP + l * (MiB / 2)), 1024, PLE, E, tid0); }
        GSYNC();
        { pg8::EpiResid E{X, X, ALPHA}; run_gemm(lds, HB, (const u16*)(ws + WS_W2 + l * 8 * MiB), 1024, FFD, E, tid0); }
        GSYNC();
        { PHASE_IDS(); ln_rows(X, XB, A.ln2_g + l * 1024, A.ln2_b + l * 1024, nullptr, nullptr, nullptr, gw, NGW, lane); }
        GSYNC();
        { pg8::EpiGate E{X, MIX, rowss, A.ple_norm_g + l * 1024, l == 0 ? AUX : nullptr}; run_gemm(lds, XB, (const u16*)(ws + WS_WG + l * 2 * MiB), 1024, 1024, E, tid0); }
        if (l == 0) GSYNC();
    }
}

extern "C" void kernel_launch(void* const* d_in, const int* in_sizes, int n_in, void* d_out, int out_size, void* d_ws, size_t ws_size, hipStream_t stream) {
    static int grid = 0;
    if (grid == 0) {
        if (n_in != 19 || out_size != MTOK * DMODEL || ws_size < WS_END) { fprintf(stderr, "kernel_launch: unexpected shapes (n_in %d, out %d, ws %zu)\n", n_in, out_size, ws_size); grid = -1; return; }
        int dev = 0, cus = 0, per_cu = 0;
        if (hipGetDevice(&dev) != hipSuccess || hipDeviceGetAttribute(&cus, hipDeviceAttributeMultiprocessorCount, dev) != hipSuccess) { grid = -1; return; }
        if (hipFuncSetAttribute((const void*)fwd_kernel, hipFuncAttributeMaxDynamicSharedMemorySize, LDS_BYTES) != hipSuccess) { fprintf(stderr, "kernel_launch: hipFuncSetAttribute failed\n"); grid = -1; return; }
        if (hipOccupancyMaxActiveBlocksPerMultiprocessor(&per_cu, (const void*)fwd_kernel, 512, LDS_BYTES) != hipSuccess || per_cu < 1) { fprintf(stderr, "kernel_launch: occupancy query says %d\n", per_cu); per_cu = 1; }
        (void)hipGetLastError();
        grid = cus * per_cu;
    }
    if (grid < 0) return;
    if (hipMemsetAsync((char*)d_ws + WS_BAR, 0, 256, stream) != hipSuccess) { fprintf(stderr, "kernel_launch: memset failed\n"); return; }
    Args a{};
    const float** f = (const float**)&a;
    for (int i = 0; i < 19; ++i) f[i] = (const float*)d_in[i];
    a.out = (float*)d_out; a.ws = (unsigned char*)d_ws;
    void* args[] = {&a};
    hipError_t e = hipLaunchCooperativeKernel((const void*)fwd_kernel, dim3(grid), dim3(512), args, LDS_BYTES, stream);
    if (e != hipSuccess) fprintf(stderr, "cooperative launch failed: %s (grid %d)\n", hipGetErrorString(e), grid);
}
```

```cpp
#include <hip/hip_runtime.h>
#include <hip/hip_cooperative_groups.h>
#include <cstdio>
#include <cstdint>
namespace cg = cooperative_groups;
namespace pg8 {
#define PG8_LAS __attribute__((address_space(3)))
typedef unsigned short bf16_t;
typedef short bf16x8 __attribute__((ext_vector_type(8)));
typedef float f32x4 __attribute__((ext_vector_type(4)));
typedef unsigned u32x4 __attribute__((ext_vector_type(4)));
constexpr int BM = 256, BK = 64, HALF = 128, HTB = HALF * BK * 2  , STAGE_BYTES = 8 * HTB, NXCD = 8, WGM = 8;

__host__ __device__ __forceinline__ int lds_byte(int r, int c) { const int st = (r >> 4) * 2 + (c >> 5), rr = r & 15, cc = c & 31, ob = rr * 64 + cc * 2; return st * 1024 + (ob ^ (((ob >> 9) & 1) << 5)); }
__host__ __device__ __forceinline__ void stage_rc(int b, int& R, int& C) { const int st = b / 1024, sb = b % 1024, swz = sb ^ (((sb >> 9) & 1) << 5); R = (st >> 1) * 16 + swz / 64; C = (st & 1) * 32 + (swz % 64) / 2; }
__host__ __device__ __forceinline__ int perm32(int rho) { const int n = rho >> 4, i = rho & 15; return 8 * (i >> 2) + 4 * n + (i & 3); }

struct Unit { int pm, pn; };
struct Gemm { const bf16_t* A; const bf16_t* Bt; int M, N, K; };

struct StaticOrder {
    int nM, nN, nwg, G, c;
    __host__ __device__ void init(int M, int N, int G_, int c_) { nM = M / BM; nN = N / BM; nwg = nM * nN; G = G_; c = c_; }
    __host__ __device__ bool next(int i, Unit& u) const {
        const long L = (long)i * G + c; if (L >= nwg) return false;
        int wgid = (int)L; { const int q = nwg / NXCD, r = nwg % NXCD, xcd = wgid % NXCD, off = wgid / NXCD; wgid = (xcd < r ? xcd * (q + 1) : r * (q + 1) + (xcd - r) * q) + off; }
        const int nig = WGM * nN, gid = wgid / nig, fm = gid * WGM, gsz = (nM - fm) < WGM ? (nM - fm) : WGM;
        u.pm = fm + ((wgid % nig) % gsz); u.pn = (wgid % nig) / gsz; return true;
    }
    __device__ __forceinline__ void a_ready(const Unit&) const {}
    __device__ __forceinline__ void done(const Unit&) const {}
};

__device__ __forceinline__ unsigned cvt_pk_bf16(float lo, float hi) { unsigned r; asm volatile("v_cvt_pk_bf16_f32 %0, %1, %2" : "=v"(r) : "v"(lo), "v"(hi)); return r; }
typedef float f32x2 __attribute__((ext_vector_type(2)));
template <class Epi, class Sched, bool ALIGN_EPI = false, bool SP2 = false>
__device__ __forceinline__ void gemm_phase(PG8_LAS unsigned char* lds, const Gemm g, const Sched& S, const Epi& E, const int tid_in) {
    const int tid = tid_in, wid = __builtin_amdgcn_readfirstlane(tid >> 6), lane = tid & 63, wr = wid >> 2, wc = wid & 3, fr = lane & 15, fq = lane >> 4;
    const int K = g.K, nt = K / BK;
    unsigned voffA[2], voffB[2];
#pragma unroll
    for (int i = 0; i < 2; ++i) { int R, C; stage_rc(tid * 16 + i * 8192, R, C); const int Rb = Epi::PERM ? ((R & ~31) + perm32(R & 31)) : R;
        voffA[i] = (unsigned)(R * K + C) * 2u; voffB[i] = (unsigned)(Rb * K + C) * 2u; }
    const size_t kstep = (size_t)(BK * 2);
    const size_t hstep = (size_t)HALF * K * 2;
    const size_t tstep = 2 * hstep;
    const unsigned ldsw = (unsigned)wid * 1024u;
    const int aoff = lds_byte(wr * 64 + fr, fq * 8), boff = lds_byte(wc * 32 + fr, fq * 8);
#define PG8_SA(b, h) (((b) * 2 + (h)) * HTB)
#define PG8_SB(b, h) ((4 + (b) * 2 + (h)) * HTB)
#define PG8_STAGE(bufoff, gbase, voff) do { _Pragma("unroll") for (int _i = 0; _i < 2; ++_i) \
        __builtin_amdgcn_global_load_lds((const unsigned*)((const char*)(gbase) + (voff)[_i]), (PG8_LAS unsigned*)(lds + (bufoff) + ldsw + _i * 8192), 16, 0, 0); } while (0)
#define PG8_LDA(dst, b, h) do { _Pragma("unroll") for (int m = 0; m < 4; ++m) _Pragma("unroll") for (int k = 0; k < 2; ++k) dst[m][k] = *(const PG8_LAS bf16x8*)(lds + PG8_SA(b, h) + aoff + m * 2048 + k * 1024); } while (0)
#define PG8_LDB(dst, b, h) do { _Pragma("unroll") for (int n = 0; n < 2; ++n) _Pragma("unroll") for (int k = 0; k < 2; ++k) dst[n][k] = *(const PG8_LAS bf16x8*)(lds + PG8_SB(b, h) + boff + n * 2048 + k * 1024); } while (0)
#define PG8_MMA(ai, bj, At, Bt) do { __builtin_amdgcn_s_setprio(1); _Pragma("unroll") for (int m = 0; m < 4; ++m) _Pragma("unroll") for (int n = 0; n < 2; ++n) _Pragma("unroll") for (int k = 0; k < 2; ++k) \
        acc[ai][bj][m][n] = __builtin_amdgcn_mfma_f32_16x16x32_bf16(Bt[n][k], At[m][k], acc[ai][bj][m][n], 0, 0, 0); __builtin_amdgcn_s_setprio(0); } while (0)
#define PG8_WAIT_V(n) asm volatile("s_waitcnt vmcnt(" #n ")" ::: "memory")
#define PG8_WAIT_L(n) asm volatile("s_waitcnt lgkmcnt(" #n ")" ::: "memory")
#define PG8_BAR __builtin_amdgcn_s_barrier()
#define PG8_SCHED __builtin_amdgcn_sched_barrier(0)
    Unit cur, nxt; int ui = 0;
    if (!S.next(0, cur)) return;
    f32x4 acc[2][2][4][2];
#pragma unroll
    for (int a = 0; a < 2; ++a)
#pragma unroll
        for (int b = 0; b < 2; ++b)
#pragma unroll
            for (int m = 0; m < 4; ++m)
#pragma unroll
                for (int n = 0; n < 2; ++n) acc[a][b][m][n] = (f32x4){0.f, 0.f, 0.f, 0.f};
    bf16x8 At[4][2], B0[2][2], B1[2][2];
    const char* cA = (const char*)g.A + (size_t)cur.pm * tstep; const char* cB = (const char*)g.Bt + (size_t)cur.pn * tstep;
    S.a_ready(cur);
    if constexpr (SP2) {
        PG8_STAGE(PG8_SB(0, 0), cB, voffB); PG8_STAGE(PG8_SB(0, 1), cB + hstep, voffB); PG8_STAGE(PG8_SA(0, 0), cA, voffA); PG8_STAGE(PG8_SA(0, 1), cA + hstep, voffA);
        if (wr == 1) PG8_BAR;
        PG8_WAIT_V(2); PG8_BAR;
        PG8_STAGE(PG8_SB(1, 0), cB + kstep, voffB); PG8_STAGE(PG8_SA(1, 0), cA + kstep, voffA); PG8_STAGE(PG8_SB(1, 1), cB + hstep + kstep, voffB);
        PG8_WAIT_V(6); PG8_BAR;
    } else {
        PG8_STAGE(PG8_SB(0, 0), cB, voffB); PG8_STAGE(PG8_SA(0, 0), cA, voffA); PG8_STAGE(PG8_SB(0, 1), cB + hstep, voffB); PG8_STAGE(PG8_SA(0, 1), cA + hstep, voffA);
        if (wr == 1) PG8_BAR;
        PG8_WAIT_V(4); PG8_BAR;
        PG8_STAGE(PG8_SB(1, 0), cB + kstep, voffB); PG8_STAGE(PG8_SA(1, 0), cA + kstep, voffA); PG8_STAGE(PG8_SB(1, 1), cB + hstep + kstep, voffB);
        PG8_WAIT_V(6); PG8_BAR;
    }
    for (;;) {
        const bool has_next = S.next(ui + 1, nxt);
        const char* nA = has_next ? (const char*)g.A + (size_t)nxt.pm * tstep : cA; const char* nB = has_next ? (const char*)g.Bt + (size_t)nxt.pn * tstep : cB;
        for (int t = 0; t < nt; t += 2) {
            const bool last = (t == nt - 2);
            const char* a1 = cA + (size_t)(t + 1) * kstep;
            const char* a2 = last ? nA : cA + (size_t)(t + 2) * kstep; const char* b2 = last ? nB : cB + (size_t)(t + 2) * kstep;
            const char* a3 = a2 + kstep; const char* b3 = b2 + kstep;
            if (last && has_next) S.a_ready(nxt);
            if constexpr (SP2) {
            PG8_LDB(B0, 0, 0); PG8_LDB(B1, 0, 1); PG8_SCHED; PG8_LDA(At, 0, 0); PG8_STAGE(PG8_SA(1, 1), a1 + hstep, voffA);
            PG8_WAIT_V(8); PG8_WAIT_L(0); PG8_BAR; PG8_MMA(0, 0, At, B0); PG8_MMA(0, 1, At, B1); PG8_BAR; PG8_SCHED;
            PG8_LDA(At, 0, 1); PG8_STAGE(PG8_SB(0, 0), b2, voffB); PG8_STAGE(PG8_SB(0, 1), b2 + hstep, voffB); PG8_STAGE(PG8_SA(0, 0), a2, voffA);
            PG8_WAIT_V(8); PG8_WAIT_L(0); PG8_BAR; PG8_MMA(1, 0, At, B0); PG8_MMA(1, 1, At, B1); PG8_BAR; PG8_SCHED;
            PG8_LDB(B0, 1, 0); PG8_LDB(B1, 1, 1); PG8_SCHED; PG8_LDA(At, 1, 0); PG8_STAGE(PG8_SA(0, 1), a2 + hstep, voffA);
            PG8_WAIT_V(8); PG8_WAIT_L(0); PG8_BAR; PG8_MMA(0, 0, At, B0); PG8_MMA(0, 1, At, B1); PG8_BAR; PG8_SCHED;
            PG8_LDA(At, 1, 1); PG8_STAGE(PG8_SB(1, 0), b3, voffB); PG8_STAGE(PG8_SB(1, 1), b3 + hstep, voffB); PG8_STAGE(PG8_SA(1, 0), a3, voffA);
            PG8_WAIT_V(8); PG8_WAIT_L(0); PG8_BAR; PG8_MMA(1, 0, At, B0); PG8_MMA(1, 1, At, B1); PG8_BAR; PG8_SCHED;
            } else {
            PG8_LDB(B0, 0, 0); PG8_SCHED; PG8_LDA(At, 0, 0); PG8_STAGE(PG8_SA(1, 1), a1 + hstep, voffA);
            PG8_WAIT_L(8); PG8_BAR; PG8_WAIT_L(0); PG8_MMA(0, 0, At, B0); PG8_BAR; PG8_SCHED;
            PG8_LDB(B1, 0, 1); PG8_STAGE(PG8_SB(0, 0), b2, voffB);
            PG8_BAR; PG8_WAIT_L(0); PG8_MMA(0, 1, At, B1); PG8_BAR;
            PG8_LDA(At, 0, 1); PG8_STAGE(PG8_SA(0, 0), a2, voffA);
            PG8_BAR; PG8_WAIT_L(0); PG8_MMA(1, 0, At, B0); PG8_BAR; PG8_SCHED;
            PG8_STAGE(PG8_SB(0, 1), b2 + hstep, voffB);
            PG8_WAIT_V(6); PG8_BAR; PG8_MMA(1, 1, At, B1); PG8_BAR;
            PG8_LDB(B0, 1, 0); PG8_SCHED; PG8_LDA(At, 1, 0); PG8_STAGE(PG8_SA(0, 1), a2 + hstep, voffA);
            PG8_WAIT_L(8); PG8_BAR; PG8_WAIT_L(0); PG8_MMA(0, 0, At, B0); PG8_BAR; PG8_SCHED;
            PG8_LDB(B1, 1, 1); PG8_STAGE(PG8_SB(1, 0), b3, voffB);
            PG8_BAR; PG8_WAIT_L(0); PG8_MMA(0, 1, At, B1); PG8_BAR;
            PG8_LDA(At, 1, 1); PG8_STAGE(PG8_SA(1, 0), a3, voffA);
            PG8_BAR; PG8_WAIT_L(0); PG8_MMA(1, 0, At, B0); PG8_BAR; PG8_SCHED;
            PG8_STAGE(PG8_SB(1, 1), b3 + hstep, voffB);
            PG8_WAIT_V(6); PG8_BAR; PG8_MMA(1, 1, At, B1); PG8_BAR;
            }
        }
        if constexpr (ALIGN_EPI) { if (wr == 0) PG8_BAR; }
        if constexpr (!Epi::AFTER_DRAIN) { E(acc, cur, wr, wc, fr, fq); S.done(cur); }
        if (!has_next) break;
#pragma unroll
        for (int a = 0; a < 2; ++a)
#pragma unroll
            for (int b = 0; b < 2; ++b)
#pragma unroll
                for (int m = 0; m < 4; ++m)
#pragma unroll
                    for (int n = 0; n < 2; ++n) acc[a][b][m][n] = (f32x4){0.f, 0.f, 0.f, 0.f};
        cur = nxt; cA = nA; cB = nB; ++ui;
        if constexpr (ALIGN_EPI) { if (wr == 1) PG8_BAR; }
    }
    PG8_WAIT_V(0);
    if constexpr (!ALIGN_EPI) { if (wr == 0) PG8_BAR; }
    PG8_BAR;
    if constexpr (Epi::AFTER_DRAIN) { E.fused(acc, cur, wr, wc, fr, fq, lds, wid, lane); S.done(cur); }
#undef PG8_SA
#undef PG8_SB
#undef PG8_STAGE
#undef PG8_LDA
#undef PG8_LDB
#undef PG8_MMA
#undef PG8_WAIT_V
#undef PG8_WAIT_L
#undef PG8_BAR
#undef PG8_SCHED
}
}
namespace pg8 {
__device__ __forceinline__ float shx(float v, int m, int lane) { return __builtin_bit_cast(float, __builtin_amdgcn_ds_bpermute((lane ^ m) << 2, __builtin_bit_cast(int, v))); }
constexpr float QSCALE = 0.125f * 1.4426950408889634f;
struct EpiStore {
    static constexpr bool PERM = true, AFTER_DRAIN = false;
    bf16_t* O; int ldc; int act; int rope_cols; int scale_cols; const float* cs;
    const float* st; const float* c1; const float* c2;
    __device__ __forceinline__ void operator()(f32x4 (&acc)[2][2][4][2], const Unit& u, int wr, int wc, int fr, int fq) const {
        { int ln_; asm volatile("v_mbcnt_lo_u32_b32 %0, -1, 0\n\tv_mbcnt_hi_u32_b32 %0, -1, %0" : "=v"(ln_)); fr = ln_ & 15; fq = ln_ >> 4; }
        const int row0 = u.pm * BM + wr * 64 + fr; const int colt = u.pn * BM;
        const int col0 = colt + wc * 32 + 8 * fq;
        if (colt < rope_cols && (wc & 1) == 0) {
            const float sgn = fq == 0 ? -1.f : 1.f; const int lane = fq * 16 + fr;
            const int fqc = fq & 1;
#pragma unroll
            for (int ai = 0; ai < 2; ++ai)
#pragma unroll
                for (int m = 0; m < 4; ++m) {
                    const int pos = (row0 + ai * HALF + m * 16) & 8191;
                    const float* cp = cs + pos * 8;
#pragma unroll
                    for (int n = 0; n < 2; ++n) {
                        const f32x4 cv = *(const f32x4*)(cp + 4 * n), sv = *(const f32x4*)(cp + 65536 + 4 * n);
#pragma unroll
                        for (int bj = 0; bj < 2; ++bj)
#pragma unroll
                            for (int e = 0; e < 4; ++e) {
                                const float v = acc[ai][bj][m][n][e]; const float pv = shx(v, 16, lane);
                                const float nv = v * cv[e] + sgn * pv * sv[e];
                                acc[ai][bj][m][n][e] = (fq < 2) ? nv : v;
                            }
                        asm volatile("" ::: "memory");
                    }
                }
            (void)fqc;
        }
        if (st) {
#pragma unroll
            for (int bj = 0; bj < 2; ++bj) {
                const f32x4 c1a = *(const f32x4*)(c1 + col0 + bj * HALF), c1b = *(const f32x4*)(c1 + col0 + bj * HALF + 4), c2a = *(const f32x4*)(c2 + col0 + bj * HALF), c2b = *(const f32x4*)(c2 + col0 + bj * HALF + 4);
#pragma unroll
                for (int ai = 0; ai < 2; ++ai)
#pragma unroll
                    for (int m = 0; m < 4; ++m) { const int row = row0 + ai * HALF + m * 16; const float sm = st[2 * row], sq = st[2 * row + 1];
                        const float mu = sm * (1.f / 1024.f), rstd = 1.0f / sqrtf(sq * (1.f / 1024.f) - mu * mu + 1e-5f);
                        acc[ai][bj][m][0] = (acc[ai][bj][m][0] - mu * c1a) * rstd + c2a; acc[ai][bj][m][1] = (acc[ai][bj][m][1] - mu * c1b) * rstd + c2b; }
                asm volatile("" ::: "memory");
            }
        }
        const float sc = (colt < scale_cols) ? QSCALE : 1.f;
#pragma unroll
        for (int ai = 0; ai < 2; ++ai)
#pragma unroll
            for (int m = 0; m < 4; ++m) { bf16_t* rowp = O + (size_t)(row0 + ai * HALF + m * 16) * ldc + col0;
#pragma unroll
                for (int bj = 0; bj < 2; ++bj) { f32x4 v0 = acc[ai][bj][m][0], v1 = acc[ai][bj][m][1];
                    if (act == 1) {
#pragma unroll
                        for (int e = 0; e < 4; ++e) { float a = fmaxf(v0[e], 0.f), b = fmaxf(v1[e], 0.f); v0[e] = a * a; v1[e] = b * b; } }
                    v0 = v0 * sc; v1 = v1 * sc; u32x4 w; w.x = cvt_pk_bf16(v0[0], v0[1]); w.y = cvt_pk_bf16(v0[2], v0[3]); w.z = cvt_pk_bf16(v1[0], v1[1]); w.w = cvt_pk_bf16(v1[2], v1[3]);
                    *(u32x4*)(rowp + bj * HALF) = w; } }
    }
};
struct EpiResid {
    static constexpr bool PERM = false, AFTER_DRAIN = false;
    const float* xin; float* out; bf16_t* outb; float alpha; const float* st_in; const float* g; const float* b; float* st_out;
    __device__ __forceinline__ void operator()(f32x4 (&acc)[2][2][4][2], const Unit& u, int wr, int wc, int fr, int fq) const {
        typedef unsigned u32x2v __attribute__((ext_vector_type(2)));
        { int ln_; asm volatile("v_mbcnt_lo_u32_b32 %0, -1, 0\n\tv_mbcnt_hi_u32_b32 %0, -1, %0" : "=v"(ln_)); fr = ln_ & 15; fq = ln_ >> 4; }
        const int lane = fq * 16 + fr;
        const int col0 = u.pn * BM + wc * 32 + 4 * fq;
#pragma unroll
        for (int ai = 0; ai < 2; ++ai)
#pragma unroll
            for (int m = 0; m < 4; ++m) { const int row = u.pm * BM + ai * HALF + wr * 64 + m * 16 + fr; const size_t off = (size_t)row * 1024 + col0;
                float mu = 0.f, rstd = 1.f;
                if (st_in) { const float sm = st_in[2 * row], sq = st_in[2 * row + 1]; mu = sm * (1.f / 1024.f); rstd = 1.0f / sqrtf(sq * (1.f / 1024.f) - mu * mu + 1e-5f); }
                float s1 = 0.f, s2 = 0.f;
#pragma unroll
                for (int bj = 0; bj < 2; ++bj)
#pragma unroll
                    for (int n = 0; n < 2; ++n) { const int c = col0 + bj * HALF + n * 16; const size_t o2 = off + bj * HALF + n * 16;
                        f32x4 xv = *(const f32x4*)(xin + o2);
                        if (st_in) { const f32x4 gv = *(const f32x4*)(g + c), bv = *(const f32x4*)(b + c); xv = (xv - mu) * rstd * gv + bv; }
                        const f32x4 y = xv * 1.4142135623730951f + acc[ai][bj][m][n];
                        *(f32x4*)(out + o2) = y; u32x2v w; w.x = cvt_pk_bf16(y[0], y[1]); w.y = cvt_pk_bf16(y[2], y[3]); *(u32x2v*)(outb + o2) = w;
                        s1 += (y[0] + y[1]) + (y[2] + y[3]); s2 += (y[0] * y[0] + y[1] * y[1]) + (y[2] * y[2] + y[3] * y[3]); }
                s1 += shx(s1, 16, lane); s1 += shx(s1, 32, lane); s2 += shx(s2, 16, lane); s2 += shx(s2, 32, lane);
                if (fq == 0) { atomicAdd(st_out + 2 * row, s1); atomicAdd(st_out + 2 * row + 1, s2); }
                asm volatile("" ::: "memory"); }
    }
};
struct EpiE {
    static constexpr bool PERM = true, AFTER_DRAIN = false;
    bf16_t* O; float* rowss;
    __device__ __forceinline__ void operator()(f32x4 (&acc)[2][2][4][2], const Unit& u, int wr, int wc, int fr, int fq) const {
        { int ln_; asm volatile("v_mbcnt_lo_u32_b32 %0, -1, 0\n\tv_mbcnt_hi_u32_b32 %0, -1, %0" : "=v"(ln_)); fr = ln_ & 15; fq = ln_ >> 4; }
        const int row0 = u.pm * BM + wr * 64 + fr; const int col0 = u.pn * BM + wc * 32 + 8 * fq; const int lane = fq * 16 + fr;
#pragma unroll
        for (int ai = 0; ai < 2; ++ai)
#pragma unroll
            for (int m = 0; m < 4; ++m) { const int row = row0 + ai * HALF + m * 16; bf16_t* rowp = O + (size_t)row * 1024 + col0; float ss = 0.f;
#pragma unroll
                for (int bj = 0; bj < 2; ++bj) { const f32x4 v0 = acc[ai][bj][m][0], v1 = acc[ai][bj][m][1];
                    ss += (v0[0] * v0[0] + v0[1] * v0[1]) + (v0[2] * v0[2] + v0[3] * v0[3]) + (v1[0] * v1[0] + v1[1] * v1[1]) + (v1[2] * v1[2] + v1[3] * v1[3]);
                    u32x4 w; w.x = cvt_pk_bf16(v0[0], v0[1]); w.y = cvt_pk_bf16(v0[2], v0[3]); w.z = cvt_pk_bf16(v1[0], v1[1]); w.w = cvt_pk_bf16(v1[2], v1[3]);
                    *(u32x4*)(rowp + bj * HALF) = w; }
                ss += shx(ss, 16, lane); ss += shx(ss, 32, lane);
                if (fq == 0) atomicAdd(rowss + row, ss); }
    }
};
struct EpiGate {
    static constexpr bool PERM = false, AFTER_DRAIN = false;
    float* x; const float* st; const float* g2; const float* b2; const float* c1; const float* c2; const bf16_t* E; const float* rowss; const float* gp; bf16_t* xb;
    __device__ __forceinline__ void operator()(f32x4 (&acc)[2][2][4][2], const Unit& u, int wr, int wc, int fr, int fq) const {
        typedef unsigned u32x2v __attribute__((ext_vector_type(2)));
        { int ln_; asm volatile("v_mbcnt_lo_u32_b32 %0, -1, 0\n\tv_mbcnt_hi_u32_b32 %0, -1, %0" : "=v"(ln_)); fr = ln_ & 15; fq = ln_ >> 4; }
        const int col0 = u.pn * BM + wc * 32 + 4 * fq;
#pragma unroll
        for (int ai = 0; ai < 2; ++ai)
#pragma unroll
            for (int m = 0; m < 4; ++m) { const int row = u.pm * BM + ai * HALF + wr * 64 + m * 16 + fr; const size_t off = (size_t)row * 1024 + col0;
                const float rs = 1.0f / sqrtf(rowss[row] * (1.0f / 1024.0f) + 1e-5f);
                const float sm = st[2 * row], sq = st[2 * row + 1]; const float mu = sm * (1.f / 1024.f), rstd = 1.0f / sqrtf(sq * (1.f / 1024.f) - mu * mu + 1e-5f);
#pragma unroll
                for (int bj = 0; bj < 2; ++bj)
#pragma unroll
                    for (int n = 0; n < 2; ++n) { const size_t o2 = off + bj * HALF + n * 16; const int c = col0 + bj * HALF + n * 16;
                        const f32x4 yv = *(const f32x4*)(x + o2); const f32x4 gv = *(const f32x4*)(gp + c); const u32x2v ev = *(const u32x2v*)(E + o2);
                        const f32x4 g2v = *(const f32x4*)(g2 + c), b2v = *(const f32x4*)(b2 + c), c1v = *(const f32x4*)(c1 + c), c2v = *(const f32x4*)(c2 + c);
                        const f32x4 xv = (yv - mu) * rstd * g2v + b2v;
                        const f32x4 a = (acc[ai][bj][m][n] - mu * c1v) * rstd + c2v; f32x4 o;
                        const float e0 = __uint_as_float(ev.x << 16), e1 = __uint_as_float(ev.x & 0xffff0000u), e2 = __uint_as_float(ev.y << 16), e3 = __uint_as_float(ev.y & 0xffff0000u);
                        o[0] = xv[0] + e0 * rs * gv[0] / (1.f + __expf(-a[0])); o[1] = xv[1] + e1 * rs * gv[1] / (1.f + __expf(-a[1]));
                        o[2] = xv[2] + e2 * rs * gv[2] / (1.f + __expf(-a[2])); o[3] = xv[3] + e3 * rs * gv[3] / (1.f + __expf(-a[3]));
                        *(f32x4*)(x + o2) = o;
                        if (xb) { u32x2v w; w.x = cvt_pk_bf16(o[0], o[1]); w.y = cvt_pk_bf16(o[2], o[3]); *(u32x2v*)(xb + o2) = w; } }
                asm volatile("" ::: "memory"); }
    }
};
}
#define PG8_SP2 true
#define PG8_ALIGN true
#include <hip/hip_bf16.h>
#include <cmath>
namespace attn_body {
using bf16=__hip_bfloat16;
using bf16x8=__attribute__((ext_vector_type(8)))short;
using s16x4=__attribute__((ext_vector_type(4)))short;
using f32x16=__attribute__((ext_vector_type(16)))float;
using u32x4=__attribute__((ext_vector_type(4)))unsigned;
constexpr int SEQ=8192,D=64,DM=3584,DMO=1024;
constexpr int NW=8,QBLK=32,QB=QBLK*NW,KVBLK=64,NQB=SEQ/QB;
constexpr int ATTN_PITCH=DM, ATTN_UNIT_ROWS=QB;
__device__ __forceinline__ int crow(int r,int hi){return (r&3)+8*(r>>2)+4*hi;}
#define SBAR() __builtin_amdgcn_sched_barrier(0)
__device__ __forceinline__ void cmask(f32x16&p0,f32x16&p1,int jb,int qrel,int hi){
  const float NEG=-INFINITY; int kb=64*jb+4*hi;
  #pragma unroll
  for(int r=0;r<16;++r){int kv=kb+(r&3)+8*(r>>2); if(kv>qrel)p0[r]=NEG; if(kv+32>qrel)p1[r]=NEG;}
}

constexpr int NSLOT=3, SLOTB=8192;
constexpr int LDS_K=0, LDS_V=NSLOT*SLOTB, LDS_WS=2*NSLOT*SLOTB, LDS_OST=LDS_WS+NW*64*4, LDS_BYTES=LDS_OST+NW*4096;
constexpr float C2=0.125f*1.4426950408889634f;
__device__ __forceinline__ void glds16(const void*gsrc,unsigned lds_dst){unsigned keep;
  asm volatile("s_mov_b32 %0, m0\n\ts_mov_b32 m0, %2\n\ts_nop 0\n\tglobal_load_lds_dwordx4 %1, off\n\ts_mov_b32 m0, %0":"=&s"(keep):"v"(gsrc),"s"(lds_dst):"memory");}
__device__ __forceinline__ float max3f(float a,float b,float c){float r;asm("v_max3_f32 %0, %1, %2, %3":"=v"(r):"v"(a),"v"(b),"v"(c));return r;}
__device__ __forceinline__ float max2f(float a,float b){float r;asm("v_max_f32_e32 %0, %1, %2":"=v"(r):"v"(a),"v"(b));return r;}
__device__ __forceinline__ float fadd_s(float a,float b){float r;asm("v_add_f32_e32 %0, %1, %2":"=v"(r):"v"(a),"v"(b));return r;}
__device__ __forceinline__ float fsub_s(float a,float b){float r;asm("v_sub_f32_e32 %0, %1, %2":"=v"(r):"v"(a),"v"(b));return r;}
typedef float f32x2_t __attribute__((ext_vector_type(2))); typedef __bf16 bf16x2_t __attribute__((ext_vector_type(2)));
__device__ __forceinline__ unsigned cvtpk_s(float lo,float hi){f32x2_t v={lo,hi};bf16x2_t b=__builtin_convertvector(v,bf16x2_t);return __builtin_bit_cast(unsigned,b);}
#define WAIT_BAR(N) asm volatile("s_waitcnt vmcnt(" #N ") lgkmcnt(0)\n\ts_barrier":::"memory")

__device__ __forceinline__ void qkt(f32x16&p0,f32x16&p1,const char*Kslot,const bf16x8*qr,const f32x16&negm,int r32,int hi){
  const char*kb=Kslot+hi*1024+r32*16;
  #pragma unroll
  for(int d0=0;d0<4;++d0){
    const bf16x8 b0=*reinterpret_cast<const bf16x8*>(kb+d0*2048);
    const bf16x8 b1=*reinterpret_cast<const bf16x8*>(kb+d0*2048+512);
    if(d0==0){p0=__builtin_amdgcn_mfma_f32_32x32x16_bf16(b0,qr[0],negm,0,0,0);p1=__builtin_amdgcn_mfma_f32_32x32x16_bf16(b1,qr[0],negm,0,0,0);}
    else{p0=__builtin_amdgcn_mfma_f32_32x32x16_bf16(b0,qr[d0],p0,0,0,0);p1=__builtin_amdgcn_mfma_f32_32x32x16_bf16(b1,qr[d0],p1,0,0,0);}}
}
typedef __attribute__((address_space(3))) const char* lds_cptr;
typedef short v4i16_t __attribute__((ext_vector_type(4)));
__device__ __forceinline__ void kload8(bf16x8*kf,lds_cptr kp){
  kf[0]=*(const __attribute__((address_space(3))) bf16x8*)(kp);      kf[1]=*(const __attribute__((address_space(3))) bf16x8*)(kp+512);
  kf[2]=*(const __attribute__((address_space(3))) bf16x8*)(kp+2048); kf[3]=*(const __attribute__((address_space(3))) bf16x8*)(kp+2560);
  kf[4]=*(const __attribute__((address_space(3))) bf16x8*)(kp+4096); kf[5]=*(const __attribute__((address_space(3))) bf16x8*)(kp+4608);
  kf[6]=*(const __attribute__((address_space(3))) bf16x8*)(kp+6144); kf[7]=*(const __attribute__((address_space(3))) bf16x8*)(kp+6656);
}
__device__ __forceinline__ void kload2(bf16x8*kf,lds_cptr kp,int j){ kf[2*j]=*(const __attribute__((address_space(3))) bf16x8*)(kp+j*2048); kf[2*j+1]=*(const __attribute__((address_space(3))) bf16x8*)(kp+j*2048+512); }
__device__ __forceinline__ s16x4 vtr(lds_cptr p){ return __builtin_bit_cast(s16x4,__builtin_amdgcn_ds_read_tr16_b64_v4i16((__attribute__((address_space(3))) v4i16_t*)p)); }
__device__ __forceinline__ float rowmax(const f32x16&p0,const f32x16&p1){
  float a=max3f(p0[0],p0[1],p1[0]),b=max3f(p0[2],p0[3],p1[1]);a=max3f(a,p1[2],p1[3]);
  #pragma unroll
  for(int r=4;r<16;r+=4){a=max3f(a,p0[r],p0[r+1]);b=max3f(b,p0[r+2],p0[r+3]);a=max3f(a,p1[r],p1[r+1]);b=max3f(b,p1[r+2],p1[r+3]);}
  const float m=max2f(a,b);
  auto rr=__builtin_amdgcn_permlane32_swap(__float_as_uint(m),__float_as_uint(m),false,false);
  return max2f(__uint_as_float(rr[0]),__uint_as_float(rr[1]));
}
__device__ __forceinline__ void pv(f32x16*o,int vb,bf16x8 pa0,bf16x8 pa1,bf16x8 pa2,bf16x8 pa3){
  #pragma unroll
  for(int d0=0;d0<2;++d0){s16x4 lo[4],hi[4];
    #pragma unroll
    for(int ks=0;ks<4;++ks){
      asm volatile("ds_read_b64_tr_b16 %0,%1 offset:%c2":"=&v"(lo[ks]):"v"(vb),"i"(d0*4096+ks*1024):"memory");
      asm volatile("ds_read_b64_tr_b16 %0,%1 offset:%c2":"=&v"(hi[ks]):"v"(vb),"i"(d0*4096+ks*1024+512):"memory");}
    asm volatile("s_waitcnt lgkmcnt(0)":::"memory");SBAR();
    #define PK(k) (bf16x8){lo[k][0],lo[k][1],lo[k][2],lo[k][3],hi[k][0],hi[k][1],hi[k][2],hi[k][3]}
    o[d0]=__builtin_amdgcn_mfma_f32_32x32x16_bf16(pa0,PK(0),o[d0],0,0,0);
    o[d0]=__builtin_amdgcn_mfma_f32_32x32x16_bf16(pa1,PK(1),o[d0],0,0,0);
    o[d0]=__builtin_amdgcn_mfma_f32_32x32x16_bf16(pa2,PK(2),o[d0],0,0,0);
    o[d0]=__builtin_amdgcn_mfma_f32_32x32x16_bf16(pa3,PK(3),o[d0],0,0,0);
    #undef PK
  }
}

#ifndef ATTN_STORE16
#define ATTN_STORE16(p,v) (*(u32x4*)(p)=(v))
#endif
template<int THRL> __device__ __forceinline__ void attn_unit(int b,int colq,int colk,int colv,int colo,int qb,const bf16*Q,const bf16*__restrict__ K,const bf16*__restrict__ V,bf16*O,char*shm,const int tid_in){
  const int tid=tid_in,lane=tid&63,r32=lane&31,hi=lane>>5; const int wid=__builtin_amdgcn_readfirstlane(tid>>6);
  const long rowbase=(long)b*SEQ; const int q0=qb*QB;
  const bf16*Qw=Q+(rowbase+q0+wid*QBLK)*DM+colq;
  const bf16*Kh=K+rowbase*DM+colk,*Vh=V+rowbase*DM+colv;
  const unsigned lds0=(unsigned)(uintptr_t)shm;
  float*wsf=(float*)(shm+LDS_WS)+wid*64;
  const bf16*ksrc=Kh+(long)lane*DM+wid*8;
  const bf16*vsrc=Vh+(long)(16*(wid&3)+(lane>>2))*DM+(wid>>2)*32+(lane&3)*8;
  const unsigned kdst=lds0+LDS_K+wid*1024, vdst=lds0+LDS_V+wid*1024;
  #define DMA_K(t,slot) glds16(ksrc+(long)(t)*KVBLK*DM,(unsigned)__builtin_amdgcn_readfirstlane(kdst+(slot)))
  #define DMA_V(t,slot) glds16(vsrc+(long)(t)*KVBLK*DM,(unsigned)__builtin_amdgcn_readfirstlane(vdst+(slot)))
  const int vb0=(int)(lds0+LDS_V)+((lane>>4)&1)*32+(lane&3)*8+(4*hi+((lane&15)>>2))*64;
  const char*Kbase=shm+LDS_K; bf16x8 kf[8];
  const lds_cptr shm3=(lds_cptr)shm; const lds_cptr kp0=shm3+LDS_K+hi*1024+r32*16; const lds_cptr vp0=shm3+LDS_V+((lane>>4)&1)*32+(lane&3)*8+(4*hi+((lane&15)>>2))*64;
  const int NT=(q0+QB)/KVBLK;
  DMA_K(0,0);DMA_V(0,0);DMA_K(1,SLOTB);
  bf16x8 qr[4];
  #pragma unroll
  for(int d0=0;d0<4;++d0)qr[d0]=*reinterpret_cast<const bf16x8*>(&Qw[(long)r32*DM+d0*16+hi*8]);
  float mhat=0.f,l_reg=0.f;f32x16 o[2];o[0]=f32x16{};o[1]=f32x16{};f32x16 negm=f32x16{};asm volatile("":"+v"(negm));
  const int qrel=wid*QBLK+r32;
  #define CMASK(P0,P1,t) do{int jb_=(t)-(NT-4); if(jb_>=0)cmask(P0,P1,jb_,qrel,hi);}while(0)
  bool resc=false;
  #define START(P0,P1) do{ const float rm=rowmax(P0,P1); resc=false; \
    { const float dl=rm; mhat=fadd_s(mhat,dl); \
      _Pragma("unroll") for(int r=0;r<16;++r){P0[r]=fsub_s(P0[r],dl);P1[r]=fsub_s(P1[r],dl);} \
      _Pragma("unroll") for(int r=0;r<16;++r)negm[r]=-mhat; asm volatile("":"+v"(negm)); } \
    _Pragma("unroll") for(int r=0;r<16;++r)P0[r]=__builtin_amdgcn_exp2f(P0[r]); }while(0)
  #define RESC() do{ if(resc){ asm volatile("s_waitcnt lgkmcnt(0)":::"memory"); \
      _Pragma("unroll") for(int d_=0;d_<2;++d_) _Pragma("unroll") for(int r=0;r<16;++r)o[d_][r]*=wsf[crow(r,hi)]; } }while(0)
  f32x16 pA0,pA1,pB0,pB1;
  int sl_prev=0,sl_cur=0,sl_next=SLOTB;
  #define ROT() do{sl_prev=sl_cur;sl_cur=sl_next;sl_next=(sl_next==(NSLOT-1)*SLOTB)?0:sl_next+SLOTB;}while(0)
  DMA_K(2,2*SLOTB);
  WAIT_BAR(3);
  qkt(pA0,pA1,Kbase,qr,negm,r32,hi);asm volatile("s_nop 15\n\ts_nop 7":"+v"(pA0),"+v"(pA1));CMASK(pA0,pA1,0);
  START(pA0,pA1);
  _Pragma("unroll") for(int r=0;r<16;++r)pA1[r]=__builtin_amdgcn_exp2f(pA1[r]);
  WAIT_BAR(0);
  DMA_K(3,0);DMA_V(1,SLOTB);
  ROT();
  kload8(kf,kp0+sl_cur);
  WAIT_BAR(2);
  s16x4 vlo[8],vhi[8]; u32x4 pw0,pw1,pw2,pw3;
  #define PKW(P,B) cvtpk_s(P[B],P[B+1])
  #define PAF(k) __builtin_bit_cast(bf16x8,pw##k)
  #define VFR(i) (bf16x8){vlo[i][0],vlo[i][1],vlo[i][2],vlo[i][3],vhi[i][0],vhi[i][1],vhi[i][2],vhi[i][3]}
  #define PIN(x) asm volatile("":"+v"(x))
  #define MX3(a,b,c) __builtin_fmaxf(__builtin_fmaxf((a),(b)),(c))
  #define GAPA(MF,A0,A1,A2,A3,W0,W1,PW) do{ MF; sacc+=A0; sacc+=A1; sacc+=A2; sacc+=A3; PIN(sacc); W0; W1; PIN(PW); SBAR(); }while(0)
  #define EX(v) __builtin_amdgcn_exp2f(v)
  #define GAPB(MF,X,B) do{ MF; X[B]=EX(X[B]); X[B+1]=EX(X[B+1]); X[B+2]=EX(X[B+2]); X[B+3]=EX(X[B+3]); PIN(X); SBAR(); }while(0)
  #define VRD(i) do{ vlo[i]=vtr(vp_+(((i)>>2)*4096+((i)&3)*1024)); vhi[i]=vtr(vp_+(((i)>>2)*4096+((i)&3)*1024+512)); }while(0)
  #define KRD(G,j) do{ if(G){ kload2(kf,kp0+sl_next,j); SBAR(); } }while(0)
  #define STEP(C0,C1,P0,P1,t,GK,GV,GL) do{ SBAR(); \
    const lds_cptr vp_=vp0+sl_prev; \
    VRD(0); SBAR(); float sacc=(P0[0]+P0[1]); \
    GAPA(C0=__builtin_amdgcn_mfma_f32_32x32x16_bf16(kf[0],qr[0],negm,0,0,0), P0[2],P0[3],P0[4],P0[5],     pw0[0]=PKW(P0,0), pw0[1]=PKW(P0,2), pw0); \
    VRD(4); SBAR(); GAPA(C1=__builtin_amdgcn_mfma_f32_32x32x16_bf16(kf[1],qr[0],negm,0,0,0), P0[6],P0[7],P0[8],P0[9],     pw0[2]=PKW(P0,4), pw0[3]=PKW(P0,6), pw0); \
    VRD(1); SBAR(); GAPA(C0=__builtin_amdgcn_mfma_f32_32x32x16_bf16(kf[2],qr[1],C0,0,0,0),   P0[10],P0[11],P0[12],P0[13], pw1[0]=PKW(P0,8), pw1[1]=PKW(P0,10), pw1); \
    VRD(5); SBAR(); GAPA(C1=__builtin_amdgcn_mfma_f32_32x32x16_bf16(kf[3],qr[1],C1,0,0,0),   P0[14],P0[15],P1[0],P1[1],   pw1[2]=PKW(P0,12),pw1[3]=PKW(P0,14), pw1); \
    VRD(2); SBAR(); GAPA(C0=__builtin_amdgcn_mfma_f32_32x32x16_bf16(kf[4],qr[2],C0,0,0,0),   P1[2],P1[3],P1[4],P1[5],     pw2[0]=PKW(P1,0), pw2[1]=PKW(P1,2), pw2); \
    VRD(6); SBAR(); GAPA(C1=__builtin_amdgcn_mfma_f32_32x32x16_bf16(kf[5],qr[2],C1,0,0,0),   P1[6],P1[7],P1[8],P1[9],     pw2[2]=PKW(P1,4), pw2[3]=PKW(P1,6), pw2); \
    VRD(3); SBAR(); GAPA(C0=__builtin_amdgcn_mfma_f32_32x32x16_bf16(kf[6],qr[3],C0,0,0,0),   P1[10],P1[11],P1[12],P1[13], pw3[0]=PKW(P1,8), pw3[1]=PKW(P1,10), pw3); \
    VRD(7); SBAR(); GAPA(C1=__builtin_amdgcn_mfma_f32_32x32x16_bf16(kf[7],qr[3],C1,0,0,0),   P1[14],P1[15],0.f,0.f,       pw3[2]=PKW(P1,12),pw3[3]=PKW(P1,14), pw3); \
    l_reg+=sacc; \
    if(GK){DMA_K((t)+3,sl_cur);} if(GV){DMA_V((t)+1,sl_next);} \
    CMASK(C0,C1,t); \
    { float a=MX3(C0[0],C0[1],C1[0]),b=MX3(C0[2],C0[3],C1[1]); a=MX3(a,C1[2],C1[3]); \
      _Pragma("unroll") for(int r=4;r<16;r+=4){a=MX3(a,C0[r],C0[r+1]);b=MX3(b,C0[r+2],C0[r+3]);a=MX3(a,C1[r],C1[r+1]);b=MX3(b,C1[r+2],C1[r+3]);} \
      float rm=__builtin_fmaxf(a,b); { auto rr=__builtin_amdgcn_permlane32_swap(__float_as_uint(rm),__float_as_uint(rm),false,false); rm=__builtin_fmaxf(__uint_as_float(rr[0]),__uint_as_float(rr[1])); } \
      resc=false; \
      if(__builtin_expect(__any(rm>(float)THRL),0)){ const float dl=__builtin_fmaxf(rm,0.f); mhat+=dl; \
        _Pragma("unroll") for(int r=0;r<16;++r){C0[r]-=dl;C1[r]-=dl;} \
        _Pragma("unroll") for(int r=0;r<16;++r)negm[r]=-mhat; asm volatile("":"+v"(negm)); \
        const float f=__builtin_amdgcn_exp2f(-dl); l_reg*=f; if(hi==0)wsf[r32]=f; resc=true; } } \
    SBAR(); \
    GAPB(o[0]=__builtin_amdgcn_mfma_f32_32x32x16_bf16(PAF(0),VFR(0),o[0],0,0,0), C0,0); \
    GAPB(o[1]=__builtin_amdgcn_mfma_f32_32x32x16_bf16(PAF(0),VFR(4),o[1],0,0,0), C0,4); \
    KRD(GL,0); GAPB(o[0]=__builtin_amdgcn_mfma_f32_32x32x16_bf16(PAF(1),VFR(1),o[0],0,0,0), C0,8); \
    KRD(GL,1); GAPB(o[1]=__builtin_amdgcn_mfma_f32_32x32x16_bf16(PAF(1),VFR(5),o[1],0,0,0), C0,12); \
    KRD(GL,2); GAPB(o[0]=__builtin_amdgcn_mfma_f32_32x32x16_bf16(PAF(2),VFR(2),o[0],0,0,0), C1,0); \
    KRD(GL,3); GAPB(o[1]=__builtin_amdgcn_mfma_f32_32x32x16_bf16(PAF(2),VFR(6),o[1],0,0,0), C1,4); \
    GAPB(o[0]=__builtin_amdgcn_mfma_f32_32x32x16_bf16(PAF(3),VFR(3),o[0],0,0,0), C1,8); \
    GAPB(o[1]=__builtin_amdgcn_mfma_f32_32x32x16_bf16(PAF(3),VFR(7),o[1],0,0,0), C1,12); \
    }while(0)
  int t=1;
  #undef CMASK
  #define CMASK(P0,P1,t) do{}while(0)
  for(;t+5<NT;t+=2){
    STEP(pB0,pB1,pA0,pA1,t,true,true,true);     WAIT_BAR(2); RESC(); ROT();
    STEP(pA0,pA1,pB0,pB1,t+1,true,true,true);   WAIT_BAR(2); RESC(); ROT();
  }
  #undef CMASK
  #define CMASK(P0,P1,t) do{int jb_=(t)-(NT-4); if(jb_>=0)cmask(P0,P1,jb_,qrel,hi);}while(0)
  #define ENDW(tt) do{ if((tt)+3<NT){WAIT_BAR(2);} else if((tt)+2<NT){WAIT_BAR(1);} else {WAIT_BAR(0);} }while(0)
  for(;t+1<NT;t+=2){
    STEP(pB0,pB1,pA0,pA1,t,(t+3<NT),(t+1<NT),(t+1<NT));       ENDW(t);   RESC(); ROT();
    STEP(pA0,pA1,pB0,pB1,t+1,(t+4<NT),(t+2<NT),(t+2<NT));     ENDW(t+1); RESC(); ROT();
  }
  STEP(pB0,pB1,pA0,pA1,NT-1,false,false,false); RESC();
  { float sacc=pB0[0]+pB0[1]; _Pragma("unroll") for(int r=2;r<16;++r)sacc+=pB0[r]; _Pragma("unroll") for(int r=0;r<16;++r)sacc+=pB1[r]; l_reg+=sacc;
    pw0=(u32x4){PKW(pB0,0),PKW(pB0,2),PKW(pB0,4),PKW(pB0,6)};pw1=(u32x4){PKW(pB0,8),PKW(pB0,10),PKW(pB0,12),PKW(pB0,14)};pw2=(u32x4){PKW(pB1,0),PKW(pB1,2),PKW(pB1,4),PKW(pB1,6)};pw3=(u32x4){PKW(pB1,8),PKW(pB1,10),PKW(pB1,12),PKW(pB1,14)};
    SBAR(); pv(o,vb0+sl_cur,PAF(0),PAF(1),PAF(2),PAF(3)); }
  #undef PKW
  #undef PAF
  #undef VFR
  #undef PIN
  #undef MX3
  #undef GAPA
  #undef GAPB
  #undef EX
  #undef VRD
  #undef KRD
  #undef STEP
  #undef ENDW
  {auto rr=__builtin_amdgcn_permlane32_swap(__float_as_uint(l_reg),__float_as_uint(l_reg),false,false);l_reg=__uint_as_float(rr[0])+__uint_as_float(rr[1]);}
  if(hi==0)wsf[32+r32]=l_reg;asm volatile("s_waitcnt lgkmcnt(0)":::"memory");
  float rli[16];
  #pragma unroll
  for(int r=0;r<16;++r)rli[r]=__builtin_amdgcn_rcpf(wsf[32+crow(r,hi)]);
  bf16*Ow=O+(rowbase+q0+wid*QBLK)*DMO+colo;
  { bf16*stg=(bf16*)(shm+LDS_OST)+wid*2048;
    #pragma unroll
    for(int r=0;r<16;++r){const int orow=crow(r,hi);
      #pragma unroll
      for(int d0=0;d0<2;++d0)stg[orow*64+d0*32+r32]=__float2bfloat16(o[d0][r]*rli[r]);}
    asm volatile("s_waitcnt lgkmcnt(0)":::"memory");
    #pragma unroll
    for(int i=0;i<4;++i){const int row=i*8+(lane>>3),ch=lane&7; const u32x4 v=*(const u32x4*)(stg+row*64+ch*8); ATTN_STORE16(Ow+(long)row*DMO+ch*8,v);} }
  asm volatile("s_waitcnt lgkmcnt(0)\n\ts_barrier":::"memory");
  #undef DMA_K
  #undef DMA_V
  #undef CMASK
  #undef START
  #undef RESC
  #undef ROT
}
constexpr int ATTN_LDS_BYTES=LDS_BYTES;
#undef SBAR
#undef WAIT_BAR
}
#define LAS __attribute__((address_space(3)))
typedef unsigned short u16;
typedef unsigned v4u __attribute__((ext_vector_type(4)));
typedef unsigned v2u __attribute__((ext_vector_type(2)));
typedef float f32x4 __attribute__((ext_vector_type(4)));
typedef short bf16x8 __attribute__((ext_vector_type(8)));
typedef short s16x4 __attribute__((ext_vector_type(4)));
typedef float f32x16 __attribute__((ext_vector_type(16)));
typedef float f32x2_t __attribute__((ext_vector_type(2)));
typedef __bf16 bf16x2_t __attribute__((ext_vector_type(2)));

constexpr int MTOK = 32768, SEQL = 8192, DMODEL = 1024, FFD = 4096, NIN0 = 3584, NIN1 = 3072, PLE = 256;
constexpr float LN_EPS = 1e-5f;
constexpr float ALPHA = 1.4142135623730951f;
constexpr size_t MiB = 1u << 20;
constexpr size_t WS_CVEC = 0;
constexpr size_t WS_STATS = 62 * MiB;
constexpr size_t WS_ROWSS = 63 * MiB;
constexpr size_t WS_BAR = 256 * 1024;
constexpr size_t WS_MISC = 512 * 1024;
constexpr size_t WS_CS = 1 * MiB;
constexpr size_t WS_WIN0 = 2 * MiB, WS_WOUT0 = 9 * MiB, WS_WIN1 = 11 * MiB, WS_WOUT1 = 17 * MiB, WS_W1 = 19 * MiB  , WS_W2 = 35 * MiB  , WS_WP = 51 * MiB  , WS_WG = 52 * MiB  ;
constexpr size_t WS_LSE = 56 * MiB;
constexpr size_t WS_XB = 64 * MiB, WS_MIX = 128 * MiB, WS_HB = 192 * MiB, WS_AUX = 448 * MiB, WS_END = 512 * MiB;
constexpr size_t WS_HGS = 416 * MiB, WS_HGD = 432 * MiB;
constexpr size_t WS_OB1 = 384 * MiB;
constexpr int LDS_BYTES = 147456;

__device__ __forceinline__ unsigned f2bf(float f) { unsigned u = __builtin_bit_cast(unsigned, f); return (u + 0x7fffu + ((u >> 16) & 1u)) >> 16; }
__device__ __forceinline__ unsigned pk2(float lo, float hi) { f32x2_t v = {lo, hi}; bf16x2_t b = __builtin_convertvector(v, bf16x2_t); return __builtin_bit_cast(unsigned, b); }
__device__ __forceinline__ float bf2f(unsigned v) { return __uint_as_float(v << 16); }
__device__ __forceinline__ float bflo(unsigned w) { return __uint_as_float(w << 16); }
__device__ __forceinline__ float bfhi(unsigned w) { return __uint_as_float(w & 0xffff0000u); }
__device__ __forceinline__ float shx(float v, int m, int lane) { return __builtin_bit_cast(float, __builtin_amdgcn_ds_bpermute((lane ^ m) << 2, __builtin_bit_cast(int, v))); }
__device__ __forceinline__ float wave_sum(float v, int lane) {
#pragma unroll
    for (int o = 1; o < 64; o <<= 1) v += shx(v, o, lane);
    return v;
}
__device__ __forceinline__ int crow(int reg, int h) { return (reg & 3) + 8 * (reg >> 2) + 4 * h; }
#define MFMA32(a, b, c) __builtin_amdgcn_mfma_f32_32x32x16_bf16((a), (b), (c), 0, 0, 0)
__device__ __forceinline__ bf16x8 pack8(const f32x16& x, int base) {
    v4u p; p.x = pk2(x[base], x[base + 1]); p.y = pk2(x[base + 2], x[base + 3]); p.z = pk2(x[base + 4], x[base + 5]); p.w = pk2(x[base + 6], x[base + 7]);
    return __builtin_bit_cast(bf16x8, p);
}
typedef short v4i16_t __attribute__((ext_vector_type(4)));
__device__ __forceinline__ s16x4 trrd(LAS unsigned char* p) { return __builtin_bit_cast(s16x4, __builtin_amdgcn_ds_read_tr16_b64_v4i16((LAS v4i16_t*)p)); }
__device__ __forceinline__ bf16x8 trfrag(LAS unsigned char* img, int pitch, int row_lo, int hi_delta, int col0, int lane) {
    const int i16 = lane & 15, q = i16 >> 2, p = i16 & 3, g16 = (lane >> 4) & 1;
    LAS unsigned char* a = img + (row_lo + q) * pitch + (col0 + 16 * g16 + 4 * p) * 2;
    const s16x4 lo = trrd(a), hi = trrd(a + hi_delta * pitch);
    return (bf16x8){lo[0], lo[1], lo[2], lo[3], hi[0], hi[1], hi[2], hi[3]};
}

struct Args {
    const float *x, *p, *ev_w_in, *ev_w_out, *da_lambda, *da_subln_g, *hg_lb_logits, *hg_norm_g, *od_w_in, *od_w_out, *ln1_g, *ln1_b, *ffn_w1, *ffn_w2, *ln2_g, *ln2_b, *ple_w_proj, *ple_w_gate, *ple_norm_g;
    float* out; unsigned char* ws;
};

__device__ __forceinline__ void p0_transpose_item(const float* W, int K, int N, u16* WT, LAS float* scr, int item, int lane, const float* gk = nullptr, const float* bk = nullptr, float* c1 = nullptr, float* c2 = nullptr) {
    const int nblk = N / 32, kb = item / nblk, nb = item % nblk, k0 = 64 * kb, n0 = 32 * nb;
#pragma unroll 8
    for (int i = 0; i < 32; ++i) { const int kk = 2 * i + (lane >> 5); scr[kk * 33 + (lane & 31)] = W[(size_t)(k0 + kk) * N + n0 + (lane & 31)]; }
    asm volatile("s_waitcnt lgkmcnt(0)" ::: "memory");
    const int c = lane & 7;
    float gs[8];
#pragma unroll
    for (int e = 0; e < 8; ++e) gs[e] = gk ? gk[k0 + 8 * c + e] : 1.f;
    if (gk) {
        const int n = lane & 31, kh = (lane >> 5) * 32; float s1 = 0.f, s2 = 0.f;
#pragma unroll 8
        for (int kk = 0; kk < 32; ++kk) { const float wv = scr[(kh + kk) * 33 + n]; s1 += gk[k0 + kh + kk] * wv; s2 += bk[k0 + kh + kk] * wv; }
        s1 += shx(s1, 32, lane); s2 += shx(s2, 32, lane);
        if (lane < 32) { atomicAdd(c1 + n0 + n, s1); atomicAdd(c2 + n0 + n, s2); }
    }
#pragma unroll
    for (int j = 0; j < 4; ++j) { const int n = (lane >> 3) + 8 * j; const LAS float* sp = scr + (8 * c) * 33 + n;
        v4u o; o.x = pk2(sp[0 * 33] * gs[0], sp[1 * 33] * gs[1]); o.y = pk2(sp[2 * 33] * gs[2], sp[3 * 33] * gs[3]); o.z = pk2(sp[4 * 33] * gs[4], sp[5 * 33] * gs[5]); o.w = pk2(sp[6 * 33] * gs[6], sp[7 * 33] * gs[7]);
        *(v4u*)(WT + (size_t)(n0 + n) * K + k0 + 8 * c) = o; }
    asm volatile("s_waitcnt lgkmcnt(0)" ::: "memory");
}
__device__ __forceinline__ void prologue(const Args& A, LAS unsigned char* lds, int gw, int NGW, int wave, int lane) {
    unsigned char* ws = A.ws;
    LAS float* scr = (LAS float*)(lds + wave * 16384);
    const int cnt[12] = {(1024 / 64) * (NIN0 / 32), 512, (1024 / 64) * (NIN1 / 32), 512, 2048, 2048, 2048, 2048, 128, 128, 512, 512};
    int total = 0;
#pragma unroll
    for (int i = 0; i < 12; ++i) total += cnt[i];
    for (int it = gw; it < total; it += NGW) {
        int r = it;
        if (r < cnt[0]) { p0_transpose_item(A.ev_w_in, 1024, NIN0, (u16*)(ws + WS_WIN0), scr, r, lane); continue; } r -= cnt[0];
        if (r < cnt[1]) { p0_transpose_item(A.ev_w_out, 1024, 1024, (u16*)(ws + WS_WOUT0), scr, r, lane); continue; } r -= cnt[1];
        if (r < cnt[2]) { p0_transpose_item(A.od_w_in, 1024, NIN1, (u16*)(ws + WS_WIN1), scr, r, lane); continue; } r -= cnt[2];
        if (r < cnt[3]) { p0_transpose_item(A.od_w_out, 1024, 1024, (u16*)(ws + WS_WOUT1), scr, r, lane); continue; } r -= cnt[3];
        if (r < 4096) { const int l = r >> 11; float* cv = (float*)(ws + WS_CVEC) + l * 10240; p0_transpose_item(A.ffn_w1 + (size_t)l * 1024 * 4096, 1024, 4096, (u16*)(ws + WS_W1 + l * 8 * MiB), scr, r & 2047, lane, A.ln1_g + l * 1024, A.ln1_b + l * 1024, cv, cv + 4096); continue; } r -= 4096;
        if (r < 4096) { const int l = r >> 11; p0_transpose_item(A.ffn_w2 + (size_t)l * 1024 * 4096, 4096, 1024, (u16*)(ws + WS_W2 + l * 8 * MiB), scr, r & 2047, lane); continue; } r -= 4096;
        if (r < 256) { const int l = r >> 7; p0_transpose_item(A.ple_w_proj + (size_t)l * 256 * 1024, 256, 1024, (u16*)(ws + WS_WP + l * (MiB / 2)), scr, r & 127, lane); continue; } r -= 256;
        { const int l = r >> 9; float* cv = (float*)(ws + WS_CVEC) + l * 10240 + 8192; p0_transpose_item(A.ple_w_gate + (size_t)l * 1024 * 1024, 1024, 1024, (u16*)(ws + WS_WG + l * 2 * MiB), scr, r & 511, lane, A.ln2_g + l * 1024, A.ln2_b + l * 1024, cv, cv + 1024); }
    }
    u16* XB = (u16*)(ws + WS_XB);
    for (int m = gw; m < MTOK; m += NGW) {
        const f32x4* xr = (const f32x4*)(A.x + (size_t)m * 1024) + lane; v2u* o = (v2u*)(XB + (size_t)m * 1024) + lane;
#pragma unroll
        for (int j = 0; j < 4; ++j) { const f32x4 v = xr[64 * j]; v2u w; w.x = pk2(v[0], v[1]); w.y = pk2(v[2], v[3]); o[64 * j] = w; }
    }
    { v4u* z = (v4u*)(ws + WS_STATS); for (int i = gw * 64 + lane; i < (int)((MiB + 256 * 1024) / 16); i += NGW * 64) z[i] = (v4u){0u, 0u, 0u, 0u}; }
    float* cs = (float*)(ws + WS_CS);
    for (int idx = gw * 64 + lane; idx < 65536; idx += NGW * 64) {
        const int pos = idx >> 3, e = idx & 7;
        double iv = 1.0;
#pragma unroll 1
        for (int k = 0; k < e; ++k) iv *= 0.19392274474868576;
        const float inv = (float)iv;
        const float angf = (float)pos * inv;
        double a = (double)angf; const double twopi = 6.283185307179586476925;
        const double kq = __builtin_rint(a / twopi); a -= kq * twopi;
        const double a2 = a * a; double sn = 0.0, cn = 0.0;
        double ts = a, tc = 1.0;
#pragma unroll 1
        for (int n = 0; n < 16; ++n) { cn += tc; sn += ts; tc *= -a2 / (double)((2 * n + 1) * (2 * n + 2)); ts *= -a2 / (double)((2 * n + 2) * (2 * n + 3)); }
        cs[idx] = (float)cn; cs[65536 + idx] = (float)sn;
    }
    float* misc = (float*)(ws + WS_MISC);
    for (int i = gw * 64 + lane; i < 512; i += NGW * 64) { const float l0 = A.hg_lb_logits[i], l1 = A.hg_lb_logits[512 + i]; misc[i] = 1.f / (1.f + __expf(l1 - l0)); }
}

__device__ __forceinline__ void ln_rows(float* X, u16* XBo, const float* g, const float* bta, float* rowss, const float* prow, u16* PBo, int gw, int NGW, int lane) {
    for (int m = gw; m < MTOK; m += NGW) {
        f32x4* xr = (f32x4*)(X + (size_t)m * 1024) + lane;
        f32x4 v[4]; float s = 0.f;
#pragma unroll
        for (int j = 0; j < 4; ++j) { v[j] = xr[64 * j]; s += (v[j][0] + v[j][1]) + (v[j][2] + v[j][3]); }
        const float mean = wave_sum(s, lane) * (1.f / 1024.f); float s2 = 0.f;
#pragma unroll
        for (int j = 0; j < 4; ++j) { v[j] = v[j] - mean; s2 += (v[j][0] * v[j][0] + v[j][1] * v[j][1]) + (v[j][2] * v[j][2] + v[j][3] * v[j][3]); }
        const float rstd = 1.f / sqrtf(wave_sum(s2, lane) * (1.f / 1024.f) + LN_EPS);
        v2u* o8 = (v2u*)(XBo + (size_t)m * 1024) + lane;
#pragma unroll
        for (int j = 0; j < 4; ++j) { const f32x4 gv = ((const f32x4*)g)[lane + 64 * j], bv = ((const f32x4*)bta)[lane + 64 * j];
            const f32x4 o = v[j] * rstd * gv + bv; xr[64 * j] = o; v2u w; w.x = pk2(o[0], o[1]); w.y = pk2(o[2], o[3]); o8[64 * j] = w; }
        if (rowss && lane == 0) rowss[m] = 0.f;
        if (prow) { const f32x4 pv = ((const f32x4*)(prow + (size_t)m * 256))[lane]; v2u w; w.x = pk2(pv[0], pv[1]); w.y = pk2(pv[2], pv[3]); ((v2u*)(PBo + (size_t)m * 256))[lane] = w; }
    }
}
__device__ __forceinline__ void p_rows(const float* prow, u16* PBo, int gw, int NGW, int lane) {
    for (int m = gw; m < MTOK; m += NGW) { const f32x4 pv = ((const f32x4*)(prow + (size_t)m * 256))[lane]; v2u w; w.x = pk2(pv[0], pv[1]); w.y = pk2(pv[2], pv[3]); ((v2u*)(PBo + (size_t)m * 256))[lane] = w; }
}
__device__ __forceinline__ void diff_combine(const u16* AUX, u16* MIX, const float* lam_p, const float* subg, int gw, int NGW, int lane) {
    const float s01 = wave_sum(lam_p[lane] * lam_p[64 + lane], lane), s23 = wave_sum(lam_p[128 + lane] * lam_p[192 + lane], lane);
    const float lam = __expf(s01) - __expf(s23) + 0.2f;
    const int h = lane >> 4, d0 = (lane & 15) * 8;
    float gv[8];
#pragma unroll
    for (int e = 0; e < 8; ++e) gv[e] = subg[d0 + e] * 0.8f;
    for (int m = gw; m < MTOK; m += NGW) {
        const v4u a0 = *(const v4u*)(AUX + (size_t)m * 1024 + h * 256 + d0), a1 = *(const v4u*)(AUX + (size_t)m * 1024 + h * 256 + 128 + d0);
        float o[8];
        o[0] = bflo(a0.x) - lam * bflo(a1.x); o[1] = bfhi(a0.x) - lam * bfhi(a1.x); o[2] = bflo(a0.y) - lam * bflo(a1.y); o[3] = bfhi(a0.y) - lam * bfhi(a1.y);
        o[4] = bflo(a0.z) - lam * bflo(a1.z); o[5] = bfhi(a0.z) - lam * bfhi(a1.z); o[6] = bflo(a0.w) - lam * bflo(a1.w); o[7] = bfhi(a0.w) - lam * bfhi(a1.w);
        float ss = 0.f;
#pragma unroll
        for (int e = 0; e < 8; ++e) ss += o[e] * o[e];
        ss += shx(ss, 1, lane); ss += shx(ss, 2, lane); ss += shx(ss, 4, lane); ss += shx(ss, 8, lane);
        const float rs = 1.f / sqrtf(ss * (1.f / 128.f) + LN_EPS);
        v4u w; w.x = pk2(o[0] * rs * gv[0], o[1] * rs * gv[1]); w.y = pk2(o[2] * rs * gv[2], o[3] * rs * gv[3]); w.z = pk2(o[4] * rs * gv[4], o[5] * rs * gv[5]); w.w = pk2(o[6] * rs * gv[6], o[7] * rs * gv[7]);
        *(v4u*)(MIX + (size_t)m * 1024 + h * 128 + d0) = w;
    }
}
namespace hg {
constexpr int P_QA = 272, P_QO = 264, P_TR = 320;
constexpr int O_QA = 0, O_KA = O_QA + 64 * P_QA, O_QO = O_KA + 64 * P_QA, O_KST = O_QO + 64 * P_QO, O_V = O_KST + 64 * P_TR, O_OST = O_V + 64 * P_TR, O_TOT = O_OST + 64 * 132 * 4, O_DEC = O_TOT + 2048, O_END = O_DEC + 512;
static_assert(O_END <= 131072, "hgrn lds");
template <bool OUT>
__device__ __forceinline__ void item(LAS unsigned char* L, const u16* __restrict__ H, int it, const float* __restrict__ lbv, float* Send, float* Drun, const float* __restrict__ outg, u16* MIX, const int tid) {
    const int  lane = tid & 63, w = __builtin_amdgcn_readfirstlane(tid >> 6), r = lane & 31, h = lane >> 5;
    const int tt = w & 1, vt = w >> 1;
    const int bh = it >> 4, run = it & 15, b = bh >> 2, hh = bh & 3;
    const int kd = tid & 127, seg = tid >> 7;
    const size_t row0 = (size_t)b * 8192 + (size_t)run * 512;
    const float lb = lbv[hh * 128 + kd];
    LAS float* TOT = (LAS float*)(L + O_TOT); LAS float* DEC = (LAS float*)(L + O_DEC); LAS float* OST = (LAS float*)(L + O_OST);
    f32x16 S[4];
#pragma unroll
    for (int k = 0; k < 4; ++k) S[k] = f32x16{};
    if (OUT) {
        for (int rp = 0; rp < run; ++rp) { const int ip = bh * 16 + rp;
#pragma unroll
            for (int k = 0; k < 4; ++k)
#pragma unroll
                for (int i = 0; i < 16; ++i) S[k][i] = Drun[ip * 128 + 32 * k + crow(i, h)] * S[k][i] + Send[((((size_t)ip * 4 + vt) * 4 + k) * 16 + i) * 64 + lane];
        }
    }
    float bsum = 0.f;
    for (int ch = 0; ch < 8; ++ch) {
        const size_t rowc = row0 + ch * 64;
        float fg[16], cs[16], hq[16];
#pragma unroll
        for (int i = 0; i < 16; ++i) { const u16* p = H + (rowc + seg * 16 + i) * NIN0 + hh * 128 + kd; fg[i] = bf2f(p[2048]); if (OUT) hq[i] = bf2f(p[1536]); }
#pragma unroll
        for (int n = 0; n < 2; ++n) { const int id = tid + 512 * n, t = id >> 4, c = id & 15;
            const v4u v = *(const v4u*)(H + (rowc + t) * NIN0 + 2560 + hh * 128 + c * 8); *(LAS v4u*)(L + O_V + t * P_TR + c * 16) = v; }
        float runs = 0.f;
#pragma unroll
        for (int i = 0; i < 16; ++i) { const float sg = 1.f / (1.f + __expf(-fg[i])); const float f = lb + (1.f - lb) * sg; fg[i] = (1.f - lb) * (1.f - sg); runs += __logf(f); cs[i] = runs; }
        TOT[seg * 128 + kd] = runs;
        __syncthreads();
        const float t0 = TOT[kd], t1 = TOT[128 + kd], t2 = TOT[256 + kd], t3 = TOT[384 + kd];
        const float off = (seg > 0 ? t0 : 0.f) + (seg > 1 ? t1 : 0.f) + (seg > 2 ? t2 : 0.f);
        const float bmid = t0 + t1, blast = (t0 + t1) + (t2 + t3);
        const float elm = __expf(blast - bmid), em = __expf(bmid);
#pragma unroll
        for (int i = 0; i < 16; ++i) {
            const int t = seg * 16 + i; const float bi = off + cs[i];
            const float e1 = __expf(bi - bmid), e2 = __expf(bmid - bi); const float kk = fg[i];
            *(LAS u16*)(L + O_KST + t * P_TR + kd * 2) = (u16)f2bf(kk * e2 * elm);
            if (OUT) { const float q = hq[i] / (1.f + __expf(-hq[i]));
                *(LAS u16*)(L + O_QA + t * P_QA + kd * 2) = (u16)f2bf(q * e1);
                *(LAS u16*)(L + O_KA + t * P_QA + kd * 2) = (u16)f2bf(kk * e2);
                *(LAS u16*)(L + O_QO + t * P_QO + kd * 2) = (u16)f2bf(q * e1 * em); }
        }
        if (seg == 0) { DEC[kd] = __expf(blast); bsum += blast; }
        __syncthreads();
        if (OUT) {
            f32x16 acc = f32x16{};
            for (int st = 0; st <= tt; ++st) {
                f32x16 X = f32x16{};
#pragma unroll
                for (int ks = 0; ks < 8; ++ks) { const bf16x8 a = *(LAS bf16x8*)(L + O_KA + (32 * st + r) * P_QA + (16 * ks + 8 * h) * 2); const bf16x8 bq = *(LAS bf16x8*)(L + O_QA + (32 * tt + r) * P_QA + (16 * ks + 8 * h) * 2); X = MFMA32(a, bq, X); }
                if (st == tt) {
#pragma unroll
                    for (int i = 0; i < 16; ++i) if (crow(i, h) > r) X[i] = 0.f; }
#pragma unroll
                for (int s2 = 0; s2 < 2; ++s2) { const bf16x8 pa = pack8(X, 8 * s2); const bf16x8 vf = trfrag(L + O_V, P_TR, 32 * st + 16 * s2 + 4 * h, 8, 32 * vt, lane); acc = MFMA32(pa, vf, acc); }
            }
#pragma unroll
            for (int k = 0; k < 4; ++k)
#pragma unroll
                for (int s2 = 0; s2 < 2; ++s2) {
                    LAS unsigned char* qp = L + O_QO + (32 * tt + r) * P_QO + (32 * k + 16 * s2 + 4 * h) * 2;
                    const s16x4 lo = *(LAS s16x4*)qp, hi = *(LAS s16x4*)(qp + 16);
                    const bf16x8 a2 = (bf16x8){lo[0], lo[1], lo[2], lo[3], hi[0], hi[1], hi[2], hi[3]};
                    acc = MFMA32(a2, pack8(S[k], 8 * s2), acc); }
#pragma unroll
            for (int i = 0; i < 16; ++i) OST[(32 * tt + crow(i, h)) * 132 + 32 * vt + r] = acc[i];
        }
#pragma unroll
        for (int k = 0; k < 4; ++k) {
#pragma unroll
            for (int i = 0; i < 16; ++i) S[k][i] *= DEC[32 * k + crow(i, h)];
#pragma unroll
            for (int ks = 0; ks < 4; ++ks) { const bf16x8 a = trfrag(L + O_KST, P_TR, 16 * ks + 8 * h, 4, 32 * k, lane); const bf16x8 bv = trfrag(L + O_V, P_TR, 16 * ks + 8 * h, 4, 32 * vt, lane); S[k] = MFMA32(a, bv, S[k]); }
        }
        __syncthreads();
        if (OUT) {
            const int t = tid >> 3, c8 = tid & 7; float o[16]; float ss = 0.f;
#pragma unroll
            for (int j = 0; j < 4; ++j) { const f32x4 v = *(LAS f32x4*)(OST + t * 132 + c8 * 16 + 4 * j); o[4 * j] = v[0]; o[4 * j + 1] = v[1]; o[4 * j + 2] = v[2]; o[4 * j + 3] = v[3]; ss += (v[0] * v[0] + v[1] * v[1]) + (v[2] * v[2] + v[3] * v[3]); }
            ss += shx(ss, 1, lane); ss += shx(ss, 2, lane); ss += shx(ss, 4, lane);
            const float rs = 1.f / sqrtf(ss * (1.f / 128.f) + LN_EPS);
            const u16* gp = H + (rowc + t) * NIN0 + 3072 + hh * 128 + c8 * 16; u16* op = MIX + (rowc + t) * 1024 + 512 + hh * 128 + c8 * 16;
#pragma unroll
            for (int j = 0; j < 2; ++j) { const v4u gvv = *(const v4u*)(gp + 8 * j); const unsigned gw_[4] = {gvv.x, gvv.y, gvv.z, gvv.w}; unsigned ow[4];
#pragma unroll
                for (int e = 0; e < 4; ++e) { const float g0 = bflo(gw_[e]), g1 = bfhi(gw_[e]); const int c = 8 * j + 2 * e;
                    const float y0 = o[c] * rs * outg[c8 * 16 + c] * (g0 / (1.f + __expf(-g0))), y1 = o[c + 1] * rs * outg[c8 * 16 + c + 1] * (g1 / (1.f + __expf(-g1)));
                    ow[e] = pk2(y0, y1); }
                *(v4u*)(op + 8 * j) = (v4u){ow[0], ow[1], ow[2], ow[3]}; }
        }
    }
    if (!OUT) {
        if (tt == 0) {
#pragma unroll
            for (int k = 0; k < 4; ++k)
#pragma unroll
                for (int i = 0; i < 16; ++i) Send[((((size_t)it * 4 + vt) * 4 + k) * 16 + i) * 64 + lane] = S[k][i]; }
        if (seg == 0) Drun[it * 128 + kd] = __expf(bsum);
    }
}
}

__device__ __forceinline__ void dil_task(LAS unsigned char* Lw, const u16* __restrict__ QKV, int task, u16* OBg0, u16* OBg1, u16* OBg2, float* LSE, int lane) {
    const int r = lane & 31, h = lane >> 5;
    const int bh = task / 768, rem = task - bh * 768, g = rem >> 8, j = rem & 255;
    const int sh = 2 * g, res = j >> (8 - sh), qt = j & ((256 >> sh) - 1);
    const int b = bh >> 4, hd = bh & 15;
    const size_t rowb = (size_t)b * 8192;
    const int qpos = res + ((32 * qt + r) << sh);
    const u16* qp = QKV + (rowb + qpos) * NIN1 + hd * 64;
    bf16x8 qf[4];
#pragma unroll
    for (int ks = 0; ks < 4; ++ks) qf[ks] = *(const bf16x8*)(qp + 16 * ks + 8 * h);
    f32x16 X[5];
#pragma unroll
    for (int kb = 0; kb < 5; ++kb) {
        int ki = 32 * qt - 128 + 32 * kb + r; ki = ki < 0 ? 0 : ki;
        const u16* kp = QKV + (rowb + res + (ki << sh)) * NIN1 + 1024 + hd * 64;
        X[kb] = f32x16{};
#pragma unroll
        for (int ks = 0; ks < 4; ++ks) { const bf16x8 kf = *(const bf16x8*)(kp + 16 * ks + 8 * h); X[kb] = MFMA32(kf, qf[ks], X[kb]); }
    }
    float m = -INFINITY;
#pragma unroll
    for (int kb = 0; kb < 5; ++kb)
#pragma unroll
        for (int i = 0; i < 16; ++i) { const int c = crow(i, h); bool valid = (32 * qt - 128 + 32 * kb + c) >= 0;
            if (kb == 0) valid = valid && (c >= r);
            if (kb == 4) valid = valid && (c <= r);
            X[kb][i] = valid ? X[kb][i] : -INFINITY; m = fmaxf(m, X[kb][i]); }
    m = fmaxf(m, shx(m, 32, lane));
    float l = 0.f;
#pragma unroll
    for (int kb = 0; kb < 5; ++kb)
#pragma unroll
        for (int i = 0; i < 16; ++i) { X[kb][i] = __builtin_amdgcn_exp2f(X[kb][i] - m); l += X[kb][i]; }
    l += shx(l, 32, lane);
    f32x16 y[2]; y[0] = f32x16{}; y[1] = f32x16{};
#pragma unroll
    for (int kb = 0; kb < 5; ++kb) {
#pragma unroll
        for (int n = 0; n < 4; ++n) { const int id = lane + 64 * n, key = id >> 3, c = id & 7; int ki = 32 * qt - 128 + 32 * kb + key; ki = ki < 0 ? 0 : ki;
            const v4u v = *(const v4u*)(QKV + (rowb + res + (ki << sh)) * NIN1 + 2048 + hd * 64 + c * 8); *(LAS v4u*)(Lw + key * 192 + c * 16) = v; }
#pragma unroll
        for (int s2 = 0; s2 < 2; ++s2) { const bf16x8 pb = pack8(X[kb], 8 * s2);
#pragma unroll
            for (int dt = 0; dt < 2; ++dt) { const bf16x8 a = trfrag(Lw, 192, 16 * s2 + 4 * h, 8, 32 * dt, lane); y[dt] = MFMA32(a, pb, y[dt]); } }
    }
    const float inv = 1.f / l;
    u16* ob = (g == 0 ? OBg0 : g == 1 ? OBg1 : OBg2) + (rowb + qpos) * 1024 + hd * 64;
#pragma unroll
    for (int dt = 0; dt < 2; ++dt)
#pragma unroll
        for (int gq = 0; gq < 4; ++gq) { v2u w; w.x = pk2(y[dt][4 * gq] * inv, y[dt][4 * gq + 1] * inv); w.y = pk2(y[dt][4 * gq + 2] * inv, y[dt][4 * gq + 3] * inv); *(v2u*)(ob + 32 * dt + 8 * gq + 4 * h) = w; }
    if (h == 0) LSE[((size_t)g * MTOK + rowb + qpos) * 16 + hd] = (m + __log2f(l)) * 0.6931471805599453f;
}
namespace dl {
constexpr int KP = 144, VP = 192, O_K = 0, O_V = 384 * KP, O_END = O_V + 384 * VP;
static_assert(O_END <= 131072, "dilated lds");
struct Dec { int g, sh, res, i0, hd; size_t rowb; };
__device__ __forceinline__ Dec decode(int task) {
    Dec d; const int bh = task / 96, rem = task - bh * 96; d.g = rem >> 5; const int j = rem & 31;
    d.sh = 2 * d.g; d.res = j >> (5 - d.sh); d.i0 = 256 * (j & ((32 >> d.sh) - 1)); d.hd = bh & 15; d.rowb = (size_t)(bh >> 4) * 8192; return d;
}
__device__ __forceinline__ void issue(const u16* __restrict__ QKV, int task, int tid, v4u (&pk)[6], v4u (&pv)[6], bf16x8 (&qn)[4]) {
    const Dec d = decode(task); const int lane = tid & 63, w = tid >> 6, r = lane & 31, h = lane >> 5;
#pragma unroll
    for (int n = 0; n < 6; ++n) { const int id = tid + 512 * n, c = id >> 3, ch = id & 7; int ki = d.i0 - 128 + c; ki = ki < 0 ? 0 : ki;
        const u16* src = QKV + (d.rowb + d.res + (ki << d.sh)) * NIN1 + d.hd * 64 + ch * 8;
        pk[n] = *(const v4u*)(src + 1024); pv[n] = *(const v4u*)(src + 2048); }
    const u16* qp = QKV + (d.rowb + d.res + ((d.i0 + 32 * w + r) << d.sh)) * NIN1 + d.hd * 64;
#pragma unroll
    for (int ks = 0; ks < 4; ++ks) qn[ks] = *(const bf16x8*)(qp + 16 * ks + 8 * h);
}
__device__ __forceinline__ void phase(LAS unsigned char* L, const u16* __restrict__ QKV, u16* OBg0, u16* OBg1, u16* OBg2, float* LSE, int first, int stride, const int tid) {
    const int lane = tid & 63, w = __builtin_amdgcn_readfirstlane(tid >> 6), r = lane & 31, h = lane >> 5;
    const bool xl = (stride == 256); const int nround = xl ? 24 : (6144 - first + stride - 1) / stride;
    if (first >= 6144) return;
#define DL_TASK(k) (xl ? (((first >> 5) * 8 + (k) / 3) * 96 + ((k) % 3) * 32 + (first & 31)) : (first + (k) * stride))
    v4u pk[6], pv[6]; bf16x8 qn[4];
    issue(QKV, DL_TASK(0), tid, pk, pv, qn);
    for (int kr = 0; kr < nround; ++kr) {
        const int task = DL_TASK(kr);
        const Dec d = decode(task);
#pragma unroll
        for (int n = 0; n < 6; ++n) { const int id = tid + 512 * n, c = id >> 3, ch = id & 7; *(LAS v4u*)(L + O_K + c * KP + ch * 16) = pk[n]; *(LAS v4u*)(L + O_V + c * VP + ch * 16) = pv[n]; }
        bf16x8 qf[4];
#pragma unroll
        for (int ks = 0; ks < 4; ++ks) qf[ks] = qn[ks];
        __syncthreads();
        if (kr + 1 < nround) issue(QKV, DL_TASK(kr + 1), tid, pk, pv, qn);
        const int i0 = d.i0, g = d.g, sh = d.sh;
        const int qpos = d.res + ((i0 + 32 * w + r) << sh);
        f32x16 X[5];
#pragma unroll
        for (int kb = 0; kb < 5; ++kb) {
            X[kb] = f32x16{};
#pragma unroll
            for (int ks = 0; ks < 4; ++ks) { const bf16x8 kf = *(LAS bf16x8*)(L + O_K + (32 * w + 32 * kb + r) * KP + (16 * ks + 8 * h) * 2); X[kb] = MFMA32(kf, qf[ks], X[kb]); }
        }
        float m = -INFINITY;
#pragma unroll
        for (int kb = 0; kb < 5; ++kb)
#pragma unroll
            for (int i = 0; i < 16; ++i) { const int c = crow(i, h); bool valid = (i0 - 128 + 32 * w + 32 * kb + c) >= 0;
                if (kb == 0) valid = valid && (c >= r);
                if (kb == 4) valid = valid && (c <= r);
                X[kb][i] = valid ? X[kb][i] : -INFINITY; m = fmaxf(m, X[kb][i]); }
        m = fmaxf(m, shx(m, 32, lane));
        float l = 0.f;
#pragma unroll
        for (int kb = 0; kb < 5; ++kb)
#pragma unroll
            for (int i = 0; i < 16; ++i) { X[kb][i] = __builtin_amdgcn_exp2f(X[kb][i] - m); l += X[kb][i]; }
        l += shx(l, 32, lane);
        f32x16 y[2]; y[0] = f32x16{}; y[1] = f32x16{};
#pragma unroll
        for (int kb = 0; kb < 5; ++kb)
#pragma unroll
            for (int s2 = 0; s2 < 2; ++s2) { const bf16x8 pb = pack8(X[kb], 8 * s2);
#pragma unroll
                for (int dt = 0; dt < 2; ++dt) { const bf16x8 a = trfrag(L + O_V, VP, 32 * w + 32 * kb + 16 * s2 + 4 * h, 8, 32 * dt, lane); y[dt] = MFMA32(a, pb, y[dt]); } }
        const float inv = 1.f / l;
        u16* ob = (g == 0 ? OBg0 : g == 1 ? OBg1 : OBg2) + (d.rowb + qpos) * 1024 + d.hd * 64;
#pragma unroll
        for (int dt = 0; dt < 2; ++dt)
#pragma unroll
            for (int gq = 0; gq < 4; ++gq) { v2u wv; wv.x = pk2(y[dt][4 * gq] * inv, y[dt][4 * gq + 1] * inv); wv.y = pk2(y[dt][4 * gq + 2] * inv, y[dt][4 * gq + 3] * inv); *(v2u*)(ob + 32 * dt + 8 * gq + 4 * h) = wv; }
        if (h == 0) LSE[((size_t)g * MTOK + d.rowb + qpos) * 16 + d.hd] = (m + __log2f(l)) * 0.6931471805599453f;
        __syncthreads();
    }
}
}
__device__ __forceinline__ void dil_merge(const u16* OB0, const u16* OB1, const u16* OB2, const float* LSE, u16* MIX, int gw, int NGW, int lane) {
    const int hd = lane >> 2, dq = (lane & 3) * 16;
    for (int m = gw; m < MTOK; m += NGW) {
        const float l0 = LSE[((size_t)m) * 16 + hd], l1 = LSE[((size_t)MTOK + m) * 16 + hd], l2 = LSE[((size_t)2 * MTOK + m) * 16 + hd];
        const float mx = fmaxf(l0, fmaxf(l1, l2)); float w0 = __expf(l0 - mx), w1 = __expf(l1 - mx), w2 = __expf(l2 - mx); const float iz = 1.f / (w0 + w1 + w2); w0 *= iz; w1 *= iz; w2 *= iz;
        const size_t off = (size_t)m * 1024 + hd * 64 + dq;
#pragma unroll
        for (int j = 0; j < 2; ++j) { const v4u a = *(const v4u*)(OB0 + off + 8 * j), bq = *(const v4u*)(OB1 + off + 8 * j), c = *(const v4u*)(OB2 + off + 8 * j);
            const unsigned aw[4] = {a.x, a.y, a.z, a.w}, bw[4] = {bq.x, bq.y, bq.z, bq.w}, cw[4] = {c.x, c.y, c.z, c.w}; unsigned ow[4];
#pragma unroll
            for (int e = 0; e < 4; ++e) ow[e] = pk2(w0 * bflo(aw[e]) + w1 * bflo(bw[e]) + w2 * bflo(cw[e]), w0 * bfhi(aw[e]) + w1 * bfhi(bw[e]) + w2 * bfhi(cw[e]));
            *(v4u*)(MIX + off + 8 * j) = (v4u){ow[0], ow[1], ow[2], ow[3]}; }
    }
}
#ifndef REP_PRO
#define REP_PRO 1
#endif
#ifndef REP_P1
#define REP_P1 1
#endif
#ifndef REP_HGA
#define REP_HGA 1
#endif
#ifndef REP_HGC
#define REP_HGC 1
#endif
#ifndef REP_CMB
#define REP_CMB 1
#endif
#ifndef REP_DIL
#define REP_DIL 1
#endif
#ifndef REP_MRG
#define REP_MRG 1
#endif
#ifndef REP_P6
#define REP_P6 1
#endif
#ifndef REP_ATT
#define REP_ATT 1
#endif
#ifndef PH_LO
#define PH_LO 0
#endif
#ifndef PH_HI
#define PH_HI 100
#endif
__device__ __forceinline__ int fresh_lane() { int l; asm volatile("v_mbcnt_lo_u32_b32 %0, -1, 0\n\tv_mbcnt_hi_u32_b32 %0, -1, %0" : "=v"(l)); return l; }
__device__ __forceinline__ void grid_bar(unsigned* bar, unsigned target, int wave0) {
    asm volatile("s_waitcnt vmcnt(0) lgkmcnt(0)" ::: "memory");
    __syncthreads();
    if (wave0 == 0) {
        const int ln = fresh_lane();
        if (ln == 0) {
            __builtin_amdgcn_fence(__ATOMIC_RELEASE, "agent");
            asm volatile("s_waitcnt vmcnt(0)" ::: "memory");
            __hip_atomic_fetch_add(bar, 1u, __ATOMIC_RELAXED, __HIP_MEMORY_SCOPE_AGENT);
            while (__hip_atomic_load(bar, __ATOMIC_RELAXED, __HIP_MEMORY_SCOPE_AGENT) < target) __builtin_amdgcn_s_sleep(2);
            __builtin_amdgcn_fence(__ATOMIC_ACQUIRE, "agent");
            asm volatile("s_waitcnt vmcnt(0)" ::: "memory");
        }
    }
    __syncthreads();
}
template <class Epi>
__device__ __forceinline__ void run_gemm(LAS unsigned char* lds, const u16* A, const u16* Bt, int N, int K, const Epi& E, int tid) {
    asm volatile("" : "+v"(tid));
    pg8::Gemm g{A, Bt, MTOK, N, K}; pg8::StaticOrder S; S.init(MTOK, N, (int)gridDim.x, (int)blockIdx.x);
    pg8::gemm_phase<Epi, pg8::StaticOrder, PG8_ALIGN, PG8_SP2>(lds, g, S, E, tid);
}
__global__ void __launch_bounds__(512, 2) fwd_kernel(Args A) {
    extern __shared__ __attribute__((aligned(16))) unsigned char lds_raw[];
    LAS unsigned char* lds = (LAS unsigned char*)lds_raw;
    cg::grid_group grid = cg::this_grid();
    const int wave0 = __builtin_amdgcn_readfirstlane((int)threadIdx.x >> 6);
#define tid0 (wave0 * 64 + fresh_lane())
    const int G = gridDim.x, bx = blockIdx.x;
    const int vcu = (G % 8 == 0) ? (bx % 8) * (G / 8) + bx / 8 : bx;
    const int NGW = G * 8;
#define PHASE_IDS() int tid = tid0; asm volatile("" : "+v"(tid)); const int lane = tid & 63, wave = __builtin_amdgcn_readfirstlane(tid >> 6), gw = bx * 8 + wave; (void)lane; (void)gw;
    unsigned char* ws = A.ws;
    float* rowss0 = (float*)(ws + WS_ROWSS); float* stats0 = (float*)(ws + WS_STATS); const float* cvec0 = (const float*)(ws + WS_CVEC); const float* lbv = (const float*)(ws + WS_MISC); const float* cs = (const float*)(ws + WS_CS);
    u16* XB = (u16*)(ws + WS_XB); u16* MIX = (u16*)(ws + WS_MIX); u16* HB = (u16*)(ws + WS_HB); u16* AUX = (u16*)(ws + WS_AUX);
    float* HGS = (float*)(ws + WS_HGS); float* HGD = (float*)(ws + WS_HGD); float* LSE = (float*)(ws + WS_LSE); u16* OB1 = (u16*)(ws + WS_OB1);
    float* X = A.out;
    unsigned* barw = (unsigned*)(ws + WS_BAR); unsigned nbar = 0;
#define GSYNC() do { ++nbar; grid_bar(barw, nbar * (unsigned)G, wave0); } while (0)

    for (int rep_ = 0; rep_ < REP_PRO; ++rep_) { { PHASE_IDS(); prologue(A, lds, gw, NGW, wave, lane); } }
    grid.sync();

    for (int l = 0; l < 2; ++l) {
        const u16* Ain = (l == 0) ? XB : AUX;
        if (l == 0) {
            for (int rep_ = 0; rep_ < REP_P1; ++rep_) { { pg8::EpiStore E{HB, NIN0, 0, 1024, 512, cs, nullptr, nullptr, nullptr}; run_gemm(lds, Ain, (const u16*)(ws + WS_WIN0), NIN0, 1024, E, tid0); } }
            GSYNC();
#ifndef NO_HGA
            for (int rep_ = 0; rep_ < REP_HGA; ++rep_) { for (int it = vcu; it < 256; it += G) { PHASE_IDS(); hg::item<false>(lds, HB, it, lbv, HGS, HGD, nullptr, nullptr, tid); } }
#endif
            __syncthreads();
            for (int rep_ = 0; rep_ < REP_ATT; ++rep_)
            for (int i = 0; i < 2048; ++i) {
                int tidA = tid0; asm volatile("" : "+v"(tidA));
                int pair, qb;
                if (G == 256) { if (i >= 8) break; const int s = vcu & 3, k = 7 - i; pair = vcu >> 2; qb = 4 * k + ((k & 1) ? 3 - s : s); }
                else { const int u = vcu + i * G; if (u >= 2048) break; pair = u >> 5; qb = 31 - (u & 31); }
                const int b = pair >> 4, vh = pair & 15, hh = vh >> 2, c = (vh >> 1) & 1, half = vh & 1;
#ifndef NO_ATTN
                attn_body::attn_unit<8>(b, (2 * hh + c) * 64, 512 + (2 * hh + c) * 64, 1024 + hh * 128 + half * 64, vh * 64, qb,
                                        (const attn_body::bf16*)HB, (const attn_body::bf16*)HB, (const attn_body::bf16*)HB, (attn_body::bf16*)AUX, (char*)lds_raw, tidA);
#endif
            }
            GSYNC();
#ifndef NO_HGC
            for (int rep_ = 0; rep_ < REP_HGC; ++rep_) { for (int it = vcu; it < 256; it += G) { PHASE_IDS(); hg::item<true>(lds, HB, it, lbv, HGS, HGD, A.hg_norm_g, MIX, tid); } }
#endif
            for (int rep_ = 0; rep_ < REP_CMB; ++rep_) { { PHASE_IDS(); diff_combine(AUX, MIX, A.da_lambda, A.da_subln_g, gw, NGW, lane); } }
            GSYNC();
        } else {
            { pg8::EpiStore E{HB, NIN1, 0, 2048, 1024, cs, nullptr, nullptr, nullptr}; run_gemm(lds, Ain, (const u16*)(ws + WS_WIN1), NIN1, 1024, E, tid0); }
            GSYNC();
#ifndef NO_DIL
            for (int rep_ = 0; rep_ < REP_DIL; ++rep_) { { PHASE_IDS(); dl::phase(lds, HB, AUX, OB1, XB, LSE, vcu, G, tid); } }
#endif
            GSYNC();
            for (int rep_ = 0; rep_ < REP_MRG; ++rep_) { { PHASE_IDS(); dil_merge(AUX, OB1, XB, LSE, MIX, gw, NGW, lane); } }
            GSYNC();
        }
        float* rowss = rowss0 + (size_t)l * MTOK; float* st1 = stats0 + (size_t)(2 * l) * MTOK * 2; float* st2 = stats0 + (size_t)(2 * l + 1) * MTOK * 2; const float* cv = cvec0 + l * 10240;
        { PHASE_IDS(); p_rows(A.p + (size_t)l * MTOK * PLE, AUX, gw, NGW, lane); }
        { pg8::EpiResid E{l == 0 ? A.x : X, X, XB, ALPHA, nullptr, nullptr, nullptr, st1}; run_gemm(lds, MIX, (const u16*)(ws + (l == 0 ? WS_WOUT0 : WS_WOUT1)), 1024, 1024, E, tid0); }
        GSYNC();
        for (int rep_ = 0; rep_ < REP_P6; ++rep_) { pg8::EpiStore E{HB, FFD, 1, 0, 0, cs, st1, cv, cv + 4096}; run_gemm(lds, XB, (const u16*)(ws + WS_W1 + l * 8 * MiB), FFD, 1024, E, tid0); }
        { pg8::EpiE E{MIX, rowss}; run_gemm(lds, AUX, (const u16*)(ws + WS_WP + l * (MiB / 2)), 1024, PLE, E, tid0); }
        GSYNC();
        { pg8::EpiResid E{X, X, XB, ALPHA, st1, A.ln1_g + l * 1024, A.ln1_b + l * 1024, st2}; run_gemm(lds, HB, (const u16*)(ws + WS_W2 + l * 8 * MiB), 1024, FFD, E, tid0); }
        GSYNC();
        { pg8::EpiGate E{X, st2, A.ln2_g + l * 1024, A.ln2_b + l * 1024, cv + 8192, cv + 9216, MIX, rowss, A.ple_norm_g + l * 1024, l == 0 ? AUX : nullptr}; run_gemm(lds, XB, (const u16*)(ws + WS_WG + l * 2 * MiB), 1024, 1024, E, tid0); }
        if (l == 0) GSYNC();
    }
#ifdef PROBE_BARS
    for (int i = 0; i < PROBE_BARS; ++i) GSYNC();
#endif
}

extern "C" void kernel_launch(void* const* d_in, const int* in_sizes, int n_in, void* d_out, int out_size, void* d_ws, size_t ws_size, hipStream_t stream) {
    static int grid = 0;
    if (grid == 0) {
        if (n_in != 19 || out_size != MTOK * DMODEL || ws_size < WS_END) { fprintf(stderr, "kernel_launch: unexpected shapes (n_in %d, out %d, ws %zu)\n", n_in, out_size, ws_size); grid = -1; return; }
        int dev = 0, cus = 0, per_cu = 0;
        if (hipGetDevice(&dev) != hipSuccess || hipDeviceGetAttribute(&cus, hipDeviceAttributeMultiprocessorCount, dev) != hipSuccess) { grid = -1; return; }
        if (hipFuncSetAttribute((const void*)fwd_kernel, hipFuncAttributeMaxDynamicSharedMemorySize, LDS_BYTES) != hipSuccess) { fprintf(stderr, "kernel_launch: hipFuncSetAttribute failed\n"); grid = -1; return; }
        if (hipOccupancyMaxActiveBlocksPerMultiprocessor(&per_cu, (const void*)fwd_kernel, 512, LDS_BYTES) != hipSuccess || per_cu < 1) { fprintf(stderr, "kernel_launch: occupancy query says %d\n", per_cu); per_cu = 1; }
        (void)hipGetLastError();
        grid = cus * per_cu;
    }
    if (grid < 0) return;
    if (hipMemsetAsync((char*)d_ws, 0, WS_BAR + 256, stream) != hipSuccess) { fprintf(stderr, "kernel_launch: memset failed\n"); return; }
    Args a{};
    const float** f = (const float**)&a;
    for (int i = 0; i < 19; ++i) f[i] = (const float*)d_in[i];
    a.out = (float*)d_out; a.ws = (unsigned char*)d_ws;
    void* args[] = {&a};
    hipError_t e = hipLaunchCooperativeKernel((const void*)fwd_kernel, dim3(grid), dim3(512), args, LDS_BYTES, stream);
    if (e != hipSuccess) fprintf(stderr, "cooperative launch failed: %s (grid %d)\n", hipGetErrorString(e), grid);
}
```

```cpp
#include <hip/hip_runtime.h>
#include <hip/hip_cooperative_groups.h>
#include <cstdio>
#include <cstdint>
namespace cg = cooperative_groups;
namespace pg8 {
#define PG8_LAS __attribute__((address_space(3)))
typedef unsigned short bf16_t;
typedef short bf16x8 __attribute__((ext_vector_type(8)));
typedef float f32x4 __attribute__((ext_vector_type(4)));
typedef unsigned u32x4 __attribute__((ext_vector_type(4)));
constexpr int BM = 256, BK = 64, HALF = 128, HTB = HALF * BK * 2  , STAGE_BYTES = 8 * HTB, NXCD = 8, WGM = 8;

__host__ __device__ __forceinline__ int lds_byte(int r, int c) { const int st = (r >> 4) * 2 + (c >> 5), rr = r & 15, cc = c & 31, ob = rr * 64 + cc * 2; return st * 1024 + (ob ^ (((ob >> 9) & 1) << 5)); }
__host__ __device__ __forceinline__ void stage_rc(int b, int& R, int& C) { const int st = b / 1024, sb = b % 1024, swz = sb ^ (((sb >> 9) & 1) << 5); R = (st >> 1) * 16 + swz / 64; C = (st & 1) * 32 + (swz % 64) / 2; }
__host__ __device__ __forceinline__ int perm32(int rho) { const int n = rho >> 4, i = rho & 15; return 8 * (i >> 2) + 4 * n + (i & 3); }

struct Unit { int pm, pn; };
struct Gemm { const bf16_t* A; const bf16_t* Bt; int M, N, K; };

struct StaticOrder {
    int nM, nN, nwg, G, c;
    __host__ __device__ void init(int M, int N, int G_, int c_) { nM = M / BM; nN = N / BM; nwg = nM * nN; G = G_; c = c_; }
    __host__ __device__ bool next(int i, Unit& u) const {
        const long L = (long)i * G + c; if (L >= nwg) return false;
        int wgid = (int)L; { const int q = nwg / NXCD, r = nwg % NXCD, xcd = wgid % NXCD, off = wgid / NXCD; wgid = (xcd < r ? xcd * (q + 1) : r * (q + 1) + (xcd - r) * q) + off; }
        const int nig = WGM * nN, gid = wgid / nig, fm = gid * WGM, gsz = (nM - fm) < WGM ? (nM - fm) : WGM;
        u.pm = fm + ((wgid % nig) % gsz); u.pn = (wgid % nig) / gsz; return true;
    }
    __device__ __forceinline__ void a_ready(const Unit&) const {}
    __device__ __forceinline__ void done(const Unit&) const {}
};

__device__ __forceinline__ unsigned cvt_pk_bf16(float lo, float hi) { unsigned r; asm volatile("v_cvt_pk_bf16_f32 %0, %1, %2" : "=v"(r) : "v"(lo), "v"(hi)); return r; }
typedef float f32x2 __attribute__((ext_vector_type(2)));
template <class Epi, class Sched, bool ALIGN_EPI = false, bool SP2 = false>
__device__ __forceinline__ void gemm_phase(PG8_LAS unsigned char* lds, const Gemm g, const Sched& S, const Epi& E, const int tid_in) {
    const int tid = tid_in, wid = __builtin_amdgcn_readfirstlane(tid >> 6), lane = tid & 63, wr = wid >> 2, wc = wid & 3, fr = lane & 15, fq = lane >> 4;
    const int K = g.K, nt = K / BK;
    unsigned voffA[2], voffB[2];
#pragma unroll
    for (int i = 0; i < 2; ++i) { int R, C; stage_rc(tid * 16 + i * 8192, R, C); const int Rb = Epi::PERM ? ((R & ~31) + perm32(R & 31)) : R;
        voffA[i] = (unsigned)(R * K + C) * 2u; voffB[i] = (unsigned)(Rb * K + C) * 2u; }
    const size_t kstep = (size_t)(BK * 2);
    const size_t hstep = (size_t)HALF * K * 2;
    const size_t tstep = 2 * hstep;
    const unsigned ldsw = (unsigned)wid * 1024u;
    const int aoff = lds_byte(wr * 64 + fr, fq * 8), boff = lds_byte(wc * 32 + fr, fq * 8);
#define PG8_SA(b, h) (((b) * 2 + (h)) * HTB)
#define PG8_SB(b, h) ((4 + (b) * 2 + (h)) * HTB)
#define PG8_STAGE(bufoff, gbase, voff) do { _Pragma("unroll") for (int _i = 0; _i < 2; ++_i) \
        __builtin_amdgcn_global_load_lds((const unsigned*)((const char*)(gbase) + (voff)[_i]), (PG8_LAS unsigned*)(lds + (bufoff) + ldsw + _i * 8192), 16, 0, 0); } while (0)
#define PG8_LDA(dst, b, h) do { _Pragma("unroll") for (int m = 0; m < 4; ++m) _Pragma("unroll") for (int k = 0; k < 2; ++k) dst[m][k] = *(const PG8_LAS bf16x8*)(lds + PG8_SA(b, h) + aoff + m * 2048 + k * 1024); } while (0)
#define PG8_LDB(dst, b, h) do { _Pragma("unroll") for (int n = 0; n < 2; ++n) _Pragma("unroll") for (int k = 0; k < 2; ++k) dst[n][k] = *(const PG8_LAS bf16x8*)(lds + PG8_SB(b, h) + boff + n * 2048 + k * 1024); } while (0)
#define PG8_MMA(ai, bj, At, Bt) do { __builtin_amdgcn_s_setprio(1); _Pragma("unroll") for (int m = 0; m < 4; ++m) _Pragma("unroll") for (int n = 0; n < 2; ++n) _Pragma("unroll") for (int k = 0; k < 2; ++k) \
        acc[ai][bj][m][n] = __builtin_amdgcn_mfma_f32_16x16x32_bf16(Bt[n][k], At[m][k], acc[ai][bj][m][n], 0, 0, 0); __builtin_amdgcn_s_setprio(0); } while (0)
#define PG8_WAIT_V(n) asm volatile("s_waitcnt vmcnt(" #n ")" ::: "memory")
#define PG8_WAIT_L(n) asm volatile("s_waitcnt lgkmcnt(" #n ")" ::: "memory")
#define PG8_BAR __builtin_amdgcn_s_barrier()
#define PG8_SCHED __builtin_amdgcn_sched_barrier(0)
    Unit cur, nxt; int ui = 0;
    if (!S.next(0, cur)) return;
    f32x4 acc[2][2][4][2];
#pragma unroll
    for (int a = 0; a < 2; ++a)
#pragma unroll
        for (int b = 0; b < 2; ++b)
#pragma unroll
            for (int m = 0; m < 4; ++m)
#pragma unroll
                for (int n = 0; n < 2; ++n) acc[a][b][m][n] = (f32x4){0.f, 0.f, 0.f, 0.f};
    bf16x8 At[4][2], B0[2][2], B1[2][2];
    const char* cA = (const char*)g.A + (size_t)cur.pm * tstep; const char* cB = (const char*)g.Bt + (size_t)cur.pn * tstep;
    S.a_ready(cur);
    if constexpr (SP2) {
        PG8_STAGE(PG8_SB(0, 0), cB, voffB); PG8_STAGE(PG8_SB(0, 1), cB + hstep, voffB); PG8_STAGE(PG8_SA(0, 0), cA, voffA); PG8_STAGE(PG8_SA(0, 1), cA + hstep, voffA);
        if (wr == 1) PG8_BAR;
        PG8_WAIT_V(2); PG8_BAR;
        PG8_STAGE(PG8_SB(1, 0), cB + kstep, voffB); PG8_STAGE(PG8_SA(1, 0), cA + kstep, voffA); PG8_STAGE(PG8_SB(1, 1), cB + hstep + kstep, voffB);
        PG8_WAIT_V(6); PG8_BAR;
    } else {
        PG8_STAGE(PG8_SB(0, 0), cB, voffB); PG8_STAGE(PG8_SA(0, 0), cA, voffA); PG8_STAGE(PG8_SB(0, 1), cB + hstep, voffB); PG8_STAGE(PG8_SA(0, 1), cA + hstep, voffA);
        if (wr == 1) PG8_BAR;
        PG8_WAIT_V(4); PG8_BAR;
        PG8_STAGE(PG8_SB(1, 0), cB + kstep, voffB); PG8_STAGE(PG8_SA(1, 0), cA + kstep, voffA); PG8_STAGE(PG8_SB(1, 1), cB + hstep + kstep, voffB);
        PG8_WAIT_V(6); PG8_BAR;
    }
    for (;;) {
        const bool has_next = S.next(ui + 1, nxt);
        const char* nA = has_next ? (const char*)g.A + (size_t)nxt.pm * tstep : cA; const char* nB = has_next ? (const char*)g.Bt + (size_t)nxt.pn * tstep : cB;
        for (int t = 0; t < nt; t += 2) {
            const bool last = (t == nt - 2);
            const char* a1 = cA + (size_t)(t + 1) * kstep;
            const char* a2 = last ? nA : cA + (size_t)(t + 2) * kstep; const char* b2 = last ? nB : cB + (size_t)(t + 2) * kstep;
            const char* a3 = a2 + kstep; const char* b3 = b2 + kstep;
            if (last && has_next) S.a_ready(nxt);
            if constexpr (SP2) {
            PG8_LDB(B0, 0, 0); PG8_LDB(B1, 0, 1); PG8_SCHED; PG8_LDA(At, 0, 0); PG8_STAGE(PG8_SA(1, 1), a1 + hstep, voffA);
            PG8_WAIT_V(8); PG8_WAIT_L(0); PG8_BAR; PG8_MMA(0, 0, At, B0); PG8_MMA(0, 1, At, B1); PG8_BAR; PG8_SCHED;
            PG8_LDA(At, 0, 1); PG8_STAGE(PG8_SB(0, 0), b2, voffB); PG8_STAGE(PG8_SB(0, 1), b2 + hstep, voffB); PG8_STAGE(PG8_SA(0, 0), a2, voffA);
            PG8_WAIT_V(8); PG8_WAIT_L(0); PG8_BAR; PG8_MMA(1, 0, At, B0); PG8_MMA(1, 1, At, B1); PG8_BAR; PG8_SCHED;
            PG8_LDB(B0, 1, 0); PG8_LDB(B1, 1, 1); PG8_SCHED; PG8_LDA(At, 1, 0); PG8_STAGE(PG8_SA(0, 1), a2 + hstep, voffA);
            PG8_WAIT_V(8); PG8_WAIT_L(0); PG8_BAR; PG8_MMA(0, 0, At, B0); PG8_MMA(0, 1, At, B1); PG8_BAR; PG8_SCHED;
            PG8_LDA(At, 1, 1); PG8_STAGE(PG8_SB(1, 0), b3, voffB); PG8_STAGE(PG8_SB(1, 1), b3 + hstep, voffB); PG8_STAGE(PG8_SA(1, 0), a3, voffA);
            PG8_WAIT_V(8); PG8_WAIT_L(0); PG8_BAR; PG8_MMA(1, 0, At, B0); PG8_MMA(1, 1, At, B1); PG8_BAR; PG8_SCHED;
            } else {
            PG8_LDB(B0, 0, 0); PG8_SCHED; PG8_LDA(At, 0, 0); PG8_STAGE(PG8_SA(1, 1), a1 + hstep, voffA);
            PG8_WAIT_L(8); PG8_BAR; PG8_WAIT_L(0); PG8_MMA(0, 0, At, B0); PG8_BAR; PG8_SCHED;
            PG8_LDB(B1, 0, 1); PG8_STAGE(PG8_SB(0, 0), b2, voffB);
            PG8_BAR; PG8_WAIT_L(0); PG8_MMA(0, 1, At, B1); PG8_BAR;
            PG8_LDA(At, 0, 1); PG8_STAGE(PG8_SA(0, 0), a2, voffA);
            PG8_BAR; PG8_WAIT_L(0); PG8_MMA(1, 0, At, B0); PG8_BAR; PG8_SCHED;
            PG8_STAGE(PG8_SB(0, 1), b2 + hstep, voffB);
            PG8_WAIT_V(6); PG8_BAR; PG8_MMA(1, 1, At, B1); PG8_BAR;
            PG8_LDB(B0, 1, 0); PG8_SCHED; PG8_LDA(At, 1, 0); PG8_STAGE(PG8_SA(0, 1), a2 + hstep, voffA);
            PG8_WAIT_L(8); PG8_BAR; PG8_WAIT_L(0); PG8_MMA(0, 0, At, B0); PG8_BAR; PG8_SCHED;
            PG8_LDB(B1, 1, 1); PG8_STAGE(PG8_SB(1, 0), b3, voffB);
            PG8_BAR; PG8_WAIT_L(0); PG8_MMA(0, 1, At, B1); PG8_BAR;
            PG8_LDA(At, 1, 1); PG8_STAGE(PG8_SA(1, 0), a3, voffA);
            PG8_BAR; PG8_WAIT_L(0); PG8_MMA(1, 0, At, B0); PG8_BAR; PG8_SCHED;
            PG8_STAGE(PG8_SB(1, 1), b3 + hstep, voffB);
            PG8_WAIT_V(6); PG8_BAR; PG8_MMA(1, 1, At, B1); PG8_BAR;
            }
        }
        if constexpr (ALIGN_EPI) { if (wr == 0) PG8_BAR; }
        if constexpr (!Epi::AFTER_DRAIN) { E(acc, cur, wr, wc, fr, fq); S.done(cur); }
        if (!has_next) break;
#pragma unroll
        for (int a = 0; a < 2; ++a)
#pragma unroll
            for (int b = 0; b < 2; ++b)
#pragma unroll
                for (int m = 0; m < 4; ++m)
#pragma unroll
                    for (int n = 0; n < 2; ++n) acc[a][b][m][n] = (f32x4){0.f, 0.f, 0.f, 0.f};
        cur = nxt; cA = nA; cB = nB; ++ui;
        if constexpr (ALIGN_EPI) { if (wr == 1) PG8_BAR; }
    }
    PG8_WAIT_V(0);
    if constexpr (!ALIGN_EPI) { if (wr == 0) PG8_BAR; }
    PG8_BAR;
    if constexpr (Epi::AFTER_DRAIN) { E.fused(acc, cur, wr, wc, fr, fq, lds, wid, lane); S.done(cur); }
#undef PG8_SA
#undef PG8_SB
#undef PG8_STAGE
#undef PG8_LDA
#undef PG8_LDB
#undef PG8_MMA
#undef PG8_WAIT_V
#undef PG8_WAIT_L
#undef PG8_BAR
#undef PG8_SCHED
}
}
namespace pg8 {
__device__ __forceinline__ float shx(float v, int m, int lane) { return __builtin_bit_cast(float, __builtin_amdgcn_ds_bpermute((lane ^ m) << 2, __builtin_bit_cast(int, v))); }
constexpr float QSCALE = 0.125f * 1.4426950408889634f;
struct EpiStore {
    static constexpr bool PERM = true, AFTER_DRAIN = false;
    bf16_t* O; int ldc; int act; int rope_cols; int scale_cols; const float* cs;
    const float* st; const float* c1; const float* c2;
    __device__ __forceinline__ void operator()(f32x4 (&acc)[2][2][4][2], const Unit& u, int wr, int wc, int fr, int fq) const {
        { int ln_; asm volatile("v_mbcnt_lo_u32_b32 %0, -1, 0\n\tv_mbcnt_hi_u32_b32 %0, -1, %0" : "=v"(ln_)); fr = ln_ & 15; fq = ln_ >> 4; }
        const int row0 = u.pm * BM + wr * 64 + fr; const int colt = u.pn * BM;
        const int col0 = colt + wc * 32 + 8 * fq;
        if (colt < rope_cols && (wc & 1) == 0) {
            const float sgn = fq == 0 ? -1.f : 1.f; const int lane = fq * 16 + fr;
            const int fqc = fq & 1;
#pragma unroll
            for (int ai = 0; ai < 2; ++ai)
#pragma unroll
                for (int m = 0; m < 4; ++m) {
                    const int pos = (row0 + ai * HALF + m * 16) & 8191;
                    const float* cp = cs + pos * 8;
#pragma unroll
                    for (int n = 0; n < 2; ++n) {
                        const f32x4 cv = *(const f32x4*)(cp + 4 * n), sv = *(const f32x4*)(cp + 65536 + 4 * n);
#pragma unroll
                        for (int bj = 0; bj < 2; ++bj)
#pragma unroll
                            for (int e = 0; e < 4; ++e) {
                                const float v = acc[ai][bj][m][n][e]; const float pv = shx(v, 16, lane);
                                const float nv = v * cv[e] + sgn * pv * sv[e];
                                acc[ai][bj][m][n][e] = (fq < 2) ? nv : v;
                            }
                        asm volatile("" ::: "memory");
                    }
                }
            (void)fqc;
        }
        if (st) {
            float muv[2][4], rsv[2][4];
#pragma unroll
            for (int ai = 0; ai < 2; ++ai)
#pragma unroll
                for (int m = 0; m < 4; ++m) { const int row = row0 + ai * HALF + m * 16; const f32x2 sv = *(const f32x2*)(st + 2 * row); muv[ai][m] = sv.x; rsv[ai][m] = sv.y; }
#pragma unroll
            for (int ai = 0; ai < 2; ++ai)
#pragma unroll
                for (int m = 0; m < 4; ++m) { const float mu = muv[ai][m] * (1.f / 1024.f); rsv[ai][m] = 1.0f / sqrtf(rsv[ai][m] * (1.f / 1024.f) - mu * mu + 1e-5f); muv[ai][m] = mu; }
#pragma unroll
            for (int bj = 0; bj < 2; ++bj) {
                const f32x4 c1a = *(const f32x4*)(c1 + col0 + bj * HALF), c1b = *(const f32x4*)(c1 + col0 + bj * HALF + 4), c2a = *(const f32x4*)(c2 + col0 + bj * HALF), c2b = *(const f32x4*)(c2 + col0 + bj * HALF + 4);
#pragma unroll
                for (int ai = 0; ai < 2; ++ai)
#pragma unroll
                    for (int m = 0; m < 4; ++m) { const float mu = muv[ai][m], rstd = rsv[ai][m];
                        acc[ai][bj][m][0] = (acc[ai][bj][m][0] - mu * c1a) * rstd + c2a; acc[ai][bj][m][1] = (acc[ai][bj][m][1] - mu * c1b) * rstd + c2b; }
            }
        }
        const float sc = (colt < scale_cols) ? QSCALE : 1.f;
#pragma unroll
        for (int ai = 0; ai < 2; ++ai)
#pragma unroll
            for (int m = 0; m < 4; ++m) { bf16_t* rowp = O + (size_t)(row0 + ai * HALF + m * 16) * ldc + col0;
#pragma unroll
                for (int bj = 0; bj < 2; ++bj) { f32x4 v0 = acc[ai][bj][m][0], v1 = acc[ai][bj][m][1];
                    if (act == 1) {
#pragma unroll
                        for (int e = 0; e < 4; ++e) { float a = fmaxf(v0[e], 0.f), b = fmaxf(v1[e], 0.f); v0[e] = a * a; v1[e] = b * b; } }
                    v0 = v0 * sc; v1 = v1 * sc; u32x4 w; w.x = cvt_pk_bf16(v0[0], v0[1]); w.y = cvt_pk_bf16(v0[2], v0[3]); w.z = cvt_pk_bf16(v1[0], v1[1]); w.w = cvt_pk_bf16(v1[2], v1[3]);
                    *(u32x4*)(rowp + bj * HALF) = w; } }
    }
};
struct EpiResid {
    static constexpr bool PERM = false, AFTER_DRAIN = false;
    const bf16_t* xinb; bf16_t* outb; const float* st_in; const float* g; const float* b; float* st_out;
    __device__ __forceinline__ void operator()(f32x4 (&acc)[2][2][4][2], const Unit& u, int wr, int wc, int fr, int fq) const {
        typedef unsigned u32x2v __attribute__((ext_vector_type(2)));
        { int ln_; asm volatile("v_mbcnt_lo_u32_b32 %0, -1, 0\n\tv_mbcnt_hi_u32_b32 %0, -1, %0" : "=v"(ln_)); fr = ln_ & 15; fq = ln_ >> 4; }
        const int lane = fq * 16 + fr;
        const int col0 = u.pn * BM + wc * 32 + 4 * fq;
        f32x4 gv[2][2], bv[2][2];
        if (st_in) {
#pragma unroll
            for (int bj = 0; bj < 2; ++bj)
#pragma unroll
                for (int n = 0; n < 2; ++n) { gv[bj][n] = *(const f32x4*)(g + col0 + bj * HALF + n * 16); bv[bj][n] = *(const f32x4*)(b + col0 + bj * HALF + n * 16); } }
#pragma unroll
        for (int ai = 0; ai < 2; ++ai) {
            const int rowa = u.pm * BM + ai * HALF + wr * 64 + fr;
            float mu[4], rstd[4];
            u32x2v xw[4][2][2];
#pragma unroll
            for (int m = 0; m < 4; ++m)
#pragma unroll
                for (int bj = 0; bj < 2; ++bj)
#pragma unroll
                    for (int n = 0; n < 2; ++n) xw[m][bj][n] = *(const u32x2v*)(xinb + (size_t)(rowa + m * 16) * 1024 + col0 + bj * HALF + n * 16);
#pragma unroll
            for (int m = 0; m < 4; ++m) { mu[m] = 0.f; rstd[m] = 1.f;
                if (st_in) { const f32x2 sv = *(const f32x2*)(st_in + 2 * (rowa + m * 16)); mu[m] = sv.x * (1.f / 1024.f); rstd[m] = 1.0f / sqrtf(sv.y * (1.f / 1024.f) - mu[m] * mu[m] + 1e-5f); } }
#pragma unroll
            for (int m = 0; m < 4; ++m) { const int row = rowa + m * 16; const size_t off = (size_t)row * 1024 + col0;
                float s1 = 0.f, s2 = 0.f;
#pragma unroll
                for (int bj = 0; bj < 2; ++bj)
#pragma unroll
                    for (int n = 0; n < 2; ++n) { const size_t o2 = off + bj * HALF + n * 16;
                        const u32x2v w0 = xw[m][bj][n]; f32x4 x1 = {__uint_as_float(w0.x << 16), __uint_as_float(w0.x & 0xffff0000u), __uint_as_float(w0.y << 16), __uint_as_float(w0.y & 0xffff0000u)};
                        if (st_in) x1 = (x1 - mu[m]) * rstd[m] * gv[bj][n] + bv[bj][n];
                        const f32x4 y = x1 * 1.4142135623730951f + acc[ai][bj][m][n];
                        u32x2v w; w.x = cvt_pk_bf16(y[0], y[1]); w.y = cvt_pk_bf16(y[2], y[3]); *(u32x2v*)(outb + o2) = w;
                        s1 += (y[0] + y[1]) + (y[2] + y[3]); s2 += (y[0] * y[0] + y[1] * y[1]) + (y[2] * y[2] + y[3] * y[3]); }
                s1 += shx(s1, 16, lane); s1 += shx(s1, 32, lane); s2 += shx(s2, 16, lane); s2 += shx(s2, 32, lane);
                if (fq == 0) { atomicAdd(st_out + 2 * row, s1); atomicAdd(st_out + 2 * row + 1, s2); } }
            asm volatile("" ::: "memory");
        }
    }
};
struct EpiE {
    static constexpr bool PERM = true, AFTER_DRAIN = false;
    bf16_t* O; float* rowss;
    __device__ __forceinline__ void operator()(f32x4 (&acc)[2][2][4][2], const Unit& u, int wr, int wc, int fr, int fq) const {
        { int ln_; asm volatile("v_mbcnt_lo_u32_b32 %0, -1, 0\n\tv_mbcnt_hi_u32_b32 %0, -1, %0" : "=v"(ln_)); fr = ln_ & 15; fq = ln_ >> 4; }
        const int row0 = u.pm * BM + wr * 64 + fr; const int col0 = u.pn * BM + wc * 32 + 8 * fq; const int lane = fq * 16 + fr;
#pragma unroll
        for (int ai = 0; ai < 2; ++ai)
#pragma unroll
            for (int m = 0; m < 4; ++m) { const int row = row0 + ai * HALF + m * 16; bf16_t* rowp = O + (size_t)row * 1024 + col0; float ss = 0.f;
#pragma unroll
                for (int bj = 0; bj < 2; ++bj) { const f32x4 v0 = acc[ai][bj][m][0], v1 = acc[ai][bj][m][1];
                    ss += (v0[0] * v0[0] + v0[1] * v0[1]) + (v0[2] * v0[2] + v0[3] * v0[3]) + (v1[0] * v1[0] + v1[1] * v1[1]) + (v1[2] * v1[2] + v1[3] * v1[3]);
                    u32x4 w; w.x = cvt_pk_bf16(v0[0], v0[1]); w.y = cvt_pk_bf16(v0[2], v0[3]); w.z = cvt_pk_bf16(v1[0], v1[1]); w.w = cvt_pk_bf16(v1[2], v1[3]);
                    *(u32x4*)(rowp + bj * HALF) = w; }
                ss += shx(ss, 16, lane); ss += shx(ss, 32, lane);
                if (fq == 0) atomicAdd(rowss + row, ss); }
    }
};
struct EpiGate {
    static constexpr bool PERM = false, AFTER_DRAIN = false;
    float* x; const bf16_t* yb; const float* st; const float* g2; const float* b2; const float* c1; const float* c2; const bf16_t* E; const float* rowss; const float* gp; bf16_t* xb;
    __device__ __forceinline__ void operator()(f32x4 (&acc)[2][2][4][2], const Unit& u, int wr, int wc, int fr, int fq) const {
        typedef unsigned u32x2v __attribute__((ext_vector_type(2)));
        { int ln_; asm volatile("v_mbcnt_lo_u32_b32 %0, -1, 0\n\tv_mbcnt_hi_u32_b32 %0, -1, %0" : "=v"(ln_)); fr = ln_ & 15; fq = ln_ >> 4; }
        const int col0 = u.pn * BM + wc * 32 + 4 * fq;
#pragma unroll
        for (int ai = 0; ai < 2; ++ai)
#pragma unroll
        for (int mp = 0; mp < 2; ++mp) {
            const int rowa = u.pm * BM + ai * HALF + wr * 64 + mp * 32 + fr;
            const bf16_t* ybp = yb + (size_t)rowa * 1024 + col0; const bf16_t* ep = E + (size_t)rowa * 1024 + col0;
            u32x2v yw[2][2][2], ew[2][2][2]; float mu[2], rstd[2], rs[2];
#pragma unroll
            for (int m = 0; m < 2; ++m)
#pragma unroll
                for (int bj = 0; bj < 2; ++bj)
#pragma unroll
                    for (int n = 0; n < 2; ++n) { const int o2 = m * 16 * 1024 + bj * HALF + n * 16; yw[m][bj][n] = *(const u32x2v*)(ybp + o2); ew[m][bj][n] = *(const u32x2v*)(ep + o2); }
#pragma unroll
            for (int m = 0; m < 2; ++m) { const int row = rowa + m * 16; const f32x2 sv = *(const f32x2*)(st + 2 * row); rs[m] = rowss[row]; mu[m] = sv.x; rstd[m] = sv.y; }
#pragma unroll
            for (int m = 0; m < 2; ++m) { rs[m] = 1.0f / sqrtf(rs[m] * (1.0f / 1024.0f) + 1e-5f); mu[m] *= (1.f / 1024.f); rstd[m] = 1.0f / sqrtf(rstd[m] * (1.f / 1024.f) - mu[m] * mu[m] + 1e-5f); }
#pragma unroll
            for (int bj = 0; bj < 2; ++bj)
#pragma unroll
                for (int n = 0; n < 2; ++n) { const int c = col0 + bj * HALF + n * 16;
                    const f32x4 gv = *(const f32x4*)(gp + c), g2v = *(const f32x4*)(g2 + c), b2v = *(const f32x4*)(b2 + c), c1v = *(const f32x4*)(c1 + c), c2v = *(const f32x4*)(c2 + c);
#pragma unroll
                    for (int m = 0; m < 2; ++m) { const size_t o2 = (size_t)(rowa + m * 16) * 1024 + c;
                        const u32x2v w0 = yw[m][bj][n], ev = ew[m][bj][n];
                        const f32x4 yv = {__uint_as_float(w0.x << 16), __uint_as_float(w0.x & 0xffff0000u), __uint_as_float(w0.y << 16), __uint_as_float(w0.y & 0xffff0000u)};
                        const f32x4 ef = {__uint_as_float(ev.x << 16), __uint_as_float(ev.x & 0xffff0000u), __uint_as_float(ev.y << 16), __uint_as_float(ev.y & 0xffff0000u)};
                        const f32x4 xv = (yv - mu[m]) * rstd[m] * g2v + b2v;
                        const f32x4 a = (acc[ai][bj][2 * mp + m][n] - mu[m] * c1v) * rstd[m] + c2v; f32x4 o;
#pragma unroll
                        for (int e = 0; e < 4; ++e) o[e] = xv[e] + ef[e] * rs[m] * gv[e] / (1.f + __expf(-a[e]));
                        if (x) *(f32x4*)(x + o2) = o;
                        if (xb) { u32x2v w; w.x = cvt_pk_bf16(o[0], o[1]); w.y = cvt_pk_bf16(o[2], o[3]); *(u32x2v*)(xb + o2) = w; } } }
            asm volatile("" ::: "memory");
        }
    }
};
}
#define PG8_SP2 true
#define PG8_ALIGN true
#include <hip/hip_bf16.h>
#include <cmath>
namespace attn_body {
using bf16=__hip_bfloat16;
using bf16x8=__attribute__((ext_vector_type(8)))short;
using s16x4=__attribute__((ext_vector_type(4)))short;
using f32x16=__attribute__((ext_vector_type(16)))float;
using u32x4=__attribute__((ext_vector_type(4)))unsigned;
constexpr int SEQ=8192,D=64,DM=3584,DMO=1024;
constexpr int NW=8,QBLK=32,QB=QBLK*NW,KVBLK=64,NQB=SEQ/QB;
constexpr int ATTN_PITCH=DM, ATTN_UNIT_ROWS=QB;
__device__ __forceinline__ int crow(int r,int hi){return (r&3)+8*(r>>2)+4*hi;}
#define SBAR() __builtin_amdgcn_sched_barrier(0)
__device__ __forceinline__ void cmask(f32x16&p0,f32x16&p1,int jb,int qrel,int hi){
  const float NEG=-INFINITY; int kb=64*jb+4*hi;
  #pragma unroll
  for(int r=0;r<16;++r){int kv=kb+(r&3)+8*(r>>2); if(kv>qrel)p0[r]=NEG; if(kv+32>qrel)p1[r]=NEG;}
}

constexpr int NSLOT=3, SLOTB=8192;
constexpr int LDS_K=0, LDS_V=NSLOT*SLOTB, LDS_WS=2*NSLOT*SLOTB, LDS_OST=LDS_WS+NW*64*4, LDS_BYTES=LDS_OST+NW*4096;
constexpr float C2=0.125f*1.4426950408889634f;
__device__ __forceinline__ void glds16(const void*gsrc,unsigned lds_dst){unsigned keep;
  asm volatile("s_mov_b32 %0, m0\n\ts_mov_b32 m0, %2\n\ts_nop 0\n\tglobal_load_lds_dwordx4 %1, off\n\ts_mov_b32 m0, %0":"=&s"(keep):"v"(gsrc),"s"(lds_dst):"memory");}
__device__ __forceinline__ float max3f(float a,float b,float c){float r;asm("v_max3_f32 %0, %1, %2, %3":"=v"(r):"v"(a),"v"(b),"v"(c));return r;}
__device__ __forceinline__ float max2f(float a,float b){float r;asm("v_max_f32_e32 %0, %1, %2":"=v"(r):"v"(a),"v"(b));return r;}
__device__ __forceinline__ float fadd_s(float a,float b){float r;asm("v_add_f32_e32 %0, %1, %2":"=v"(r):"v"(a),"v"(b));return r;}
__device__ __forceinline__ float fsub_s(float a,float b){float r;asm("v_sub_f32_e32 %0, %1, %2":"=v"(r):"v"(a),"v"(b));return r;}
typedef float f32x2_t __attribute__((ext_vector_type(2))); typedef __bf16 bf16x2_t __attribute__((ext_vector_type(2)));
__device__ __forceinline__ unsigned cvtpk_s(float lo,float hi){f32x2_t v={lo,hi};bf16x2_t b=__builtin_convertvector(v,bf16x2_t);return __builtin_bit_cast(unsigned,b);}
#define WAIT_BAR(N) asm volatile("s_waitcnt vmcnt(" #N ") lgkmcnt(0)\n\ts_barrier":::"memory")

__device__ __forceinline__ void qkt(f32x16&p0,f32x16&p1,const char*Kslot,const bf16x8*qr,const f32x16&negm,int r32,int hi){
  const char*kb=Kslot+hi*1024+r32*16;
  #pragma unroll
  for(int d0=0;d0<4;++d0){
    const bf16x8 b0=*reinterpret_cast<const bf16x8*>(kb+d0*2048);
    const bf16x8 b1=*reinterpret_cast<const bf16x8*>(kb+d0*2048+512);
    if(d0==0){p0=__builtin_amdgcn_mfma_f32_32x32x16_bf16(b0,qr[0],negm,0,0,0);p1=__builtin_amdgcn_mfma_f32_32x32x16_bf16(b1,qr[0],negm,0,0,0);}
    else{p0=__builtin_amdgcn_mfma_f32_32x32x16_bf16(b0,qr[d0],p0,0,0,0);p1=__builtin_amdgcn_mfma_f32_32x32x16_bf16(b1,qr[d0],p1,0,0,0);}}
}
typedef __attribute__((address_space(3))) const char* lds_cptr;
typedef short v4i16_t __attribute__((ext_vector_type(4)));
__device__ __forceinline__ void kload8(bf16x8*kf,lds_cptr kp){
  kf[0]=*(const __attribute__((address_space(3))) bf16x8*)(kp);      kf[1]=*(const __attribute__((address_space(3))) bf16x8*)(kp+512);
  kf[2]=*(const __attribute__((address_space(3))) bf16x8*)(kp+2048); kf[3]=*(const __attribute__((address_space(3))) bf16x8*)(kp+2560);
  kf[4]=*(const __attribute__((address_space(3))) bf16x8*)(kp+4096); kf[5]=*(const __attribute__((address_space(3))) bf16x8*)(kp+4608);
  kf[6]=*(const __attribute__((address_space(3))) bf16x8*)(kp+6144); kf[7]=*(const __attribute__((address_space(3))) bf16x8*)(kp+6656);
}
__device__ __forceinline__ void kload2(bf16x8*kf,lds_cptr kp,int j){ kf[2*j]=*(const __attribute__((address_space(3))) bf16x8*)(kp+j*2048); kf[2*j+1]=*(const __attribute__((address_space(3))) bf16x8*)(kp+j*2048+512); }
__device__ __forceinline__ s16x4 vtr(lds_cptr p){ return __builtin_bit_cast(s16x4,__builtin_amdgcn_ds_read_tr16_b64_v4i16((__attribute__((address_space(3))) v4i16_t*)p)); }
__device__ __forceinline__ float rowmax(const f32x16&p0,const f32x16&p1){
  float a=max3f(p0[0],p0[1],p1[0]),b=max3f(p0[2],p0[3],p1[1]);a=max3f(a,p1[2],p1[3]);
  #pragma unroll
  for(int r=4;r<16;r+=4){a=max3f(a,p0[r],p0[r+1]);b=max3f(b,p0[r+2],p0[r+3]);a=max3f(a,p1[r],p1[r+1]);b=max3f(b,p1[r+2],p1[r+3]);}
  const float m=max2f(a,b);
  auto rr=__builtin_amdgcn_permlane32_swap(__float_as_uint(m),__float_as_uint(m),false,false);
  return max2f(__uint_as_float(rr[0]),__uint_as_float(rr[1]));
}
__device__ __forceinline__ void pv(f32x16*o,int vb,bf16x8 pa0,bf16x8 pa1,bf16x8 pa2,bf16x8 pa3){
  #pragma unroll
  for(int d0=0;d0<2;++d0){s16x4 lo[4],hi[4];
    #pragma unroll
    for(int ks=0;ks<4;++ks){
      asm volatile("ds_read_b64_tr_b16 %0,%1 offset:%c2":"=&v"(lo[ks]):"v"(vb),"i"(d0*4096+ks*1024):"memory");
      asm volatile("ds_read_b64_tr_b16 %0,%1 offset:%c2":"=&v"(hi[ks]):"v"(vb),"i"(d0*4096+ks*1024+512):"memory");}
    asm volatile("s_waitcnt lgkmcnt(0)":::"memory");SBAR();
    #define PK(k) (bf16x8){lo[k][0],lo[k][1],lo[k][2],lo[k][3],hi[k][0],hi[k][1],hi[k][2],hi[k][3]}
    o[d0]=__builtin_amdgcn_mfma_f32_32x32x16_bf16(pa0,PK(0),o[d0],0,0,0);
    o[d0]=__builtin_amdgcn_mfma_f32_32x32x16_bf16(pa1,PK(1),o[d0],0,0,0);
    o[d0]=__builtin_amdgcn_mfma_f32_32x32x16_bf16(pa2,PK(2),o[d0],0,0,0);
    o[d0]=__builtin_amdgcn_mfma_f32_32x32x16_bf16(pa3,PK(3),o[d0],0,0,0);
    #undef PK
  }
}

#ifndef ATTN_STORE16
#define ATTN_STORE16(p,v) (*(u32x4*)(p)=(v))
#endif
template<int THRL> __device__ __forceinline__ void attn_unit(int b,int colq,int colk,int colv,int colo,int qb,const bf16*Q,const bf16*__restrict__ K,const bf16*__restrict__ V,bf16*O,char*shm,const int tid_in){
  const int tid=tid_in,lane=tid&63,r32=lane&31,hi=lane>>5; const int wid=__builtin_amdgcn_readfirstlane(tid>>6);
  const long rowbase=(long)b*SEQ; const int q0=qb*QB;
  const bf16*Qw=Q+(rowbase+q0+wid*QBLK)*DM+colq;
  const bf16*Kh=K+rowbase*DM+colk,*Vh=V+rowbase*DM+colv;
  const unsigned lds0=(unsigned)(uintptr_t)shm;
  float*wsf=(float*)(shm+LDS_WS)+wid*64;
  const bf16*ksrc=Kh+(long)lane*DM+wid*8;
  const bf16*vsrc=Vh+(long)(16*(wid&3)+(lane>>2))*DM+(wid>>2)*32+(lane&3)*8;
  const unsigned kdst=lds0+LDS_K+wid*1024, vdst=lds0+LDS_V+wid*1024;
  #define DMA_K(t,slot) glds16(ksrc+(long)(t)*KVBLK*DM,(unsigned)__builtin_amdgcn_readfirstlane(kdst+(slot)))
  #define DMA_V(t,slot) glds16(vsrc+(long)(t)*KVBLK*DM,(unsigned)__builtin_amdgcn_readfirstlane(vdst+(slot)))
  const int vb0=(int)(lds0+LDS_V)+((lane>>4)&1)*32+(lane&3)*8+(4*hi+((lane&15)>>2))*64;
  const char*Kbase=shm+LDS_K; bf16x8 kf[8];
  const lds_cptr shm3=(lds_cptr)shm; const lds_cptr kp0=shm3+LDS_K+hi*1024+r32*16; const lds_cptr vp0=shm3+LDS_V+((lane>>4)&1)*32+(lane&3)*8+(4*hi+((lane&15)>>2))*64;
  const int NT=(q0+QB)/KVBLK;
  DMA_K(0,0);DMA_V(0,0);DMA_K(1,SLOTB);
  bf16x8 qr[4];
  #pragma unroll
  for(int d0=0;d0<4;++d0)qr[d0]=*reinterpret_cast<const bf16x8*>(&Qw[(long)r32*DM+d0*16+hi*8]);
  float mhat=0.f,l_reg=0.f;f32x16 o[2];o[0]=f32x16{};o[1]=f32x16{};f32x16 negm=f32x16{};asm volatile("":"+v"(negm));
  const int qrel=wid*QBLK+r32;
  #define CMASK(P0,P1,t) do{int jb_=(t)-(NT-4); if(jb_>=0)cmask(P0,P1,jb_,qrel,hi);}while(0)
  bool resc=false;
  #define START(P0,P1) do{ const float rm=rowmax(P0,P1); resc=false; \
    { const float dl=rm; mhat=fadd_s(mhat,dl); \
      _Pragma("unroll") for(int r=0;r<16;++r){P0[r]=fsub_s(P0[r],dl);P1[r]=fsub_s(P1[r],dl);} \
      _Pragma("unroll") for(int r=0;r<16;++r)negm[r]=-mhat; asm volatile("":"+v"(negm)); } \
    _Pragma("unroll") for(int r=0;r<16;++r)P0[r]=__builtin_amdgcn_exp2f(P0[r]); }while(0)
  #define RESC() do{ if(resc){ asm volatile("s_waitcnt lgkmcnt(0)":::"memory"); \
      _Pragma("unroll") for(int d_=0;d_<2;++d_) _Pragma("unroll") for(int r=0;r<16;++r)o[d_][r]*=wsf[crow(r,hi)]; } }while(0)
  f32x16 pA0,pA1,pB0,pB1;
  int sl_prev=0,sl_cur=0,sl_next=SLOTB;
  #define ROT() do{sl_prev=sl_cur;sl_cur=sl_next;sl_next=(sl_next==(NSLOT-1)*SLOTB)?0:sl_next+SLOTB;}while(0)
  DMA_K(2,2*SLOTB);
  WAIT_BAR(3);
  qkt(pA0,pA1,Kbase,qr,negm,r32,hi);asm volatile("s_nop 15\n\ts_nop 7":"+v"(pA0),"+v"(pA1));CMASK(pA0,pA1,0);
  START(pA0,pA1);
  _Pragma("unroll") for(int r=0;r<16;++r)pA1[r]=__builtin_amdgcn_exp2f(pA1[r]);
  WAIT_BAR(0);
  DMA_K(3,0);DMA_V(1,SLOTB);
  ROT();
  kload8(kf,kp0+sl_cur);
  WAIT_BAR(2);
  s16x4 vlo[8],vhi[8]; u32x4 pw0,pw1,pw2,pw3;
  #define PKW(P,B) cvtpk_s(P[B],P[B+1])
  #define PAF(k) __builtin_bit_cast(bf16x8,pw##k)
  #define VFR(i) (bf16x8){vlo[i][0],vlo[i][1],vlo[i][2],vlo[i][3],vhi[i][0],vhi[i][1],vhi[i][2],vhi[i][3]}
  #define PIN(x) asm volatile("":"+v"(x))
  #define MX3(a,b,c) __builtin_fmaxf(__builtin_fmaxf((a),(b)),(c))
  #define GAPA(MF,A0,A1,A2,A3,W0,W1,PW) do{ MF; sacc+=A0; sacc+=A1; sacc+=A2; sacc+=A3; PIN(sacc); W0; W1; PIN(PW); SBAR(); }while(0)
  #define EX(v) __builtin_amdgcn_exp2f(v)
  #define GAPB(MF,X,B) do{ MF; X[B]=EX(X[B]); X[B+1]=EX(X[B+1]); X[B+2]=EX(X[B+2]); X[B+3]=EX(X[B+3]); PIN(X); SBAR(); }while(0)
  #define VRD(i) do{ vlo[i]=vtr(vp_+(((i)>>2)*4096+((i)&3)*1024)); vhi[i]=vtr(vp_+(((i)>>2)*4096+((i)&3)*1024+512)); }while(0)
  #define KRD(G,j) do{ if(G){ kload2(kf,kp0+sl_next,j); SBAR(); } }while(0)
  #define STEP(C0,C1,P0,P1,t,GK,GV,GL) do{ SBAR(); \
    const lds_cptr vp_=vp0+sl_prev; \
    VRD(0); SBAR(); float sacc=(P0[0]+P0[1]); \
    GAPA(C0=__builtin_amdgcn_mfma_f32_32x32x16_bf16(kf[0],qr[0],negm,0,0,0), P0[2],P0[3],P0[4],P0[5],     pw0[0]=PKW(P0,0), pw0[1]=PKW(P0,2), pw0); \
    VRD(4); SBAR(); GAPA(C1=__builtin_amdgcn_mfma_f32_32x32x16_bf16(kf[1],qr[0],negm,0,0,0), P0[6],P0[7],P0[8],P0[9],     pw0[2]=PKW(P0,4), pw0[3]=PKW(P0,6), pw0); \
    VRD(1); SBAR(); GAPA(C0=__builtin_amdgcn_mfma_f32_32x32x16_bf16(kf[2],qr[1],C0,0,0,0),   P0[10],P0[11],P0[12],P0[13], pw1[0]=PKW(P0,8), pw1[1]=PKW(P0,10), pw1); \
    VRD(5); SBAR(); GAPA(C1=__builtin_amdgcn_mfma_f32_32x32x16_bf16(kf[3],qr[1],C1,0,0,0),   P0[14],P0[15],P1[0],P1[1],   pw1[2]=PKW(P0,12),pw1[3]=PKW(P0,14), pw1); \
    VRD(2); SBAR(); GAPA(C0=__builtin_amdgcn_mfma_f32_32x32x16_bf16(kf[4],qr[2],C0,0,0,0),   P1[2],P1[3],P1[4],P1[5],     pw2[0]=PKW(P1,0), pw2[1]=PKW(P1,2), pw2); \
    VRD(6); SBAR(); GAPA(C1=__builtin_amdgcn_mfma_f32_32x32x16_bf16(kf[5],qr[2],C1,0,0,0),   P1[6],P1[7],P1[8],P1[9],     pw2[2]=PKW(P1,4), pw2[3]=PKW(P1,6), pw2); \
    VRD(3); SBAR(); GAPA(C0=__builtin_amdgcn_mfma_f32_32x32x16_bf16(kf[6],qr[3],C0,0,0,0),   P1[10],P1[11],P1[12],P1[13], pw3[0]=PKW(P1,8), pw3[1]=PKW(P1,10), pw3); \
    VRD(7); SBAR(); GAPA(C1=__builtin_amdgcn_mfma_f32_32x32x16_bf16(kf[7],qr[3],C1,0,0,0),   P1[14],P1[15],0.f,0.f,       pw3[2]=PKW(P1,12),pw3[3]=PKW(P1,14), pw3); \
    l_reg+=sacc; \
    if(GK){DMA_K((t)+3,sl_cur);} if(GV){DMA_V((t)+1,sl_next);} \
    CMASK(C0,C1,t); \
    { float a=MX3(C0[0],C0[1],C1[0]),b=MX3(C0[2],C0[3],C1[1]); a=MX3(a,C1[2],C1[3]); \
      _Pragma("unroll") for(int r=4;r<16;r+=4){a=MX3(a,C0[r],C0[r+1]);b=MX3(b,C0[r+2],C0[r+3]);a=MX3(a,C1[r],C1[r+1]);b=MX3(b,C1[r+2],C1[r+3]);} \
      float rm=__builtin_fmaxf(a,b); { auto rr=__builtin_amdgcn_permlane32_swap(__float_as_uint(rm),__float_as_uint(rm),false,false); rm=__builtin_fmaxf(__uint_as_float(rr[0]),__uint_as_float(rr[1])); } \
      resc=false; \
      if(__builtin_expect(__any(rm>(float)THRL),0)){ const float dl=__builtin_fmaxf(rm,0.f); mhat+=dl; \
        _Pragma("unroll") for(int r=0;r<16;++r){C0[r]-=dl;C1[r]-=dl;} \
        _Pragma("unroll") for(int r=0;r<16;++r)negm[r]=-mhat; asm volatile("":"+v"(negm)); \
        const float f=__builtin_amdgcn_exp2f(-dl); l_reg*=f; if(hi==0)wsf[r32]=f; resc=true; } } \
    SBAR(); \
    GAPB(o[0]=__builtin_amdgcn_mfma_f32_32x32x16_bf16(PAF(0),VFR(0),o[0],0,0,0), C0,0); \
    GAPB(o[1]=__builtin_amdgcn_mfma_f32_32x32x16_bf16(PAF(0),VFR(4),o[1],0,0,0), C0,4); \
    KRD(GL,0); GAPB(o[0]=__builtin_amdgcn_mfma_f32_32x32x16_bf16(PAF(1),VFR(1),o[0],0,0,0), C0,8); \
    KRD(GL,1); GAPB(o[1]=__builtin_amdgcn_mfma_f32_32x32x16_bf16(PAF(1),VFR(5),o[1],0,0,0), C0,12); \
    KRD(GL,2); GAPB(o[0]=__builtin_amdgcn_mfma_f32_32x32x16_bf16(PAF(2),VFR(2),o[0],0,0,0), C1,0); \
    KRD(GL,3); GAPB(o[1]=__builtin_amdgcn_mfma_f32_32x32x16_bf16(PAF(2),VFR(6),o[1],0,0,0), C1,4); \
    GAPB(o[0]=__builtin_amdgcn_mfma_f32_32x32x16_bf16(PAF(3),VFR(3),o[0],0,0,0), C1,8); \
    GAPB(o[1]=__builtin_amdgcn_mfma_f32_32x32x16_bf16(PAF(3),VFR(7),o[1],0,0,0), C1,12); \
    }while(0)
  int t=1;
  #undef CMASK
  #define CMASK(P0,P1,t) do{}while(0)
  for(;t+5<NT;t+=2){
    STEP(pB0,pB1,pA0,pA1,t,true,true,true);     WAIT_BAR(2); RESC(); ROT();
    STEP(pA0,pA1,pB0,pB1,t+1,true,true,true);   WAIT_BAR(2); RESC(); ROT();
  }
  #undef CMASK
  #define CMASK(P0,P1,t) do{int jb_=(t)-(NT-4); if(jb_>=0)cmask(P0,P1,jb_,qrel,hi);}while(0)
  #define ENDW(tt) do{ if((tt)+3<NT){WAIT_BAR(2);} else if((tt)+2<NT){WAIT_BAR(1);} else {WAIT_BAR(0);} }while(0)
  for(;t+1<NT;t+=2){
    STEP(pB0,pB1,pA0,pA1,t,(t+3<NT),(t+1<NT),(t+1<NT));       ENDW(t);   RESC(); ROT();
    STEP(pA0,pA1,pB0,pB1,t+1,(t+4<NT),(t+2<NT),(t+2<NT));     ENDW(t+1); RESC(); ROT();
  }
  STEP(pB0,pB1,pA0,pA1,NT-1,false,false,false); RESC();
  { float sacc=pB0[0]+pB0[1]; _Pragma("unroll") for(int r=2;r<16;++r)sacc+=pB0[r]; _Pragma("unroll") for(int r=0;r<16;++r)sacc+=pB1[r]; l_reg+=sacc;
    pw0=(u32x4){PKW(pB0,0),PKW(pB0,2),PKW(pB0,4),PKW(pB0,6)};pw1=(u32x4){PKW(pB0,8),PKW(pB0,10),PKW(pB0,12),PKW(pB0,14)};pw2=(u32x4){PKW(pB1,0),PKW(pB1,2),PKW(pB1,4),PKW(pB1,6)};pw3=(u32x4){PKW(pB1,8),PKW(pB1,10),PKW(pB1,12),PKW(pB1,14)};
    SBAR(); pv(o,vb0+sl_cur,PAF(0),PAF(1),PAF(2),PAF(3)); }
  #undef PKW
  #undef PAF
  #undef VFR
  #undef PIN
  #undef MX3
  #undef GAPA
  #undef GAPB
  #undef EX
  #undef VRD
  #undef KRD
  #undef STEP
  #undef ENDW
  {auto rr=__builtin_amdgcn_permlane32_swap(__float_as_uint(l_reg),__float_as_uint(l_reg),false,false);l_reg=__uint_as_float(rr[0])+__uint_as_float(rr[1]);}
  if(hi==0)wsf[32+r32]=l_reg;asm volatile("s_waitcnt lgkmcnt(0)":::"memory");
  float rli[16];
  #pragma unroll
  for(int r=0;r<16;++r)rli[r]=__builtin_amdgcn_rcpf(wsf[32+crow(r,hi)]);
  bf16*Ow=O+(rowbase+q0+wid*QBLK)*DMO+colo;
  { bf16*stg=(bf16*)(shm+LDS_OST)+wid*2048;
    #pragma unroll
    for(int r=0;r<16;++r){const int orow=crow(r,hi);
      #pragma unroll
      for(int d0=0;d0<2;++d0)stg[orow*64+d0*32+r32]=__float2bfloat16(o[d0][r]*rli[r]);}
    asm volatile("s_waitcnt lgkmcnt(0)":::"memory");
    #pragma unroll
    for(int i=0;i<4;++i){const int row=i*8+(lane>>3),ch=lane&7; const u32x4 v=*(const u32x4*)(stg+row*64+ch*8); ATTN_STORE16(Ow+(long)row*DMO+ch*8,v);} }
  asm volatile("s_waitcnt lgkmcnt(0)\n\ts_barrier":::"memory");
  #undef DMA_K
  #undef DMA_V
  #undef CMASK
  #undef START
  #undef RESC
  #undef ROT
}
constexpr int ATTN_LDS_BYTES=LDS_BYTES;
#undef SBAR
#undef WAIT_BAR
}
#define LAS __attribute__((address_space(3)))
typedef unsigned short u16;
typedef unsigned v4u __attribute__((ext_vector_type(4)));
typedef unsigned v2u __attribute__((ext_vector_type(2)));
typedef float f32x4 __attribute__((ext_vector_type(4)));
typedef short bf16x8 __attribute__((ext_vector_type(8)));
typedef short s16x4 __attribute__((ext_vector_type(4)));
typedef float f32x16 __attribute__((ext_vector_type(16)));
typedef float f32x2_t __attribute__((ext_vector_type(2)));
typedef __bf16 bf16x2_t __attribute__((ext_vector_type(2)));

constexpr int MTOK = 32768, SEQL = 8192, DMODEL = 1024, FFD = 4096, NIN0 = 3584, NIN1 = 3072, PLE = 256;
constexpr float LN_EPS = 1e-5f;
constexpr float ALPHA = 1.4142135623730951f;
constexpr size_t MiB = 1u << 20;
constexpr size_t WS_CVEC = 0;
constexpr size_t WS_STATS = 62 * MiB;
constexpr size_t WS_ROWSS = 63 * MiB;
constexpr size_t WS_BAR = 256 * 1024;
constexpr size_t WS_MISC = 512 * 1024;
constexpr size_t WS_CS = 1 * MiB;
constexpr size_t WS_WIN0 = 2 * MiB, WS_WOUT0 = 9 * MiB, WS_WIN1 = 11 * MiB, WS_WOUT1 = 17 * MiB, WS_W1 = 19 * MiB  , WS_W2 = 35 * MiB  , WS_WP = 51 * MiB  , WS_WG = 52 * MiB  ;
constexpr size_t WS_LSE = 56 * MiB;
constexpr size_t WS_XB = 64 * MiB, WS_MIX = 128 * MiB, WS_HB = 192 * MiB, WS_AUX = 448 * MiB, WS_END = 512 * MiB;
constexpr size_t WS_HGS = 416 * MiB, WS_HGD = 432 * MiB;
constexpr size_t WS_OB1 = 384 * MiB;
constexpr int LDS_BYTES = 147456;

__device__ __forceinline__ unsigned f2bf(float f) { unsigned u = __builtin_bit_cast(unsigned, f); return (u + 0x7fffu + ((u >> 16) & 1u)) >> 16; }
__device__ __forceinline__ unsigned pk2(float lo, float hi) { f32x2_t v = {lo, hi}; bf16x2_t b = __builtin_convertvector(v, bf16x2_t); return __builtin_bit_cast(unsigned, b); }
__device__ __forceinline__ float bf2f(unsigned v) { return __uint_as_float(v << 16); }
__device__ __forceinline__ float bflo(unsigned w) { return __uint_as_float(w << 16); }
__device__ __forceinline__ float bfhi(unsigned w) { return __uint_as_float(w & 0xffff0000u); }
__device__ __forceinline__ float shx(float v, int m, int lane) { return __builtin_bit_cast(float, __builtin_amdgcn_ds_bpermute((lane ^ m) << 2, __builtin_bit_cast(int, v))); }
__device__ __forceinline__ float wave_sum(float v, int lane) {
#pragma unroll
    for (int o = 1; o < 64; o <<= 1) v += shx(v, o, lane);
    return v;
}
__device__ __forceinline__ int crow(int reg, int h) { return (reg & 3) + 8 * (reg >> 2) + 4 * h; }
#define MFMA32(a, b, c) __builtin_amdgcn_mfma_f32_32x32x16_bf16((a), (b), (c), 0, 0, 0)
__device__ __forceinline__ bf16x8 pack8(const f32x16& x, int base) {
    v4u p; p.x = pk2(x[base], x[base + 1]); p.y = pk2(x[base + 2], x[base + 3]); p.z = pk2(x[base + 4], x[base + 5]); p.w = pk2(x[base + 6], x[base + 7]);
    return __builtin_bit_cast(bf16x8, p);
}
typedef short v4i16_t __attribute__((ext_vector_type(4)));
__device__ __forceinline__ s16x4 trrd(LAS unsigned char* p) { return __builtin_bit_cast(s16x4, __builtin_amdgcn_ds_read_tr16_b64_v4i16((LAS v4i16_t*)p)); }
__device__ __forceinline__ bf16x8 trfrag(LAS unsigned char* img, int pitch, int row_lo, int hi_delta, int col0, int lane) {
    const int i16 = lane & 15, q = i16 >> 2, p = i16 & 3, g16 = (lane >> 4) & 1;
    LAS unsigned char* a = img + (row_lo + q) * pitch + (col0 + 16 * g16 + 4 * p) * 2;
    const s16x4 lo = trrd(a), hi = trrd(a + hi_delta * pitch);
    return (bf16x8){lo[0], lo[1], lo[2], lo[3], hi[0], hi[1], hi[2], hi[3]};
}

struct Args {
    const float *x, *p, *ev_w_in, *ev_w_out, *da_lambda, *da_subln_g, *hg_lb_logits, *hg_norm_g, *od_w_in, *od_w_out, *ln1_g, *ln1_b, *ffn_w1, *ffn_w2, *ln2_g, *ln2_b, *ple_w_proj, *ple_w_gate, *ple_norm_g;
    float* out; unsigned char* ws;
};

__device__ __forceinline__ void p0_transpose_item(const float* W, int K, int N, u16* WT, LAS float* scr, int item, int lane, const float* gk = nullptr, const float* bk = nullptr, float* c1 = nullptr, float* c2 = nullptr) {
    const int nblk = N / 32, kb = item / nblk, nb = item % nblk, k0 = 64 * kb, n0 = 32 * nb;
#pragma unroll 8
    for (int i = 0; i < 32; ++i) { const int kk = 2 * i + (lane >> 5); scr[kk * 33 + (lane & 31)] = W[(size_t)(k0 + kk) * N + n0 + (lane & 31)]; }
    asm volatile("s_waitcnt lgkmcnt(0)" ::: "memory");
    const int c = lane & 7;
    float gs[8];
#pragma unroll
    for (int e = 0; e < 8; ++e) gs[e] = gk ? gk[k0 + 8 * c + e] : 1.f;
    if (gk) {
        const int n = lane & 31, kh = (lane >> 5) * 32; float s1 = 0.f, s2 = 0.f;
#pragma unroll 8
        for (int kk = 0; kk < 32; ++kk) { const float wv = scr[(kh + kk) * 33 + n]; s1 += gk[k0 + kh + kk] * wv; s2 += bk[k0 + kh + kk] * wv; }
        s1 += shx(s1, 32, lane); s2 += shx(s2, 32, lane);
        if (lane < 32) { atomicAdd(c1 + n0 + n, s1); atomicAdd(c2 + n0 + n, s2); }
    }
#pragma unroll
    for (int j = 0; j < 4; ++j) { const int n = (lane >> 3) + 8 * j; const LAS float* sp = scr + (8 * c) * 33 + n;
        v4u o; o.x = pk2(sp[0 * 33] * gs[0], sp[1 * 33] * gs[1]); o.y = pk2(sp[2 * 33] * gs[2], sp[3 * 33] * gs[3]); o.z = pk2(sp[4 * 33] * gs[4], sp[5 * 33] * gs[5]); o.w = pk2(sp[6 * 33] * gs[6], sp[7 * 33] * gs[7]);
        *(v4u*)(WT + (size_t)(n0 + n) * K + k0 + 8 * c) = o; }
    asm volatile("s_waitcnt lgkmcnt(0)" ::: "memory");
}
__device__ __forceinline__ void prologue(const Args& A, LAS unsigned char* lds, int gw, int NGW, int wave, int lane) {
    unsigned char* ws = A.ws;
    LAS float* scr = (LAS float*)(lds + wave * 16384);
    const int cnt[12] = {(1024 / 64) * (NIN0 / 32), 512, (1024 / 64) * (NIN1 / 32), 512, 2048, 2048, 2048, 2048, 128, 128, 512, 512};
    int total = 0;
#pragma unroll
    for (int i = 0; i < 12; ++i) total += cnt[i];
    for (int it = gw; it < total; it += NGW) {
        int r = it;
        if (r < cnt[0]) { p0_transpose_item(A.ev_w_in, 1024, NIN0, (u16*)(ws + WS_WIN0), scr, r, lane); continue; } r -= cnt[0];
        if (r < cnt[1]) { p0_transpose_item(A.ev_w_out, 1024, 1024, (u16*)(ws + WS_WOUT0), scr, r, lane); continue; } r -= cnt[1];
        if (r < cnt[2]) { p0_transpose_item(A.od_w_in, 1024, NIN1, (u16*)(ws + WS_WIN1), scr, r, lane); continue; } r -= cnt[2];
        if (r < cnt[3]) { p0_transpose_item(A.od_w_out, 1024, 1024, (u16*)(ws + WS_WOUT1), scr, r, lane); continue; } r -= cnt[3];
        if (r < 4096) { const int l = r >> 11; float* cv = (float*)(ws + WS_CVEC) + l * 10240; p0_transpose_item(A.ffn_w1 + (size_t)l * 1024 * 4096, 1024, 4096, (u16*)(ws + WS_W1 + l * 8 * MiB), scr, r & 2047, lane, A.ln1_g + l * 1024, A.ln1_b + l * 1024, cv, cv + 4096); continue; } r -= 4096;
        if (r < 4096) { const int l = r >> 11; p0_transpose_item(A.ffn_w2 + (size_t)l * 1024 * 4096, 4096, 1024, (u16*)(ws + WS_W2 + l * 8 * MiB), scr, r & 2047, lane); continue; } r -= 4096;
        if (r < 256) { const int l = r >> 7; p0_transpose_item(A.ple_w_proj + (size_t)l * 256 * 1024, 256, 1024, (u16*)(ws + WS_WP + l * (MiB / 2)), scr, r & 127, lane); continue; } r -= 256;
        { const int l = r >> 9; float* cv = (float*)(ws + WS_CVEC) + l * 10240 + 8192; p0_transpose_item(A.ple_w_gate + (size_t)l * 1024 * 1024, 1024, 1024, (u16*)(ws + WS_WG + l * 2 * MiB), scr, r & 511, lane, A.ln2_g + l * 1024, A.ln2_b + l * 1024, cv, cv + 1024); }
    }
    u16* XB = (u16*)(ws + WS_XB);
    for (int m = gw; m < MTOK; m += NGW) {
        const f32x4* xr = (const f32x4*)(A.x + (size_t)m * 1024) + lane; v2u* o = (v2u*)(XB + (size_t)m * 1024) + lane;
#pragma unroll
        for (int j = 0; j < 4; ++j) { const f32x4 v = xr[64 * j]; v2u w; w.x = pk2(v[0], v[1]); w.y = pk2(v[2], v[3]); o[64 * j] = w; }
    }
    { v4u* z = (v4u*)(ws + WS_STATS); for (int i = gw * 64 + lane; i < (int)((MiB + 256 * 1024) / 16); i += NGW * 64) z[i] = (v4u){0u, 0u, 0u, 0u}; }
    float* cs = (float*)(ws + WS_CS);
    for (int idx = gw * 64 + lane; idx < 65536; idx += NGW * 64) {
        const int pos = idx >> 3, e = idx & 7;
        double iv = 1.0;
#pragma unroll 1
        for (int k = 0; k < e; ++k) iv *= 0.19392274474868576;
        const float inv = (float)iv;
        const float angf = (float)pos * inv;
        double a = (double)angf; const double twopi = 6.283185307179586476925;
        const double kq = __builtin_rint(a / twopi); a -= kq * twopi;
        const double a2 = a * a; double sn = 0.0, cn = 0.0;
        double ts = a, tc = 1.0;
#pragma unroll 1
        for (int n = 0; n < 16; ++n) { cn += tc; sn += ts; tc *= -a2 / (double)((2 * n + 1) * (2 * n + 2)); ts *= -a2 / (double)((2 * n + 2) * (2 * n + 3)); }
        cs[idx] = (float)cn; cs[65536 + idx] = (float)sn;
    }
    float* misc = (float*)(ws + WS_MISC);
    for (int i = gw * 64 + lane; i < 512; i += NGW * 64) { const float l0 = A.hg_lb_logits[i], l1 = A.hg_lb_logits[512 + i]; misc[i] = 1.f / (1.f + __expf(l1 - l0)); }
}

__device__ __forceinline__ void ln_rows(float* X, u16* XBo, const float* g, const float* bta, float* rowss, const float* prow, u16* PBo, int gw, int NGW, int lane) {
    for (int m = gw; m < MTOK; m += NGW) {
        f32x4* xr = (f32x4*)(X + (size_t)m * 1024) + lane;
        f32x4 v[4]; float s = 0.f;
#pragma unroll
        for (int j = 0; j < 4; ++j) { v[j] = xr[64 * j]; s += (v[j][0] + v[j][1]) + (v[j][2] + v[j][3]); }
        const float mean = wave_sum(s, lane) * (1.f / 1024.f); float s2 = 0.f;
#pragma unroll
        for (int j = 0; j < 4; ++j) { v[j] = v[j] - mean; s2 += (v[j][0] * v[j][0] + v[j][1] * v[j][1]) + (v[j][2] * v[j][2] + v[j][3] * v[j][3]); }
        const float rstd = 1.f / sqrtf(wave_sum(s2, lane) * (1.f / 1024.f) + LN_EPS);
        v2u* o8 = (v2u*)(XBo + (size_t)m * 1024) + lane;
#pragma unroll
        for (int j = 0; j < 4; ++j) { const f32x4 gv = ((const f32x4*)g)[lane + 64 * j], bv = ((const f32x4*)bta)[lane + 64 * j];
            const f32x4 o = v[j] * rstd * gv + bv; xr[64 * j] = o; v2u w; w.x = pk2(o[0], o[1]); w.y = pk2(o[2], o[3]); o8[64 * j] = w; }
        if (rowss && lane == 0) rowss[m] = 0.f;
        if (prow) { const f32x4 pv = ((const f32x4*)(prow + (size_t)m * 256))[lane]; v2u w; w.x = pk2(pv[0], pv[1]); w.y = pk2(pv[2], pv[3]); ((v2u*)(PBo + (size_t)m * 256))[lane] = w; }
    }
}
__device__ __forceinline__ void p_rows(const float* prow, u16* PBo, int gw, int NGW, int lane) {
    for (int m = gw; m < MTOK; m += NGW) { const f32x4 pv = ((const f32x4*)(prow + (size_t)m * 256))[lane]; v2u w; w.x = pk2(pv[0], pv[1]); w.y = pk2(pv[2], pv[3]); ((v2u*)(PBo + (size_t)m * 256))[lane] = w; }
}
__device__ __forceinline__ void diff_combine(const u16* AUX, u16* MIX, const float* lam_p, const float* subg, int gw, int NGW, int lane) {
    const float s01 = wave_sum(lam_p[lane] * lam_p[64 + lane], lane), s23 = wave_sum(lam_p[128 + lane] * lam_p[192 + lane], lane);
    const float lam = __expf(s01) - __expf(s23) + 0.2f;
    const int h = lane >> 4, d0 = (lane & 15) * 8;
    float gv[8];
#pragma unroll
    for (int e = 0; e < 8; ++e) gv[e] = subg[d0 + e] * 0.8f;
    for (int m = gw; m < MTOK; m += NGW) {
        const v4u a0 = *(const v4u*)(AUX + (size_t)m * 1024 + h * 256 + d0), a1 = *(const v4u*)(AUX + (size_t)m * 1024 + h * 256 + 128 + d0);
        float o[8];
        o[0] = bflo(a0.x) - lam * bflo(a1.x); o[1] = bfhi(a0.x) - lam * bfhi(a1.x); o[2] = bflo(a0.y) - lam * bflo(a1.y); o[3] = bfhi(a0.y) - lam * bfhi(a1.y);
        o[4] = bflo(a0.z) - lam * bflo(a1.z); o[5] = bfhi(a0.z) - lam * bfhi(a1.z); o[6] = bflo(a0.w) - lam * bflo(a1.w); o[7] = bfhi(a0.w) - lam * bfhi(a1.w);
        float ss = 0.f;
#pragma unroll
        for (int e = 0; e < 8; ++e) ss += o[e] * o[e];
        ss += shx(ss, 1, lane); ss += shx(ss, 2, lane); ss += shx(ss, 4, lane); ss += shx(ss, 8, lane);
        const float rs = 1.f / sqrtf(ss * (1.f / 128.f) + LN_EPS);
        v4u w; w.x = pk2(o[0] * rs * gv[0], o[1] * rs * gv[1]); w.y = pk2(o[2] * rs * gv[2], o[3] * rs * gv[3]); w.z = pk2(o[4] * rs * gv[4], o[5] * rs * gv[5]); w.w = pk2(o[6] * rs * gv[6], o[7] * rs * gv[7]);
        *(v4u*)(MIX + (size_t)m * 1024 + h * 128 + d0) = w;
    }
}
namespace hg {
constexpr int P_QA = 272, P_QO = 264, P_TR = 320;
constexpr int O_QA = 0, O_KA = O_QA + 64 * P_QA, O_QO = O_KA + 64 * P_QA, O_KST = O_QO + 64 * P_QO, O_V = O_KST + 64 * P_TR, O_OST = O_V + 64 * P_TR, O_TOT = O_OST + 64 * 132 * 4, O_DEC = O_TOT + 2048, O_END = O_DEC + 512;
static_assert(O_END <= 131072, "hgrn lds");
template <bool OUT>
__device__ __forceinline__ void item(LAS unsigned char* L, const u16* __restrict__ H, int it, const float* __restrict__ lbv, float* Send, float* Drun, const float* __restrict__ outg, u16* MIX, const int tid) {
    const int  lane = tid & 63, w = __builtin_amdgcn_readfirstlane(tid >> 6), r = lane & 31, h = lane >> 5;
    const int tt = w & 1, vt = w >> 1;
    const int bh = it >> 4, run = it & 15, b = bh >> 2, hh = bh & 3;
    const int kd = tid & 127, seg = tid >> 7;
    const size_t row0 = (size_t)b * 8192 + (size_t)run * 512;
    const float lb = lbv[hh * 128 + kd];
    LAS float* TOT = (LAS float*)(L + O_TOT); LAS float* DEC = (LAS float*)(L + O_DEC); LAS float* OST = (LAS float*)(L + O_OST);
    f32x16 S[4];
#pragma unroll
    for (int k = 0; k < 4; ++k) S[k] = f32x16{};
    if (OUT) {
        for (int rp = 0; rp < run; ++rp) { const int ip = bh * 16 + rp;
#pragma unroll
            for (int k = 0; k < 4; ++k)
#pragma unroll
                for (int i = 0; i < 16; ++i) S[k][i] = Drun[ip * 128 + 32 * k + crow(i, h)] * S[k][i] + Send[((((size_t)ip * 4 + vt) * 4 + k) * 16 + i) * 64 + lane];
        }
    }
    float bsum = 0.f;
    for (int ch = 0; ch < 8; ++ch) {
        const size_t rowc = row0 + ch * 64;
        float fg[16], cs[16], hq[16];
#pragma unroll
        for (int i = 0; i < 16; ++i) { const u16* p = H + (rowc + seg * 16 + i) * NIN0 + hh * 128 + kd; fg[i] = bf2f(p[2048]); if (OUT) hq[i] = bf2f(p[1536]); }
#pragma unroll
        for (int n = 0; n < 2; ++n) { const int id = tid + 512 * n, t = id >> 4, c = id & 15;
            const v4u v = *(const v4u*)(H + (rowc + t) * NIN0 + 2560 + hh * 128 + c * 8); *(LAS v4u*)(L + O_V + t * P_TR + c * 16) = v; }
        float runs = 0.f;
#pragma unroll
        for (int i = 0; i < 16; ++i) { const float sg = 1.f / (1.f + __expf(-fg[i])); const float f = lb + (1.f - lb) * sg; fg[i] = (1.f - lb) * (1.f - sg); runs += __logf(f); cs[i] = runs; }
        TOT[seg * 128 + kd] = runs;
        __syncthreads();
        const float t0 = TOT[kd], t1 = TOT[128 + kd], t2 = TOT[256 + kd], t3 = TOT[384 + kd];
        const float off = (seg > 0 ? t0 : 0.f) + (seg > 1 ? t1 : 0.f) + (seg > 2 ? t2 : 0.f);
        const float bmid = t0 + t1, blast = (t0 + t1) + (t2 + t3);
        const float elm = __expf(blast - bmid), em = __expf(bmid);
#pragma unroll
        for (int i = 0; i < 16; ++i) {
            const int t = seg * 16 + i; const float bi = off + cs[i];
            const float e1 = __expf(bi - bmid), e2 = __expf(bmid - bi); const float kk = fg[i];
            *(LAS u16*)(L + O_KST + t * P_TR + kd * 2) = (u16)f2bf(kk * e2 * elm);
            if (OUT) { const float q = hq[i] / (1.f + __expf(-hq[i]));
                *(LAS u16*)(L + O_QA + t * P_QA + kd * 2) = (u16)f2bf(q * e1);
                *(LAS u16*)(L + O_KA + t * P_QA + kd * 2) = (u16)f2bf(kk * e2);
                *(LAS u16*)(L + O_QO + t * P_QO + kd * 2) = (u16)f2bf(q * e1 * em); }
        }
        if (seg == 0) { DEC[kd] = __expf(blast); bsum += blast; }
        __syncthreads();
        if (OUT) {
            f32x16 acc = f32x16{};
            for (int st = 0; st <= tt; ++st) {
                f32x16 X = f32x16{};
#pragma unroll
                for (int ks = 0; ks < 8; ++ks) { const bf16x8 a = *(LAS bf16x8*)(L + O_KA + (32 * st + r) * P_QA + (16 * ks + 8 * h) * 2); const bf16x8 bq = *(LAS bf16x8*)(L + O_QA + (32 * tt + r) * P_QA + (16 * ks + 8 * h) * 2); X = MFMA32(a, bq, X); }
                if (st == tt) {
#pragma unroll
                    for (int i = 0; i < 16; ++i) if (crow(i, h) > r) X[i] = 0.f; }
#pragma unroll
                for (int s2 = 0; s2 < 2; ++s2) { const bf16x8 pa = pack8(X, 8 * s2); const bf16x8 vf = trfrag(L + O_V, P_TR, 32 * st + 16 * s2 + 4 * h, 8, 32 * vt, lane); acc = MFMA32(pa, vf, acc); }
            }
#pragma unroll
            for (int k = 0; k < 4; ++k)
#pragma unroll
                for (int s2 = 0; s2 < 2; ++s2) {
                    LAS unsigned char* qp = L + O_QO + (32 * tt + r) * P_QO + (32 * k + 16 * s2 + 4 * h) * 2;
                    const s16x4 lo = *(LAS s16x4*)qp, hi = *(LAS s16x4*)(qp + 16);
                    const bf16x8 a2 = (bf16x8){lo[0], lo[1], lo[2], lo[3], hi[0], hi[1], hi[2], hi[3]};
                    acc = MFMA32(a2, pack8(S[k], 8 * s2), acc); }
#pragma unroll
            for (int i = 0; i < 16; ++i) OST[(32 * tt + crow(i, h)) * 132 + 32 * vt + r] = acc[i];
        }
#pragma unroll
        for (int k = 0; k < 4; ++k) {
#pragma unroll
            for (int i = 0; i < 16; ++i) S[k][i] *= DEC[32 * k + crow(i, h)];
#pragma unroll
            for (int ks = 0; ks < 4; ++ks) { const bf16x8 a = trfrag(L + O_KST, P_TR, 16 * ks + 8 * h, 4, 32 * k, lane); const bf16x8 bv = trfrag(L + O_V, P_TR, 16 * ks + 8 * h, 4, 32 * vt, lane); S[k] = MFMA32(a, bv, S[k]); }
        }
        __syncthreads();
        if (OUT) {
            const int t = tid >> 3, c8 = tid & 7; float o[16]; float ss = 0.f;
#pragma unroll
            for (int j = 0; j < 4; ++j) { const f32x4 v = *(LAS f32x4*)(OST + t * 132 + c8 * 16 + 4 * j); o[4 * j] = v[0]; o[4 * j + 1] = v[1]; o[4 * j + 2] = v[2]; o[4 * j + 3] = v[3]; ss += (v[0] * v[0] + v[1] * v[1]) + (v[2] * v[2] + v[3] * v[3]); }
            ss += shx(ss, 1, lane); ss += shx(ss, 2, lane); ss += shx(ss, 4, lane);
            const float rs = 1.f / sqrtf(ss * (1.f / 128.f) + LN_EPS);
            const u16* gp = H + (rowc + t) * NIN0 + 3072 + hh * 128 + c8 * 16; u16* op = MIX + (rowc + t) * 1024 + 512 + hh * 128 + c8 * 16;
#pragma unroll
            for (int j = 0; j < 2; ++j) { const v4u gvv = *(const v4u*)(gp + 8 * j); const unsigned gw_[4] = {gvv.x, gvv.y, gvv.z, gvv.w}; unsigned ow[4];
#pragma unroll
                for (int e = 0; e < 4; ++e) { const float g0 = bflo(gw_[e]), g1 = bfhi(gw_[e]); const int c = 8 * j + 2 * e;
                    const float y0 = o[c] * rs * outg[c8 * 16 + c] * (g0 / (1.f + __expf(-g0))), y1 = o[c + 1] * rs * outg[c8 * 16 + c + 1] * (g1 / (1.f + __expf(-g1)));
                    ow[e] = pk2(y0, y1); }
                *(v4u*)(op + 8 * j) = (v4u){ow[0], ow[1], ow[2], ow[3]}; }
        }
    }
    if (!OUT) {
        if (tt == 0) {
#pragma unroll
            for (int k = 0; k < 4; ++k)
#pragma unroll
                for (int i = 0; i < 16; ++i) Send[((((size_t)it * 4 + vt) * 4 + k) * 16 + i) * 64 + lane] = S[k][i]; }
        if (seg == 0) Drun[it * 128 + kd] = __expf(bsum);
    }
}
}

__device__ __forceinline__ void dil_task(LAS unsigned char* Lw, const u16* __restrict__ QKV, int task, u16* OBg0, u16* OBg1, u16* OBg2, float* LSE, int lane) {
    const int r = lane & 31, h = lane >> 5;
    const int bh = task / 768, rem = task - bh * 768, g = rem >> 8, j = rem & 255;
    const int sh = 2 * g, res = j >> (8 - sh), qt = j & ((256 >> sh) - 1);
    const int b = bh >> 4, hd = bh & 15;
    const size_t rowb = (size_t)b * 8192;
    const int qpos = res + ((32 * qt + r) << sh);
    const u16* qp = QKV + (rowb + qpos) * NIN1 + hd * 64;
    bf16x8 qf[4];
#pragma unroll
    for (int ks = 0; ks < 4; ++ks) qf[ks] = *(const bf16x8*)(qp + 16 * ks + 8 * h);
    f32x16 X[5];
#pragma unroll
    for (int kb = 0; kb < 5; ++kb) {
        int ki = 32 * qt - 128 + 32 * kb + r; ki = ki < 0 ? 0 : ki;
        const u16* kp = QKV + (rowb + res + (ki << sh)) * NIN1 + 1024 + hd * 64;
        X[kb] = f32x16{};
#pragma unroll
        for (int ks = 0; ks < 4; ++ks) { const bf16x8 kf = *(const bf16x8*)(kp + 16 * ks + 8 * h); X[kb] = MFMA32(kf, qf[ks], X[kb]); }
    }
    float m = -INFINITY;
#pragma unroll
    for (int kb = 0; kb < 5; ++kb)
#pragma unroll
        for (int i = 0; i < 16; ++i) { const int c = crow(i, h); bool valid = (32 * qt - 128 + 32 * kb + c) >= 0;
            if (kb == 0) valid = valid && (c >= r);
            if (kb == 4) valid = valid && (c <= r);
            X[kb][i] = valid ? X[kb][i] : -INFINITY; m = fmaxf(m, X[kb][i]); }
    m = fmaxf(m, shx(m, 32, lane));
    float l = 0.f;
#pragma unroll
    for (int kb = 0; kb < 5; ++kb)
#pragma unroll
        for (int i = 0; i < 16; ++i) { X[kb][i] = __builtin_amdgcn_exp2f(X[kb][i] - m); l += X[kb][i]; }
    l += shx(l, 32, lane);
    f32x16 y[2]; y[0] = f32x16{}; y[1] = f32x16{};
#pragma unroll
    for (int kb = 0; kb < 5; ++kb) {
#pragma unroll
        for (int n = 0; n < 4; ++n) { const int id = lane + 64 * n, key = id >> 3, c = id & 7; int ki = 32 * qt - 128 + 32 * kb + key; ki = ki < 0 ? 0 : ki;
            const v4u v = *(const v4u*)(QKV + (rowb + res + (ki << sh)) * NIN1 + 2048 + hd * 64 + c * 8); *(LAS v4u*)(Lw + key * 192 + c * 16) = v; }
#pragma unroll
        for (int s2 = 0; s2 < 2; ++s2) { const bf16x8 pb = pack8(X[kb], 8 * s2);
#pragma unroll
            for (int dt = 0; dt < 2; ++dt) { const bf16x8 a = trfrag(Lw, 192, 16 * s2 + 4 * h, 8, 32 * dt, lane); y[dt] = MFMA32(a, pb, y[dt]); } }
    }
    const float inv = 1.f / l;
    u16* ob = (g == 0 ? OBg0 : g == 1 ? OBg1 : OBg2) + (rowb + qpos) * 1024 + hd * 64;
#pragma unroll
    for (int dt = 0; dt < 2; ++dt)
#pragma unroll
        for (int gq = 0; gq < 4; ++gq) { v2u w; w.x = pk2(y[dt][4 * gq] * inv, y[dt][4 * gq + 1] * inv); w.y = pk2(y[dt][4 * gq + 2] * inv, y[dt][4 * gq + 3] * inv); *(v2u*)(ob + 32 * dt + 8 * gq + 4 * h) = w; }
    if (h == 0) LSE[((size_t)g * MTOK + rowb + qpos) * 16 + hd] = (m + __log2f(l)) * 0.6931471805599453f;
}
namespace dl {
constexpr int KP = 144, VP = 192, O_K = 0, O_V = 384 * KP, O_END = O_V + 384 * VP;
static_assert(O_END <= 131072, "dilated lds");
struct Dec { int g, sh, res, i0, hd; size_t rowb; };
__device__ __forceinline__ Dec decode(int task) {
    Dec d; const int bh = task / 96, rem = task - bh * 96; d.g = rem >> 5; const int j = rem & 31;
    d.sh = 2 * d.g; d.res = j >> (5 - d.sh); d.i0 = 256 * (j & ((32 >> d.sh) - 1)); d.hd = bh & 15; d.rowb = (size_t)(bh >> 4) * 8192; return d;
}
__device__ __forceinline__ void issue(const u16* __restrict__ QKV, int task, int tid, v4u (&pk)[6], v4u (&pv)[6], bf16x8 (&qn)[4]) {
    const Dec d = decode(task); const int lane = tid & 63, w = tid >> 6, r = lane & 31, h = lane >> 5;
#pragma unroll
    for (int n = 0; n < 6; ++n) { const int id = tid + 512 * n, c = id >> 3, ch = id & 7; int ki = d.i0 - 128 + c; ki = ki < 0 ? 0 : ki;
        const u16* src = QKV + (d.rowb + d.res + (ki << d.sh)) * NIN1 + d.hd * 64 + ch * 8;
        pk[n] = *(const v4u*)(src + 1024); pv[n] = *(const v4u*)(src + 2048); }
    const u16* qp = QKV + (d.rowb + d.res + ((d.i0 + 32 * w + r) << d.sh)) * NIN1 + d.hd * 64;
#pragma unroll
    for (int ks = 0; ks < 4; ++ks) qn[ks] = *(const bf16x8*)(qp + 16 * ks + 8 * h);
}
__device__ __forceinline__ void phase(LAS unsigned char* L, const u16* __restrict__ QKV, u16* OBg0, u16* OBg1, u16* OBg2, float* LSE, int first, int stride, const int tid) {
    const int lane = tid & 63, w = __builtin_amdgcn_readfirstlane(tid >> 6), r = lane & 31, h = lane >> 5;
    const bool xl = (stride == 256); const int nround = xl ? 24 : (6144 - first + stride - 1) / stride;
    if (first >= 6144) return;
#define DL_TASK(k) (xl ? (((first >> 5) * 8 + (k) / 3) * 96 + ((k) % 3) * 32 + (first & 31)) : (first + (k) * stride))
    v4u pk[6], pv[6]; bf16x8 qn[4];
    issue(QKV, DL_TASK(0), tid, pk, pv, qn);
    for (int kr = 0; kr < nround; ++kr) {
        const int task = DL_TASK(kr);
        const Dec d = decode(task);
#pragma unroll
        for (int n = 0; n < 6; ++n) { const int id = tid + 512 * n, c = id >> 3, ch = id & 7; *(LAS v4u*)(L + O_K + c * KP + ch * 16) = pk[n]; *(LAS v4u*)(L + O_V + c * VP + ch * 16) = pv[n]; }
        bf16x8 qf[4];
#pragma unroll
        for (int ks = 0; ks < 4; ++ks) qf[ks] = qn[ks];
        __syncthreads();
        if (kr + 1 < nround) issue(QKV, DL_TASK(kr + 1), tid, pk, pv, qn);
        const int i0 = d.i0, g = d.g, sh = d.sh;
        const int qpos = d.res + ((i0 + 32 * w + r) << sh);
        f32x16 X[5];
#pragma unroll
        for (int kb = 0; kb < 5; ++kb) {
            X[kb] = f32x16{};
#pragma unroll
            for (int ks = 0; ks < 4; ++ks) { const bf16x8 kf = *(LAS bf16x8*)(L + O_K + (32 * w + 32 * kb + r) * KP + (16 * ks + 8 * h) * 2); X[kb] = MFMA32(kf, qf[ks], X[kb]); }
        }
        float m = -INFINITY;
#pragma unroll
        for (int kb = 0; kb < 5; ++kb)
#pragma unroll
            for (int i = 0; i < 16; ++i) { const int c = crow(i, h); bool valid = (i0 - 128 + 32 * w + 32 * kb + c) >= 0;
                if (kb == 0) valid = valid && (c >= r);
                if (kb == 4) valid = valid && (c <= r);
                X[kb][i] = valid ? X[kb][i] : -INFINITY; m = fmaxf(m, X[kb][i]); }
        m = fmaxf(m, shx(m, 32, lane));
        float l = 0.f;
#pragma unroll
        for (int kb = 0; kb < 5; ++kb)
#pragma unroll
            for (int i = 0; i < 16; ++i) { X[kb][i] = __builtin_amdgcn_exp2f(X[kb][i] - m); l += X[kb][i]; }
        l += shx(l, 32, lane);
        f32x16 y[2]; y[0] = f32x16{}; y[1] = f32x16{};
#pragma unroll
        for (int kb = 0; kb < 5; ++kb)
#pragma unroll
            for (int s2 = 0; s2 < 2; ++s2) { const bf16x8 pb = pack8(X[kb], 8 * s2);
#pragma unroll
                for (int dt = 0; dt < 2; ++dt) { const bf16x8 a = trfrag(L + O_V, VP, 32 * w + 32 * kb + 16 * s2 + 4 * h, 8, 32 * dt, lane); y[dt] = MFMA32(a, pb, y[dt]); } }
        const float inv = 1.f / l;
        u16* ob = (g == 0 ? OBg0 : g == 1 ? OBg1 : OBg2) + (d.rowb + qpos) * 1024 + d.hd * 64;
#pragma unroll
        for (int dt = 0; dt < 2; ++dt)
#pragma unroll
            for (int gq = 0; gq < 4; ++gq) { v2u wv; wv.x = pk2(y[dt][4 * gq] * inv, y[dt][4 * gq + 1] * inv); wv.y = pk2(y[dt][4 * gq + 2] * inv, y[dt][4 * gq + 3] * inv); *(v2u*)(ob + 32 * dt + 8 * gq + 4 * h) = wv; }
        if (h == 0) LSE[((size_t)g * MTOK + d.rowb + qpos) * 16 + d.hd] = (m + __log2f(l)) * 0.6931471805599453f;
        __syncthreads();
    }
}
}
__device__ __forceinline__ void dil_merge(const u16* OB0, const u16* OB1, const u16* OB2, const float* LSE, u16* MIX, int gw, int NGW, int lane) {
    const int hd = lane >> 2, dq = (lane & 3) * 16;
    for (int m = gw; m < MTOK; m += NGW) {
        const float l0 = LSE[((size_t)m) * 16 + hd], l1 = LSE[((size_t)MTOK + m) * 16 + hd], l2 = LSE[((size_t)2 * MTOK + m) * 16 + hd];
        const float mx = fmaxf(l0, fmaxf(l1, l2)); float w0 = __expf(l0 - mx), w1 = __expf(l1 - mx), w2 = __expf(l2 - mx); const float iz = 1.f / (w0 + w1 + w2); w0 *= iz; w1 *= iz; w2 *= iz;
        const size_t off = (size_t)m * 1024 + hd * 64 + dq;
#pragma unroll
        for (int j = 0; j < 2; ++j) { const v4u a = *(const v4u*)(OB0 + off + 8 * j), bq = *(const v4u*)(OB1 + off + 8 * j), c = *(const v4u*)(OB2 + off + 8 * j);
            const unsigned aw[4] = {a.x, a.y, a.z, a.w}, bw[4] = {bq.x, bq.y, bq.z, bq.w}, cw[4] = {c.x, c.y, c.z, c.w}; unsigned ow[4];
#pragma unroll
            for (int e = 0; e < 4; ++e) ow[e] = pk2(w0 * bflo(aw[e]) + w1 * bflo(bw[e]) + w2 * bflo(cw[e]), w0 * bfhi(aw[e]) + w1 * bfhi(bw[e]) + w2 * bfhi(cw[e]));
            *(v4u*)(MIX + off + 8 * j) = (v4u){ow[0], ow[1], ow[2], ow[3]}; }
    }
}
#ifndef REP_PRO
#define REP_PRO 1
#endif
#ifndef REP_P1
#define REP_P1 1
#endif
#ifndef REP_HGA
#define REP_HGA 1
#endif
#ifndef REP_HGC
#define REP_HGC 1
#endif
#ifndef REP_CMB
#define REP_CMB 1
#endif
#ifndef REP_DIL
#define REP_DIL 1
#endif
#ifndef REP_MRG
#define REP_MRG 1
#endif
#ifndef REP_P6
#define REP_P6 1
#endif
#ifndef REP_ATT
#define REP_ATT 1
#endif
#ifndef PH_LO
#define PH_LO 0
#endif
#ifndef PH_HI
#define PH_HI 100
#endif
__device__ __forceinline__ int fresh_lane() { int l; asm volatile("v_mbcnt_lo_u32_b32 %0, -1, 0\n\tv_mbcnt_hi_u32_b32 %0, -1, %0" : "=v"(l)); return l; }
__device__ __forceinline__ void grid_bar(unsigned* bar, unsigned target, int wave0) {
    asm volatile("s_waitcnt vmcnt(0) lgkmcnt(0)" ::: "memory");
    __syncthreads();
    if (wave0 == 0) {
        const int ln = fresh_lane();
        if (ln == 0) {
            __builtin_amdgcn_fence(__ATOMIC_RELEASE, "agent");
            asm volatile("s_waitcnt vmcnt(0)" ::: "memory");
            __hip_atomic_fetch_add(bar, 1u, __ATOMIC_RELAXED, __HIP_MEMORY_SCOPE_AGENT);
            while (__hip_atomic_load(bar, __ATOMIC_RELAXED, __HIP_MEMORY_SCOPE_AGENT) < target) __builtin_amdgcn_s_sleep(2);
            __builtin_amdgcn_fence(__ATOMIC_ACQUIRE, "agent");
            asm volatile("s_waitcnt vmcnt(0)" ::: "memory");
        }
    }
    __syncthreads();
}
template <class Epi>
__device__ __forceinline__ void run_gemm(LAS unsigned char* lds, const u16* A, const u16* Bt, int N, int K, const Epi& E, int tid) {
    asm volatile("" : "+v"(tid));
    pg8::Gemm g{A, Bt, MTOK, N, K}; pg8::StaticOrder S; S.init(MTOK, N, (int)gridDim.x, (int)blockIdx.x);
    pg8::gemm_phase<Epi, pg8::StaticOrder, PG8_ALIGN, PG8_SP2>(lds, g, S, E, tid);
}
__global__ void __launch_bounds__(512, 2) fwd_kernel(Args A) {
    extern __shared__ __attribute__((aligned(16))) unsigned char lds_raw[];
    LAS unsigned char* lds = (LAS unsigned char*)lds_raw;
    cg::grid_group grid = cg::this_grid();
    const int wave0 = __builtin_amdgcn_readfirstlane((int)threadIdx.x >> 6);
#define tid0 (wave0 * 64 + fresh_lane())
    const int G = gridDim.x, bx = blockIdx.x;
    const int vcu = (G % 8 == 0) ? (bx % 8) * (G / 8) + bx / 8 : bx;
    const int NGW = G * 8;
#define PHASE_IDS() int tid = tid0; asm volatile("" : "+v"(tid)); const int lane = tid & 63, wave = __builtin_amdgcn_readfirstlane(tid >> 6), gw = bx * 8 + wave; (void)lane; (void)gw;
    unsigned char* ws = A.ws;
    float* rowss0 = (float*)(ws + WS_ROWSS); float* stats0 = (float*)(ws + WS_STATS); const float* cvec0 = (const float*)(ws + WS_CVEC); const float* lbv = (const float*)(ws + WS_MISC); const float* cs = (const float*)(ws + WS_CS);
    u16* XB = (u16*)(ws + WS_XB); u16* MIX = (u16*)(ws + WS_MIX); u16* HB = (u16*)(ws + WS_HB); u16* AUX = (u16*)(ws + WS_AUX);
    float* HGS = (float*)(ws + WS_HGS); float* HGD = (float*)(ws + WS_HGD); float* LSE = (float*)(ws + WS_LSE); u16* OB1 = (u16*)(ws + WS_OB1);
    float* X = A.out;
    unsigned* barw = (unsigned*)(ws + WS_BAR); unsigned nbar = 0;
#define GSYNC() do { ++nbar; grid_bar(barw, nbar * (unsigned)G, wave0); } while (0)

    for (int rep_ = 0; rep_ < REP_PRO; ++rep_) { { PHASE_IDS(); prologue(A, lds, gw, NGW, wave, lane); } }
    grid.sync();

    for (int l = 0; l < 2; ++l) {
        const u16* Ain = (l == 0) ? XB : (const u16*)X;
        if (l == 0) {
            for (int rep_ = 0; rep_ < REP_P1; ++rep_) { { pg8::EpiStore E{HB, NIN0, 0, 1024, 512, cs, nullptr, nullptr, nullptr}; run_gemm(lds, Ain, (const u16*)(ws + WS_WIN0), NIN0, 1024, E, tid0); } }
            GSYNC();
#ifndef NO_HGA
            for (int rep_ = 0; rep_ < REP_HGA; ++rep_) { for (int it = vcu; it < 256; it += G) { PHASE_IDS(); hg::item<false>(lds, HB, it, lbv, HGS, HGD, nullptr, nullptr, tid); } }
#endif
            __syncthreads();
            for (int rep_ = 0; rep_ < REP_ATT; ++rep_)
            for (int i = 0; i < 2048; ++i) {
                int tidA = tid0; asm volatile("" : "+v"(tidA));
                int pair, qb;
                if (G == 256) { if (i >= 8) break; const int s = vcu & 3, k = 7 - i; pair = vcu >> 2; qb = 4 * k + ((k & 1) ? 3 - s : s); }
                else { const int u = vcu + i * G; if (u >= 2048) break; pair = u >> 5; qb = 31 - (u & 31); }
                const int b = pair >> 4, vh = pair & 15, hh = vh >> 2, c = (vh >> 1) & 1, half = vh & 1;
#ifndef NO_ATTN
                attn_body::attn_unit<8>(b, (2 * hh + c) * 64, 512 + (2 * hh + c) * 64, 1024 + hh * 128 + half * 64, vh * 64, qb,
                                        (const attn_body::bf16*)HB, (const attn_body::bf16*)HB, (const attn_body::bf16*)HB, (attn_body::bf16*)AUX, (char*)lds_raw, tidA);
#endif
            }
            GSYNC();
#ifndef NO_HGC
            for (int rep_ = 0; rep_ < REP_HGC; ++rep_) { for (int it = vcu; it < 256; it += G) { PHASE_IDS(); hg::item<true>(lds, HB, it, lbv, HGS, HGD, A.hg_norm_g, MIX, tid); } }
#endif
            for (int rep_ = 0; rep_ < REP_CMB; ++rep_) { { PHASE_IDS(); diff_combine(AUX, MIX, A.da_lambda, A.da_subln_g, gw, NGW, lane); } }
            GSYNC();
        } else {
            { pg8::EpiStore E{HB, NIN1, 0, 2048, 1024, cs, nullptr, nullptr, nullptr}; run_gemm(lds, Ain, (const u16*)(ws + WS_WIN1), NIN1, 1024, E, tid0); }
            GSYNC();
#ifndef NO_DIL
            for (int rep_ = 0; rep_ < REP_DIL; ++rep_) { { PHASE_IDS(); dl::phase(lds, HB, AUX, OB1, XB, LSE, vcu, G, tid); } }
#endif
            GSYNC();
            for (int rep_ = 0; rep_ < REP_MRG; ++rep_) { { PHASE_IDS(); dil_merge(AUX, OB1, XB, LSE, MIX, gw, NGW, lane); } }
            GSYNC();
        }
        float* rowss = rowss0 + (size_t)l * MTOK; float* st1 = stats0 + (size_t)(2 * l) * MTOK * 2; float* st2 = stats0 + (size_t)(2 * l + 1) * MTOK * 2; const float* cv = cvec0 + l * 10240;
        { PHASE_IDS(); p_rows(A.p + (size_t)l * MTOK * PLE, AUX, gw, NGW, lane); }
        { pg8::EpiResid E{Ain, XB, nullptr, nullptr, nullptr, st1}; run_gemm(lds, MIX, (const u16*)(ws + (l == 0 ? WS_WOUT0 : WS_WOUT1)), 1024, 1024, E, tid0); }
        GSYNC();
        for (int rep_ = 0; rep_ < REP_P6; ++rep_) { pg8::EpiStore E{HB, FFD, 1, 0, 0, cs, st1, cv, cv + 4096}; run_gemm(lds, XB, (const u16*)(ws + WS_W1 + l * 8 * MiB), FFD, 1024, E, tid0); }
        { pg8::EpiE E{MIX, rowss}; run_gemm(lds, AUX, (const u16*)(ws + WS_WP + l * (MiB / 2)), 1024, PLE, E, tid0); }
        GSYNC();
#ifdef PROBE_FFN2
        { pg8::EpiStore E{AUX, 1024, 0, 0, 0, cs, nullptr, nullptr, nullptr}; run_gemm(lds, HB, (const u16*)(ws + WS_W2 + l * 8 * MiB), 1024, FFD, E, tid0); }
#endif
        { pg8::EpiResid E{XB, XB, st1, A.ln1_g + l * 1024, A.ln1_b + l * 1024, st2}; run_gemm(lds, HB, (const u16*)(ws + WS_W2 + l * 8 * MiB), 1024, FFD, E, tid0); }
        GSYNC();
        { pg8::EpiGate E{l == 0 ? (float*)nullptr : X, XB, st2, A.ln2_g + l * 1024, A.ln2_b + l * 1024, cv + 8192, cv + 9216, MIX, rowss, A.ple_norm_g + l * 1024, l == 0 ? (u16*)X : (u16*)nullptr}; run_gemm(lds, XB, (const u16*)(ws + WS_WG + l * 2 * MiB), 1024, 1024, E, tid0); }
        if (l == 0) GSYNC();
    }
#ifdef PROBE_BARS
    for (int i = 0; i < PROBE_BARS; ++i) GSYNC();
#endif
}

extern "C" void kernel_launch(void* const* d_in, const int* in_sizes, int n_in, void* d_out, int out_size, void* d_ws, size_t ws_size, hipStream_t stream) {
    static int grid = 0;
    if (grid == 0) {
        if (n_in != 19 || out_size != MTOK * DMODEL || ws_size < WS_END) { fprintf(stderr, "kernel_launch: unexpected shapes (n_in %d, out %d, ws %zu)\n", n_in, out_size, ws_size); grid = -1; return; }
        int dev = 0, cus = 0, per_cu = 0;
        if (hipGetDevice(&dev) != hipSuccess || hipDeviceGetAttribute(&cus, hipDeviceAttributeMultiprocessorCount, dev) != hipSuccess) { grid = -1; return; }
        if (hipFuncSetAttribute((const void*)fwd_kernel, hipFuncAttributeMaxDynamicSharedMemorySize, LDS_BYTES) != hipSuccess) { fprintf(stderr, "kernel_launch: hipFuncSetAttribute failed\n"); grid = -1; return; }
        if (hipOccupancyMaxActiveBlocksPerMultiprocessor(&per_cu, (const void*)fwd_kernel, 512, LDS_BYTES) != hipSuccess || per_cu < 1) { fprintf(stderr, "kernel_launch: occupancy query says %d\n", per_cu); per_cu = 1; }
        (void)hipGetLastError();
        grid = cus * per_cu;
    }
    if (grid < 0) return;
    if (hipMemsetAsync((char*)d_ws, 0, WS_BAR + 256, stream) != hipSuccess) { fprintf(stderr, "kernel_launch: memset failed\n"); return; }
    Args a{};
    const float** f = (const float**)&a;
    for (int i = 0; i < 19; ++i) f[i] = (const float*)d_in[i];
    a.out = (float*)d_out; a.ws = (unsigned char*)d_ws;
    void* args[] = {&a};
    hipError_t e = hipLaunchCooperativeKernel((const void*)fwd_kernel, dim3(grid), dim3(512), args, LDS_BYTES, stream);
    if (e != hipSuccess) fprintf(stderr, "cooperative launch failed: %s (grid %d)\n", hipGetErrorString(e), grid);
}
```

```cpp
#include <hip/hip_runtime.h>
#include <hip/hip_cooperative_groups.h>
#include <cstdio>
#include <cstdint>
namespace cg = cooperative_groups;
namespace pg8 {
#define PG8_LAS __attribute__((address_space(3)))
typedef unsigned short bf16_t;
typedef short bf16x8 __attribute__((ext_vector_type(8)));
typedef float f32x4 __attribute__((ext_vector_type(4)));
typedef unsigned u32x4 __attribute__((ext_vector_type(4)));
constexpr int BM = 256, BK = 64, HALF = 128, HTB = HALF * BK * 2  , STAGE_BYTES = 8 * HTB, NXCD = 8, WGM = 8;

__host__ __device__ __forceinline__ int lds_byte(int r, int c) { const int st = (r >> 4) * 2 + (c >> 5), rr = r & 15, cc = c & 31, ob = rr * 64 + cc * 2; return st * 1024 + (ob ^ (((ob >> 9) & 1) << 5)); }
__host__ __device__ __forceinline__ void stage_rc(int b, int& R, int& C) { const int st = b / 1024, sb = b % 1024, swz = sb ^ (((sb >> 9) & 1) << 5); R = (st >> 1) * 16 + swz / 64; C = (st & 1) * 32 + (swz % 64) / 2; }
__host__ __device__ __forceinline__ int perm32(int rho) { const int n = rho >> 4, i = rho & 15; return 8 * (i >> 2) + 4 * n + (i & 3); }

struct Unit { int pm, pn; };
struct Gemm { const bf16_t* A; const bf16_t* Bt; int M, N, K; };

struct StaticOrder {
    int nM, nN, nwg, G, c;
    __host__ __device__ void init(int M, int N, int G_, int c_) { nM = M / BM; nN = N / BM; nwg = nM * nN; G = G_; c = c_; }
    __host__ __device__ bool next(int i, Unit& u) const {
        const long L = (long)i * G + c; if (L >= nwg) return false;
        int wgid = (int)L; { const int q = nwg / NXCD, r = nwg % NXCD, xcd = wgid % NXCD, off = wgid / NXCD; wgid = (xcd < r ? xcd * (q + 1) : r * (q + 1) + (xcd - r) * q) + off; }
        const int nig = WGM * nN, gid = wgid / nig, fm = gid * WGM, gsz = (nM - fm) < WGM ? (nM - fm) : WGM;
        u.pm = fm + ((wgid % nig) % gsz); u.pn = (wgid % nig) / gsz; return true;
    }
    __device__ __forceinline__ void a_ready(const Unit&) const {}
    __device__ __forceinline__ void done(const Unit&) const {}
};

__device__ __forceinline__ unsigned cvt_pk_bf16(float lo, float hi) { unsigned r; asm volatile("v_cvt_pk_bf16_f32 %0, %1, %2" : "=v"(r) : "v"(lo), "v"(hi)); return r; }
typedef float f32x2 __attribute__((ext_vector_type(2)));
template <class Epi, class Sched, bool ALIGN_EPI = false, bool SP2 = false>
__device__ __forceinline__ void gemm_phase(PG8_LAS unsigned char* lds, const Gemm g, const Sched& S, const Epi& E, const int tid_in) {
    const int tid = tid_in, wid = __builtin_amdgcn_readfirstlane(tid >> 6), lane = tid & 63, wr = wid >> 2, wc = wid & 3, fr = lane & 15, fq = lane >> 4;
    const int K = g.K, nt = K / BK;
    unsigned voffA[2], voffB[2];
#pragma unroll
    for (int i = 0; i < 2; ++i) { int R, C; stage_rc(tid * 16 + i * 8192, R, C); const int Rb = Epi::PERM ? ((R & ~31) + perm32(R & 31)) : R;
        voffA[i] = (unsigned)(R * K + C) * 2u; voffB[i] = (unsigned)(Rb * K + C) * 2u; }
    const size_t kstep = (size_t)(BK * 2);
    const size_t hstep = (size_t)HALF * K * 2;
    const size_t tstep = 2 * hstep;
    const unsigned ldsw = (unsigned)wid * 1024u;
    const int aoff = lds_byte(wr * 64 + fr, fq * 8), boff = lds_byte(wc * 32 + fr, fq * 8);
#define PG8_SA(b, h) (((b) * 2 + (h)) * HTB)
#define PG8_SB(b, h) ((4 + (b) * 2 + (h)) * HTB)
#define PG8_STAGE(bufoff, gbase, voff) do { _Pragma("unroll") for (int _i = 0; _i < 2; ++_i) \
        __builtin_amdgcn_global_load_lds((const unsigned*)((const char*)(gbase) + (voff)[_i]), (PG8_LAS unsigned*)(lds + (bufoff) + ldsw + _i * 8192), 16, 0, 0); } while (0)
#define PG8_LDA(dst, b, h) do { _Pragma("unroll") for (int m = 0; m < 4; ++m) _Pragma("unroll") for (int k = 0; k < 2; ++k) dst[m][k] = *(const PG8_LAS bf16x8*)(lds + PG8_SA(b, h) + aoff + m * 2048 + k * 1024); } while (0)
#define PG8_LDB(dst, b, h) do { _Pragma("unroll") for (int n = 0; n < 2; ++n) _Pragma("unroll") for (int k = 0; k < 2; ++k) dst[n][k] = *(const PG8_LAS bf16x8*)(lds + PG8_SB(b, h) + boff + n * 2048 + k * 1024); } while (0)
#define PG8_MMA(ai, bj, At, Bt) do { __builtin_amdgcn_s_setprio(1); _Pragma("unroll") for (int m = 0; m < 4; ++m) _Pragma("unroll") for (int n = 0; n < 2; ++n) _Pragma("unroll") for (int k = 0; k < 2; ++k) \
        acc[ai][bj][m][n] = __builtin_amdgcn_mfma_f32_16x16x32_bf16(Bt[n][k], At[m][k], acc[ai][bj][m][n], 0, 0, 0); __builtin_amdgcn_s_setprio(0); } while (0)
#define PG8_WAIT_V(n) asm volatile("s_waitcnt vmcnt(" #n ")" ::: "memory")
#define PG8_WAIT_L(n) asm volatile("s_waitcnt lgkmcnt(" #n ")" ::: "memory")
#define PG8_BAR __builtin_amdgcn_s_barrier()
#define PG8_SCHED __builtin_amdgcn_sched_barrier(0)
    Unit cur, nxt; int ui = 0;
    if (!S.next(0, cur)) return;
    f32x4 acc[2][2][4][2];
#pragma unroll
    for (int a = 0; a < 2; ++a)
#pragma unroll
        for (int b = 0; b < 2; ++b)
#pragma unroll
            for (int m = 0; m < 4; ++m)
#pragma unroll
                for (int n = 0; n < 2; ++n) acc[a][b][m][n] = (f32x4){0.f, 0.f, 0.f, 0.f};
    bf16x8 At[4][2], B0[2][2], B1[2][2];
    const char* cA = (const char*)g.A + (size_t)cur.pm * tstep; const char* cB = (const char*)g.Bt + (size_t)cur.pn * tstep;
    S.a_ready(cur);
    if constexpr (SP2) {
        PG8_STAGE(PG8_SB(0, 0), cB, voffB); PG8_STAGE(PG8_SB(0, 1), cB + hstep, voffB); PG8_STAGE(PG8_SA(0, 0), cA, voffA); PG8_STAGE(PG8_SA(0, 1), cA + hstep, voffA);
        if (wr == 1) PG8_BAR;
        PG8_WAIT_V(2); PG8_BAR;
        PG8_STAGE(PG8_SB(1, 0), cB + kstep, voffB); PG8_STAGE(PG8_SA(1, 0), cA + kstep, voffA); PG8_STAGE(PG8_SB(1, 1), cB + hstep + kstep, voffB);
        PG8_WAIT_V(6); PG8_BAR;
    } else {
        PG8_STAGE(PG8_SB(0, 0), cB, voffB); PG8_STAGE(PG8_SA(0, 0), cA, voffA); PG8_STAGE(PG8_SB(0, 1), cB + hstep, voffB); PG8_STAGE(PG8_SA(0, 1), cA + hstep, voffA);
        if (wr == 1) PG8_BAR;
        PG8_WAIT_V(4); PG8_BAR;
        PG8_STAGE(PG8_SB(1, 0), cB + kstep, voffB); PG8_STAGE(PG8_SA(1, 0), cA + kstep, voffA); PG8_STAGE(PG8_SB(1, 1), cB + hstep + kstep, voffB);
        PG8_WAIT_V(6); PG8_BAR;
    }
    for (;;) {
        const bool has_next = S.next(ui + 1, nxt);
        const char* nA = has_next ? (const char*)g.A + (size_t)nxt.pm * tstep : cA; const char* nB = has_next ? (const char*)g.Bt + (size_t)nxt.pn * tstep : cB;
        for (int t = 0; t < nt; t += 2) {
            const bool last = (t == nt - 2);
            const char* a1 = cA + (size_t)(t + 1) * kstep;
            const char* a2 = last ? nA : cA + (size_t)(t + 2) * kstep; const char* b2 = last ? nB : cB + (size_t)(t + 2) * kstep;
            const char* a3 = a2 + kstep; const char* b3 = b2 + kstep;
            if (last && has_next) S.a_ready(nxt);
            if constexpr (SP2) {
            PG8_LDB(B0, 0, 0); PG8_LDB(B1, 0, 1); PG8_SCHED; PG8_LDA(At, 0, 0); PG8_STAGE(PG8_SA(1, 1), a1 + hstep, voffA);
            PG8_WAIT_V(8); PG8_WAIT_L(0); PG8_BAR; PG8_MMA(0, 0, At, B0); PG8_MMA(0, 1, At, B1); PG8_BAR; PG8_SCHED;
            PG8_LDA(At, 0, 1); PG8_STAGE(PG8_SB(0, 0), b2, voffB); PG8_STAGE(PG8_SB(0, 1), b2 + hstep, voffB); PG8_STAGE(PG8_SA(0, 0), a2, voffA);
            PG8_WAIT_V(8); PG8_WAIT_L(0); PG8_BAR; PG8_MMA(1, 0, At, B0); PG8_MMA(1, 1, At, B1); PG8_BAR; PG8_SCHED;
            PG8_LDB(B0, 1, 0); PG8_LDB(B1, 1, 1); PG8_SCHED; PG8_LDA(At, 1, 0); PG8_STAGE(PG8_SA(0, 1), a2 + hstep, voffA);
            PG8_WAIT_V(8); PG8_WAIT_L(0); PG8_BAR; PG8_MMA(0, 0, At, B0); PG8_MMA(0, 1, At, B1); PG8_BAR; PG8_SCHED;
            PG8_LDA(At, 1, 1); PG8_STAGE(PG8_SB(1, 0), b3, voffB); PG8_STAGE(PG8_SB(1, 1), b3 + hstep, voffB); PG8_STAGE(PG8_SA(1, 0), a3, voffA);
            PG8_WAIT_V(8); PG8_WAIT_L(0); PG8_BAR; PG8_MMA(1, 0, At, B0); PG8_MMA(1, 1, At, B1); PG8_BAR; PG8_SCHED;
            } else {
            PG8_LDB(B0, 0, 0); PG8_SCHED; PG8_LDA(At, 0, 0); PG8_STAGE(PG8_SA(1, 1), a1 + hstep, voffA);
            PG8_WAIT_L(8); PG8_BAR; PG8_WAIT_L(0); PG8_MMA(0, 0, At, B0); PG8_BAR; PG8_SCHED;
            PG8_LDB(B1, 0, 1); PG8_STAGE(PG8_SB(0, 0), b2, voffB);
            PG8_BAR; PG8_WAIT_L(0); PG8_MMA(0, 1, At, B1); PG8_BAR;
            PG8_LDA(At, 0, 1); PG8_STAGE(PG8_SA(0, 0), a2, voffA);
            PG8_BAR; PG8_WAIT_L(0); PG8_MMA(1, 0, At, B0); PG8_BAR; PG8_SCHED;
            PG8_STAGE(PG8_SB(0, 1), b2 + hstep, voffB);
            PG8_WAIT_V(6); PG8_BAR; PG8_MMA(1, 1, At, B1); PG8_BAR;
            PG8_LDB(B0, 1, 0); PG8_SCHED; PG8_LDA(At, 1, 0); PG8_STAGE(PG8_SA(0, 1), a2 + hstep, voffA);
            PG8_WAIT_L(8); PG8_BAR; PG8_WAIT_L(0); PG8_MMA(0, 0, At, B0); PG8_BAR; PG8_SCHED;
            PG8_LDB(B1, 1, 1); PG8_STAGE(PG8_SB(1, 0), b3, voffB);
            PG8_BAR; PG8_WAIT_L(0); PG8_MMA(0, 1, At, B1); PG8_BAR;
            PG8_LDA(At, 1, 1); PG8_STAGE(PG8_SA(1, 0), a3, voffA);
            PG8_BAR; PG8_WAIT_L(0); PG8_MMA(1, 0, At, B0); PG8_BAR; PG8_SCHED;
            PG8_STAGE(PG8_SB(1, 1), b3 + hstep, voffB);
            PG8_WAIT_V(6); PG8_BAR; PG8_MMA(1, 1, At, B1); PG8_BAR;
            }
        }
        if constexpr (ALIGN_EPI) { if (wr == 0) PG8_BAR; }
        if constexpr (!Epi::AFTER_DRAIN) { E(acc, cur, wr, wc, fr, fq); S.done(cur); }
        if (!has_next) break;
#pragma unroll
        for (int a = 0; a < 2; ++a)
#pragma unroll
            for (int b = 0; b < 2; ++b)
#pragma unroll
                for (int m = 0; m < 4; ++m)
#pragma unroll
                    for (int n = 0; n < 2; ++n) acc[a][b][m][n] = (f32x4){0.f, 0.f, 0.f, 0.f};
        cur = nxt; cA = nA; cB = nB; ++ui;
        if constexpr (ALIGN_EPI) { if (wr == 1) PG8_BAR; }
    }
    PG8_WAIT_V(0);
    if constexpr (!ALIGN_EPI) { if (wr == 0) PG8_BAR; }
    PG8_BAR;
    if constexpr (Epi::AFTER_DRAIN) { E.fused(acc, cur, wr, wc, fr, fq, lds, wid, lane); S.done(cur); }
#undef PG8_SA
#undef PG8_SB
#undef PG8_STAGE
#undef PG8_LDA
#undef PG8_LDB
#undef PG8_MMA
#undef PG8_WAIT_V
#undef PG8_WAIT_L
#undef PG8_BAR
#undef PG8_SCHED
}
}
namespace pg8 {
__device__ __forceinline__ float shx(float v, int m, int lane) { return __builtin_bit_cast(float, __builtin_amdgcn_ds_bpermute((lane ^ m) << 2, __builtin_bit_cast(int, v))); }
constexpr float QSCALE = 0.125f * 1.4426950408889634f;
struct EpiStore {
    static constexpr bool PERM = true, AFTER_DRAIN = false;
    bf16_t* O; int ldc; int act; int rope_cols; int scale_cols; const float* cs;
    const float* st; const float* c1; const float* c2;
    __device__ __forceinline__ void operator()(f32x4 (&acc)[2][2][4][2], const Unit& u, int wr, int wc, int fr, int fq) const {
        { int ln_; asm volatile("v_mbcnt_lo_u32_b32 %0, -1, 0\n\tv_mbcnt_hi_u32_b32 %0, -1, %0" : "=v"(ln_)); fr = ln_ & 15; fq = ln_ >> 4; }
        const int row0 = u.pm * BM + wr * 64 + fr; const int colt = u.pn * BM;
        const int col0 = colt + wc * 32 + 8 * fq;
        if (colt < rope_cols && (wc & 1) == 0) {
            const float sgn = fq == 0 ? -1.f : 1.f; const int lane = fq * 16 + fr;
            const int fqc = fq & 1;
#pragma unroll
            for (int ai = 0; ai < 2; ++ai)
#pragma unroll
                for (int m = 0; m < 4; ++m) {
                    const int pos = (row0 + ai * HALF + m * 16) & 8191;
                    const float* cp = cs + pos * 8;
#pragma unroll
                    for (int n = 0; n < 2; ++n) {
                        const f32x4 cv = *(const f32x4*)(cp + 4 * n), sv = *(const f32x4*)(cp + 65536 + 4 * n);
#pragma unroll
                        for (int bj = 0; bj < 2; ++bj)
#pragma unroll
                            for (int e = 0; e < 4; ++e) {
                                const float v = acc[ai][bj][m][n][e]; const float pv = shx(v, 16, lane);
                                const float nv = v * cv[e] + sgn * pv * sv[e];
                                acc[ai][bj][m][n][e] = (fq < 2) ? nv : v;
                            }
                        asm volatile("" ::: "memory");
                    }
                }
            (void)fqc;
        }
        if (st) {
            float muv[2][4], rsv[2][4];
#pragma unroll
            for (int ai = 0; ai < 2; ++ai)
#pragma unroll
                for (int m = 0; m < 4; ++m) { const int row = row0 + ai * HALF + m * 16; const f32x2 sv = *(const f32x2*)(st + 2 * row); muv[ai][m] = sv.x; rsv[ai][m] = sv.y; }
#pragma unroll
            for (int ai = 0; ai < 2; ++ai)
#pragma unroll
                for (int m = 0; m < 4; ++m) { const float mu = muv[ai][m] * (1.f / 1024.f); rsv[ai][m] = __builtin_amdgcn_rsqf(rsv[ai][m] * (1.f / 1024.f) - mu * mu + 1e-5f); muv[ai][m] = mu; }
#pragma unroll
            for (int bj = 0; bj < 2; ++bj) {
                const f32x4 c1a = *(const f32x4*)(c1 + col0 + bj * HALF), c1b = *(const f32x4*)(c1 + col0 + bj * HALF + 4), c2a = *(const f32x4*)(c2 + col0 + bj * HALF), c2b = *(const f32x4*)(c2 + col0 + bj * HALF + 4);
#pragma unroll
                for (int ai = 0; ai < 2; ++ai)
#pragma unroll
                    for (int m = 0; m < 4; ++m) { const float mu = muv[ai][m], rstd = rsv[ai][m];
                        acc[ai][bj][m][0] = (acc[ai][bj][m][0] - mu * c1a) * rstd + c2a; acc[ai][bj][m][1] = (acc[ai][bj][m][1] - mu * c1b) * rstd + c2b; }
            }
        }
        const float sc = (colt < scale_cols) ? QSCALE : 1.f;
#pragma unroll
        for (int ai = 0; ai < 2; ++ai)
#pragma unroll
            for (int m = 0; m < 4; ++m) { bf16_t* rowp = O + (size_t)(row0 + ai * HALF + m * 16) * ldc + col0;
#pragma unroll
                for (int bj = 0; bj < 2; ++bj) { f32x4 v0 = acc[ai][bj][m][0], v1 = acc[ai][bj][m][1];
                    if (act == 1) {
#pragma unroll
                        for (int e = 0; e < 4; ++e) { float a = fmaxf(v0[e], 0.f), b = fmaxf(v1[e], 0.f); v0[e] = a * a; v1[e] = b * b; } }
                    v0 = v0 * sc; v1 = v1 * sc; u32x4 w; w.x = cvt_pk_bf16(v0[0], v0[1]); w.y = cvt_pk_bf16(v0[2], v0[3]); w.z = cvt_pk_bf16(v1[0], v1[1]); w.w = cvt_pk_bf16(v1[2], v1[3]);
                    *(u32x4*)(rowp + bj * HALF) = w; } }
    }
};
struct EpiResid {
    static constexpr bool PERM = false, AFTER_DRAIN = false;
    const bf16_t* xinb; bf16_t* outb; const float* st_in; const float* g; const float* b; float* st_out;
    __device__ __forceinline__ void operator()(f32x4 (&acc)[2][2][4][2], const Unit& u, int wr, int wc, int fr, int fq) const {
        typedef unsigned u32x2v __attribute__((ext_vector_type(2)));
        { int ln_; asm volatile("v_mbcnt_lo_u32_b32 %0, -1, 0\n\tv_mbcnt_hi_u32_b32 %0, -1, %0" : "=v"(ln_)); fr = ln_ & 15; fq = ln_ >> 4; }
        const int lane = fq * 16 + fr;
        const int col0 = u.pn * BM + wc * 32 + 4 * fq;
        f32x4 gv[2][2], bv[2][2];
        if (st_in) {
#pragma unroll
            for (int bj = 0; bj < 2; ++bj)
#pragma unroll
                for (int n = 0; n < 2; ++n) { gv[bj][n] = *(const f32x4*)(g + col0 + bj * HALF + n * 16); bv[bj][n] = *(const f32x4*)(b + col0 + bj * HALF + n * 16); } }
#pragma unroll
        for (int ai = 0; ai < 2; ++ai) {
            const int rowa = u.pm * BM + ai * HALF + wr * 64 + fr;
            float mu[4], rstd[4];
            u32x2v xw[4][2][2];
#pragma unroll
            for (int m = 0; m < 4; ++m)
#pragma unroll
                for (int bj = 0; bj < 2; ++bj)
#pragma unroll
                    for (int n = 0; n < 2; ++n) xw[m][bj][n] = *(const u32x2v*)(xinb + (size_t)(rowa + m * 16) * 1024 + col0 + bj * HALF + n * 16);
#pragma unroll
            for (int m = 0; m < 4; ++m) { mu[m] = 0.f; rstd[m] = 1.f;
                if (st_in) { const f32x2 sv = *(const f32x2*)(st_in + 2 * (rowa + m * 16)); mu[m] = sv.x * (1.f / 1024.f); rstd[m] = __builtin_amdgcn_rsqf(sv.y * (1.f / 1024.f) - mu[m] * mu[m] + 1e-5f); } }
#pragma unroll
            for (int m = 0; m < 4; ++m) { const int row = rowa + m * 16; const size_t off = (size_t)row * 1024 + col0;
                float s1 = 0.f, s2 = 0.f;
#pragma unroll
                for (int bj = 0; bj < 2; ++bj)
#pragma unroll
                    for (int n = 0; n < 2; ++n) { const size_t o2 = off + bj * HALF + n * 16;
                        const u32x2v w0 = xw[m][bj][n]; f32x4 x1 = {__uint_as_float(w0.x << 16), __uint_as_float(w0.x & 0xffff0000u), __uint_as_float(w0.y << 16), __uint_as_float(w0.y & 0xffff0000u)};
                        if (st_in) x1 = (x1 - mu[m]) * rstd[m] * gv[bj][n] + bv[bj][n];
                        const f32x4 y = x1 * 1.4142135623730951f + acc[ai][bj][m][n];
                        u32x2v w; w.x = cvt_pk_bf16(y[0], y[1]); w.y = cvt_pk_bf16(y[2], y[3]); *(u32x2v*)(outb + o2) = w;
                        s1 += (y[0] + y[1]) + (y[2] + y[3]); s2 += (y[0] * y[0] + y[1] * y[1]) + (y[2] * y[2] + y[3] * y[3]); }
                s1 += shx(s1, 16, lane); s1 += shx(s1, 32, lane); s2 += shx(s2, 16, lane); s2 += shx(s2, 32, lane);
                if (fq == 0) { atomicAdd(st_out + 2 * row, s1); atomicAdd(st_out + 2 * row + 1, s2); } }
            asm volatile("" ::: "memory");
        }
    }
};
struct EpiE {
    static constexpr bool PERM = true, AFTER_DRAIN = false;
    bf16_t* O; float* rowss;
    __device__ __forceinline__ void operator()(f32x4 (&acc)[2][2][4][2], const Unit& u, int wr, int wc, int fr, int fq) const {
        { int ln_; asm volatile("v_mbcnt_lo_u32_b32 %0, -1, 0\n\tv_mbcnt_hi_u32_b32 %0, -1, %0" : "=v"(ln_)); fr = ln_ & 15; fq = ln_ >> 4; }
        const int row0 = u.pm * BM + wr * 64 + fr; const int col0 = u.pn * BM + wc * 32 + 8 * fq; const int lane = fq * 16 + fr;
#pragma unroll
        for (int ai = 0; ai < 2; ++ai)
#pragma unroll
            for (int m = 0; m < 4; ++m) { const int row = row0 + ai * HALF + m * 16; bf16_t* rowp = O + (size_t)row * 1024 + col0; float ss = 0.f;
#pragma unroll
                for (int bj = 0; bj < 2; ++bj) { const f32x4 v0 = acc[ai][bj][m][0], v1 = acc[ai][bj][m][1];
                    ss += (v0[0] * v0[0] + v0[1] * v0[1]) + (v0[2] * v0[2] + v0[3] * v0[3]) + (v1[0] * v1[0] + v1[1] * v1[1]) + (v1[2] * v1[2] + v1[3] * v1[3]);
                    u32x4 w; w.x = cvt_pk_bf16(v0[0], v0[1]); w.y = cvt_pk_bf16(v0[2], v0[3]); w.z = cvt_pk_bf16(v1[0], v1[1]); w.w = cvt_pk_bf16(v1[2], v1[3]);
                    *(u32x4*)(rowp + bj * HALF) = w; }
                ss += shx(ss, 16, lane); ss += shx(ss, 32, lane);
                if (fq == 0) atomicAdd(rowss + row, ss); }
    }
};
struct EpiGate {
    static constexpr bool PERM = false, AFTER_DRAIN = false;
    float* x; const bf16_t* yb; const float* st; const float* g2; const float* b2; const float* c1; const float* c2; const bf16_t* E; const float* rowss; const float* gp; bf16_t* xb;
    __device__ __forceinline__ void operator()(f32x4 (&acc)[2][2][4][2], const Unit& u, int wr, int wc, int fr, int fq) const {
        typedef unsigned u32x2v __attribute__((ext_vector_type(2)));
        { int ln_; asm volatile("v_mbcnt_lo_u32_b32 %0, -1, 0\n\tv_mbcnt_hi_u32_b32 %0, -1, %0" : "=v"(ln_)); fr = ln_ & 15; fq = ln_ >> 4; }
        const int col0 = u.pn * BM + wc * 32 + 4 * fq;
#pragma unroll
        for (int ai = 0; ai < 2; ++ai)
#pragma unroll
        for (int mp = 0; mp < 2; ++mp) {
            const int rowa = u.pm * BM + ai * HALF + wr * 64 + mp * 32 + fr;
            const bf16_t* ybp = yb + (size_t)rowa * 1024 + col0; const bf16_t* ep = E + (size_t)rowa * 1024 + col0;
            u32x2v yw[2][2][2], ew[2][2][2]; float mu[2], rstd[2], rs[2];
#pragma unroll
            for (int m = 0; m < 2; ++m)
#pragma unroll
                for (int bj = 0; bj < 2; ++bj)
#pragma unroll
                    for (int n = 0; n < 2; ++n) { const int o2 = m * 16 * 1024 + bj * HALF + n * 16; yw[m][bj][n] = *(const u32x2v*)(ybp + o2); ew[m][bj][n] = *(const u32x2v*)(ep + o2); }
#pragma unroll
            for (int m = 0; m < 2; ++m) { const int row = rowa + m * 16; const f32x2 sv = *(const f32x2*)(st + 2 * row); rs[m] = rowss[row]; mu[m] = sv.x; rstd[m] = sv.y; }
#pragma unroll
            for (int m = 0; m < 2; ++m) { rs[m] = __builtin_amdgcn_rsqf(rs[m] * (1.0f / 1024.0f) + 1e-5f); mu[m] *= (1.f / 1024.f); rstd[m] = __builtin_amdgcn_rsqf(rstd[m] * (1.f / 1024.f) - mu[m] * mu[m] + 1e-5f); }
#pragma unroll
            for (int bj = 0; bj < 2; ++bj)
#pragma unroll
                for (int n = 0; n < 2; ++n) { const int c = col0 + bj * HALF + n * 16;
                    const f32x4 gv = *(const f32x4*)(gp + c), g2v = *(const f32x4*)(g2 + c), b2v = *(const f32x4*)(b2 + c), c1v = *(const f32x4*)(c1 + c), c2v = *(const f32x4*)(c2 + c);
#pragma unroll
                    for (int m = 0; m < 2; ++m) { const size_t o2 = (size_t)(rowa + m * 16) * 1024 + c;
                        const u32x2v w0 = yw[m][bj][n], ev = ew[m][bj][n];
                        const f32x4 yv = {__uint_as_float(w0.x << 16), __uint_as_float(w0.x & 0xffff0000u), __uint_as_float(w0.y << 16), __uint_as_float(w0.y & 0xffff0000u)};
                        const f32x4 ef = {__uint_as_float(ev.x << 16), __uint_as_float(ev.x & 0xffff0000u), __uint_as_float(ev.y << 16), __uint_as_float(ev.y & 0xffff0000u)};
                        const f32x4 xv = (yv - mu[m]) * rstd[m] * g2v + b2v;
                        const f32x4 a = (acc[ai][bj][2 * mp + m][n] - mu[m] * c1v) * rstd[m] + c2v; f32x4 o;
#pragma unroll
                        for (int e = 0; e < 4; ++e) o[e] = xv[e] + ef[e] * rs[m] * gv[e] * __builtin_amdgcn_rcpf(1.f + __expf(-a[e]));
                        if (x) *(f32x4*)(x + o2) = o;
                        if (xb) { u32x2v w; w.x = cvt_pk_bf16(o[0], o[1]); w.y = cvt_pk_bf16(o[2], o[3]); *(u32x2v*)(xb + o2) = w; } } }
            asm volatile("" ::: "memory");
        }
    }
};
}
#define PG8_SP2 true
#define PG8_ALIGN true
#include <hip/hip_bf16.h>
#include <cmath>
namespace attn_body {
using bf16=__hip_bfloat16;
using bf16x8=__attribute__((ext_vector_type(8)))short;
using s16x4=__attribute__((ext_vector_type(4)))short;
using f32x16=__attribute__((ext_vector_type(16)))float;
using u32x4=__attribute__((ext_vector_type(4)))unsigned;
constexpr int SEQ=8192,D=64,DM=3584,DMO=1024;
constexpr int NW=8,QBLK=32,QB=QBLK*NW,KVBLK=64,NQB=SEQ/QB;
constexpr int ATTN_PITCH=DM, ATTN_UNIT_ROWS=QB;
__device__ __forceinline__ int crow(int r,int hi){return (r&3)+8*(r>>2)+4*hi;}
#define SBAR() __builtin_amdgcn_sched_barrier(0)
__device__ __forceinline__ void cmask(f32x16&p0,f32x16&p1,int jb,int qrel,int hi){
  const float NEG=-INFINITY; int kb=64*jb+4*hi;
  #pragma unroll
  for(int r=0;r<16;++r){int kv=kb+(r&3)+8*(r>>2); if(kv>qrel)p0[r]=NEG; if(kv+32>qrel)p1[r]=NEG;}
}

constexpr int NSLOT=3, SLOTB=8192;
constexpr int LDS_K=0, LDS_V=NSLOT*SLOTB, LDS_WS=2*NSLOT*SLOTB, LDS_OST=LDS_WS+NW*64*4, LDS_BYTES=LDS_OST+NW*4096;
constexpr float C2=0.125f*1.4426950408889634f;
__device__ __forceinline__ void glds16(const void*gsrc,unsigned lds_dst){unsigned keep;
  asm volatile("s_mov_b32 %0, m0\n\ts_mov_b32 m0, %2\n\ts_nop 0\n\tglobal_load_lds_dwordx4 %1, off\n\ts_mov_b32 m0, %0":"=&s"(keep):"v"(gsrc),"s"(lds_dst):"memory");}
__device__ __forceinline__ float max3f(float a,float b,float c){float r;asm("v_max3_f32 %0, %1, %2, %3":"=v"(r):"v"(a),"v"(b),"v"(c));return r;}
__device__ __forceinline__ float max2f(float a,float b){float r;asm("v_max_f32_e32 %0, %1, %2":"=v"(r):"v"(a),"v"(b));return r;}
__device__ __forceinline__ float fadd_s(float a,float b){float r;asm("v_add_f32_e32 %0, %1, %2":"=v"(r):"v"(a),"v"(b));return r;}
__device__ __forceinline__ float fsub_s(float a,float b){float r;asm("v_sub_f32_e32 %0, %1, %2":"=v"(r):"v"(a),"v"(b));return r;}
typedef float f32x2_t __attribute__((ext_vector_type(2))); typedef __bf16 bf16x2_t __attribute__((ext_vector_type(2)));
__device__ __forceinline__ unsigned cvtpk_s(float lo,float hi){f32x2_t v={lo,hi};bf16x2_t b=__builtin_convertvector(v,bf16x2_t);return __builtin_bit_cast(unsigned,b);}
#define WAIT_BAR(N) asm volatile("s_waitcnt vmcnt(" #N ") lgkmcnt(0)\n\ts_barrier":::"memory")

__device__ __forceinline__ void qkt(f32x16&p0,f32x16&p1,const char*Kslot,const bf16x8*qr,const f32x16&negm,int r32,int hi){
  const char*kb=Kslot+hi*1024+r32*16;
  #pragma unroll
  for(int d0=0;d0<4;++d0){
    const bf16x8 b0=*reinterpret_cast<const bf16x8*>(kb+d0*2048);
    const bf16x8 b1=*reinterpret_cast<const bf16x8*>(kb+d0*2048+512);
    if(d0==0){p0=__builtin_amdgcn_mfma_f32_32x32x16_bf16(b0,qr[0],negm,0,0,0);p1=__builtin_amdgcn_mfma_f32_32x32x16_bf16(b1,qr[0],negm,0,0,0);}
    else{p0=__builtin_amdgcn_mfma_f32_32x32x16_bf16(b0,qr[d0],p0,0,0,0);p1=__builtin_amdgcn_mfma_f32_32x32x16_bf16(b1,qr[d0],p1,0,0,0);}}
}
typedef __attribute__((address_space(3))) const char* lds_cptr;
typedef short v4i16_t __attribute__((ext_vector_type(4)));
__device__ __forceinline__ void kload8(bf16x8*kf,lds_cptr kp){
  kf[0]=*(const __attribute__((address_space(3))) bf16x8*)(kp);      kf[1]=*(const __attribute__((address_space(3))) bf16x8*)(kp+512);
  kf[2]=*(const __attribute__((address_space(3))) bf16x8*)(kp+2048); kf[3]=*(const __attribute__((address_space(3))) bf16x8*)(kp+2560);
  kf[4]=*(const __attribute__((address_space(3))) bf16x8*)(kp+4096); kf[5]=*(const __attribute__((address_space(3))) bf16x8*)(kp+4608);
  kf[6]=*(const __attribute__((address_space(3))) bf16x8*)(kp+6144); kf[7]=*(const __attribute__((address_space(3))) bf16x8*)(kp+6656);
}
__device__ __forceinline__ void kload2(bf16x8*kf,lds_cptr kp,int j){ kf[2*j]=*(const __attribute__((address_space(3))) bf16x8*)(kp+j*2048); kf[2*j+1]=*(const __attribute__((address_space(3))) bf16x8*)(kp+j*2048+512); }
__device__ __forceinline__ s16x4 vtr(lds_cptr p){ return __builtin_bit_cast(s16x4,__builtin_amdgcn_ds_read_tr16_b64_v4i16((__attribute__((address_space(3))) v4i16_t*)p)); }
__device__ __forceinline__ float rowmax(const f32x16&p0,const f32x16&p1){
  float a=max3f(p0[0],p0[1],p1[0]),b=max3f(p0[2],p0[3],p1[1]);a=max3f(a,p1[2],p1[3]);
  #pragma unroll
  for(int r=4;r<16;r+=4){a=max3f(a,p0[r],p0[r+1]);b=max3f(b,p0[r+2],p0[r+3]);a=max3f(a,p1[r],p1[r+1]);b=max3f(b,p1[r+2],p1[r+3]);}
  const float m=max2f(a,b);
  auto rr=__builtin_amdgcn_permlane32_swap(__float_as_uint(m),__float_as_uint(m),false,false);
  return max2f(__uint_as_float(rr[0]),__uint_as_float(rr[1]));
}
__device__ __forceinline__ void pv(f32x16*o,int vb,bf16x8 pa0,bf16x8 pa1,bf16x8 pa2,bf16x8 pa3){
  #pragma unroll
  for(int d0=0;d0<2;++d0){s16x4 lo[4],hi[4];
    #pragma unroll
    for(int ks=0;ks<4;++ks){
      asm volatile("ds_read_b64_tr_b16 %0,%1 offset:%c2":"=&v"(lo[ks]):"v"(vb),"i"(d0*4096+ks*1024):"memory");
      asm volatile("ds_read_b64_tr_b16 %0,%1 offset:%c2":"=&v"(hi[ks]):"v"(vb),"i"(d0*4096+ks*1024+512):"memory");}
    asm volatile("s_waitcnt lgkmcnt(0)":::"memory");SBAR();
    #define PK(k) (bf16x8){lo[k][0],lo[k][1],lo[k][2],lo[k][3],hi[k][0],hi[k][1],hi[k][2],hi[k][3]}
    o[d0]=__builtin_amdgcn_mfma_f32_32x32x16_bf16(pa0,PK(0),o[d0],0,0,0);
    o[d0]=__builtin_amdgcn_mfma_f32_32x32x16_bf16(pa1,PK(1),o[d0],0,0,0);
    o[d0]=__builtin_amdgcn_mfma_f32_32x32x16_bf16(pa2,PK(2),o[d0],0,0,0);
    o[d0]=__builtin_amdgcn_mfma_f32_32x32x16_bf16(pa3,PK(3),o[d0],0,0,0);
    #undef PK
  }
}

#ifndef ATTN_STORE16
#define ATTN_STORE16(p,v) (*(u32x4*)(p)=(v))
#endif
template<int THRL> __device__ __forceinline__ void attn_unit(int b,int colq,int colk,int colv,int colo,int qb,const bf16*Q,const bf16*__restrict__ K,const bf16*__restrict__ V,bf16*O,char*shm,const int tid_in){
  const int tid=tid_in,lane=tid&63,r32=lane&31,hi=lane>>5; const int wid=__builtin_amdgcn_readfirstlane(tid>>6);
  const long rowbase=(long)b*SEQ; const int q0=qb*QB;
  const bf16*Qw=Q+(rowbase+q0+wid*QBLK)*DM+colq;
  const bf16*Kh=K+rowbase*DM+colk,*Vh=V+rowbase*DM+colv;
  const unsigned lds0=(unsigned)(uintptr_t)shm;
  float*wsf=(float*)(shm+LDS_WS)+wid*64;
  const bf16*ksrc=Kh+(long)lane*DM+wid*8;
  const bf16*vsrc=Vh+(long)(16*(wid&3)+(lane>>2))*DM+(wid>>2)*32+(lane&3)*8;
  const unsigned kdst=lds0+LDS_K+wid*1024, vdst=lds0+LDS_V+wid*1024;
  #define DMA_K(t,slot) glds16(ksrc+(long)(t)*KVBLK*DM,(unsigned)__builtin_amdgcn_readfirstlane(kdst+(slot)))
  #define DMA_V(t,slot) glds16(vsrc+(long)(t)*KVBLK*DM,(unsigned)__builtin_amdgcn_readfirstlane(vdst+(slot)))
  const int vb0=(int)(lds0+LDS_V)+((lane>>4)&1)*32+(lane&3)*8+(4*hi+((lane&15)>>2))*64;
  const char*Kbase=shm+LDS_K; bf16x8 kf[8];
  const lds_cptr shm3=(lds_cptr)shm; const lds_cptr kp0=shm3+LDS_K+hi*1024+r32*16; const lds_cptr vp0=shm3+LDS_V+((lane>>4)&1)*32+(lane&3)*8+(4*hi+((lane&15)>>2))*64;
  const int NT=(q0+QB)/KVBLK;
  DMA_K(0,0);DMA_V(0,0);DMA_K(1,SLOTB);
  bf16x8 qr[4];
  #pragma unroll
  for(int d0=0;d0<4;++d0)qr[d0]=*reinterpret_cast<const bf16x8*>(&Qw[(long)r32*DM+d0*16+hi*8]);
  float mhat=0.f,l_reg=0.f;f32x16 o[2];o[0]=f32x16{};o[1]=f32x16{};f32x16 negm=f32x16{};asm volatile("":"+v"(negm));
  const int qrel=wid*QBLK+r32;
  #define CMASK(P0,P1,t) do{int jb_=(t)-(NT-4); if(jb_>=0)cmask(P0,P1,jb_,qrel,hi);}while(0)
  bool resc=false;
  #define START(P0,P1) do{ const float rm=rowmax(P0,P1); resc=false; \
    { const float dl=rm; mhat=fadd_s(mhat,dl); \
      _Pragma("unroll") for(int r=0;r<16;++r){P0[r]=fsub_s(P0[r],dl);P1[r]=fsub_s(P1[r],dl);} \
      _Pragma("unroll") for(int r=0;r<16;++r)negm[r]=-mhat; asm volatile("":"+v"(negm)); } \
    _Pragma("unroll") for(int r=0;r<16;++r)P0[r]=__builtin_amdgcn_exp2f(P0[r]); }while(0)
  #define RESC() do{ if(resc){ asm volatile("s_waitcnt lgkmcnt(0)":::"memory"); \
      _Pragma("unroll") for(int d_=0;d_<2;++d_) _Pragma("unroll") for(int r=0;r<16;++r)o[d_][r]*=wsf[crow(r,hi)]; } }while(0)
  f32x16 pA0,pA1,pB0,pB1;
  int sl_prev=0,sl_cur=0,sl_next=SLOTB;
  #define ROT() do{sl_prev=sl_cur;sl_cur=sl_next;sl_next=(sl_next==(NSLOT-1)*SLOTB)?0:sl_next+SLOTB;}while(0)
  DMA_K(2,2*SLOTB);
  WAIT_BAR(3);
  qkt(pA0,pA1,Kbase,qr,negm,r32,hi);asm volatile("s_nop 15\n\ts_nop 7":"+v"(pA0),"+v"(pA1));CMASK(pA0,pA1,0);
  START(pA0,pA1);
  _Pragma("unroll") for(int r=0;r<16;++r)pA1[r]=__builtin_amdgcn_exp2f(pA1[r]);
  WAIT_BAR(0);
  DMA_K(3,0);DMA_V(1,SLOTB);
  ROT();
  kload8(kf,kp0+sl_cur);
  WAIT_BAR(2);
  s16x4 vlo[8],vhi[8]; u32x4 pw0,pw1,pw2,pw3;
  #define PKW(P,B) cvtpk_s(P[B],P[B+1])
  #define PAF(k) __builtin_bit_cast(bf16x8,pw##k)
  #define VFR(i) (bf16x8){vlo[i][0],vlo[i][1],vlo[i][2],vlo[i][3],vhi[i][0],vhi[i][1],vhi[i][2],vhi[i][3]}
  #define PIN(x) asm volatile("":"+v"(x))
  #define MX3(a,b,c) __builtin_fmaxf(__builtin_fmaxf((a),(b)),(c))
  #define GAPA(MF,A0,A1,A2,A3,W0,W1,PW) do{ MF; sacc+=A0; sacc+=A1; sacc+=A2; sacc+=A3; PIN(sacc); W0; W1; PIN(PW); SBAR(); }while(0)
  #define EX(v) __builtin_amdgcn_exp2f(v)
  #define GAPB(MF,X,B) do{ MF; X[B]=EX(X[B]); X[B+1]=EX(X[B+1]); X[B+2]=EX(X[B+2]); X[B+3]=EX(X[B+3]); PIN(X); SBAR(); }while(0)
  #define VRD(i) do{ vlo[i]=vtr(vp_+(((i)>>2)*4096+((i)&3)*1024)); vhi[i]=vtr(vp_+(((i)>>2)*4096+((i)&3)*1024+512)); }while(0)
  #define KRD(G,j) do{ if(G){ kload2(kf,kp0+sl_next,j); SBAR(); } }while(0)
  #define STEP(C0,C1,P0,P1,t,GK,GV,GL) do{ SBAR(); \
    const lds_cptr vp_=vp0+sl_prev; \
    VRD(0); SBAR(); float sacc=(P0[0]+P0[1]); \
    GAPA(C0=__builtin_amdgcn_mfma_f32_32x32x16_bf16(kf[0],qr[0],negm,0,0,0), P0[2],P0[3],P0[4],P0[5],     pw0[0]=PKW(P0,0), pw0[1]=PKW(P0,2), pw0); \
    VRD(4); SBAR(); GAPA(C1=__builtin_amdgcn_mfma_f32_32x32x16_bf16(kf[1],qr[0],negm,0,0,0), P0[6],P0[7],P0[8],P0[9],     pw0[2]=PKW(P0,4), pw0[3]=PKW(P0,6), pw0); \
    VRD(1); SBAR(); GAPA(C0=__builtin_amdgcn_mfma_f32_32x32x16_bf16(kf[2],qr[1],C0,0,0,0),   P0[10],P0[11],P0[12],P0[13], pw1[0]=PKW(P0,8), pw1[1]=PKW(P0,10), pw1); \
    VRD(5); SBAR(); GAPA(C1=__builtin_amdgcn_mfma_f32_32x32x16_bf16(kf[3],qr[1],C1,0,0,0),   P0[14],P0[15],P1[0],P1[1],   pw1[2]=PKW(P0,12),pw1[3]=PKW(P0,14), pw1); \
    VRD(2); SBAR(); GAPA(C0=__builtin_amdgcn_mfma_f32_32x32x16_bf16(kf[4],qr[2],C0,0,0,0),   P1[2],P1[3],P1[4],P1[5],     pw2[0]=PKW(P1,0), pw2[1]=PKW(P1,2), pw2); \
    VRD(6); SBAR(); GAPA(C1=__builtin_amdgcn_mfma_f32_32x32x16_bf16(kf[5],qr[2],C1,0,0,0),   P1[6],P1[7],P1[8],P1[9],     pw2[2]=PKW(P1,4), pw2[3]=PKW(P1,6), pw2); \
    VRD(3); SBAR(); GAPA(C0=__builtin_amdgcn_mfma_f32_32x32x16_bf16(kf[6],qr[3],C0,0,0,0),   P1[10],P1[11],P1[12],P1[13], pw3[0]=PKW(P1,8), pw3[1]=PKW(P1,10), pw3); \
    VRD(7); SBAR(); GAPA(C1=__builtin_amdgcn_mfma_f32_32x32x16_bf16(kf[7],qr[3],C1,0,0,0),   P1[14],P1[15],0.f,0.f,       pw3[2]=PKW(P1,12),pw3[3]=PKW(P1,14), pw3); \
    l_reg+=sacc; \
    if(GK){DMA_K((t)+3,sl_cur);} if(GV){DMA_V((t)+1,sl_next);} \
    CMASK(C0,C1,t); \
    { float a=MX3(C0[0],C0[1],C1[0]),b=MX3(C0[2],C0[3],C1[1]); a=MX3(a,C1[2],C1[3]); \
      _Pragma("unroll") for(int r=4;r<16;r+=4){a=MX3(a,C0[r],C0[r+1]);b=MX3(b,C0[r+2],C0[r+3]);a=MX3(a,C1[r],C1[r+1]);b=MX3(b,C1[r+2],C1[r+3]);} \
      float rm=__builtin_fmaxf(a,b); { auto rr=__builtin_amdgcn_permlane32_swap(__float_as_uint(rm),__float_as_uint(rm),false,false); rm=__builtin_fmaxf(__uint_as_float(rr[0]),__uint_as_float(rr[1])); } \
      resc=false; \
      if(__builtin_expect(__any(rm>(float)THRL),0)){ const float dl=__builtin_fmaxf(rm,0.f); mhat+=dl; \
        _Pragma("unroll") for(int r=0;r<16;++r){C0[r]-=dl;C1[r]-=dl;} \
        _Pragma("unroll") for(int r=0;r<16;++r)negm[r]=-mhat; asm volatile("":"+v"(negm)); \
        const float f=__builtin_amdgcn_exp2f(-dl); l_reg*=f; if(hi==0)wsf[r32]=f; resc=true; } } \
    SBAR(); \
    GAPB(o[0]=__builtin_amdgcn_mfma_f32_32x32x16_bf16(PAF(0),VFR(0),o[0],0,0,0), C0,0); \
    GAPB(o[1]=__builtin_amdgcn_mfma_f32_32x32x16_bf16(PAF(0),VFR(4),o[1],0,0,0), C0,4); \
    KRD(GL,0); GAPB(o[0]=__builtin_amdgcn_mfma_f32_32x32x16_bf16(PAF(1),VFR(1),o[0],0,0,0), C0,8); \
    KRD(GL,1); GAPB(o[1]=__builtin_amdgcn_mfma_f32_32x32x16_bf16(PAF(1),VFR(5),o[1],0,0,0), C0,12); \
    KRD(GL,2); GAPB(o[0]=__builtin_amdgcn_mfma_f32_32x32x16_bf16(PAF(2),VFR(2),o[0],0,0,0), C1,0); \
    KRD(GL,3); GAPB(o[1]=__builtin_amdgcn_mfma_f32_32x32x16_bf16(PAF(2),VFR(6),o[1],0,0,0), C1,4); \
    GAPB(o[0]=__builtin_amdgcn_mfma_f32_32x32x16_bf16(PAF(3),VFR(3),o[0],0,0,0), C1,8); \
    GAPB(o[1]=__builtin_amdgcn_mfma_f32_32x32x16_bf16(PAF(3),VFR(7),o[1],0,0,0), C1,12); \
    }while(0)
  int t=1;
  #undef CMASK
  #define CMASK(P0,P1,t) do{}while(0)
  for(;t+5<NT;t+=2){
    STEP(pB0,pB1,pA0,pA1,t,true,true,true);     WAIT_BAR(2); RESC(); ROT();
    STEP(pA0,pA1,pB0,pB1,t+1,true,true,true);   WAIT_BAR(2); RESC(); ROT();
  }
  #undef CMASK
  #define CMASK(P0,P1,t) do{int jb_=(t)-(NT-4); if(jb_>=0)cmask(P0,P1,jb_,qrel,hi);}while(0)
  #define ENDW(tt) do{ if((tt)+3<NT){WAIT_BAR(2);} else if((tt)+2<NT){WAIT_BAR(1);} else {WAIT_BAR(0);} }while(0)
  for(;t+1<NT;t+=2){
    STEP(pB0,pB1,pA0,pA1,t,(t+3<NT),(t+1<NT),(t+1<NT));       ENDW(t);   RESC(); ROT();
    STEP(pA0,pA1,pB0,pB1,t+1,(t+4<NT),(t+2<NT),(t+2<NT));     ENDW(t+1); RESC(); ROT();
  }
  STEP(pB0,pB1,pA0,pA1,NT-1,false,false,false); RESC();
  { float sacc=pB0[0]+pB0[1]; _Pragma("unroll") for(int r=2;r<16;++r)sacc+=pB0[r]; _Pragma("unroll") for(int r=0;r<16;++r)sacc+=pB1[r]; l_reg+=sacc;
    pw0=(u32x4){PKW(pB0,0),PKW(pB0,2),PKW(pB0,4),PKW(pB0,6)};pw1=(u32x4){PKW(pB0,8),PKW(pB0,10),PKW(pB0,12),PKW(pB0,14)};pw2=(u32x4){PKW(pB1,0),PKW(pB1,2),PKW(pB1,4),PKW(pB1,6)};pw3=(u32x4){PKW(pB1,8),PKW(pB1,10),PKW(pB1,12),PKW(pB1,14)};
    SBAR(); pv(o,vb0+sl_cur,PAF(0),PAF(1),PAF(2),PAF(3)); }
  #undef PKW
  #undef PAF
  #undef VFR
  #undef PIN
  #undef MX3
  #undef GAPA
  #undef GAPB
  #undef EX
  #undef VRD
  #undef KRD
  #undef STEP
  #undef ENDW
  {auto rr=__builtin_amdgcn_permlane32_swap(__float_as_uint(l_reg),__float_as_uint(l_reg),false,false);l_reg=__uint_as_float(rr[0])+__uint_as_float(rr[1]);}
  if(hi==0)wsf[32+r32]=l_reg;asm volatile("s_waitcnt lgkmcnt(0)":::"memory");
  float rli[16];
  #pragma unroll
  for(int r=0;r<16;++r)rli[r]=__builtin_amdgcn_rcpf(wsf[32+crow(r,hi)]);
  bf16*Ow=O+(rowbase+q0+wid*QBLK)*DMO+colo;
  { bf16*stg=(bf16*)(shm+LDS_OST)+wid*2048;
    #pragma unroll
    for(int r=0;r<16;++r){const int orow=crow(r,hi);
      #pragma unroll
      for(int d0=0;d0<2;++d0)stg[orow*64+d0*32+r32]=__float2bfloat16(o[d0][r]*rli[r]);}
    asm volatile("s_waitcnt lgkmcnt(0)":::"memory");
    #pragma unroll
    for(int i=0;i<4;++i){const int row=i*8+(lane>>3),ch=lane&7; const u32x4 v=*(const u32x4*)(stg+row*64+ch*8); ATTN_STORE16(Ow+(long)row*DMO+ch*8,v);} }
  asm volatile("s_waitcnt lgkmcnt(0)\n\ts_barrier":::"memory");
  #undef DMA_K
  #undef DMA_V
  #undef CMASK
  #undef START
  #undef RESC
  #undef ROT
}
constexpr int ATTN_LDS_BYTES=LDS_BYTES;
#undef SBAR
#undef WAIT_BAR
}
#define LAS __attribute__((address_space(3)))
typedef unsigned short u16;
typedef unsigned v4u __attribute__((ext_vector_type(4)));
typedef unsigned v2u __attribute__((ext_vector_type(2)));
typedef float f32x4 __attribute__((ext_vector_type(4)));
typedef short bf16x8 __attribute__((ext_vector_type(8)));
typedef short s16x4 __attribute__((ext_vector_type(4)));
typedef float f32x16 __attribute__((ext_vector_type(16)));
typedef float f32x2_t __attribute__((ext_vector_type(2)));
typedef __bf16 bf16x2_t __attribute__((ext_vector_type(2)));

constexpr int MTOK = 32768, SEQL = 8192, DMODEL = 1024, FFD = 4096, NIN0 = 3584, NIN1 = 3072, PLE = 256;
constexpr float LN_EPS = 1e-5f;
constexpr float ALPHA = 1.4142135623730951f;
constexpr size_t MiB = 1u << 20;
constexpr size_t WS_CVEC = 0;
constexpr size_t WS_STATS = 62 * MiB;
constexpr size_t WS_ROWSS = 63 * MiB;
constexpr size_t WS_BAR = 256 * 1024;
constexpr size_t WS_MISC = 512 * 1024;
constexpr size_t WS_CS = 1 * MiB;
constexpr size_t WS_WIN0 = 2 * MiB, WS_WOUT0 = 9 * MiB, WS_WIN1 = 11 * MiB, WS_WOUT1 = 17 * MiB, WS_W1 = 19 * MiB  , WS_W2 = 35 * MiB  , WS_WP = 51 * MiB  , WS_WG = 52 * MiB  ;
constexpr size_t WS_LSE = 56 * MiB;
constexpr size_t WS_XB = 64 * MiB, WS_MIX = 128 * MiB, WS_HB = 192 * MiB, WS_AUX = 448 * MiB, WS_END = 512 * MiB;
constexpr size_t WS_HGS = 416 * MiB, WS_HGD = 432 * MiB;
constexpr size_t WS_OB1 = 384 * MiB;
constexpr int LDS_BYTES = 147456;

__device__ __forceinline__ unsigned f2bf(float f) { unsigned u = __builtin_bit_cast(unsigned, f); return (u + 0x7fffu + ((u >> 16) & 1u)) >> 16; }
__device__ __forceinline__ unsigned pk2(float lo, float hi) { f32x2_t v = {lo, hi}; bf16x2_t b = __builtin_convertvector(v, bf16x2_t); return __builtin_bit_cast(unsigned, b); }
__device__ __forceinline__ float bf2f(unsigned v) { return __uint_as_float(v << 16); }
__device__ __forceinline__ float bflo(unsigned w) { return __uint_as_float(w << 16); }
__device__ __forceinline__ float bfhi(unsigned w) { return __uint_as_float(w & 0xffff0000u); }
__device__ __forceinline__ float shx(float v, int m, int lane) { return __builtin_bit_cast(float, __builtin_amdgcn_ds_bpermute((lane ^ m) << 2, __builtin_bit_cast(int, v))); }
__device__ __forceinline__ float wave_sum(float v, int lane) {
#pragma unroll
    for (int o = 1; o < 64; o <<= 1) v += shx(v, o, lane);
    return v;
}
__device__ __forceinline__ int crow(int reg, int h) { return (reg & 3) + 8 * (reg >> 2) + 4 * h; }
#define MFMA32(a, b, c) __builtin_amdgcn_mfma_f32_32x32x16_bf16((a), (b), (c), 0, 0, 0)
__device__ __forceinline__ bf16x8 pack8(const f32x16& x, int base) {
    v4u p; p.x = pk2(x[base], x[base + 1]); p.y = pk2(x[base + 2], x[base + 3]); p.z = pk2(x[base + 4], x[base + 5]); p.w = pk2(x[base + 6], x[base + 7]);
    return __builtin_bit_cast(bf16x8, p);
}
typedef short v4i16_t __attribute__((ext_vector_type(4)));
__device__ __forceinline__ s16x4 trrd(LAS unsigned char* p) { return __builtin_bit_cast(s16x4, __builtin_amdgcn_ds_read_tr16_b64_v4i16((LAS v4i16_t*)p)); }
__device__ __forceinline__ bf16x8 trfrag(LAS unsigned char* img, int pitch, int row_lo, int hi_delta, int col0, int lane) {
    const int i16 = lane & 15, q = i16 >> 2, p = i16 & 3, g16 = (lane >> 4) & 1;
    LAS unsigned char* a = img + (row_lo + q) * pitch + (col0 + 16 * g16 + 4 * p) * 2;
    const s16x4 lo = trrd(a), hi = trrd(a + hi_delta * pitch);
    return (bf16x8){lo[0], lo[1], lo[2], lo[3], hi[0], hi[1], hi[2], hi[3]};
}

struct Args {
    const float *x, *p, *ev_w_in, *ev_w_out, *da_lambda, *da_subln_g, *hg_lb_logits, *hg_norm_g, *od_w_in, *od_w_out, *ln1_g, *ln1_b, *ffn_w1, *ffn_w2, *ln2_g, *ln2_b, *ple_w_proj, *ple_w_gate, *ple_norm_g;
    float* out; unsigned char* ws;
};

__device__ __forceinline__ void p0_transpose_item(const float* W, int K, int N, u16* WT, LAS float* scr, int item, int lane, const float* gk = nullptr, const float* bk = nullptr, float* c1 = nullptr, float* c2 = nullptr) {
    const int nblk = N / 32, kb = item / nblk, nb = item % nblk, k0 = 64 * kb, n0 = 32 * nb;
#pragma unroll 8
    for (int i = 0; i < 32; ++i) { const int kk = 2 * i + (lane >> 5); scr[kk * 33 + (lane & 31)] = W[(size_t)(k0 + kk) * N + n0 + (lane & 31)]; }
    asm volatile("s_waitcnt lgkmcnt(0)" ::: "memory");
    const int c = lane & 7;
    float gs[8];
#pragma unroll
    for (int e = 0; e < 8; ++e) gs[e] = gk ? gk[k0 + 8 * c + e] : 1.f;
    if (gk) {
        const int n = lane & 31, kh = (lane >> 5) * 32; float s1 = 0.f, s2 = 0.f;
#pragma unroll 8
        for (int kk = 0; kk < 32; ++kk) { const float wv = scr[(kh + kk) * 33 + n]; s1 += gk[k0 + kh + kk] * wv; s2 += bk[k0 + kh + kk] * wv; }
        s1 += shx(s1, 32, lane); s2 += shx(s2, 32, lane);
        if (lane < 32) { atomicAdd(c1 + n0 + n, s1); atomicAdd(c2 + n0 + n, s2); }
    }
#pragma unroll
    for (int j = 0; j < 4; ++j) { const int n = (lane >> 3) + 8 * j; const LAS float* sp = scr + (8 * c) * 33 + n;
        v4u o; o.x = pk2(sp[0 * 33] * gs[0], sp[1 * 33] * gs[1]); o.y = pk2(sp[2 * 33] * gs[2], sp[3 * 33] * gs[3]); o.z = pk2(sp[4 * 33] * gs[4], sp[5 * 33] * gs[5]); o.w = pk2(sp[6 * 33] * gs[6], sp[7 * 33] * gs[7]);
        *(v4u*)(WT + (size_t)(n0 + n) * K + k0 + 8 * c) = o; }
    asm volatile("s_waitcnt lgkmcnt(0)" ::: "memory");
}
__device__ __forceinline__ void prologue(const Args& A, LAS unsigned char* lds, int gw, int NGW, int wave, int lane) {
    unsigned char* ws = A.ws;
    LAS float* scr = (LAS float*)(lds + wave * 16384);
    const int cnt[12] = {(1024 / 64) * (NIN0 / 32), 512, (1024 / 64) * (NIN1 / 32), 512, 2048, 2048, 2048, 2048, 128, 128, 512, 512};
    int total = 0;
#pragma unroll
    for (int i = 0; i < 12; ++i) total += cnt[i];
    for (int it = gw; it < total; it += NGW) {
        int r = it;
        if (r < cnt[0]) { p0_transpose_item(A.ev_w_in, 1024, NIN0, (u16*)(ws + WS_WIN0), scr, r, lane); continue; } r -= cnt[0];
        if (r < cnt[1]) { p0_transpose_item(A.ev_w_out, 1024, 1024, (u16*)(ws + WS_WOUT0), scr, r, lane); continue; } r -= cnt[1];
        if (r < cnt[2]) { p0_transpose_item(A.od_w_in, 1024, NIN1, (u16*)(ws + WS_WIN1), scr, r, lane); continue; } r -= cnt[2];
        if (r < cnt[3]) { p0_transpose_item(A.od_w_out, 1024, 1024, (u16*)(ws + WS_WOUT1), scr, r, lane); continue; } r -= cnt[3];
        if (r < 4096) { const int l = r >> 11; float* cv = (float*)(ws + WS_CVEC) + l * 10240; p0_transpose_item(A.ffn_w1 + (size_t)l * 1024 * 4096, 1024, 4096, (u16*)(ws + WS_W1 + l * 8 * MiB), scr, r & 2047, lane, A.ln1_g + l * 1024, A.ln1_b + l * 1024, cv, cv + 4096); continue; } r -= 4096;
        if (r < 4096) { const int l = r >> 11; p0_transpose_item(A.ffn_w2 + (size_t)l * 1024 * 4096, 4096, 1024, (u16*)(ws + WS_W2 + l * 8 * MiB), scr, r & 2047, lane); continue; } r -= 4096;
        if (r < 256) { const int l = r >> 7; p0_transpose_item(A.ple_w_proj + (size_t)l * 256 * 1024, 256, 1024, (u16*)(ws + WS_WP + l * (MiB / 2)), scr, r & 127, lane); continue; } r -= 256;
        { const int l = r >> 9; float* cv = (float*)(ws + WS_CVEC) + l * 10240 + 8192; p0_transpose_item(A.ple_w_gate + (size_t)l * 1024 * 1024, 1024, 1024, (u16*)(ws + WS_WG + l * 2 * MiB), scr, r & 511, lane, A.ln2_g + l * 1024, A.ln2_b + l * 1024, cv, cv + 1024); }
    }
    u16* XB = (u16*)(ws + WS_XB);
    for (int m = gw; m < MTOK; m += NGW) {
        const f32x4* xr = (const f32x4*)(A.x + (size_t)m * 1024) + lane; v2u* o = (v2u*)(XB + (size_t)m * 1024) + lane;
#pragma unroll
        for (int j = 0; j < 4; ++j) { const f32x4 v = xr[64 * j]; v2u w; w.x = pk2(v[0], v[1]); w.y = pk2(v[2], v[3]); o[64 * j] = w; }
    }
    { v4u* z = (v4u*)(ws + WS_STATS); for (int i = gw * 64 + lane; i < (int)((MiB + 256 * 1024) / 16); i += NGW * 64) z[i] = (v4u){0u, 0u, 0u, 0u}; }
    float* cs = (float*)(ws + WS_CS);
    for (int idx = gw * 64 + lane; idx < 65536; idx += NGW * 64) {
        const int pos = idx >> 3, e = idx & 7;
        double iv = 1.0;
#pragma unroll 1
        for (int k = 0; k < e; ++k) iv *= 0.19392274474868576;
        const float inv = (float)iv;
        const float angf = (float)pos * inv;
        double a = (double)angf; const double twopi = 6.283185307179586476925;
        const double kq = __builtin_rint(a / twopi); a -= kq * twopi;
        const double a2 = a * a; double sn = 0.0, cn = 0.0;
        double ts = a, tc = 1.0;
#pragma unroll 1
        for (int n = 0; n < 16; ++n) { cn += tc; sn += ts; tc *= -a2 / (double)((2 * n + 1) * (2 * n + 2)); ts *= -a2 / (double)((2 * n + 2) * (2 * n + 3)); }
        cs[idx] = (float)cn; cs[65536 + idx] = (float)sn;
    }
    float* misc = (float*)(ws + WS_MISC);
    for (int i = gw * 64 + lane; i < 512; i += NGW * 64) { const float l0 = A.hg_lb_logits[i], l1 = A.hg_lb_logits[512 + i]; misc[i] = 1.f / (1.f + __expf(l1 - l0)); }
}

__device__ __forceinline__ void ln_rows(float* X, u16* XBo, const float* g, const float* bta, float* rowss, const float* prow, u16* PBo, int gw, int NGW, int lane) {
    for (int m = gw; m < MTOK; m += NGW) {
        f32x4* xr = (f32x4*)(X + (size_t)m * 1024) + lane;
        f32x4 v[4]; float s = 0.f;
#pragma unroll
        for (int j = 0; j < 4; ++j) { v[j] = xr[64 * j]; s += (v[j][0] + v[j][1]) + (v[j][2] + v[j][3]); }
        const float mean = wave_sum(s, lane) * (1.f / 1024.f); float s2 = 0.f;
#pragma unroll
        for (int j = 0; j < 4; ++j) { v[j] = v[j] - mean; s2 += (v[j][0] * v[j][0] + v[j][1] * v[j][1]) + (v[j][2] * v[j][2] + v[j][3] * v[j][3]); }
        const float rstd = 1.f / sqrtf(wave_sum(s2, lane) * (1.f / 1024.f) + LN_EPS);
        v2u* o8 = (v2u*)(XBo + (size_t)m * 1024) + lane;
#pragma unroll
        for (int j = 0; j < 4; ++j) { const f32x4 gv = ((const f32x4*)g)[lane + 64 * j], bv = ((const f32x4*)bta)[lane + 64 * j];
            const f32x4 o = v[j] * rstd * gv + bv; xr[64 * j] = o; v2u w; w.x = pk2(o[0], o[1]); w.y = pk2(o[2], o[3]); o8[64 * j] = w; }
        if (rowss && lane == 0) rowss[m] = 0.f;
        if (prow) { const f32x4 pv = ((const f32x4*)(prow + (size_t)m * 256))[lane]; v2u w; w.x = pk2(pv[0], pv[1]); w.y = pk2(pv[2], pv[3]); ((v2u*)(PBo + (size_t)m * 256))[lane] = w; }
    }
}
__device__ __forceinline__ void p_rows(const float* prow, u16* PBo, int gw, int NGW, int lane) {
    for (int m = gw; m < MTOK; m += NGW) { const f32x4 pv = ((const f32x4*)(prow + (size_t)m * 256))[lane]; v2u w; w.x = pk2(pv[0], pv[1]); w.y = pk2(pv[2], pv[3]); ((v2u*)(PBo + (size_t)m * 256))[lane] = w; }
}
__device__ __forceinline__ void diff_combine(const u16* AUX, u16* MIX, const float* lam_p, const float* subg, int gw, int NGW, int lane) {
    const float s01 = wave_sum(lam_p[lane] * lam_p[64 + lane], lane), s23 = wave_sum(lam_p[128 + lane] * lam_p[192 + lane], lane);
    const float lam = __expf(s01) - __expf(s23) + 0.2f;
    const int h = lane >> 4, d0 = (lane & 15) * 8;
    float gv[8];
#pragma unroll
    for (int e = 0; e < 8; ++e) gv[e] = subg[d0 + e] * 0.8f;
    for (int m = gw; m < MTOK; m += NGW) {
        const v4u a0 = *(const v4u*)(AUX + (size_t)m * 1024 + h * 256 + d0), a1 = *(const v4u*)(AUX + (size_t)m * 1024 + h * 256 + 128 + d0);
        float o[8];
        o[0] = bflo(a0.x) - lam * bflo(a1.x); o[1] = bfhi(a0.x) - lam * bfhi(a1.x); o[2] = bflo(a0.y) - lam * bflo(a1.y); o[3] = bfhi(a0.y) - lam * bfhi(a1.y);
        o[4] = bflo(a0.z) - lam * bflo(a1.z); o[5] = bfhi(a0.z) - lam * bfhi(a1.z); o[6] = bflo(a0.w) - lam * bflo(a1.w); o[7] = bfhi(a0.w) - lam * bfhi(a1.w);
        float ss = 0.f;
#pragma unroll
        for (int e = 0; e < 8; ++e) ss += o[e] * o[e];
        ss += shx(ss, 1, lane); ss += shx(ss, 2, lane); ss += shx(ss, 4, lane); ss += shx(ss, 8, lane);
        const float rs = 1.f / sqrtf(ss * (1.f / 128.f) + LN_EPS);
        v4u w; w.x = pk2(o[0] * rs * gv[0], o[1] * rs * gv[1]); w.y = pk2(o[2] * rs * gv[2], o[3] * rs * gv[3]); w.z = pk2(o[4] * rs * gv[4], o[5] * rs * gv[5]); w.w = pk2(o[6] * rs * gv[6], o[7] * rs * gv[7]);
        *(v4u*)(MIX + (size_t)m * 1024 + h * 128 + d0) = w;
    }
}
namespace hg {
constexpr int P_QA = 272, P_QO = 264, P_TR = 320;
constexpr int O_QA = 0, O_KA = O_QA + 64 * P_QA, O_QO = O_KA + 64 * P_QA, O_KST = O_QO + 64 * P_QO, O_V = O_KST + 64 * P_TR, O_OST = O_V + 64 * P_TR, O_TOT = O_OST + 64 * 132 * 4, O_DEC = O_TOT + 2048, O_END = O_DEC + 512;
static_assert(O_END <= 131072, "hgrn lds");
template <bool OUT>
__device__ __forceinline__ void item(LAS unsigned char* L, const u16* __restrict__ H, int it, const float* __restrict__ lbv, float* Send, float* Drun, const float* __restrict__ outg, u16* MIX, const int tid) {
    const int  lane = tid & 63, w = __builtin_amdgcn_readfirstlane(tid >> 6), r = lane & 31, h = lane >> 5;
    const int tt = w & 1, vt = w >> 1;
    const int bh = it >> 4, run = it & 15, b = bh >> 2, hh = bh & 3;
    const int kd = tid & 127, seg = tid >> 7;
    const size_t row0 = (size_t)b * 8192 + (size_t)run * 512;
    const float lb = lbv[hh * 128 + kd];
    LAS float* TOT = (LAS float*)(L + O_TOT); LAS float* DEC = (LAS float*)(L + O_DEC); LAS float* OST = (LAS float*)(L + O_OST);
    f32x16 S[4];
#pragma unroll
    for (int k = 0; k < 4; ++k) S[k] = f32x16{};
    if (OUT) {
        for (int rp = 0; rp < run; ++rp) { const int ip = bh * 16 + rp;
#pragma unroll
            for (int k = 0; k < 4; ++k)
#pragma unroll
                for (int i = 0; i < 16; ++i) S[k][i] = Drun[ip * 128 + 32 * k + crow(i, h)] * S[k][i] + Send[((((size_t)ip * 4 + vt) * 4 + k) * 16 + i) * 64 + lane];
        }
    }
    float bsum = 0.f;
    u16 nf[16], nq[16]; v4u nv[2];
#define HG_ISSUE(rowc_) do { _Pragma("unroll") for (int i = 0; i < 16; ++i) { const u16* p = H + ((rowc_) + seg * 16 + i) * NIN0 + hh * 128 + kd; nf[i] = p[2048]; if (OUT) nq[i] = p[1536]; } \
        _Pragma("unroll") for (int n = 0; n < 2; ++n) { const int id = tid + 512 * n, t = id >> 4, c = id & 15; nv[n] = *(const v4u*)(H + ((rowc_) + t) * NIN0 + 2560 + hh * 128 + c * 8); } } while (0)
    HG_ISSUE(row0);
    for (int ch = 0; ch < 8; ++ch) {
        const size_t rowc = row0 + ch * 64;
        float fg[16], cs[16], hq[16];
#pragma unroll
        for (int i = 0; i < 16; ++i) { fg[i] = bf2f(nf[i]); if (OUT) hq[i] = bf2f(nq[i]); }
#pragma unroll
        for (int n = 0; n < 2; ++n) { const int id = tid + 512 * n, t = id >> 4, c = id & 15; *(LAS v4u*)(L + O_V + t * P_TR + c * 16) = nv[n]; }
        if (ch + 1 < 8) HG_ISSUE(rowc + 64);
        float runs = 0.f;
#pragma unroll
        for (int i = 0; i < 16; ++i) { const float sg = __builtin_amdgcn_rcpf(1.f + __expf(-fg[i])); const float f = lb + (1.f - lb) * sg; fg[i] = (1.f - lb) * (1.f - sg); runs += __logf(f); cs[i] = runs; }
        TOT[seg * 128 + kd] = runs;
        __syncthreads();
        const float t0 = TOT[kd], t1 = TOT[128 + kd], t2 = TOT[256 + kd], t3 = TOT[384 + kd];
        const float off = (seg > 0 ? t0 : 0.f) + (seg > 1 ? t1 : 0.f) + (seg > 2 ? t2 : 0.f);
        const float bmid = t0 + t1, blast = (t0 + t1) + (t2 + t3);
        const float elm = __expf(blast - bmid), em = __expf(bmid);
#pragma unroll
        for (int i = 0; i < 16; ++i) {
            const int t = seg * 16 + i; const float bi = off + cs[i];
            const float e1 = __expf(bi - bmid), e2 = __builtin_amdgcn_rcpf(e1); const float kk = fg[i];
            *(LAS u16*)(L + O_KST + t * P_TR + kd * 2) = (u16)f2bf(kk * e2 * elm);
            if (OUT) { const float q = hq[i] * __builtin_amdgcn_rcpf(1.f + __expf(-hq[i]));
                *(LAS u16*)(L + O_QA + t * P_QA + kd * 2) = (u16)f2bf(q * e1);
                *(LAS u16*)(L + O_KA + t * P_QA + kd * 2) = (u16)f2bf(kk * e2);
                *(LAS u16*)(L + O_QO + t * P_QO + kd * 2) = (u16)f2bf(q * e1 * em); }
        }
        if (seg == 0) { DEC[kd] = __expf(blast); bsum += blast; }
        __syncthreads();
        if (OUT) {
            f32x16 acc = f32x16{};
            for (int st = 0; st <= tt; ++st) {
                f32x16 X = f32x16{};
#pragma unroll
                for (int ks = 0; ks < 8; ++ks) { const bf16x8 a = *(LAS bf16x8*)(L + O_KA + (32 * st + r) * P_QA + (16 * ks + 8 * h) * 2); const bf16x8 bq = *(LAS bf16x8*)(L + O_QA + (32 * tt + r) * P_QA + (16 * ks + 8 * h) * 2); X = MFMA32(a, bq, X); }
                if (st == tt) {
#pragma unroll
                    for (int i = 0; i < 16; ++i) if (crow(i, h) > r) X[i] = 0.f; }
#pragma unroll
                for (int s2 = 0; s2 < 2; ++s2) { const bf16x8 pa = pack8(X, 8 * s2); const bf16x8 vf = trfrag(L + O_V, P_TR, 32 * st + 16 * s2 + 4 * h, 8, 32 * vt, lane); acc = MFMA32(pa, vf, acc); }
            }
#pragma unroll
            for (int k = 0; k < 4; ++k)
#pragma unroll
                for (int s2 = 0; s2 < 2; ++s2) {
                    LAS unsigned char* qp = L + O_QO + (32 * tt + r) * P_QO + (32 * k + 16 * s2 + 4 * h) * 2;
                    const s16x4 lo = *(LAS s16x4*)qp, hi = *(LAS s16x4*)(qp + 16);
                    const bf16x8 a2 = (bf16x8){lo[0], lo[1], lo[2], lo[3], hi[0], hi[1], hi[2], hi[3]};
                    acc = MFMA32(a2, pack8(S[k], 8 * s2), acc); }
#pragma unroll
            for (int i = 0; i < 16; ++i) OST[(32 * tt + crow(i, h)) * 132 + 32 * vt + r] = acc[i];
        }
#pragma unroll
        for (int k = 0; k < 4; ++k) {
#pragma unroll
            for (int i = 0; i < 16; ++i) S[k][i] *= DEC[32 * k + crow(i, h)];
#pragma unroll
            for (int ks = 0; ks < 4; ++ks) { const bf16x8 a = trfrag(L + O_KST, P_TR, 16 * ks + 8 * h, 4, 32 * k, lane); const bf16x8 bv = trfrag(L + O_V, P_TR, 16 * ks + 8 * h, 4, 32 * vt, lane); S[k] = MFMA32(a, bv, S[k]); }
        }
        __syncthreads();
        if (OUT) {
            const int t = tid >> 3, c8 = tid & 7; float o[16]; float ss = 0.f;
#pragma unroll
            for (int j = 0; j < 4; ++j) { const f32x4 v = *(LAS f32x4*)(OST + t * 132 + c8 * 16 + 4 * j); o[4 * j] = v[0]; o[4 * j + 1] = v[1]; o[4 * j + 2] = v[2]; o[4 * j + 3] = v[3]; ss += (v[0] * v[0] + v[1] * v[1]) + (v[2] * v[2] + v[3] * v[3]); }
            ss += shx(ss, 1, lane); ss += shx(ss, 2, lane); ss += shx(ss, 4, lane);
            const float rs = __builtin_amdgcn_rsqf(ss * (1.f / 128.f) + LN_EPS);
            const u16* gp = H + (rowc + t) * NIN0 + 3072 + hh * 128 + c8 * 16; u16* op = MIX + (rowc + t) * 1024 + 512 + hh * 128 + c8 * 16;
#pragma unroll
            for (int j = 0; j < 2; ++j) { const v4u gvv = *(const v4u*)(gp + 8 * j); const unsigned gw_[4] = {gvv.x, gvv.y, gvv.z, gvv.w}; unsigned ow[4];
#pragma unroll
                for (int e = 0; e < 4; ++e) { const float g0 = bflo(gw_[e]), g1 = bfhi(gw_[e]); const int c = 8 * j + 2 * e;
                    const float y0 = o[c] * rs * outg[c8 * 16 + c] * (g0 * __builtin_amdgcn_rcpf(1.f + __expf(-g0))), y1 = o[c + 1] * rs * outg[c8 * 16 + c + 1] * (g1 * __builtin_amdgcn_rcpf(1.f + __expf(-g1)));
                    ow[e] = pk2(y0, y1); }
                *(v4u*)(op + 8 * j) = (v4u){ow[0], ow[1], ow[2], ow[3]}; }
        }
    }
    if (!OUT) {
        if (tt == 0) {
#pragma unroll
            for (int k = 0; k < 4; ++k)
#pragma unroll
                for (int i = 0; i < 16; ++i) Send[((((size_t)it * 4 + vt) * 4 + k) * 16 + i) * 64 + lane] = S[k][i]; }
        if (seg == 0) Drun[it * 128 + kd] = __expf(bsum);
    }
}
}

__device__ __forceinline__ void dil_task(LAS unsigned char* Lw, const u16* __restrict__ QKV, int task, u16* OBg0, u16* OBg1, u16* OBg2, float* LSE, int lane) {
    const int r = lane & 31, h = lane >> 5;
    const int bh = task / 768, rem = task - bh * 768, g = rem >> 8, j = rem & 255;
    const int sh = 2 * g, res = j >> (8 - sh), qt = j & ((256 >> sh) - 1);
    const int b = bh >> 4, hd = bh & 15;
    const size_t rowb = (size_t)b * 8192;
    const int qpos = res + ((32 * qt + r) << sh);
    const u16* qp = QKV + (rowb + qpos) * NIN1 + hd * 64;
    bf16x8 qf[4];
#pragma unroll
    for (int ks = 0; ks < 4; ++ks) qf[ks] = *(const bf16x8*)(qp + 16 * ks + 8 * h);
    f32x16 X[5];
#pragma unroll
    for (int kb = 0; kb < 5; ++kb) {
        int ki = 32 * qt - 128 + 32 * kb + r; ki = ki < 0 ? 0 : ki;
        const u16* kp = QKV + (rowb + res + (ki << sh)) * NIN1 + 1024 + hd * 64;
        X[kb] = f32x16{};
#pragma unroll
        for (int ks = 0; ks < 4; ++ks) { const bf16x8 kf = *(const bf16x8*)(kp + 16 * ks + 8 * h); X[kb] = MFMA32(kf, qf[ks], X[kb]); }
    }
    float m = -INFINITY;
#pragma unroll
    for (int kb = 0; kb < 5; ++kb)
#pragma unroll
        for (int i = 0; i < 16; ++i) { const int c = crow(i, h); bool valid = (32 * qt - 128 + 32 * kb + c) >= 0;
            if (kb == 0) valid = valid && (c >= r);
            if (kb == 4) valid = valid && (c <= r);
            X[kb][i] = valid ? X[kb][i] : -INFINITY; m = fmaxf(m, X[kb][i]); }
    m = fmaxf(m, shx(m, 32, lane));
    float l = 0.f;
#pragma unroll
    for (int kb = 0; kb < 5; ++kb)
#pragma unroll
        for (int i = 0; i < 16; ++i) { X[kb][i] = __builtin_amdgcn_exp2f(X[kb][i] - m); l += X[kb][i]; }
    l += shx(l, 32, lane);
    f32x16 y[2]; y[0] = f32x16{}; y[1] = f32x16{};
#pragma unroll
    for (int kb = 0; kb < 5; ++kb) {
#pragma unroll
        for (int n = 0; n < 4; ++n) { const int id = lane + 64 * n, key = id >> 3, c = id & 7; int ki = 32 * qt - 128 + 32 * kb + key; ki = ki < 0 ? 0 : ki;
            const v4u v = *(const v4u*)(QKV + (rowb + res + (ki << sh)) * NIN1 + 2048 + hd * 64 + c * 8); *(LAS v4u*)(Lw + key * 192 + c * 16) = v; }
#pragma unroll
        for (int s2 = 0; s2 < 2; ++s2) { const bf16x8 pb = pack8(X[kb], 8 * s2);
#pragma unroll
            for (int dt = 0; dt < 2; ++dt) { const bf16x8 a = trfrag(Lw, 192, 16 * s2 + 4 * h, 8, 32 * dt, lane); y[dt] = MFMA32(a, pb, y[dt]); } }
    }
    const float inv = 1.f / l;
    u16* ob = (g == 0 ? OBg0 : g == 1 ? OBg1 : OBg2) + (rowb + qpos) * 1024 + hd * 64;
#pragma unroll
    for (int dt = 0; dt < 2; ++dt)
#pragma unroll
        for (int gq = 0; gq < 4; ++gq) { v2u w; w.x = pk2(y[dt][4 * gq] * inv, y[dt][4 * gq + 1] * inv); w.y = pk2(y[dt][4 * gq + 2] * inv, y[dt][4 * gq + 3] * inv); *(v2u*)(ob + 32 * dt + 8 * gq + 4 * h) = w; }
    if (h == 0) LSE[((size_t)g * MTOK + rowb + qpos) * 16 + hd] = (m + __log2f(l)) * 0.6931471805599453f;
}
namespace dl {
constexpr int KP = 144, VP = 192, O_K = 0, O_V = 384 * KP, O_END = O_V + 384 * VP;
static_assert(O_END <= 131072, "dilated lds");
struct Dec { int g, sh, res, i0, hd; size_t rowb; };
__device__ __forceinline__ Dec decode(int task) {
    Dec d; const int bh = task / 96, rem = task - bh * 96; d.g = rem >> 5; const int j = rem & 31;
    d.sh = 2 * d.g; d.res = j >> (5 - d.sh); d.i0 = 256 * (j & ((32 >> d.sh) - 1)); d.hd = bh & 15; d.rowb = (size_t)(bh >> 4) * 8192; return d;
}
__device__ __forceinline__ void issue(const u16* __restrict__ QKV, int task, int tid, v4u (&pk)[6], v4u (&pv)[6], bf16x8 (&qn)[4]) {
    const Dec d = decode(task); const int lane = tid & 63, w = tid >> 6, r = lane & 31, h = lane >> 5;
#pragma unroll
    for (int n = 0; n < 6; ++n) { const int id = tid + 512 * n, c = id >> 3, ch = id & 7; int ki = d.i0 - 128 + c; ki = ki < 0 ? 0 : ki;
        const u16* src = QKV + (d.rowb + d.res + (ki << d.sh)) * NIN1 + d.hd * 64 + ch * 8;
        pk[n] = *(const v4u*)(src + 1024); pv[n] = *(const v4u*)(src + 2048); }
    const u16* qp = QKV + (d.rowb + d.res + ((d.i0 + 32 * w + r) << d.sh)) * NIN1 + d.hd * 64;
#pragma unroll
    for (int ks = 0; ks < 4; ++ks) qn[ks] = *(const bf16x8*)(qp + 16 * ks + 8 * h);
}
__device__ __forceinline__ void phase(LAS unsigned char* L, const u16* __restrict__ QKV, u16* OBg0, u16* OBg1, u16* OBg2, float* LSE, int first, int stride, const int tid) {
    const int lane = tid & 63, w = __builtin_amdgcn_readfirstlane(tid >> 6), r = lane & 31, h = lane >> 5;
    const bool xl = (stride == 256); const int nround = xl ? 24 : (6144 - first + stride - 1) / stride;
    if (first >= 6144) return;
#define DL_TASK(k) (xl ? (((first >> 5) * 8 + (k) / 3) * 96 + ((k) % 3) * 32 + (first & 31)) : (first + (k) * stride))
    v4u pk[6], pv[6]; bf16x8 qn[4];
    issue(QKV, DL_TASK(0), tid, pk, pv, qn);
    for (int kr = 0; kr < nround; ++kr) {
        const int task = DL_TASK(kr);
        const Dec d = decode(task);
#pragma unroll
        for (int n = 0; n < 6; ++n) { const int id = tid + 512 * n, c = id >> 3, ch = id & 7; *(LAS v4u*)(L + O_K + c * KP + ch * 16) = pk[n]; *(LAS v4u*)(L + O_V + c * VP + ch * 16) = pv[n]; }
        bf16x8 qf[4];
#pragma unroll
        for (int ks = 0; ks < 4; ++ks) qf[ks] = qn[ks];
        __syncthreads();
        if (kr + 1 < nround) issue(QKV, DL_TASK(kr + 1), tid, pk, pv, qn);
        const int i0 = d.i0, g = d.g, sh = d.sh;
        const int qpos = d.res + ((i0 + 32 * w + r) << sh);
        f32x16 X[5];
#pragma unroll
        for (int kb = 0; kb < 5; ++kb) {
            X[kb] = f32x16{};
#pragma unroll
            for (int ks = 0; ks < 4; ++ks) { const bf16x8 kf = *(LAS bf16x8*)(L + O_K + (32 * w + 32 * kb + r) * KP + (16 * ks + 8 * h) * 2); X[kb] = MFMA32(kf, qf[ks], X[kb]); }
        }
        float m = -INFINITY;
#pragma unroll
        for (int kb = 0; kb < 5; ++kb)
#pragma unroll
            for (int i = 0; i < 16; ++i) { const int c = crow(i, h); bool valid = (i0 - 128 + 32 * w + 32 * kb + c) >= 0;
                if (kb == 0) valid = valid && (c >= r);
                if (kb == 4) valid = valid && (c <= r);
                X[kb][i] = valid ? X[kb][i] : -INFINITY; m = fmaxf(m, X[kb][i]); }
        m = fmaxf(m, shx(m, 32, lane));
        float l = 0.f;
#pragma unroll
        for (int kb = 0; kb < 5; ++kb)
#pragma unroll
            for (int i = 0; i < 16; ++i) { X[kb][i] = __builtin_amdgcn_exp2f(X[kb][i] - m); l += X[kb][i]; }
        l += shx(l, 32, lane);
        f32x16 y[2]; y[0] = f32x16{}; y[1] = f32x16{};
#pragma unroll
        for (int kb = 0; kb < 5; ++kb)
#pragma unroll
            for (int s2 = 0; s2 < 2; ++s2) { const bf16x8 pb = pack8(X[kb], 8 * s2);
#pragma unroll
                for (int dt = 0; dt < 2; ++dt) { const bf16x8 a = trfrag(L + O_V, VP, 32 * w + 32 * kb + 16 * s2 + 4 * h, 8, 32 * dt, lane); y[dt] = MFMA32(a, pb, y[dt]); } }
        const float inv = 1.f / l;
        u16* ob = (g == 0 ? OBg0 : g == 1 ? OBg1 : OBg2) + (d.rowb + qpos) * 1024 + d.hd * 64;
#pragma unroll
        for (int dt = 0; dt < 2; ++dt)
#pragma unroll
            for (int gq = 0; gq < 4; ++gq) { v2u wv; wv.x = pk2(y[dt][4 * gq] * inv, y[dt][4 * gq + 1] * inv); wv.y = pk2(y[dt][4 * gq + 2] * inv, y[dt][4 * gq + 3] * inv); *(v2u*)(ob + 32 * dt + 8 * gq + 4 * h) = wv; }
        if (h == 0) LSE[((size_t)g * MTOK + d.rowb + qpos) * 16 + d.hd] = (m + __log2f(l)) * 0.6931471805599453f;
        __syncthreads();
    }
}
}
__device__ __forceinline__ void dil_merge(const u16* OB0, const u16* OB1, const u16* OB2, const float* LSE, u16* MIX, int gw, int NGW, int lane) {
    const int hd = lane >> 2, dq = (lane & 3) * 16;
    for (int m = gw; m < MTOK; m += NGW) {
        const float l0 = LSE[((size_t)m) * 16 + hd], l1 = LSE[((size_t)MTOK + m) * 16 + hd], l2 = LSE[((size_t)2 * MTOK + m) * 16 + hd];
        const float mx = fmaxf(l0, fmaxf(l1, l2)); float w0 = __expf(l0 - mx), w1 = __expf(l1 - mx), w2 = __expf(l2 - mx); const float iz = 1.f / (w0 + w1 + w2); w0 *= iz; w1 *= iz; w2 *= iz;
        const size_t off = (size_t)m * 1024 + hd * 64 + dq;
#pragma unroll
        for (int j = 0; j < 2; ++j) { const v4u a = *(const v4u*)(OB0 + off + 8 * j), bq = *(const v4u*)(OB1 + off + 8 * j), c = *(const v4u*)(OB2 + off + 8 * j);
            const unsigned aw[4] = {a.x, a.y, a.z, a.w}, bw[4] = {bq.x, bq.y, bq.z, bq.w}, cw[4] = {c.x, c.y, c.z, c.w}; unsigned ow[4];
#pragma unroll
            for (int e = 0; e < 4; ++e) ow[e] = pk2(w0 * bflo(aw[e]) + w1 * bflo(bw[e]) + w2 * bflo(cw[e]), w0 * bfhi(aw[e]) + w1 * bfhi(bw[e]) + w2 * bfhi(cw[e]));
            *(v4u*)(MIX + off + 8 * j) = (v4u){ow[0], ow[1], ow[2], ow[3]}; }
    }
}
#ifndef REP_PRO
#define REP_PRO 1
#endif
#ifndef REP_P1
#define REP_P1 1
#endif
#ifndef REP_HGA
#define REP_HGA 1
#endif
#ifndef REP_HGC
#define REP_HGC 1
#endif
#ifndef REP_CMB
#define REP_CMB 1
#endif
#ifndef REP_DIL
#define REP_DIL 1
#endif
#ifndef REP_MRG
#define REP_MRG 1
#endif
#ifndef REP_P6
#define REP_P6 1
#endif
#ifndef REP_ATT
#define REP_ATT 1
#endif
#ifndef PH_LO
#define PH_LO 0
#endif
#ifndef PH_HI
#define PH_HI 100
#endif
__device__ __forceinline__ int fresh_lane() { int l; asm volatile("v_mbcnt_lo_u32_b32 %0, -1, 0\n\tv_mbcnt_hi_u32_b32 %0, -1, %0" : "=v"(l)); return l; }
__device__ __forceinline__ unsigned xcc_id() { return (unsigned)__builtin_amdgcn_s_getreg((3 << 11) | 20) & 0xFu; }
__device__ __forceinline__ unsigned bar_ld(unsigned* p) { return __hip_atomic_load(p, __ATOMIC_RELAXED, __HIP_MEMORY_SCOPE_AGENT); }
__device__ __forceinline__ unsigned bar_add(unsigned* p) { return __hip_atomic_fetch_add(p, 1u, __ATOMIC_RELAXED, __HIP_MEMORY_SCOPE_AGENT); }
__device__ __forceinline__ void grid_bar(unsigned* bar, unsigned k, unsigned x, unsigned nloc, unsigned nx, int wave0) {
    asm volatile("s_waitcnt vmcnt(0) lgkmcnt(0)" ::: "memory");
    __syncthreads();
    if (wave0 == 0) {
        const int ln = fresh_lane();
        if (ln == 0) {
            const unsigned old = bar_add(&bar[1024 + 64 * x]);
            if (old + 1u == k * nloc) {
                __builtin_amdgcn_fence(__ATOMIC_RELEASE, "agent");
                asm volatile("s_waitcnt vmcnt(0)" ::: "memory");
                const unsigned og = bar_add(&bar[3072]);
                if (og + 1u == k * nx) bar_add(&bar[3136]);
                else while (bar_ld(&bar[3136]) < k) __builtin_amdgcn_s_sleep(1);
                __builtin_amdgcn_fence(__ATOMIC_ACQUIRE, "agent");
                bar_add(&bar[2048 + 64 * x]);
                asm volatile("s_waitcnt vmcnt(0)" ::: "memory");
            } else {
                while (bar_ld(&bar[2048 + 64 * x]) < k) __builtin_amdgcn_s_sleep(1);
                __builtin_amdgcn_fence(__ATOMIC_ACQUIRE, "agent");
                asm volatile("s_waitcnt vmcnt(0)" ::: "memory");
            }
        }
    }
    __syncthreads();
}
template <class Epi>
__device__ __forceinline__ void run_gemm(LAS unsigned char* lds, const u16* A, const u16* Bt, int N, int K, const Epi& E, int tid) {
    asm volatile("" : "+v"(tid));
    pg8::Gemm g{A, Bt, MTOK, N, K}; pg8::StaticOrder S; S.init(MTOK, N, (int)gridDim.x, (int)blockIdx.x);
    pg8::gemm_phase<Epi, pg8::StaticOrder, PG8_ALIGN, PG8_SP2>(lds, g, S, E, tid);
}
__global__ void __launch_bounds__(512, 2) fwd_kernel(Args A) {
    extern __shared__ __attribute__((aligned(16))) unsigned char lds_raw[];
    LAS unsigned char* lds = (LAS unsigned char*)lds_raw;
    cg::grid_group grid = cg::this_grid();
    const int wave0 = __builtin_amdgcn_readfirstlane((int)threadIdx.x >> 6);
#define tid0 (wave0 * 64 + fresh_lane())
    const int G = gridDim.x, bx = blockIdx.x;
    const int vcu = (G % 8 == 0) ? (bx % 8) * (G / 8) + bx / 8 : bx;
    const int NGW = G * 8;
#define PHASE_IDS() int tid = tid0; asm volatile("" : "+v"(tid)); const int lane = tid & 63, wave = __builtin_amdgcn_readfirstlane(tid >> 6), gw = bx * 8 + wave; (void)lane; (void)gw;
    unsigned char* ws = A.ws;
    float* rowss0 = (float*)(ws + WS_ROWSS); float* stats0 = (float*)(ws + WS_STATS); const float* cvec0 = (const float*)(ws + WS_CVEC); const float* lbv = (const float*)(ws + WS_MISC); const float* cs = (const float*)(ws + WS_CS);
    u16* XB = (u16*)(ws + WS_XB); u16* MIX = (u16*)(ws + WS_MIX); u16* HB = (u16*)(ws + WS_HB); u16* AUX = (u16*)(ws + WS_AUX);
    float* HGS = (float*)(ws + WS_HGS); float* HGD = (float*)(ws + WS_HGD); float* LSE = (float*)(ws + WS_LSE); u16* OB1 = (u16*)(ws + WS_OB1);
    float* X = A.out;
    unsigned* barw = (unsigned*)(ws + WS_BAR); unsigned nbar = 0;
    const unsigned myx = xcc_id();
    if (threadIdx.x == 0) bar_add(&barw[64 * myx]);
    unsigned nloc = 1, nxc = 1;
#define GSYNC() do { ++nbar; grid_bar(barw, nbar, myx, nloc, nxc, wave0); } while (0)

    for (int rep_ = 0; rep_ < REP_PRO; ++rep_) { { PHASE_IDS(); prologue(A, lds, gw, NGW, wave, lane); } }
    grid.sync();
    { unsigned cnt = 0, mine = 0;
#pragma unroll
      for (unsigned jx = 0; jx < 16; ++jx) { const unsigned c = bar_ld(&barw[64 * jx]); cnt += (c > 0u) ? 1u : 0u; mine = (jx == myx) ? c : mine; }
      nloc = (unsigned)__builtin_amdgcn_readfirstlane((int)mine); nxc = (unsigned)__builtin_amdgcn_readfirstlane((int)cnt); }

    for (int l = 0; l < 2; ++l) {
        const u16* Ain = (l == 0) ? XB : (const u16*)X;
        if (l == 0) {
            for (int rep_ = 0; rep_ < REP_P1; ++rep_) { { pg8::EpiStore E{HB, NIN0, 0, 1024, 512, cs, nullptr, nullptr, nullptr}; run_gemm(lds, Ain, (const u16*)(ws + WS_WIN0), NIN0, 1024, E, tid0); } }
            GSYNC();
#ifndef NO_HGA
            for (int rep_ = 0; rep_ < REP_HGA; ++rep_) { for (int it = vcu; it < 256; it += G) { PHASE_IDS(); hg::item<false>(lds, HB, it, lbv, HGS, HGD, nullptr, nullptr, tid); } }
#endif
            __syncthreads();
            for (int rep_ = 0; rep_ < REP_ATT; ++rep_)
            for (int i = 0; i < 2048; ++i) {
                int tidA = tid0; asm volatile("" : "+v"(tidA));
                int pair, qb;
                if (G == 256) { if (i >= 8) break; const int s = vcu & 3, k = 7 - i; pair = vcu >> 2; qb = 4 * k + ((k & 1) ? 3 - s : s); }
                else { const int u = vcu + i * G; if (u >= 2048) break; pair = u >> 5; qb = 31 - (u & 31); }
                const int b = pair >> 4, vh = pair & 15, hh = vh >> 2, c = (vh >> 1) & 1, half = vh & 1;
#ifndef NO_ATTN
                attn_body::attn_unit<8>(b, (2 * hh + c) * 64, 512 + (2 * hh + c) * 64, 1024 + hh * 128 + half * 64, vh * 64, qb,
                                        (const attn_body::bf16*)HB, (const attn_body::bf16*)HB, (const attn_body::bf16*)HB, (attn_body::bf16*)AUX, (char*)lds_raw, tidA);
#endif
            }
            GSYNC();
#ifndef NO_HGC
            for (int rep_ = 0; rep_ < REP_HGC; ++rep_) { for (int it = vcu; it < 256; it += G) { PHASE_IDS(); hg::item<true>(lds, HB, it, lbv, HGS, HGD, A.hg_norm_g, MIX, tid); } }
#endif
            for (int rep_ = 0; rep_ < REP_CMB; ++rep_) { { PHASE_IDS(); diff_combine(AUX, MIX, A.da_lambda, A.da_subln_g, gw, NGW, lane); } }
            GSYNC();
        } else {
            { pg8::EpiStore E{HB, NIN1, 0, 2048, 1024, cs, nullptr, nullptr, nullptr}; run_gemm(lds, Ain, (const u16*)(ws + WS_WIN1), NIN1, 1024, E, tid0); }
            GSYNC();
#ifndef NO_DIL
            for (int rep_ = 0; rep_ < REP_DIL; ++rep_) { { PHASE_IDS(); dl::phase(lds, HB, AUX, OB1, XB, LSE, vcu, G, tid); } }
#endif
            GSYNC();
            for (int rep_ = 0; rep_ < REP_MRG; ++rep_) { { PHASE_IDS(); dil_merge(AUX, OB1, XB, LSE, MIX, gw, NGW, lane); } }
            GSYNC();
        }
        float* rowss = rowss0 + (size_t)l * MTOK; float* st1 = stats0 + (size_t)(2 * l) * MTOK * 2; float* st2 = stats0 + (size_t)(2 * l + 1) * MTOK * 2; const float* cv = cvec0 + l * 10240;
        { PHASE_IDS(); p_rows(A.p + (size_t)l * MTOK * PLE, AUX, gw, NGW, lane); }
        { pg8::EpiResid E{Ain, XB, nullptr, nullptr, nullptr, st1}; run_gemm(lds, MIX, (const u16*)(ws + (l == 0 ? WS_WOUT0 : WS_WOUT1)), 1024, 1024, E, tid0); }
        GSYNC();
        for (int rep_ = 0; rep_ < REP_P6; ++rep_) { pg8::EpiStore E{HB, FFD, 1, 0, 0, cs, st1, cv, cv + 4096}; run_gemm(lds, XB, (const u16*)(ws + WS_W1 + l * 8 * MiB), FFD, 1024, E, tid0); }
        { pg8::EpiE E{MIX, rowss}; run_gemm(lds, AUX, (const u16*)(ws + WS_WP + l * (MiB / 2)), 1024, PLE, E, tid0); }
        GSYNC();
#ifdef PROBE_FFN2
        { pg8::EpiStore E{AUX, 1024, 0, 0, 0, cs, nullptr, nullptr, nullptr}; run_gemm(lds, HB, (const u16*)(ws + WS_W2 + l * 8 * MiB), 1024, FFD, E, tid0); }
#endif
        { pg8::EpiResid E{XB, XB, st1, A.ln1_g + l * 1024, A.ln1_b + l * 1024, st2}; run_gemm(lds, HB, (const u16*)(ws + WS_W2 + l * 8 * MiB), 1024, FFD, E, tid0); }
        GSYNC();
        { pg8::EpiGate E{l == 0 ? (float*)nullptr : X, XB, st2, A.ln2_g + l * 1024, A.ln2_b + l * 1024, cv + 8192, cv + 9216, MIX, rowss, A.ple_norm_g + l * 1024, l == 0 ? (u16*)X : (u16*)nullptr}; run_gemm(lds, XB, (const u16*)(ws + WS_WG + l * 2 * MiB), 1024, 1024, E, tid0); }
        if (l == 0) GSYNC();
    }
#ifdef PROBE_BARS
    for (int i = 0; i < PROBE_BARS; ++i) GSYNC();
#endif
}

extern "C" void kernel_launch(void* const* d_in, const int* in_sizes, int n_in, void* d_out, int out_size, void* d_ws, size_t ws_size, hipStream_t stream) {
    static int grid = 0;
    if (grid == 0) {
        if (n_in != 19 || out_size != MTOK * DMODEL || ws_size < WS_END) { fprintf(stderr, "kernel_launch: unexpected shapes (n_in %d, out %d, ws %zu)\n", n_in, out_size, ws_size); grid = -1; return; }
        int dev = 0, cus = 0, per_cu = 0;
        if (hipGetDevice(&dev) != hipSuccess || hipDeviceGetAttribute(&cus, hipDeviceAttributeMultiprocessorCount, dev) != hipSuccess) { grid = -1; return; }
        if (hipFuncSetAttribute((const void*)fwd_kernel, hipFuncAttributeMaxDynamicSharedMemorySize, LDS_BYTES) != hipSuccess) { fprintf(stderr, "kernel_launch: hipFuncSetAttribute failed\n"); grid = -1; return; }
        if (hipOccupancyMaxActiveBlocksPerMultiprocessor(&per_cu, (const void*)fwd_kernel, 512, LDS_BYTES) != hipSuccess || per_cu < 1) { fprintf(stderr, "kernel_launch: occupancy query says %d\n", per_cu); per_cu = 1; }
        (void)hipGetLastError();
        grid = cus * per_cu;
    }
    if (grid < 0) return;
    if (hipMemsetAsync((char*)d_ws, 0, WS_BAR + 16384, stream) != hipSuccess) { fprintf(stderr, "kernel_launch: memset failed\n"); return; }
    Args a{};
    const float** f = (const float**)&a;
    for (int i = 0; i < 19; ++i) f[i] = (const float*)d_in[i];
    a.out = (float*)d_out; a.ws = (unsigned char*)d_ws;
    void* args[] = {&a};
    hipError_t e = hipLaunchCooperativeKernel((const void*)fwd_kernel, dim3(grid), dim3(512), args, LDS_BYTES, stream);
    if (e != hipSuccess) fprintf(stderr, "cooperative launch failed: %s (grid %d)\n", hipGetErrorString(e), grid);
}
```

```cpp
#include <hip/hip_runtime.h>
#include <hip/hip_cooperative_groups.h>
#include <cstdio>
#include <cstdint>
namespace cg = cooperative_groups;
namespace pg8 {
#define PG8_LAS __attribute__((address_space(3)))
typedef unsigned short bf16_t;
typedef short bf16x8 __attribute__((ext_vector_type(8)));
typedef float f32x4 __attribute__((ext_vector_type(4)));
typedef unsigned u32x4 __attribute__((ext_vector_type(4)));
constexpr int BM = 256, BK = 64, HALF = 128, HTB = HALF * BK * 2  , STAGE_BYTES = 8 * HTB, NXCD = 8, WGM = 8;

__host__ __device__ __forceinline__ int lds_byte(int r, int c) { const int st = (r >> 4) * 2 + (c >> 5), rr = r & 15, cc = c & 31, ob = rr * 64 + cc * 2; return st * 1024 + (ob ^ (((ob >> 9) & 1) << 5)); }
__host__ __device__ __forceinline__ void stage_rc(int b, int& R, int& C) { const int st = b / 1024, sb = b % 1024, swz = sb ^ (((sb >> 9) & 1) << 5); R = (st >> 1) * 16 + swz / 64; C = (st & 1) * 32 + (swz % 64) / 2; }
__host__ __device__ __forceinline__ int perm32(int rho) { const int n = rho >> 4, i = rho & 15; return 8 * (i >> 2) + 4 * n + (i & 3); }

struct Unit { int pm, pn; };
struct Gemm { const bf16_t* A; const bf16_t* Bt; int M, N, K; };

struct StaticOrder {
    int nM, nN, nwg, G, c;
    __host__ __device__ void init(int M, int N, int G_, int c_) { nM = M / BM; nN = N / BM; nwg = nM * nN; G = G_; c = c_; }
    __host__ __device__ bool next(int i, Unit& u) const {
        const long L = (long)i * G + c; if (L >= nwg) return false;
        int wgid = (int)L; { const int q = nwg / NXCD, r = nwg % NXCD, xcd = wgid % NXCD, off = wgid / NXCD; wgid = (xcd < r ? xcd * (q + 1) : r * (q + 1) + (xcd - r) * q) + off; }
        const int nig = WGM * nN, gid = wgid / nig, fm = gid * WGM, gsz = (nM - fm) < WGM ? (nM - fm) : WGM;
        u.pm = fm + ((wgid % nig) % gsz); u.pn = (wgid % nig) / gsz; return true;
    }
    __device__ __forceinline__ void a_ready(const Unit&) const {}
    __device__ __forceinline__ void done(const Unit&) const {}
};

__device__ __forceinline__ unsigned cvt_pk_bf16(float lo, float hi) { unsigned r; asm volatile("v_cvt_pk_bf16_f32 %0, %1, %2" : "=v"(r) : "v"(lo), "v"(hi)); return r; }
typedef float f32x2 __attribute__((ext_vector_type(2)));
template <class Epi, class Sched, bool ALIGN_EPI = false, bool SP2 = false>
__device__ __forceinline__ void gemm_phase(PG8_LAS unsigned char* lds, const Gemm g, const Sched& S, const Epi& E, const int tid_in) {
    const int tid = tid_in, wid = __builtin_amdgcn_readfirstlane(tid >> 6), lane = tid & 63, wr = wid >> 2, wc = wid & 3, fr = lane & 15, fq = lane >> 4;
    const int K = g.K, nt = K / BK;
    unsigned voffA[2], voffB[2];
#pragma unroll
    for (int i = 0; i < 2; ++i) { int R, C; stage_rc(tid * 16 + i * 8192, R, C); const int Rb = Epi::PERM ? ((R & ~31) + perm32(R & 31)) : R;
        voffA[i] = (unsigned)(R * K + C) * 2u; voffB[i] = (unsigned)(Rb * K + C) * 2u; }
    const size_t kstep = (size_t)(BK * 2);
    const size_t hstep = (size_t)HALF * K * 2;
    const size_t tstep = 2 * hstep;
    const unsigned ldsw = (unsigned)wid * 1024u;
    const int aoff = lds_byte(wr * 64 + fr, fq * 8), boff = lds_byte(wc * 32 + fr, fq * 8);
#define PG8_SA(b, h) (((b) * 2 + (h)) * HTB)
#define PG8_SB(b, h) ((4 + (b) * 2 + (h)) * HTB)
#define PG8_STAGE(bufoff, gbase, voff) do { _Pragma("unroll") for (int _i = 0; _i < 2; ++_i) \
        __builtin_amdgcn_global_load_lds((const unsigned*)((const char*)(gbase) + (voff)[_i]), (PG8_LAS unsigned*)(lds + (bufoff) + ldsw + _i * 8192), 16, 0, 0); } while (0)
#define PG8_LDA(dst, b, h) do { _Pragma("unroll") for (int m = 0; m < 4; ++m) _Pragma("unroll") for (int k = 0; k < 2; ++k) dst[m][k] = *(const PG8_LAS bf16x8*)(lds + PG8_SA(b, h) + aoff + m * 2048 + k * 1024); } while (0)
#define PG8_LDB(dst, b, h) do { _Pragma("unroll") for (int n = 0; n < 2; ++n) _Pragma("unroll") for (int k = 0; k < 2; ++k) dst[n][k] = *(const PG8_LAS bf16x8*)(lds + PG8_SB(b, h) + boff + n * 2048 + k * 1024); } while (0)
#define PG8_MMA(ai, bj, At, Bt) do { __builtin_amdgcn_s_setprio(1); _Pragma("unroll") for (int m = 0; m < 4; ++m) _Pragma("unroll") for (int n = 0; n < 2; ++n) _Pragma("unroll") for (int k = 0; k < 2; ++k) \
        acc[ai][bj][m][n] = __builtin_amdgcn_mfma_f32_16x16x32_bf16(Bt[n][k], At[m][k], acc[ai][bj][m][n], 0, 0, 0); __builtin_amdgcn_s_setprio(0); } while (0)
#define PG8_WAIT_V(n) asm volatile("s_waitcnt vmcnt(" #n ")" ::: "memory")
#define PG8_WAIT_L(n) asm volatile("s_waitcnt lgkmcnt(" #n ")" ::: "memory")
#define PG8_BAR __builtin_amdgcn_s_barrier()
#define PG8_SCHED __builtin_amdgcn_sched_barrier(0)
    Unit cur, nxt; int ui = 0;
    if (!S.next(0, cur)) return;
    f32x4 acc[2][2][4][2];
#pragma unroll
    for (int a = 0; a < 2; ++a)
#pragma unroll
        for (int b = 0; b < 2; ++b)
#pragma unroll
            for (int m = 0; m < 4; ++m)
#pragma unroll
                for (int n = 0; n < 2; ++n) acc[a][b][m][n] = (f32x4){0.f, 0.f, 0.f, 0.f};
    bf16x8 At[4][2], B0[2][2], B1[2][2];
    const char* cA = (const char*)g.A + (size_t)cur.pm * tstep; const char* cB = (const char*)g.Bt + (size_t)cur.pn * tstep;
    S.a_ready(cur);
    if constexpr (SP2) {
        PG8_STAGE(PG8_SB(0, 0), cB, voffB); PG8_STAGE(PG8_SB(0, 1), cB + hstep, voffB); PG8_STAGE(PG8_SA(0, 0), cA, voffA); PG8_STAGE(PG8_SA(0, 1), cA + hstep, voffA);
        if (wr == 1) PG8_BAR;
        PG8_WAIT_V(2); PG8_BAR;
        PG8_STAGE(PG8_SB(1, 0), cB + kstep, voffB); PG8_STAGE(PG8_SA(1, 0), cA + kstep, voffA); PG8_STAGE(PG8_SB(1, 1), cB + hstep + kstep, voffB);
        PG8_WAIT_V(6); PG8_BAR;
    } else {
        PG8_STAGE(PG8_SB(0, 0), cB, voffB); PG8_STAGE(PG8_SA(0, 0), cA, voffA); PG8_STAGE(PG8_SB(0, 1), cB + hstep, voffB); PG8_STAGE(PG8_SA(0, 1), cA + hstep, voffA);
        if (wr == 1) PG8_BAR;
        PG8_WAIT_V(4); PG8_BAR;
        PG8_STAGE(PG8_SB(1, 0), cB + kstep, voffB); PG8_STAGE(PG8_SA(1, 0), cA + kstep, voffA); PG8_STAGE(PG8_SB(1, 1), cB + hstep + kstep, voffB);
        PG8_WAIT_V(6); PG8_BAR;
    }
    for (;;) {
        const bool has_next = S.next(ui + 1, nxt);
        const char* nA = has_next ? (const char*)g.A + (size_t)nxt.pm * tstep : cA; const char* nB = has_next ? (const char*)g.Bt + (size_t)nxt.pn * tstep : cB;
        for (int t = 0; t < nt; t += 2) {
            const bool last = (t == nt - 2);
            const char* a1 = cA + (size_t)(t + 1) * kstep;
            const char* a2 = last ? nA : cA + (size_t)(t + 2) * kstep; const char* b2 = last ? nB : cB + (size_t)(t + 2) * kstep;
            const char* a3 = a2 + kstep; const char* b3 = b2 + kstep;
            if (last && has_next) S.a_ready(nxt);
            if constexpr (SP2) {
            PG8_LDB(B0, 0, 0); PG8_LDB(B1, 0, 1); PG8_SCHED; PG8_LDA(At, 0, 0); PG8_STAGE(PG8_SA(1, 1), a1 + hstep, voffA);
            PG8_WAIT_V(8); PG8_WAIT_L(0); PG8_BAR; PG8_MMA(0, 0, At, B0); PG8_MMA(0, 1, At, B1); PG8_BAR; PG8_SCHED;
            PG8_LDA(At, 0, 1); PG8_STAGE(PG8_SB(0, 0), b2, voffB); PG8_STAGE(PG8_SB(0, 1), b2 + hstep, voffB); PG8_STAGE(PG8_SA(0, 0), a2, voffA);
            PG8_WAIT_V(8); PG8_WAIT_L(0); PG8_BAR; PG8_MMA(1, 0, At, B0); PG8_MMA(1, 1, At, B1); PG8_BAR; PG8_SCHED;
            PG8_LDB(B0, 1, 0); PG8_LDB(B1, 1, 1); PG8_SCHED; PG8_LDA(At, 1, 0); PG8_STAGE(PG8_SA(0, 1), a2 + hstep, voffA);
            PG8_WAIT_V(8); PG8_WAIT_L(0); PG8_BAR; PG8_MMA(0, 0, At, B0); PG8_MMA(0, 1, At, B1); PG8_BAR; PG8_SCHED;
            PG8_LDA(At, 1, 1); PG8_STAGE(PG8_SB(1, 0), b3, voffB); PG8_STAGE(PG8_SB(1, 1), b3 + hstep, voffB); PG8_STAGE(PG8_SA(1, 0), a3, voffA);
            PG8_WAIT_V(8); PG8_WAIT_L(0); PG8_BAR; PG8_MMA(1, 0, At, B0); PG8_MMA(1, 1, At, B1); PG8_BAR; PG8_SCHED;
            } else {
            PG8_LDB(B0, 0, 0); PG8_SCHED; PG8_LDA(At, 0, 0); PG8_STAGE(PG8_SA(1, 1), a1 + hstep, voffA);
            PG8_WAIT_L(8); PG8_BAR; PG8_WAIT_L(0); PG8_MMA(0, 0, At, B0); PG8_BAR; PG8_SCHED;
            PG8_LDB(B1, 0, 1); PG8_STAGE(PG8_SB(0, 0), b2, voffB);
            PG8_BAR; PG8_WAIT_L(0); PG8_MMA(0, 1, At, B1); PG8_BAR;
            PG8_LDA(At, 0, 1); PG8_STAGE(PG8_SA(0, 0), a2, voffA);
            PG8_BAR; PG8_WAIT_L(0); PG8_MMA(1, 0, At, B0); PG8_BAR; PG8_SCHED;
            PG8_STAGE(PG8_SB(0, 1), b2 + hstep, voffB);
            PG8_WAIT_V(6); PG8_BAR; PG8_MMA(1, 1, At, B1); PG8_BAR;
            PG8_LDB(B0, 1, 0); PG8_SCHED; PG8_LDA(At, 1, 0); PG8_STAGE(PG8_SA(0, 1), a2 + hstep, voffA);
            PG8_WAIT_L(8); PG8_BAR; PG8_WAIT_L(0); PG8_MMA(0, 0, At, B0); PG8_BAR; PG8_SCHED;
            PG8_LDB(B1, 1, 1); PG8_STAGE(PG8_SB(1, 0), b3, voffB);
            PG8_BAR; PG8_WAIT_L(0); PG8_MMA(0, 1, At, B1); PG8_BAR;
            PG8_LDA(At, 1, 1); PG8_STAGE(PG8_SA(1, 0), a3, voffA);
            PG8_BAR; PG8_WAIT_L(0); PG8_MMA(1, 0, At, B0); PG8_BAR; PG8_SCHED;
            PG8_STAGE(PG8_SB(1, 1), b3 + hstep, voffB);
            PG8_WAIT_V(6); PG8_BAR; PG8_MMA(1, 1, At, B1); PG8_BAR;
            }
        }
        if constexpr (ALIGN_EPI) { if (wr == 0) PG8_BAR; }
        if constexpr (!Epi::AFTER_DRAIN) { E(acc, cur, wr, wc, fr, fq); S.done(cur); }
        if (!has_next) break;
#pragma unroll
        for (int a = 0; a < 2; ++a)
#pragma unroll
            for (int b = 0; b < 2; ++b)
#pragma unroll
                for (int m = 0; m < 4; ++m)
#pragma unroll
                    for (int n = 0; n < 2; ++n) acc[a][b][m][n] = (f32x4){0.f, 0.f, 0.f, 0.f};
        cur = nxt; cA = nA; cB = nB; ++ui;
        if constexpr (ALIGN_EPI) { if (wr == 1) PG8_BAR; }
    }
    PG8_WAIT_V(0);
    if constexpr (!ALIGN_EPI) { if (wr == 0) PG8_BAR; }
    PG8_BAR;
    if constexpr (Epi::AFTER_DRAIN) { E.fused(acc, cur, wr, wc, fr, fq, lds, wid, lane); S.done(cur); }
#undef PG8_SA
#undef PG8_SB
#undef PG8_STAGE
#undef PG8_LDA
#undef PG8_LDB
#undef PG8_MMA
#undef PG8_WAIT_V
#undef PG8_WAIT_L
#undef PG8_BAR
#undef PG8_SCHED
}
}
namespace pg8 {
__device__ __forceinline__ float shx(float v, int m, int lane) { return __builtin_bit_cast(float, __builtin_amdgcn_ds_bpermute((lane ^ m) << 2, __builtin_bit_cast(int, v))); }
constexpr float QSCALE = 0.125f * 1.4426950408889634f;
struct EpiStore {
    static constexpr bool PERM = true, AFTER_DRAIN = false;
    bf16_t* O; int ldc; int act; int rope_cols; int scale_cols; const float* cs;
    const float* st; const float* c1; const float* c2;
    __device__ __forceinline__ void operator()(f32x4 (&acc)[2][2][4][2], const Unit& u, int wr, int wc, int fr, int fq) const {
        { int ln_; asm volatile("v_mbcnt_lo_u32_b32 %0, -1, 0\n\tv_mbcnt_hi_u32_b32 %0, -1, %0" : "=v"(ln_)); fr = ln_ & 15; fq = ln_ >> 4; }
        const int row0 = u.pm * BM + wr * 64 + fr; const int colt = u.pn * BM;
        const int col0 = colt + wc * 32 + 8 * fq;
        if (colt < rope_cols && (wc & 1) == 0) {
            const float sgn = fq == 0 ? -1.f : 1.f; const int lane = fq * 16 + fr;
            const int fqc = fq & 1;
#pragma unroll
            for (int ai = 0; ai < 2; ++ai)
#pragma unroll
                for (int m = 0; m < 4; ++m) {
                    const int pos = (row0 + ai * HALF + m * 16) & 8191;
                    const float* cp = cs + pos * 8;
#pragma unroll
                    for (int n = 0; n < 2; ++n) {
                        const f32x4 cv = *(const f32x4*)(cp + 4 * n), sv = *(const f32x4*)(cp + 65536 + 4 * n);
#pragma unroll
                        for (int bj = 0; bj < 2; ++bj)
#pragma unroll
                            for (int e = 0; e < 4; ++e) {
                                const float v = acc[ai][bj][m][n][e]; const float pv = shx(v, 16, lane);
                                const float nv = v * cv[e] + sgn * pv * sv[e];
                                acc[ai][bj][m][n][e] = (fq < 2) ? nv : v;
                            }
                        asm volatile("" ::: "memory");
                    }
                }
            (void)fqc;
        }
        if (st) {
            float muv[2][4], rsv[2][4];
#pragma unroll
            for (int ai = 0; ai < 2; ++ai)
#pragma unroll
                for (int m = 0; m < 4; ++m) { const int row = row0 + ai * HALF + m * 16; const f32x2 sv = *(const f32x2*)(st + 2 * row); muv[ai][m] = sv.x; rsv[ai][m] = sv.y; }
#pragma unroll
            for (int ai = 0; ai < 2; ++ai)
#pragma unroll
                for (int m = 0; m < 4; ++m) { const float mu = muv[ai][m] * (1.f / 1024.f); rsv[ai][m] = __builtin_amdgcn_rsqf(rsv[ai][m] * (1.f / 1024.f) - mu * mu + 1e-5f); muv[ai][m] = mu; }
#pragma unroll
            for (int bj = 0; bj < 2; ++bj) {
                const f32x4 c1a = *(const f32x4*)(c1 + col0 + bj * HALF), c1b = *(const f32x4*)(c1 + col0 + bj * HALF + 4), c2a = *(const f32x4*)(c2 + col0 + bj * HALF), c2b = *(const f32x4*)(c2 + col0 + bj * HALF + 4);
#pragma unroll
                for (int ai = 0; ai < 2; ++ai)
#pragma unroll
                    for (int m = 0; m < 4; ++m) { const float mu = muv[ai][m], rstd = rsv[ai][m];
                        acc[ai][bj][m][0] = (acc[ai][bj][m][0] - mu * c1a) * rstd + c2a; acc[ai][bj][m][1] = (acc[ai][bj][m][1] - mu * c1b) * rstd + c2b; }
            }
        }
        const float sc = (colt < scale_cols) ? QSCALE : 1.f;
#pragma unroll
        for (int ai = 0; ai < 2; ++ai)
#pragma unroll
            for (int m = 0; m < 4; ++m) { bf16_t* rowp = O + (size_t)(row0 + ai * HALF + m * 16) * ldc + col0;
#pragma unroll
                for (int bj = 0; bj < 2; ++bj) { f32x4 v0 = acc[ai][bj][m][0], v1 = acc[ai][bj][m][1];
                    if (act == 1) {
#pragma unroll
                        for (int e = 0; e < 4; ++e) { float a = fmaxf(v0[e], 0.f), b = fmaxf(v1[e], 0.f); v0[e] = a * a; v1[e] = b * b; } }
                    v0 = v0 * sc; v1 = v1 * sc; u32x4 w; w.x = cvt_pk_bf16(v0[0], v0[1]); w.y = cvt_pk_bf16(v0[2], v0[3]); w.z = cvt_pk_bf16(v1[0], v1[1]); w.w = cvt_pk_bf16(v1[2], v1[3]);
                    *(u32x4*)(rowp + bj * HALF) = w; } }
    }
};
struct EpiResid {
    static constexpr bool PERM = true, AFTER_DRAIN = false;
    const bf16_t* xinb; bf16_t* outb; const float* st_in; const float* g; const float* b; float* st_out;
    __device__ __forceinline__ void operator()(f32x4 (&acc)[2][2][4][2], const Unit& u, int wr, int wc, int fr, int fq) const {
        { int ln_; asm volatile("v_mbcnt_lo_u32_b32 %0, -1, 0\n\tv_mbcnt_hi_u32_b32 %0, -1, %0" : "=v"(ln_)); fr = ln_ & 15; fq = ln_ >> 4; }
        const int lane = fq * 16 + fr;
        const int col0 = u.pn * BM + wc * 32 + 8 * fq;
        f32x4 gv[2][2], bv[2][2];
        if (st_in) {
#pragma unroll
            for (int bj = 0; bj < 2; ++bj)
#pragma unroll
                for (int n = 0; n < 2; ++n) { gv[bj][n] = *(const f32x4*)(g + col0 + bj * HALF + n * 4); bv[bj][n] = *(const f32x4*)(b + col0 + bj * HALF + n * 4); } }
#pragma unroll
        for (int ai = 0; ai < 2; ++ai) {
            const int rowa = u.pm * BM + ai * HALF + wr * 64 + fr;
            float mu[4], rstd[4];
            u32x4 xw[4][2];
#pragma unroll
            for (int m = 0; m < 4; ++m)
#pragma unroll
                for (int bj = 0; bj < 2; ++bj) xw[m][bj] = *(const u32x4*)(xinb + (size_t)(rowa + m * 16) * 1024 + col0 + bj * HALF);
#pragma unroll
            for (int m = 0; m < 4; ++m) { mu[m] = 0.f; rstd[m] = 1.f;
                if (st_in) { const f32x2 sv = *(const f32x2*)(st_in + 2 * (rowa + m * 16)); mu[m] = sv.x * (1.f / 1024.f); rstd[m] = __builtin_amdgcn_rsqf(sv.y * (1.f / 1024.f) - mu[m] * mu[m] + 1e-5f); } }
#pragma unroll
            for (int m = 0; m < 4; ++m) { const int row = rowa + m * 16; const size_t off = (size_t)row * 1024 + col0;
                float s1 = 0.f, s2 = 0.f;
#pragma unroll
                for (int bj = 0; bj < 2; ++bj) { const u32x4 w0 = xw[m][bj];
                    f32x4 xa = {__uint_as_float(w0.x << 16), __uint_as_float(w0.x & 0xffff0000u), __uint_as_float(w0.y << 16), __uint_as_float(w0.y & 0xffff0000u)};
                    f32x4 xb2 = {__uint_as_float(w0.z << 16), __uint_as_float(w0.z & 0xffff0000u), __uint_as_float(w0.w << 16), __uint_as_float(w0.w & 0xffff0000u)};
                    if (st_in) { xa = (xa - mu[m]) * rstd[m] * gv[bj][0] + bv[bj][0]; xb2 = (xb2 - mu[m]) * rstd[m] * gv[bj][1] + bv[bj][1]; }
                    const f32x4 ya = xa * 1.4142135623730951f + acc[ai][bj][m][0], yb2 = xb2 * 1.4142135623730951f + acc[ai][bj][m][1];
                    u32x4 w; w.x = cvt_pk_bf16(ya[0], ya[1]); w.y = cvt_pk_bf16(ya[2], ya[3]); w.z = cvt_pk_bf16(yb2[0], yb2[1]); w.w = cvt_pk_bf16(yb2[2], yb2[3]);
                    *(u32x4*)(outb + off + bj * HALF) = w;
                    s1 += ((ya[0] + ya[1]) + (ya[2] + ya[3])) + ((yb2[0] + yb2[1]) + (yb2[2] + yb2[3]));
                    s2 += ((ya[0] * ya[0] + ya[1] * ya[1]) + (ya[2] * ya[2] + ya[3] * ya[3])) + ((yb2[0] * yb2[0] + yb2[1] * yb2[1]) + (yb2[2] * yb2[2] + yb2[3] * yb2[3])); }
                s1 += shx(s1, 16, lane); s1 += shx(s1, 32, lane); s2 += shx(s2, 16, lane); s2 += shx(s2, 32, lane);
                if (fq == 0 && st_out) { atomicAdd(st_out + 2 * row, s1); atomicAdd(st_out + 2 * row + 1, s2); } }
            asm volatile("" ::: "memory");
        }
    }
};
struct EpiE {
    static constexpr bool PERM = true, AFTER_DRAIN = false;
    bf16_t* O; float* rowss;
    __device__ __forceinline__ void operator()(f32x4 (&acc)[2][2][4][2], const Unit& u, int wr, int wc, int fr, int fq) const {
        { int ln_; asm volatile("v_mbcnt_lo_u32_b32 %0, -1, 0\n\tv_mbcnt_hi_u32_b32 %0, -1, %0" : "=v"(ln_)); fr = ln_ & 15; fq = ln_ >> 4; }
        const int row0 = u.pm * BM + wr * 64 + fr; const int col0 = u.pn * BM + wc * 32 + 8 * fq; const int lane = fq * 16 + fr;
#pragma unroll
        for (int ai = 0; ai < 2; ++ai)
#pragma unroll
            for (int m = 0; m < 4; ++m) { const int row = row0 + ai * HALF + m * 16; bf16_t* rowp = O + (size_t)row * 1024 + col0; float ss = 0.f;
#pragma unroll
                for (int bj = 0; bj < 2; ++bj) { const f32x4 v0 = acc[ai][bj][m][0], v1 = acc[ai][bj][m][1];
                    ss += (v0[0] * v0[0] + v0[1] * v0[1]) + (v0[2] * v0[2] + v0[3] * v0[3]) + (v1[0] * v1[0] + v1[1] * v1[1]) + (v1[2] * v1[2] + v1[3] * v1[3]);
                    u32x4 w; w.x = cvt_pk_bf16(v0[0], v0[1]); w.y = cvt_pk_bf16(v0[2], v0[3]); w.z = cvt_pk_bf16(v1[0], v1[1]); w.w = cvt_pk_bf16(v1[2], v1[3]);
                    *(u32x4*)(rowp + bj * HALF) = w; }
                ss += shx(ss, 16, lane); ss += shx(ss, 32, lane);
                if (fq == 0) atomicAdd(rowss + row, ss); }
    }
};
struct EpiGate {
    static constexpr bool PERM = true, AFTER_DRAIN = false;
    float* x; const bf16_t* yb; const float* st; const float* g2; const float* b2; const float* c1; const float* c2; const bf16_t* E; const float* rowss; const float* gp; bf16_t* xb;
    __device__ __forceinline__ void operator()(f32x4 (&acc)[2][2][4][2], const Unit& u, int wr, int wc, int fr, int fq) const {
        { int ln_; asm volatile("v_mbcnt_lo_u32_b32 %0, -1, 0\n\tv_mbcnt_hi_u32_b32 %0, -1, %0" : "=v"(ln_)); fr = ln_ & 15; fq = ln_ >> 4; }
        const int col0 = u.pn * BM + wc * 32 + 8 * fq;
#pragma unroll
        for (int ai = 0; ai < 2; ++ai)
#pragma unroll
        for (int mp = 0; mp < 2; ++mp) {
            const int rowa = u.pm * BM + ai * HALF + wr * 64 + mp * 32 + fr;
            u32x4 yw[2][2], ew[2][2]; float mu[2], rstd[2], rs[2];
#pragma unroll
            for (int m = 0; m < 2; ++m)
#pragma unroll
                for (int bj = 0; bj < 2; ++bj) { const size_t o2 = (size_t)(rowa + m * 16) * 1024 + col0 + bj * HALF; yw[m][bj] = *(const u32x4*)(yb + o2); ew[m][bj] = *(const u32x4*)(E + o2); }
#pragma unroll
            for (int m = 0; m < 2; ++m) { const int row = rowa + m * 16; const f32x2 sv = *(const f32x2*)(st + 2 * row); rs[m] = rowss[row]; mu[m] = sv.x; rstd[m] = sv.y; }
#pragma unroll
            for (int m = 0; m < 2; ++m) { rs[m] = __builtin_amdgcn_rsqf(rs[m] * (1.0f / 1024.0f) + 1e-5f); mu[m] *= (1.f / 1024.f); rstd[m] = __builtin_amdgcn_rsqf(rstd[m] * (1.f / 1024.f) - mu[m] * mu[m] + 1e-5f); }
#pragma unroll
            for (int bj = 0; bj < 2; ++bj)
#pragma unroll
                for (int n = 0; n < 2; ++n) { const int c = col0 + bj * HALF + n * 4;
                    const f32x4 gv = *(const f32x4*)(gp + c), g2v = *(const f32x4*)(g2 + c), b2v = *(const f32x4*)(b2 + c), c1v = *(const f32x4*)(c1 + c), c2v = *(const f32x4*)(c2 + c);
#pragma unroll
                    for (int m = 0; m < 2; ++m) { const size_t o2 = (size_t)(rowa + m * 16) * 1024 + c;
                        const unsigned y0 = n ? yw[m][bj].z : yw[m][bj].x, y1 = n ? yw[m][bj].w : yw[m][bj].y, e0 = n ? ew[m][bj].z : ew[m][bj].x, e1 = n ? ew[m][bj].w : ew[m][bj].y;
                        const f32x4 yv = {__uint_as_float(y0 << 16), __uint_as_float(y0 & 0xffff0000u), __uint_as_float(y1 << 16), __uint_as_float(y1 & 0xffff0000u)};
                        const f32x4 ef = {__uint_as_float(e0 << 16), __uint_as_float(e0 & 0xffff0000u), __uint_as_float(e1 << 16), __uint_as_float(e1 & 0xffff0000u)};
                        const f32x4 xv = (yv - mu[m]) * rstd[m] * g2v + b2v;
                        const f32x4 a = (acc[ai][bj][2 * mp + m][n] - mu[m] * c1v) * rstd[m] + c2v; f32x4 o;
#pragma unroll
                        for (int e = 0; e < 4; ++e) o[e] = xv[e] + ef[e] * rs[m] * gv[e] * __builtin_amdgcn_rcpf(1.f + __expf(-a[e]));
                        if (x) *(f32x4*)(x + o2) = o;
                        if (xb) { typedef unsigned u32x2v __attribute__((ext_vector_type(2))); u32x2v w; w.x = cvt_pk_bf16(o[0], o[1]); w.y = cvt_pk_bf16(o[2], o[3]); *(u32x2v*)(xb + o2) = w; } } }
            asm volatile("" ::: "memory");
        }
    }
};
}
#define PG8_SP2 true
#define PG8_ALIGN true
#include <hip/hip_bf16.h>
#include <cmath>
namespace attn_body {
using bf16=__hip_bfloat16;
using bf16x8=__attribute__((ext_vector_type(8)))short;
using s16x4=__attribute__((ext_vector_type(4)))short;
using f32x16=__attribute__((ext_vector_type(16)))float;
using u32x4=__attribute__((ext_vector_type(4)))unsigned;
constexpr int SEQ=8192,D=64,DM=3584,DMO=1024;
constexpr int NW=8,QBLK=32,QB=QBLK*NW,KVBLK=64,NQB=SEQ/QB;
constexpr int ATTN_PITCH=DM, ATTN_UNIT_ROWS=QB;
__device__ __forceinline__ int crow(int r,int hi){return (r&3)+8*(r>>2)+4*hi;}
#define SBAR() __builtin_amdgcn_sched_barrier(0)
__device__ __forceinline__ void cmask(f32x16&p0,f32x16&p1,int jb,int qrel,int hi){
  const float NEG=-INFINITY; int kb=64*jb+4*hi;
  #pragma unroll
  for(int r=0;r<16;++r){int kv=kb+(r&3)+8*(r>>2); if(kv>qrel)p0[r]=NEG; if(kv+32>qrel)p1[r]=NEG;}
}

constexpr int NSLOT=3, SLOTB=8192;
constexpr int LDS_K=0, LDS_V=NSLOT*SLOTB, LDS_WS=2*NSLOT*SLOTB, LDS_OST=LDS_WS+NW*64*4, LDS_BYTES=LDS_OST+NW*4096;
constexpr float C2=0.125f*1.4426950408889634f;
__device__ __forceinline__ void glds16(const void*gsrc,unsigned lds_dst){unsigned keep;
  asm volatile("s_mov_b32 %0, m0\n\ts_mov_b32 m0, %2\n\ts_nop 0\n\tglobal_load_lds_dwordx4 %1, off\n\ts_mov_b32 m0, %0":"=&s"(keep):"v"(gsrc),"s"(lds_dst):"memory");}
__device__ __forceinline__ float max3f(float a,float b,float c){float r;asm("v_max3_f32 %0, %1, %2, %3":"=v"(r):"v"(a),"v"(b),"v"(c));return r;}
__device__ __forceinline__ float max2f(float a,float b){float r;asm("v_max_f32_e32 %0, %1, %2":"=v"(r):"v"(a),"v"(b));return r;}
__device__ __forceinline__ float fadd_s(float a,float b){float r;asm("v_add_f32_e32 %0, %1, %2":"=v"(r):"v"(a),"v"(b));return r;}
__device__ __forceinline__ float fsub_s(float a,float b){float r;asm("v_sub_f32_e32 %0, %1, %2":"=v"(r):"v"(a),"v"(b));return r;}
typedef float f32x2_t __attribute__((ext_vector_type(2))); typedef __bf16 bf16x2_t __attribute__((ext_vector_type(2)));
__device__ __forceinline__ unsigned cvtpk_s(float lo,float hi){f32x2_t v={lo,hi};bf16x2_t b=__builtin_convertvector(v,bf16x2_t);return __builtin_bit_cast(unsigned,b);}
#define WAIT_BAR(N) asm volatile("s_waitcnt vmcnt(" #N ") lgkmcnt(0)\n\ts_barrier":::"memory")

__device__ __forceinline__ void qkt(f32x16&p0,f32x16&p1,const char*Kslot,const bf16x8*qr,const f32x16&negm,int r32,int hi){
  const char*kb=Kslot+hi*1024+r32*16;
  #pragma unroll
  for(int d0=0;d0<4;++d0){
    const bf16x8 b0=*reinterpret_cast<const bf16x8*>(kb+d0*2048);
    const bf16x8 b1=*reinterpret_cast<const bf16x8*>(kb+d0*2048+512);
    if(d0==0){p0=__builtin_amdgcn_mfma_f32_32x32x16_bf16(b0,qr[0],negm,0,0,0);p1=__builtin_amdgcn_mfma_f32_32x32x16_bf16(b1,qr[0],negm,0,0,0);}
    else{p0=__builtin_amdgcn_mfma_f32_32x32x16_bf16(b0,qr[d0],p0,0,0,0);p1=__builtin_amdgcn_mfma_f32_32x32x16_bf16(b1,qr[d0],p1,0,0,0);}}
}
typedef __attribute__((address_space(3))) const char* lds_cptr;
typedef short v4i16_t __attribute__((ext_vector_type(4)));
__device__ __forceinline__ void kload8(bf16x8*kf,lds_cptr kp){
  kf[0]=*(const __attribute__((address_space(3))) bf16x8*)(kp);      kf[1]=*(const __attribute__((address_space(3))) bf16x8*)(kp+512);
  kf[2]=*(const __attribute__((address_space(3))) bf16x8*)(kp+2048); kf[3]=*(const __attribute__((address_space(3))) bf16x8*)(kp+2560);
  kf[4]=*(const __attribute__((address_space(3))) bf16x8*)(kp+4096); kf[5]=*(const __attribute__((address_space(3))) bf16x8*)(kp+4608);
  kf[6]=*(const __attribute__((address_space(3))) bf16x8*)(kp+6144); kf[7]=*(const __attribute__((address_space(3))) bf16x8*)(kp+6656);
}
__device__ __forceinline__ void kload2(bf16x8*kf,lds_cptr kp,int j){ kf[2*j]=*(const __attribute__((address_space(3))) bf16x8*)(kp+j*2048); kf[2*j+1]=*(const __attribute__((address_space(3))) bf16x8*)(kp+j*2048+512); }
__device__ __forceinline__ s16x4 vtr(lds_cptr p){ return __builtin_bit_cast(s16x4,__builtin_amdgcn_ds_read_tr16_b64_v4i16((__attribute__((address_space(3))) v4i16_t*)p)); }
__device__ __forceinline__ float rowmax(const f32x16&p0,const f32x16&p1){
  float a=max3f(p0[0],p0[1],p1[0]),b=max3f(p0[2],p0[3],p1[1]);a=max3f(a,p1[2],p1[3]);
  #pragma unroll
  for(int r=4;r<16;r+=4){a=max3f(a,p0[r],p0[r+1]);b=max3f(b,p0[r+2],p0[r+3]);a=max3f(a,p1[r],p1[r+1]);b=max3f(b,p1[r+2],p1[r+3]);}
  const float m=max2f(a,b);
  auto rr=__builtin_amdgcn_permlane32_swap(__float_as_uint(m),__float_as_uint(m),false,false);
  return max2f(__uint_as_float(rr[0]),__uint_as_float(rr[1]));
}
__device__ __forceinline__ void pv(f32x16*o,int vb,bf16x8 pa0,bf16x8 pa1,bf16x8 pa2,bf16x8 pa3){
  #pragma unroll
  for(int d0=0;d0<2;++d0){s16x4 lo[4],hi[4];
    #pragma unroll
    for(int ks=0;ks<4;++ks){
      asm volatile("ds_read_b64_tr_b16 %0,%1 offset:%c2":"=&v"(lo[ks]):"v"(vb),"i"(d0*4096+ks*1024):"memory");
      asm volatile("ds_read_b64_tr_b16 %0,%1 offset:%c2":"=&v"(hi[ks]):"v"(vb),"i"(d0*4096+ks*1024+512):"memory");}
    asm volatile("s_waitcnt lgkmcnt(0)":::"memory");SBAR();
    #define PK(k) (bf16x8){lo[k][0],lo[k][1],lo[k][2],lo[k][3],hi[k][0],hi[k][1],hi[k][2],hi[k][3]}
    o[d0]=__builtin_amdgcn_mfma_f32_32x32x16_bf16(pa0,PK(0),o[d0],0,0,0);
    o[d0]=__builtin_amdgcn_mfma_f32_32x32x16_bf16(pa1,PK(1),o[d0],0,0,0);
    o[d0]=__builtin_amdgcn_mfma_f32_32x32x16_bf16(pa2,PK(2),o[d0],0,0,0);
    o[d0]=__builtin_amdgcn_mfma_f32_32x32x16_bf16(pa3,PK(3),o[d0],0,0,0);
    #undef PK
  }
}

#ifndef ATTN_STORE16
#define ATTN_STORE16(p,v) (*(u32x4*)(p)=(v))
#endif
template<int THRL> __device__ __forceinline__ void attn_unit(int b,int colq,int colk,int colv,int colo,int qb,const bf16*Q,const bf16*__restrict__ K,const bf16*__restrict__ V,bf16*O,char*shm,const int tid_in){
  const int tid=tid_in,lane=tid&63,r32=lane&31,hi=lane>>5; const int wid=__builtin_amdgcn_readfirstlane(tid>>6);
  const long rowbase=(long)b*SEQ; const int q0=qb*QB;
  const bf16*Qw=Q+(rowbase+q0+wid*QBLK)*DM+colq;
  const bf16*Kh=K+rowbase*DM+colk,*Vh=V+rowbase*DM+colv;
  const unsigned lds0=(unsigned)(uintptr_t)shm;
  float*wsf=(float*)(shm+LDS_WS)+wid*64;
  const bf16*ksrc=Kh+(long)lane*DM+wid*8;
  const bf16*vsrc=Vh+(long)(16*(wid&3)+(lane>>2))*DM+(wid>>2)*32+(lane&3)*8;
  const unsigned kdst=lds0+LDS_K+wid*1024, vdst=lds0+LDS_V+wid*1024;
  #define DMA_K(t,slot) glds16(ksrc+(long)(t)*KVBLK*DM,(unsigned)__builtin_amdgcn_readfirstlane(kdst+(slot)))
  #define DMA_V(t,slot) glds16(vsrc+(long)(t)*KVBLK*DM,(unsigned)__builtin_amdgcn_readfirstlane(vdst+(slot)))
  const int vb0=(int)(lds0+LDS_V)+((lane>>4)&1)*32+(lane&3)*8+(4*hi+((lane&15)>>2))*64;
  const char*Kbase=shm+LDS_K; bf16x8 kf[8];
  const lds_cptr shm3=(lds_cptr)shm; const lds_cptr kp0=shm3+LDS_K+hi*1024+r32*16; const lds_cptr vp0=shm3+LDS_V+((lane>>4)&1)*32+(lane&3)*8+(4*hi+((lane&15)>>2))*64;
  const int NT=(q0+QB)/KVBLK;
  DMA_K(0,0);DMA_V(0,0);DMA_K(1,SLOTB);
  bf16x8 qr[4];
  #pragma unroll
  for(int d0=0;d0<4;++d0)qr[d0]=*reinterpret_cast<const bf16x8*>(&Qw[(long)r32*DM+d0*16+hi*8]);
  float mhat=0.f,l_reg=0.f;f32x16 o[2];o[0]=f32x16{};o[1]=f32x16{};f32x16 negm=f32x16{};asm volatile("":"+v"(negm));
  const int qrel=wid*QBLK+r32;
  #define CMASK(P0,P1,t) do{int jb_=(t)-(NT-4); if(jb_>=0)cmask(P0,P1,jb_,qrel,hi);}while(0)
  bool resc=false;
  #define START(P0,P1) do{ const float rm=rowmax(P0,P1); resc=false; \
    { const float dl=rm; mhat=fadd_s(mhat,dl); \
      _Pragma("unroll") for(int r=0;r<16;++r){P0[r]=fsub_s(P0[r],dl);P1[r]=fsub_s(P1[r],dl);} \
      _Pragma("unroll") for(int r=0;r<16;++r)negm[r]=-mhat; asm volatile("":"+v"(negm)); } \
    _Pragma("unroll") for(int r=0;r<16;++r)P0[r]=__builtin_amdgcn_exp2f(P0[r]); }while(0)
  #define RESC() do{ if(resc){ asm volatile("s_waitcnt lgkmcnt(0)":::"memory"); \
      _Pragma("unroll") for(int d_=0;d_<2;++d_) _Pragma("unroll") for(int r=0;r<16;++r)o[d_][r]*=wsf[crow(r,hi)]; } }while(0)
  f32x16 pA0,pA1,pB0,pB1;
  int sl_prev=0,sl_cur=0,sl_next=SLOTB;
  #define ROT() do{sl_prev=sl_cur;sl_cur=sl_next;sl_next=(sl_next==(NSLOT-1)*SLOTB)?0:sl_next+SLOTB;}while(0)
  DMA_K(2,2*SLOTB);
  WAIT_BAR(3);
  qkt(pA0,pA1,Kbase,qr,negm,r32,hi);asm volatile("s_nop 15\n\ts_nop 7":"+v"(pA0),"+v"(pA1));CMASK(pA0,pA1,0);
  START(pA0,pA1);
  _Pragma("unroll") for(int r=0;r<16;++r)pA1[r]=__builtin_amdgcn_exp2f(pA1[r]);
  WAIT_BAR(0);
  DMA_K(3,0);DMA_V(1,SLOTB);
  ROT();
  kload8(kf,kp0+sl_cur);
  WAIT_BAR(2);
  s16x4 vlo[8],vhi[8]; u32x4 pw0,pw1,pw2,pw3;
  #define PKW(P,B) cvtpk_s(P[B],P[B+1])
  #define PAF(k) __builtin_bit_cast(bf16x8,pw##k)
  #define VFR(i) (bf16x8){vlo[i][0],vlo[i][1],vlo[i][2],vlo[i][3],vhi[i][0],vhi[i][1],vhi[i][2],vhi[i][3]}
  #define PIN(x) asm volatile("":"+v"(x))
  #define MX3(a,b,c) __builtin_fmaxf(__builtin_fmaxf((a),(b)),(c))
  #define GAPA(MF,A0,A1,A2,A3,W0,W1,PW) do{ MF; sacc+=A0; sacc+=A1; sacc+=A2; sacc+=A3; PIN(sacc); W0; W1; PIN(PW); SBAR(); }while(0)
  #define EX(v) __builtin_amdgcn_exp2f(v)
  #define GAPB(MF,X,B) do{ MF; X[B]=EX(X[B]); X[B+1]=EX(X[B+1]); X[B+2]=EX(X[B+2]); X[B+3]=EX(X[B+3]); PIN(X); SBAR(); }while(0)
  #define VRD(i) do{ vlo[i]=vtr(vp_+(((i)>>2)*4096+((i)&3)*1024)); vhi[i]=vtr(vp_+(((i)>>2)*4096+((i)&3)*1024+512)); }while(0)
  #define KRD(G,j) do{ if(G){ kload2(kf,kp0+sl_next,j); SBAR(); } }while(0)
  #define STEP(C0,C1,P0,P1,t,GK,GV,GL) do{ SBAR(); \
    const lds_cptr vp_=vp0+sl_prev; \
    VRD(0); SBAR(); float sacc=(P0[0]+P0[1]); \
    GAPA(C0=__builtin_amdgcn_mfma_f32_32x32x16_bf16(kf[0],qr[0],negm,0,0,0), P0[2],P0[3],P0[4],P0[5],     pw0[0]=PKW(P0,0), pw0[1]=PKW(P0,2), pw0); \
    VRD(4); SBAR(); GAPA(C1=__builtin_amdgcn_mfma_f32_32x32x16_bf16(kf[1],qr[0],negm,0,0,0), P0[6],P0[7],P0[8],P0[9],     pw0[2]=PKW(P0,4), pw0[3]=PKW(P0,6), pw0); \
    VRD(1); SBAR(); GAPA(C0=__builtin_amdgcn_mfma_f32_32x32x16_bf16(kf[2],qr[1],C0,0,0,0),   P0[10],P0[11],P0[12],P0[13], pw1[0]=PKW(P0,8), pw1[1]=PKW(P0,10), pw1); \
    VRD(5); SBAR(); GAPA(C1=__builtin_amdgcn_mfma_f32_32x32x16_bf16(kf[3],qr[1],C1,0,0,0),   P0[14],P0[15],P1[0],P1[1],   pw1[2]=PKW(P0,12),pw1[3]=PKW(P0,14), pw1); \
    VRD(2); SBAR(); GAPA(C0=__builtin_amdgcn_mfma_f32_32x32x16_bf16(kf[4],qr[2],C0,0,0,0),   P1[2],P1[3],P1[4],P1[5],     pw2[0]=PKW(P1,0), pw2[1]=PKW(P1,2), pw2); \
    VRD(6); SBAR(); GAPA(C1=__builtin_amdgcn_mfma_f32_32x32x16_bf16(kf[5],qr[2],C1,0,0,0),   P1[6],P1[7],P1[8],P1[9],     pw2[2]=PKW(P1,4), pw2[3]=PKW(P1,6), pw2); \
    VRD(3); SBAR(); GAPA(C0=__builtin_amdgcn_mfma_f32_32x32x16_bf16(kf[6],qr[3],C0,0,0,0),   P1[10],P1[11],P1[12],P1[13], pw3[0]=PKW(P1,8), pw3[1]=PKW(P1,10), pw3); \
    VRD(7); SBAR(); GAPA(C1=__builtin_amdgcn_mfma_f32_32x32x16_bf16(kf[7],qr[3],C1,0,0,0),   P1[14],P1[15],0.f,0.f,       pw3[2]=PKW(P1,12),pw3[3]=PKW(P1,14), pw3); \
    l_reg+=sacc; \
    if(GK){DMA_K((t)+3,sl_cur);} if(GV){DMA_V((t)+1,sl_next);} \
    CMASK(C0,C1,t); \
    { float a=MX3(C0[0],C0[1],C1[0]),b=MX3(C0[2],C0[3],C1[1]); a=MX3(a,C1[2],C1[3]); \
      _Pragma("unroll") for(int r=4;r<16;r+=4){a=MX3(a,C0[r],C0[r+1]);b=MX3(b,C0[r+2],C0[r+3]);a=MX3(a,C1[r],C1[r+1]);b=MX3(b,C1[r+2],C1[r+3]);} \
      float rm=__builtin_fmaxf(a,b); { auto rr=__builtin_amdgcn_permlane32_swap(__float_as_uint(rm),__float_as_uint(rm),false,false); rm=__builtin_fmaxf(__uint_as_float(rr[0]),__uint_as_float(rr[1])); } \
      resc=false; \
      if(__builtin_expect(__any(rm>(float)THRL),0)){ const float dl=__builtin_fmaxf(rm,0.f); mhat+=dl; \
        _Pragma("unroll") for(int r=0;r<16;++r){C0[r]-=dl;C1[r]-=dl;} \
        _Pragma("unroll") for(int r=0;r<16;++r)negm[r]=-mhat; asm volatile("":"+v"(negm)); \
        const float f=__builtin_amdgcn_exp2f(-dl); l_reg*=f; if(hi==0)wsf[r32]=f; resc=true; } } \
    SBAR(); \
    GAPB(o[0]=__builtin_amdgcn_mfma_f32_32x32x16_bf16(PAF(0),VFR(0),o[0],0,0,0), C0,0); \
    GAPB(o[1]=__builtin_amdgcn_mfma_f32_32x32x16_bf16(PAF(0),VFR(4),o[1],0,0,0), C0,4); \
    KRD(GL,0); GAPB(o[0]=__builtin_amdgcn_mfma_f32_32x32x16_bf16(PAF(1),VFR(1),o[0],0,0,0), C0,8); \
    KRD(GL,1); GAPB(o[1]=__builtin_amdgcn_mfma_f32_32x32x16_bf16(PAF(1),VFR(5),o[1],0,0,0), C0,12); \
    KRD(GL,2); GAPB(o[0]=__builtin_amdgcn_mfma_f32_32x32x16_bf16(PAF(2),VFR(2),o[0],0,0,0), C1,0); \
    KRD(GL,3); GAPB(o[1]=__builtin_amdgcn_mfma_f32_32x32x16_bf16(PAF(2),VFR(6),o[1],0,0,0), C1,4); \
    GAPB(o[0]=__builtin_amdgcn_mfma_f32_32x32x16_bf16(PAF(3),VFR(3),o[0],0,0,0), C1,8); \
    GAPB(o[1]=__builtin_amdgcn_mfma_f32_32x32x16_bf16(PAF(3),VFR(7),o[1],0,0,0), C1,12); \
    }while(0)
  int t=1;
  #undef CMASK
  #define CMASK(P0,P1,t) do{}while(0)
  for(;t+5<NT;t+=2){
    STEP(pB0,pB1,pA0,pA1,t,true,true,true);     WAIT_BAR(2); RESC(); ROT();
    STEP(pA0,pA1,pB0,pB1,t+1,true,true,true);   WAIT_BAR(2); RESC(); ROT();
  }
  #undef CMASK
  #define CMASK(P0,P1,t) do{int jb_=(t)-(NT-4); if(jb_>=0)cmask(P0,P1,jb_,qrel,hi);}while(0)
  #define ENDW(tt) do{ if((tt)+3<NT){WAIT_BAR(2);} else if((tt)+2<NT){WAIT_BAR(1);} else {WAIT_BAR(0);} }while(0)
  for(;t+1<NT;t+=2){
    STEP(pB0,pB1,pA0,pA1,t,(t+3<NT),(t+1<NT),(t+1<NT));       ENDW(t);   RESC(); ROT();
    STEP(pA0,pA1,pB0,pB1,t+1,(t+4<NT),(t+2<NT),(t+2<NT));     ENDW(t+1); RESC(); ROT();
  }
  STEP(pB0,pB1,pA0,pA1,NT-1,false,false,false); RESC();
  { float sacc=pB0[0]+pB0[1]; _Pragma("unroll") for(int r=2;r<16;++r)sacc+=pB0[r]; _Pragma("unroll") for(int r=0;r<16;++r)sacc+=pB1[r]; l_reg+=sacc;
    pw0=(u32x4){PKW(pB0,0),PKW(pB0,2),PKW(pB0,4),PKW(pB0,6)};pw1=(u32x4){PKW(pB0,8),PKW(pB0,10),PKW(pB0,12),PKW(pB0,14)};pw2=(u32x4){PKW(pB1,0),PKW(pB1,2),PKW(pB1,4),PKW(pB1,6)};pw3=(u32x4){PKW(pB1,8),PKW(pB1,10),PKW(pB1,12),PKW(pB1,14)};
    SBAR(); pv(o,vb0+sl_cur,PAF(0),PAF(1),PAF(2),PAF(3)); }
  #undef PKW
  #undef PAF
  #undef VFR
  #undef PIN
  #undef MX3
  #undef GAPA
  #undef GAPB
  #undef EX
  #undef VRD
  #undef KRD
  #undef STEP
  #undef ENDW
  {auto rr=__builtin_amdgcn_permlane32_swap(__float_as_uint(l_reg),__float_as_uint(l_reg),false,false);l_reg=__uint_as_float(rr[0])+__uint_as_float(rr[1]);}
  if(hi==0)wsf[32+r32]=l_reg;asm volatile("s_waitcnt lgkmcnt(0)":::"memory");
  float rli[16];
  #pragma unroll
  for(int r=0;r<16;++r)rli[r]=__builtin_amdgcn_rcpf(wsf[32+crow(r,hi)]);
  bf16*Ow=O+(rowbase+q0+wid*QBLK)*DMO+colo;
  { bf16*stg=(bf16*)(shm+LDS_OST)+wid*2048;
    #pragma unroll
    for(int r=0;r<16;++r){const int orow=crow(r,hi);
      #pragma unroll
      for(int d0=0;d0<2;++d0)stg[orow*64+d0*32+r32]=__float2bfloat16(o[d0][r]*rli[r]);}
    asm volatile("s_waitcnt lgkmcnt(0)":::"memory");
    #pragma unroll
    for(int i=0;i<4;++i){const int row=i*8+(lane>>3),ch=lane&7; const u32x4 v=*(const u32x4*)(stg+row*64+ch*8); ATTN_STORE16(Ow+(long)row*DMO+ch*8,v);} }
  asm volatile("s_waitcnt lgkmcnt(0)\n\ts_barrier":::"memory");
  #undef DMA_K
  #undef DMA_V
  #undef CMASK
  #undef START
  #undef RESC
  #undef ROT
}
constexpr int ATTN_LDS_BYTES=LDS_BYTES;
#undef SBAR
#undef WAIT_BAR
}
#define LAS __attribute__((address_space(3)))
typedef unsigned short u16;
typedef unsigned v4u __attribute__((ext_vector_type(4)));
typedef unsigned v2u __attribute__((ext_vector_type(2)));
typedef float f32x4 __attribute__((ext_vector_type(4)));
typedef short bf16x8 __attribute__((ext_vector_type(8)));
typedef short s16x4 __attribute__((ext_vector_type(4)));
typedef float f32x16 __attribute__((ext_vector_type(16)));
typedef float f32x2_t __attribute__((ext_vector_type(2)));
typedef __bf16 bf16x2_t __attribute__((ext_vector_type(2)));

constexpr int MTOK = 32768, SEQL = 8192, DMODEL = 1024, FFD = 4096, NIN0 = 3584, NIN1 = 3072, PLE = 256;
constexpr float LN_EPS = 1e-5f;
constexpr float ALPHA = 1.4142135623730951f;
constexpr size_t MiB = 1u << 20;
constexpr size_t WS_CVEC = 0;
constexpr size_t WS_STATS = 62 * MiB;
constexpr size_t WS_ROWSS = 63 * MiB;
constexpr size_t WS_BAR = 256 * 1024;
constexpr size_t WS_MISC = 512 * 1024;
constexpr size_t WS_CS = 1 * MiB;
constexpr size_t WS_WIN0 = 2 * MiB, WS_WOUT0 = 9 * MiB, WS_WIN1 = 11 * MiB, WS_WOUT1 = 17 * MiB, WS_W1 = 19 * MiB  , WS_W2 = 35 * MiB  , WS_WP = 51 * MiB  , WS_WG = 52 * MiB  ;
constexpr size_t WS_LSE = 56 * MiB;
constexpr size_t WS_XB = 64 * MiB, WS_MIX = 128 * MiB, WS_HB = 192 * MiB, WS_AUX = 448 * MiB, WS_END = 512 * MiB;
constexpr size_t WS_HGS = 416 * MiB, WS_HGD = 432 * MiB;
constexpr size_t WS_OB1 = 384 * MiB;
constexpr int LDS_BYTES = 147456;

__device__ __forceinline__ unsigned f2bf(float f) { unsigned u = __builtin_bit_cast(unsigned, f); return (u + 0x7fffu + ((u >> 16) & 1u)) >> 16; }
__device__ __forceinline__ unsigned pk2(float lo, float hi) { f32x2_t v = {lo, hi}; bf16x2_t b = __builtin_convertvector(v, bf16x2_t); return __builtin_bit_cast(unsigned, b); }
__device__ __forceinline__ float bf2f(unsigned v) { return __uint_as_float(v << 16); }
__device__ __forceinline__ float bflo(unsigned w) { return __uint_as_float(w << 16); }
__device__ __forceinline__ float bfhi(unsigned w) { return __uint_as_float(w & 0xffff0000u); }
__device__ __forceinline__ float shx(float v, int m, int lane) { return __builtin_bit_cast(float, __builtin_amdgcn_ds_bpermute((lane ^ m) << 2, __builtin_bit_cast(int, v))); }
__device__ __forceinline__ float wave_sum(float v, int lane) {
#pragma unroll
    for (int o = 1; o < 64; o <<= 1) v += shx(v, o, lane);
    return v;
}
__device__ __forceinline__ int crow(int reg, int h) { return (reg & 3) + 8 * (reg >> 2) + 4 * h; }
#define MFMA32(a, b, c) __builtin_amdgcn_mfma_f32_32x32x16_bf16((a), (b), (c), 0, 0, 0)
__device__ __forceinline__ bf16x8 pack8(const f32x16& x, int base) {
    v4u p; p.x = pk2(x[base], x[base + 1]); p.y = pk2(x[base + 2], x[base + 3]); p.z = pk2(x[base + 4], x[base + 5]); p.w = pk2(x[base + 6], x[base + 7]);
    return __builtin_bit_cast(bf16x8, p);
}
typedef short v4i16_t __attribute__((ext_vector_type(4)));
__device__ __forceinline__ s16x4 trrd(LAS unsigned char* p) { return __builtin_bit_cast(s16x4, __builtin_amdgcn_ds_read_tr16_b64_v4i16((LAS v4i16_t*)p)); }
__device__ __forceinline__ bf16x8 trfrag(LAS unsigned char* img, int pitch, int row_lo, int hi_delta, int col0, int lane) {
    const int i16 = lane & 15, q = i16 >> 2, p = i16 & 3, g16 = (lane >> 4) & 1;
    LAS unsigned char* a = img + (row_lo + q) * pitch + (col0 + 16 * g16 + 4 * p) * 2;
    const s16x4 lo = trrd(a), hi = trrd(a + hi_delta * pitch);
    return (bf16x8){lo[0], lo[1], lo[2], lo[3], hi[0], hi[1], hi[2], hi[3]};
}

struct Args {
    const float *x, *p, *ev_w_in, *ev_w_out, *da_lambda, *da_subln_g, *hg_lb_logits, *hg_norm_g, *od_w_in, *od_w_out, *ln1_g, *ln1_b, *ffn_w1, *ffn_w2, *ln2_g, *ln2_b, *ple_w_proj, *ple_w_gate, *ple_norm_g;
    float* out; unsigned char* ws;
};

__device__ __forceinline__ void p0_transpose_item(const float* W, int K, int N, u16* WT, LAS float* scr, int item, int lane, const float* gk = nullptr, const float* bk = nullptr, float* c1 = nullptr, float* c2 = nullptr) {
    const int nblk = N / 32, kb = item / nblk, nb = item % nblk, k0 = 64 * kb, n0 = 32 * nb;
#pragma unroll 8
    for (int i = 0; i < 32; ++i) { const int kk = 2 * i + (lane >> 5); scr[kk * 33 + (lane & 31)] = W[(size_t)(k0 + kk) * N + n0 + (lane & 31)]; }
    asm volatile("s_waitcnt lgkmcnt(0)" ::: "memory");
    const int c = lane & 7;
    float gs[8];
#pragma unroll
    for (int e = 0; e < 8; ++e) gs[e] = gk ? gk[k0 + 8 * c + e] : 1.f;
    if (gk) {
        const int n = lane & 31, kh = (lane >> 5) * 32; float s1 = 0.f, s2 = 0.f;
#pragma unroll 8
        for (int kk = 0; kk < 32; ++kk) { const float wv = scr[(kh + kk) * 33 + n]; s1 += gk[k0 + kh + kk] * wv; s2 += bk[k0 + kh + kk] * wv; }
        s1 += shx(s1, 32, lane); s2 += shx(s2, 32, lane);
        if (lane < 32) { atomicAdd(c1 + n0 + n, s1); atomicAdd(c2 + n0 + n, s2); }
    }
#pragma unroll
    for (int j = 0; j < 4; ++j) { const int n = (lane >> 3) + 8 * j; const LAS float* sp = scr + (8 * c) * 33 + n;
        v4u o; o.x = pk2(sp[0 * 33] * gs[0], sp[1 * 33] * gs[1]); o.y = pk2(sp[2 * 33] * gs[2], sp[3 * 33] * gs[3]); o.z = pk2(sp[4 * 33] * gs[4], sp[5 * 33] * gs[5]); o.w = pk2(sp[6 * 33] * gs[6], sp[7 * 33] * gs[7]);
        *(v4u*)(WT + (size_t)(n0 + n) * K + k0 + 8 * c) = o; }
    asm volatile("s_waitcnt lgkmcnt(0)" ::: "memory");
}
__device__ __forceinline__ void prologue(const Args& A, LAS unsigned char* lds, int gw, int NGW, int wave, int lane) {
    unsigned char* ws = A.ws;
    LAS float* scr = (LAS float*)(lds + wave * 16384);
    const int cnt[12] = {(1024 / 64) * (NIN0 / 32), 512, (1024 / 64) * (NIN1 / 32), 512, 2048, 2048, 2048, 2048, 128, 128, 512, 512};
    int total = 0;
#pragma unroll
    for (int i = 0; i < 12; ++i) total += cnt[i];
    for (int it = gw; it < total; it += NGW) {
        int r = it;
        if (r < cnt[0]) { p0_transpose_item(A.ev_w_in, 1024, NIN0, (u16*)(ws + WS_WIN0), scr, r, lane); continue; } r -= cnt[0];
        if (r < cnt[1]) { p0_transpose_item(A.ev_w_out, 1024, 1024, (u16*)(ws + WS_WOUT0), scr, r, lane); continue; } r -= cnt[1];
        if (r < cnt[2]) { p0_transpose_item(A.od_w_in, 1024, NIN1, (u16*)(ws + WS_WIN1), scr, r, lane); continue; } r -= cnt[2];
        if (r < cnt[3]) { p0_transpose_item(A.od_w_out, 1024, 1024, (u16*)(ws + WS_WOUT1), scr, r, lane); continue; } r -= cnt[3];
        if (r < 4096) { const int l = r >> 11; float* cv = (float*)(ws + WS_CVEC) + l * 10240; p0_transpose_item(A.ffn_w1 + (size_t)l * 1024 * 4096, 1024, 4096, (u16*)(ws + WS_W1 + l * 8 * MiB), scr, r & 2047, lane, A.ln1_g + l * 1024, A.ln1_b + l * 1024, cv, cv + 4096); continue; } r -= 4096;
        if (r < 4096) { const int l = r >> 11; p0_transpose_item(A.ffn_w2 + (size_t)l * 1024 * 4096, 4096, 1024, (u16*)(ws + WS_W2 + l * 8 * MiB), scr, r & 2047, lane); continue; } r -= 4096;
        if (r < 256) { const int l = r >> 7; p0_transpose_item(A.ple_w_proj + (size_t)l * 256 * 1024, 256, 1024, (u16*)(ws + WS_WP + l * (MiB / 2)), scr, r & 127, lane); continue; } r -= 256;
        { const int l = r >> 9; float* cv = (float*)(ws + WS_CVEC) + l * 10240 + 8192; p0_transpose_item(A.ple_w_gate + (size_t)l * 1024 * 1024, 1024, 1024, (u16*)(ws + WS_WG + l * 2 * MiB), scr, r & 511, lane, A.ln2_g + l * 1024, A.ln2_b + l * 1024, cv, cv + 1024); }
    }
    u16* XB = (u16*)(ws + WS_XB);
    for (int m = gw; m < MTOK; m += NGW) {
        const f32x4* xr = (const f32x4*)(A.x + (size_t)m * 1024) + lane; v2u* o = (v2u*)(XB + (size_t)m * 1024) + lane;
#pragma unroll
        for (int j = 0; j < 4; ++j) { const f32x4 v = xr[64 * j]; v2u w; w.x = pk2(v[0], v[1]); w.y = pk2(v[2], v[3]); o[64 * j] = w; }
    }
    { v4u* z = (v4u*)(ws + WS_STATS); for (int i = gw * 64 + lane; i < (int)((MiB + 256 * 1024) / 16); i += NGW * 64) z[i] = (v4u){0u, 0u, 0u, 0u}; }
    float* cs = (float*)(ws + WS_CS);
    for (int idx = gw * 64 + lane; idx < 65536; idx += NGW * 64) {
        const int pos = idx >> 3, e = idx & 7;
        double iv = 1.0;
#pragma unroll 1
        for (int k = 0; k < e; ++k) iv *= 0.19392274474868576;
        const float inv = (float)iv;
        const float angf = (float)pos * inv;
        double a = (double)angf; const double twopi = 6.283185307179586476925;
        const double kq = __builtin_rint(a / twopi); a -= kq * twopi;
        const double a2 = a * a; double sn = 0.0, cn = 0.0;
        double ts = a, tc = 1.0;
#pragma unroll 1
        for (int n = 0; n < 16; ++n) { cn += tc; sn += ts; tc *= -a2 / (double)((2 * n + 1) * (2 * n + 2)); ts *= -a2 / (double)((2 * n + 2) * (2 * n + 3)); }
        cs[idx] = (float)cn; cs[65536 + idx] = (float)sn;
    }
    float* misc = (float*)(ws + WS_MISC);
    for (int i = gw * 64 + lane; i < 512; i += NGW * 64) { const float l0 = A.hg_lb_logits[i], l1 = A.hg_lb_logits[512 + i]; misc[i] = 1.f / (1.f + __expf(l1 - l0)); }
}

__device__ __forceinline__ void ln_rows(float* X, u16* XBo, const float* g, const float* bta, float* rowss, const float* prow, u16* PBo, int gw, int NGW, int lane) {
    for (int m = gw; m < MTOK; m += NGW) {
        f32x4* xr = (f32x4*)(X + (size_t)m * 1024) + lane;
        f32x4 v[4]; float s = 0.f;
#pragma unroll
        for (int j = 0; j < 4; ++j) { v[j] = xr[64 * j]; s += (v[j][0] + v[j][1]) + (v[j][2] + v[j][3]); }
        const float mean = wave_sum(s, lane) * (1.f / 1024.f); float s2 = 0.f;
#pragma unroll
        for (int j = 0; j < 4; ++j) { v[j] = v[j] - mean; s2 += (v[j][0] * v[j][0] + v[j][1] * v[j][1]) + (v[j][2] * v[j][2] + v[j][3] * v[j][3]); }
        const float rstd = 1.f / sqrtf(wave_sum(s2, lane) * (1.f / 1024.f) + LN_EPS);
        v2u* o8 = (v2u*)(XBo + (size_t)m * 1024) + lane;
#pragma unroll
        for (int j = 0; j < 4; ++j) { const f32x4 gv = ((const f32x4*)g)[lane + 64 * j], bv = ((const f32x4*)bta)[lane + 64 * j];
            const f32x4 o = v[j] * rstd * gv + bv; xr[64 * j] = o; v2u w; w.x = pk2(o[0], o[1]); w.y = pk2(o[2], o[3]); o8[64 * j] = w; }
        if (rowss && lane == 0) rowss[m] = 0.f;
        if (prow) { const f32x4 pv = ((const f32x4*)(prow + (size_t)m * 256))[lane]; v2u w; w.x = pk2(pv[0], pv[1]); w.y = pk2(pv[2], pv[3]); ((v2u*)(PBo + (size_t)m * 256))[lane] = w; }
    }
}
__device__ __forceinline__ void p_rows(const float* prow, u16* PBo, int gw, int NGW, int lane) {
    for (int m = gw; m < MTOK; m += NGW) { const f32x4 pv = ((const f32x4*)(prow + (size_t)m * 256))[lane]; v2u w; w.x = pk2(pv[0], pv[1]); w.y = pk2(pv[2], pv[3]); ((v2u*)(PBo + (size_t)m * 256))[lane] = w; }
}
__device__ __forceinline__ void diff_combine(const u16* AUX, u16* MIX, const float* lam_p, const float* subg, int gw, int NGW, int lane) {
    const float s01 = wave_sum(lam_p[lane] * lam_p[64 + lane], lane), s23 = wave_sum(lam_p[128 + lane] * lam_p[192 + lane], lane);
    const float lam = __expf(s01) - __expf(s23) + 0.2f;
    const int h = lane >> 4, d0 = (lane & 15) * 8;
    float gv[8];
#pragma unroll
    for (int e = 0; e < 8; ++e) gv[e] = subg[d0 + e] * 0.8f;
    for (int m = gw; m < MTOK; m += NGW) {
        const v4u a0 = *(const v4u*)(AUX + (size_t)m * 1024 + h * 256 + d0), a1 = *(const v4u*)(AUX + (size_t)m * 1024 + h * 256 + 128 + d0);
        float o[8];
        o[0] = bflo(a0.x) - lam * bflo(a1.x); o[1] = bfhi(a0.x) - lam * bfhi(a1.x); o[2] = bflo(a0.y) - lam * bflo(a1.y); o[3] = bfhi(a0.y) - lam * bfhi(a1.y);
        o[4] = bflo(a0.z) - lam * bflo(a1.z); o[5] = bfhi(a0.z) - lam * bfhi(a1.z); o[6] = bflo(a0.w) - lam * bflo(a1.w); o[7] = bfhi(a0.w) - lam * bfhi(a1.w);
        float ss = 0.f;
#pragma unroll
        for (int e = 0; e < 8; ++e) ss += o[e] * o[e];
        ss += shx(ss, 1, lane); ss += shx(ss, 2, lane); ss += shx(ss, 4, lane); ss += shx(ss, 8, lane);
        const float rs = 1.f / sqrtf(ss * (1.f / 128.f) + LN_EPS);
        v4u w; w.x = pk2(o[0] * rs * gv[0], o[1] * rs * gv[1]); w.y = pk2(o[2] * rs * gv[2], o[3] * rs * gv[3]); w.z = pk2(o[4] * rs * gv[4], o[5] * rs * gv[5]); w.w = pk2(o[6] * rs * gv[6], o[7] * rs * gv[7]);
        *(v4u*)(MIX + (size_t)m * 1024 + h * 128 + d0) = w;
    }
}
namespace hg {
constexpr int P_QA = 272, P_QO = 264, P_TR = 320;
constexpr int O_QA = 0, O_KA = O_QA + 64 * P_QA, O_QO = O_KA + 64 * P_QA, O_KST = O_QO + 64 * P_QO, O_V = O_KST + 64 * P_TR, O_OST = O_V + 64 * P_TR, O_TOT = O_OST + 64 * 132 * 4, O_DEC = O_TOT + 2048, O_END = O_DEC + 512;
static_assert(O_END <= 131072, "hgrn lds");
template <bool OUT>
__device__ __forceinline__ void item(LAS unsigned char* L, const u16* __restrict__ H, int it, const float* __restrict__ lbv, float* Send, float* Drun, const float* __restrict__ outg, u16* MIX, const int tid, const float* Sst = nullptr) {
    const int  lane = tid & 63, w = __builtin_amdgcn_readfirstlane(tid >> 6), r = lane & 31, h = lane >> 5;
    const int tt = w & 1, vt = w >> 1;
    const int bh = it >> 4, run = it & 15, b = bh >> 2, hh = bh & 3;
    const int kd = tid & 127, seg = tid >> 7;
    const size_t row0 = (size_t)b * 8192 + (size_t)run * 512;
    const float lb = lbv[hh * 128 + kd];
    LAS float* TOT = (LAS float*)(L + O_TOT); LAS float* DEC = (LAS float*)(L + O_DEC); LAS float* OST = (LAS float*)(L + O_OST);
    f32x16 S[4];
#pragma unroll
    for (int k = 0; k < 4; ++k) S[k] = f32x16{};
    if (OUT && run > 0) {
#pragma unroll
        for (int k = 0; k < 4; ++k)
#pragma unroll
            for (int i = 0; i < 16; ++i) S[k][i] = Sst[((((size_t)it * 4 + vt) * 4 + k) * 16 + i) * 64 + lane];
    }
    float bsum = 0.f;
    u16 nf[16], nq[16]; v4u nv[2];
#define HG_ISSUE(rowc_) do { _Pragma("unroll") for (int i = 0; i < 16; ++i) { const u16* p = H + ((rowc_) + seg * 16 + i) * NIN0 + hh * 128 + kd; nf[i] = p[2048]; if (OUT) nq[i] = p[1536]; } \
        _Pragma("unroll") for (int n = 0; n < 2; ++n) { const int id = tid + 512 * n, t = id >> 4, c = id & 15; nv[n] = *(const v4u*)(H + ((rowc_) + t) * NIN0 + 2560 + hh * 128 + c * 8); } } while (0)
    HG_ISSUE(row0);
    for (int ch = 0; ch < 8; ++ch) {
        const size_t rowc = row0 + ch * 64;
        float fg[16], cs[16], hq[16];
#pragma unroll
        for (int i = 0; i < 16; ++i) { fg[i] = bf2f(nf[i]); if (OUT) hq[i] = bf2f(nq[i]); }
#pragma unroll
        for (int n = 0; n < 2; ++n) { const int id = tid + 512 * n, t = id >> 4, c = id & 15; *(LAS v4u*)(L + O_V + t * P_TR + c * 16) = nv[n]; }
        if (ch + 1 < 8) HG_ISSUE(rowc + 64);
        float runs = 0.f;
#pragma unroll
        for (int i = 0; i < 16; ++i) { const float sg = __builtin_amdgcn_rcpf(1.f + __expf(-fg[i])); const float f = lb + (1.f - lb) * sg; fg[i] = (1.f - lb) * (1.f - sg); runs += __logf(f); cs[i] = runs; }
        TOT[seg * 128 + kd] = runs;
        __syncthreads();
        const float t0 = TOT[kd], t1 = TOT[128 + kd], t2 = TOT[256 + kd], t3 = TOT[384 + kd];
        const float off = (seg > 0 ? t0 : 0.f) + (seg > 1 ? t1 : 0.f) + (seg > 2 ? t2 : 0.f);
        const float bmid = t0 + t1, blast = (t0 + t1) + (t2 + t3);
        const float elm = __expf(blast - bmid), em = __expf(bmid);
#pragma unroll
        for (int i = 0; i < 16; ++i) {
            const int t = seg * 16 + i; const float bi = off + cs[i];
            const float e1 = __expf(bi - bmid), e2 = __builtin_amdgcn_rcpf(e1); const float kk = fg[i];
            *(LAS u16*)(L + O_KST + t * P_TR + kd * 2) = (u16)f2bf(kk * e2 * elm);
            if (OUT) { const float q = hq[i] * __builtin_amdgcn_rcpf(1.f + __expf(-hq[i]));
                *(LAS u16*)(L + O_QA + t * P_QA + kd * 2) = (u16)f2bf(q * e1);
                *(LAS u16*)(L + O_KA + t * P_QA + kd * 2) = (u16)f2bf(kk * e2);
                *(LAS u16*)(L + O_QO + t * P_QO + kd * 2) = (u16)f2bf(q * e1 * em); }
        }
        if (seg == 0) { DEC[kd] = __expf(blast); bsum += blast; }
        __syncthreads();
        if (OUT) {
            f32x16 acc = f32x16{};
            for (int st = 0; st <= tt; ++st) {
                f32x16 X = f32x16{};
#pragma unroll
                for (int ks = 0; ks < 8; ++ks) { const bf16x8 a = *(LAS bf16x8*)(L + O_KA + (32 * st + r) * P_QA + (16 * ks + 8 * h) * 2); const bf16x8 bq = *(LAS bf16x8*)(L + O_QA + (32 * tt + r) * P_QA + (16 * ks + 8 * h) * 2); X = MFMA32(a, bq, X); }
                if (st == tt) {
#pragma unroll
                    for (int i = 0; i < 16; ++i) if (crow(i, h) > r) X[i] = 0.f; }
#pragma unroll
                for (int s2 = 0; s2 < 2; ++s2) { const bf16x8 pa = pack8(X, 8 * s2); const bf16x8 vf = trfrag(L + O_V, P_TR, 32 * st + 16 * s2 + 4 * h, 8, 32 * vt, lane); acc = MFMA32(pa, vf, acc); }
            }
#pragma unroll
            for (int k = 0; k < 4; ++k)
#pragma unroll
                for (int s2 = 0; s2 < 2; ++s2) {
                    LAS unsigned char* qp = L + O_QO + (32 * tt + r) * P_QO + (32 * k + 16 * s2 + 4 * h) * 2;
                    const s16x4 lo = *(LAS s16x4*)qp, hi = *(LAS s16x4*)(qp + 16);
                    const bf16x8 a2 = (bf16x8){lo[0], lo[1], lo[2], lo[3], hi[0], hi[1], hi[2], hi[3]};
                    acc = MFMA32(a2, pack8(S[k], 8 * s2), acc); }
#pragma unroll
            for (int i = 0; i < 16; ++i) OST[(32 * tt + crow(i, h)) * 132 + 32 * vt + r] = acc[i];
        }
#pragma unroll
        for (int k = 0; k < 4; ++k) {
#pragma unroll
            for (int i = 0; i < 16; ++i) S[k][i] *= DEC[32 * k + crow(i, h)];
#pragma unroll
            for (int ks = 0; ks < 4; ++ks) { const bf16x8 a = trfrag(L + O_KST, P_TR, 16 * ks + 8 * h, 4, 32 * k, lane); const bf16x8 bv = trfrag(L + O_V, P_TR, 16 * ks + 8 * h, 4, 32 * vt, lane); S[k] = MFMA32(a, bv, S[k]); }
        }
        __syncthreads();
        if (OUT) {
            const int t = tid >> 3, c8 = tid & 7; float o[16]; float ss = 0.f;
#pragma unroll
            for (int j = 0; j < 4; ++j) { const f32x4 v = *(LAS f32x4*)(OST + t * 132 + c8 * 16 + 4 * j); o[4 * j] = v[0]; o[4 * j + 1] = v[1]; o[4 * j + 2] = v[2]; o[4 * j + 3] = v[3]; ss += (v[0] * v[0] + v[1] * v[1]) + (v[2] * v[2] + v[3] * v[3]); }
            ss += shx(ss, 1, lane); ss += shx(ss, 2, lane); ss += shx(ss, 4, lane);
            const float rs = __builtin_amdgcn_rsqf(ss * (1.f / 128.f) + LN_EPS);
            const u16* gp = H + (rowc + t) * NIN0 + 3072 + hh * 128 + c8 * 16; u16* op = MIX + (rowc + t) * 1024 + 512 + hh * 128 + c8 * 16;
#pragma unroll
            for (int j = 0; j < 2; ++j) { const v4u gvv = *(const v4u*)(gp + 8 * j); const unsigned gw_[4] = {gvv.x, gvv.y, gvv.z, gvv.w}; unsigned ow[4];
#pragma unroll
                for (int e = 0; e < 4; ++e) { const float g0 = bflo(gw_[e]), g1 = bfhi(gw_[e]); const int c = 8 * j + 2 * e;
                    const float y0 = o[c] * rs * outg[c8 * 16 + c] * (g0 * __builtin_amdgcn_rcpf(1.f + __expf(-g0))), y1 = o[c + 1] * rs * outg[c8 * 16 + c + 1] * (g1 * __builtin_amdgcn_rcpf(1.f + __expf(-g1)));
                    ow[e] = pk2(y0, y1); }
                *(v4u*)(op + 8 * j) = (v4u){ow[0], ow[1], ow[2], ow[3]}; }
        }
    }
    if (!OUT) {
        if (tt == 0) {
#pragma unroll
            for (int k = 0; k < 4; ++k)
#pragma unroll
                for (int i = 0; i < 16; ++i) Send[((((size_t)it * 4 + vt) * 4 + k) * 16 + i) * 64 + lane] = S[k][i]; }
        if (seg == 0) Drun[it * 128 + kd] = __expf(bsum);
    }
}
__device__ __forceinline__ void scan(const float* __restrict__ Send, const float* __restrict__ Drun, float* Sst, int gtid, int nthreads) {
    for (int idx = gtid; idx < 16 * 16384; idx += nthreads) {
        const int bh = idx >> 14, e = idx & 16383, lane = e & 63, i = (e >> 6) & 15, k = (e >> 10) & 3;
        const int kd = 32 * k + crow(i, lane >> 5);
        float sv[15], dv[15];
#pragma unroll
        for (int r = 0; r < 15; ++r) { sv[r] = Send[(size_t)(bh * 16 + r) * 16384 + e]; dv[r] = Drun[(bh * 16 + r) * 128 + kd]; }
        float st = 0.f;
#pragma unroll
        for (int r = 0; r < 15; ++r) { st = dv[r] * st + sv[r]; Sst[(size_t)(bh * 16 + r + 1) * 16384 + e] = st; }
    }
}
}

__device__ __forceinline__ void dil_task(LAS unsigned char* Lw, const u16* __restrict__ QKV, int task, u16* OBg0, u16* OBg1, u16* OBg2, float* LSE, int lane) {
    const int r = lane & 31, h = lane >> 5;
    const int bh = task / 768, rem = task - bh * 768, g = rem >> 8, j = rem & 255;
    const int sh = 2 * g, res = j >> (8 - sh), qt = j & ((256 >> sh) - 1);
    const int b = bh >> 4, hd = bh & 15;
    const size_t rowb = (size_t)b * 8192;
    const int qpos = res + ((32 * qt + r) << sh);
    const u16* qp = QKV + (rowb + qpos) * NIN1 + hd * 64;
    bf16x8 qf[4];
#pragma unroll
    for (int ks = 0; ks < 4; ++ks) qf[ks] = *(const bf16x8*)(qp + 16 * ks + 8 * h);
    f32x16 X[5];
#pragma unroll
    for (int kb = 0; kb < 5; ++kb) {
        int ki = 32 * qt - 128 + 32 * kb + r; ki = ki < 0 ? 0 : ki;
        const u16* kp = QKV + (rowb + res + (ki << sh)) * NIN1 + 1024 + hd * 64;
        X[kb] = f32x16{};
#pragma unroll
        for (int ks = 0; ks < 4; ++ks) { const bf16x8 kf = *(const bf16x8*)(kp + 16 * ks + 8 * h); X[kb] = MFMA32(kf, qf[ks], X[kb]); }
    }
    float m = -INFINITY;
#pragma unroll
    for (int kb = 0; kb < 5; ++kb)
#pragma unroll
        for (int i = 0; i < 16; ++i) { const int c = crow(i, h); bool valid = (32 * qt - 128 + 32 * kb + c) >= 0;
            if (kb == 0) valid = valid && (c >= r);
            if (kb == 4) valid = valid && (c <= r);
            X[kb][i] = valid ? X[kb][i] : -INFINITY; m = fmaxf(m, X[kb][i]); }
    m = fmaxf(m, shx(m, 32, lane));
    float l = 0.f;
#pragma unroll
    for (int kb = 0; kb < 5; ++kb)
#pragma unroll
        for (int i = 0; i < 16; ++i) { X[kb][i] = __builtin_amdgcn_exp2f(X[kb][i] - m); l += X[kb][i]; }
    l += shx(l, 32, lane);
    f32x16 y[2]; y[0] = f32x16{}; y[1] = f32x16{};
#pragma unroll
    for (int kb = 0; kb < 5; ++kb) {
#pragma unroll
        for (int n = 0; n < 4; ++n) { const int id = lane + 64 * n, key = id >> 3, c = id & 7; int ki = 32 * qt - 128 + 32 * kb + key; ki = ki < 0 ? 0 : ki;
            const v4u v = *(const v4u*)(QKV + (rowb + res + (ki << sh)) * NIN1 + 2048 + hd * 64 + c * 8); *(LAS v4u*)(Lw + key * 192 + c * 16) = v; }
#pragma unroll
        for (int s2 = 0; s2 < 2; ++s2) { const bf16x8 pb = pack8(X[kb], 8 * s2);
#pragma unroll
            for (int dt = 0; dt < 2; ++dt) { const bf16x8 a = trfrag(Lw, 192, 16 * s2 + 4 * h, 8, 32 * dt, lane); y[dt] = MFMA32(a, pb, y[dt]); } }
    }
    const float inv = 1.f / l;
    u16* ob = (g == 0 ? OBg0 : g == 1 ? OBg1 : OBg2) + (rowb + qpos) * 1024 + hd * 64;
#pragma unroll
    for (int dt = 0; dt < 2; ++dt)
#pragma unroll
        for (int gq = 0; gq < 4; ++gq) { v2u w; w.x = pk2(y[dt][4 * gq] * inv, y[dt][4 * gq + 1] * inv); w.y = pk2(y[dt][4 * gq + 2] * inv, y[dt][4 * gq + 3] * inv); *(v2u*)(ob + 32 * dt + 8 * gq + 4 * h) = w; }
    if (h == 0) LSE[((size_t)g * MTOK + rowb + qpos) * 16 + hd] = (m + __log2f(l)) * 0.6931471805599453f;
}
namespace dl {
constexpr int KP = 144, VP = 192, O_K = 0, O_V = 384 * KP, O_END = O_V + 384 * VP;
static_assert(O_END <= 131072, "dilated lds");
struct Dec { int g, sh, res, i0, hd; size_t rowb; };
__device__ __forceinline__ Dec decode(int task) {
    Dec d; const int bh = task / 96, rem = task - bh * 96; d.g = rem >> 5; const int j = rem & 31;
    d.sh = 2 * d.g; d.res = j >> (5 - d.sh); d.i0 = 256 * (j & ((32 >> d.sh) - 1)); d.hd = bh & 15; d.rowb = (size_t)(bh >> 4) * 8192; return d;
}
__device__ __forceinline__ void issue(const u16* __restrict__ QKV, int task, int tid, v4u (&pk)[6], v4u (&pv)[6], bf16x8 (&qn)[4]) {
    const Dec d = decode(task); const int lane = tid & 63, w = tid >> 6, r = lane & 31, h = lane >> 5;
#pragma unroll
    for (int n = 0; n < 6; ++n) { const int id = tid + 512 * n, c = id >> 3, ch = id & 7; int ki = d.i0 - 128 + c; ki = ki < 0 ? 0 : ki;
        const u16* src = QKV + (d.rowb + d.res + (ki << d.sh)) * NIN1 + d.hd * 64 + ch * 8;
        pk[n] = *(const v4u*)(src + 1024); pv[n] = *(const v4u*)(src + 2048); }
    const u16* qp = QKV + (d.rowb + d.res + ((d.i0 + 32 * w + r) << d.sh)) * NIN1 + d.hd * 64;
#pragma unroll
    for (int ks = 0; ks < 4; ++ks) qn[ks] = *(const bf16x8*)(qp + 16 * ks + 8 * h);
}
__device__ __forceinline__ void phase(LAS unsigned char* L, const u16* __restrict__ QKV, u16* OBg0, u16* OBg1, u16* OBg2, float* LSE, int first, int stride, const int tid) {
    const int lane = tid & 63, w = __builtin_amdgcn_readfirstlane(tid >> 6), r = lane & 31, h = lane >> 5;
    const bool xl = (stride == 256); const int nround = xl ? 24 : (6144 - first + stride - 1) / stride;
    if (first >= 6144) return;
#define DL_TASK(k) (xl ? (((first >> 5) * 8 + (k) / 3) * 96 + ((k) % 3) * 32 + (first & 31)) : (first + (k) * stride))
    v4u pk[6], pv[6]; bf16x8 qn[4];
    issue(QKV, DL_TASK(0), tid, pk, pv, qn);
    for (int kr = 0; kr < nround; ++kr) {
        const int task = DL_TASK(kr);
        const Dec d = decode(task);
#pragma unroll
        for (int n = 0; n < 6; ++n) { const int id = tid + 512 * n, c = id >> 3, ch = id & 7; *(LAS v4u*)(L + O_K + c * KP + ch * 16) = pk[n]; *(LAS v4u*)(L + O_V + c * VP + ch * 16) = pv[n]; }
        bf16x8 qf[4];
#pragma unroll
        for (int ks = 0; ks < 4; ++ks) qf[ks] = qn[ks];
        __syncthreads();
        if (kr + 1 < nround) issue(QKV, DL_TASK(kr + 1), tid, pk, pv, qn);
        const int i0 = d.i0, g = d.g, sh = d.sh;
        const int qpos = d.res + ((i0 + 32 * w + r) << sh);
        f32x16 X[5];
#pragma unroll
        for (int kb = 0; kb < 5; ++kb) {
            X[kb] = f32x16{};
#pragma unroll
            for (int ks = 0; ks < 4; ++ks) { const bf16x8 kf = *(LAS bf16x8*)(L + O_K + (32 * w + 32 * kb + r) * KP + (16 * ks + 8 * h) * 2); X[kb] = MFMA32(kf, qf[ks], X[kb]); }
        }
        float m = -INFINITY;
#pragma unroll
        for (int kb = 0; kb < 5; ++kb)
#pragma unroll
            for (int i = 0; i < 16; ++i) { const int c = crow(i, h); bool valid = (i0 - 128 + 32 * w + 32 * kb + c) >= 0;
                if (kb == 0) valid = valid && (c >= r);
                if (kb == 4) valid = valid && (c <= r);
                X[kb][i] = valid ? X[kb][i] : -INFINITY; m = fmaxf(m, X[kb][i]); }
        m = fmaxf(m, shx(m, 32, lane));
        float l = 0.f;
#pragma unroll
        for (int kb = 0; kb < 5; ++kb)
#pragma unroll
            for (int i = 0; i < 16; ++i) { X[kb][i] = __builtin_amdgcn_exp2f(X[kb][i] - m); l += X[kb][i]; }
        l += shx(l, 32, lane);
        f32x16 y[2]; y[0] = f32x16{}; y[1] = f32x16{};
#pragma unroll
        for (int kb = 0; kb < 5; ++kb)
#pragma unroll
            for (int s2 = 0; s2 < 2; ++s2) { const bf16x8 pb = pack8(X[kb], 8 * s2);
#pragma unroll
                for (int dt = 0; dt < 2; ++dt) { const bf16x8 a = trfrag(L + O_V, VP, 32 * w + 32 * kb + 16 * s2 + 4 * h, 8, 32 * dt, lane); y[dt] = MFMA32(a, pb, y[dt]); } }
        const float inv = 1.f / l;
        u16* ob = (g == 0 ? OBg0 : g == 1 ? OBg1 : OBg2) + (d.rowb + qpos) * 1024 + d.hd * 64;
#pragma unroll
        for (int dt = 0; dt < 2; ++dt)
#pragma unroll
            for (int gq = 0; gq < 4; ++gq) { v2u wv; wv.x = pk2(y[dt][4 * gq] * inv, y[dt][4 * gq + 1] * inv); wv.y = pk2(y[dt][4 * gq + 2] * inv, y[dt][4 * gq + 3] * inv); *(v2u*)(ob + 32 * dt + 8 * gq + 4 * h) = wv; }
        if (h == 0) LSE[((size_t)g * MTOK + d.rowb + qpos) * 16 + d.hd] = (m + __log2f(l)) * 0.6931471805599453f;
        __syncthreads();
    }
}
}
__device__ __forceinline__ void dil_merge(const u16* OB0, const u16* OB1, const u16* OB2, const float* LSE, u16* MIX, int gw, int NGW, int lane) {
    const int hd = lane >> 2, dq = (lane & 3) * 16;
    for (int m = gw; m < MTOK; m += NGW) {
        const float l0 = LSE[((size_t)m) * 16 + hd], l1 = LSE[((size_t)MTOK + m) * 16 + hd], l2 = LSE[((size_t)2 * MTOK + m) * 16 + hd];
        const float mx = fmaxf(l0, fmaxf(l1, l2)); float w0 = __expf(l0 - mx), w1 = __expf(l1 - mx), w2 = __expf(l2 - mx); const float iz = 1.f / (w0 + w1 + w2); w0 *= iz; w1 *= iz; w2 *= iz;
        const size_t off = (size_t)m * 1024 + hd * 64 + dq;
#pragma unroll
        for (int j = 0; j < 2; ++j) { const v4u a = *(const v4u*)(OB0 + off + 8 * j), bq = *(const v4u*)(OB1 + off + 8 * j), c = *(const v4u*)(OB2 + off + 8 * j);
            const unsigned aw[4] = {a.x, a.y, a.z, a.w}, bw[4] = {bq.x, bq.y, bq.z, bq.w}, cw[4] = {c.x, c.y, c.z, c.w}; unsigned ow[4];
#pragma unroll
            for (int e = 0; e < 4; ++e) ow[e] = pk2(w0 * bflo(aw[e]) + w1 * bflo(bw[e]) + w2 * bflo(cw[e]), w0 * bfhi(aw[e]) + w1 * bfhi(bw[e]) + w2 * bfhi(cw[e]));
            *(v4u*)(MIX + off + 8 * j) = (v4u){ow[0], ow[1], ow[2], ow[3]}; }
    }
}
#ifndef HEAVY_ALIGN
#define HEAVY_ALIGN true
#endif
#ifndef REP_PRO
#define REP_PRO 1
#endif
#ifndef REP_P1
#define REP_P1 1
#endif
#ifndef REP_HGA
#define REP_HGA 1
#endif
#ifndef REP_HGC
#define REP_HGC 1
#endif
#ifndef REP_CMB
#define REP_CMB 1
#endif
#ifndef REP_DIL
#define REP_DIL 1
#endif
#ifndef REP_MRG
#define REP_MRG 1
#endif
#ifndef REP_P6
#define REP_P6 1
#endif
#ifndef REP_ATT
#define REP_ATT 1
#endif
#ifndef PH_LO
#define PH_LO 0
#endif
#ifndef PH_HI
#define PH_HI 100
#endif
__device__ __forceinline__ int fresh_lane() { int l; asm volatile("v_mbcnt_lo_u32_b32 %0, -1, 0\n\tv_mbcnt_hi_u32_b32 %0, -1, %0" : "=v"(l)); return l; }
__device__ __forceinline__ unsigned xcc_id() { return (unsigned)__builtin_amdgcn_s_getreg((3 << 11) | 20) & 0xFu; }
__device__ __forceinline__ unsigned bar_ld(unsigned* p) { return __hip_atomic_load(p, __ATOMIC_RELAXED, __HIP_MEMORY_SCOPE_AGENT); }
__device__ __forceinline__ unsigned bar_add(unsigned* p) { return __hip_atomic_fetch_add(p, 1u, __ATOMIC_RELAXED, __HIP_MEMORY_SCOPE_AGENT); }
__device__ __forceinline__ void grid_bar(unsigned* bar, unsigned k, unsigned x, unsigned nloc, unsigned nx, int wave0) {
    asm volatile("s_waitcnt vmcnt(0) lgkmcnt(0)" ::: "memory");
    __syncthreads();
    if (wave0 == 0) {
        const int ln = fresh_lane();
        if (ln == 0) {
            const unsigned old = bar_add(&bar[1024 + 64 * x]);
            if (old + 1u == k * nloc) {
                __builtin_amdgcn_fence(__ATOMIC_RELEASE, "agent");
                asm volatile("s_waitcnt vmcnt(0)" ::: "memory");
                const unsigned og = bar_add(&bar[3072]);
                if (og + 1u == k * nx) bar_add(&bar[3136]);
                else while (bar_ld(&bar[3136]) < k) __builtin_amdgcn_s_sleep(1);
                __builtin_amdgcn_fence(__ATOMIC_ACQUIRE, "agent");
                bar_add(&bar[2048 + 64 * x]);
                asm volatile("s_waitcnt vmcnt(0)" ::: "memory");
            } else {
                while (bar_ld(&bar[2048 + 64 * x]) < k) __builtin_amdgcn_s_sleep(1);
                __builtin_amdgcn_fence(__ATOMIC_ACQUIRE, "agent");
                asm volatile("s_waitcnt vmcnt(0)" ::: "memory");
            }
        }
    }
    __syncthreads();
}
template <bool ALIGN = true, class Epi>
__device__ __forceinline__ void run_gemm(LAS unsigned char* lds, const u16* A, const u16* Bt, int N, int K, const Epi& E, int tid) {
    asm volatile("" : "+v"(tid));
    pg8::Gemm g{A, Bt, MTOK, N, K}; int Gl = (int)gridDim.x, bxl = (int)blockIdx.x; asm volatile("" : "+s"(Gl), "+s"(bxl)); pg8::StaticOrder S; S.init(MTOK, N, Gl, bxl);
    pg8::gemm_phase<Epi, pg8::StaticOrder, ALIGN, PG8_SP2>(lds, g, S, E, tid);
}
__global__ void __launch_bounds__(512, 2) fwd_kernel(Args A) {
    extern __shared__ __attribute__((aligned(16))) unsigned char lds_raw[];
    LAS unsigned char* lds = (LAS unsigned char*)lds_raw;
    cg::grid_group grid = cg::this_grid();
    const int wave0 = __builtin_amdgcn_readfirstlane((int)threadIdx.x >> 6);
#define tid0 (wave0 * 64 + fresh_lane())
    const int G = gridDim.x, bx = blockIdx.x;
    const int vcu = (G % 8 == 0) ? (bx % 8) * (G / 8) + bx / 8 : bx;
    const int NGW = G * 8;
#define PHASE_IDS() int tid = tid0; asm volatile("" : "+v"(tid)); const int lane = tid & 63, wave = __builtin_amdgcn_readfirstlane(tid >> 6), gw = bx * 8 + wave; (void)lane; (void)gw;
    unsigned char* ws = A.ws;
    float* rowss0 = (float*)(ws + WS_ROWSS); float* stats0 = (float*)(ws + WS_STATS); const float* cvec0 = (const float*)(ws + WS_CVEC); const float* lbv = (const float*)(ws + WS_MISC); const float* cs = (const float*)(ws + WS_CS);
    u16* XB = (u16*)(ws + WS_XB); u16* MIX = (u16*)(ws + WS_MIX); u16* HB = (u16*)(ws + WS_HB); u16* AUX = (u16*)(ws + WS_AUX);
    float* HGS = (float*)(ws + WS_HGS); float* HGD = (float*)(ws + WS_HGD); float* LSE = (float*)(ws + WS_LSE); u16* OB1 = (u16*)(ws + WS_OB1);
    float* X = A.out;
    unsigned* barw = (unsigned*)(ws + WS_BAR); unsigned nbar = 0;
    const unsigned myx = xcc_id();
    if (threadIdx.x == 0) bar_add(&barw[64 * myx]);
    unsigned nloc = 1, nxc = 1;
#define GSYNC() do { ++nbar; grid_bar(barw, nbar, myx, nloc, nxc, wave0); } while (0)

    for (int rep_ = 0; rep_ < REP_PRO; ++rep_) { { PHASE_IDS(); prologue(A, lds, gw, NGW, wave, lane); } }
    grid.sync();
    { unsigned cnt = 0, mine = 0;
#pragma unroll
      for (unsigned jx = 0; jx < 16; ++jx) { const unsigned c = bar_ld(&barw[64 * jx]); cnt += (c > 0u) ? 1u : 0u; mine = (jx == myx) ? c : mine; }
      nloc = (unsigned)__builtin_amdgcn_readfirstlane((int)mine); nxc = (unsigned)__builtin_amdgcn_readfirstlane((int)cnt); }

    for (int l = 0; l < 2; ++l) {
        const u16* Ain = (l == 0) ? XB : (const u16*)X;
        if (l == 0) {
            for (int rep_ = 0; rep_ < REP_P1; ++rep_) { { pg8::EpiStore E{HB, NIN0, 0, 1024, 512, cs, nullptr, nullptr, nullptr}; run_gemm(lds, Ain, (const u16*)(ws + WS_WIN0), NIN0, 1024, E, tid0); } }
            GSYNC();
#ifndef NO_HGA
            for (int rep_ = 0; rep_ < REP_HGA; ++rep_) { for (int it = vcu; it < 256; it += G) { PHASE_IDS(); hg::item<false>(lds, HB, it, lbv, HGS, HGD, nullptr, nullptr, tid); } }
#endif
            GSYNC();
            { PHASE_IDS(); hg::scan(HGS, HGD, (float*)X, bx * 512 + tid, NGW * 64); }
            __syncthreads();
            for (int rep_ = 0; rep_ < REP_ATT; ++rep_)
            for (int i = 0; i < 2048; ++i) {
                int tidA = tid0; asm volatile("" : "+v"(tidA));
                int pair, qb;
                if (G == 256) { if (i >= 8) break; const int s = vcu & 3, k = 7 - i; pair = vcu >> 2; qb = 4 * k + ((k & 1) ? 3 - s : s); }
                else { const int u = vcu + i * G; if (u >= 2048) break; pair = u >> 5; qb = 31 - (u & 31); }
                const int b = pair >> 4, vh = pair & 15, hh = vh >> 2, c = (vh >> 1) & 1, half = vh & 1;
#ifndef NO_ATTN
                attn_body::attn_unit<8>(b, (2 * hh + c) * 64, 512 + (2 * hh + c) * 64, 1024 + hh * 128 + half * 64, vh * 64, qb,
                                        (const attn_body::bf16*)HB, (const attn_body::bf16*)HB, (const attn_body::bf16*)HB, (attn_body::bf16*)AUX, (char*)lds_raw, tidA);
#endif
            }
            GSYNC();
#ifndef NO_HGC
            for (int rep_ = 0; rep_ < REP_HGC; ++rep_) { for (int it = vcu; it < 256; it += G) { PHASE_IDS(); hg::item<true>(lds, HB, it, lbv, HGS, HGD, A.hg_norm_g, MIX, tid, (const float*)X); } }
#endif
            for (int rep_ = 0; rep_ < REP_CMB; ++rep_) { { PHASE_IDS(); diff_combine(AUX, MIX, A.da_lambda, A.da_subln_g, gw, NGW, lane); } }
            GSYNC();
        } else {
            { pg8::EpiStore E{HB, NIN1, 0, 2048, 1024, cs, nullptr, nullptr, nullptr}; run_gemm(lds, Ain, (const u16*)(ws + WS_WIN1), NIN1, 1024, E, tid0); }
            GSYNC();
#ifndef NO_DIL
            for (int rep_ = 0; rep_ < REP_DIL; ++rep_) { { PHASE_IDS(); dl::phase(lds, HB, AUX, OB1, XB, LSE, vcu, G, tid); } }
#endif
            GSYNC();
            for (int rep_ = 0; rep_ < REP_MRG; ++rep_) { { PHASE_IDS(); dil_merge(AUX, OB1, XB, LSE, MIX, gw, NGW, lane); } }
            GSYNC();
        }
        float* rowss = rowss0 + (size_t)l * MTOK; float* st1 = stats0 + (size_t)(2 * l) * MTOK * 2; float* st2 = stats0 + (size_t)(2 * l + 1) * MTOK * 2; const float* cv = cvec0 + l * 10240;
        { PHASE_IDS(); p_rows(A.p + (size_t)l * MTOK * PLE, AUX, gw, NGW, lane); }
        { pg8::EpiResid E{Ain, XB, nullptr, nullptr, nullptr, st1}; run_gemm<HEAVY_ALIGN>(lds, MIX, (const u16*)(ws + (l == 0 ? WS_WOUT0 : WS_WOUT1)), 1024, 1024, E, tid0); }
#ifdef PROBE_OUTP
        { pg8::EpiStore E{HB + (size_t)64 * MiB, 1024, 0, 0, 0, cs, nullptr, nullptr, nullptr}; run_gemm(lds, MIX, (const u16*)(ws + WS_WOUT0), 1024, 1024, E, tid0); }
#endif
#ifdef PROBE_RESID
        { pg8::EpiResid E{XB, HB + (size_t)64 * MiB, st1, A.ln1_g, A.ln1_b, PROBE_RESID == 2 ? (float*)nullptr : (float*)(HB + (size_t)96 * MiB)}; run_gemm(lds, MIX, (const u16*)(ws + WS_WOUT0), 1024, 1024, E, tid0); }
#endif
        GSYNC();
        for (int rep_ = 0; rep_ < REP_P6; ++rep_) { pg8::EpiStore E{HB, FFD, 1, 0, 0, cs, st1, cv, cv + 4096}; run_gemm(lds, XB, (const u16*)(ws + WS_W1 + l * 8 * MiB), FFD, 1024, E, tid0); }
        { pg8::EpiE E{MIX, rowss}; run_gemm(lds, AUX, (const u16*)(ws + WS_WP + l * (MiB / 2)), 1024, PLE, E, tid0); }
        GSYNC();
#ifdef PROBE_EGEMM
        for (int q_ = 0; q_ < PROBE_EGEMM; ++q_) { pg8::EpiE E{AUX, (float*)(ws + WS_LSE)}; run_gemm(lds, AUX, (const u16*)(ws + WS_WP + l * (MiB / 2)), 1024, PLE, E, tid0); }
#endif
#ifdef PROBE_FFN2
        { pg8::EpiStore E{AUX, 1024, 0, 0, 0, cs, nullptr, nullptr, nullptr}; run_gemm(lds, HB, (const u16*)(ws + WS_W2 + l * 8 * MiB), 1024, FFD, E, tid0); }
#endif
        { pg8::EpiResid E{XB, XB, st1, A.ln1_g + l * 1024, A.ln1_b + l * 1024, st2}; run_gemm<HEAVY_ALIGN>(lds, HB, (const u16*)(ws + WS_W2 + l * 8 * MiB), 1024, FFD, E, tid0); }
        GSYNC();
        { pg8::EpiGate E{l == 0 ? (float*)nullptr : X, XB, st2, A.ln2_g + l * 1024, A.ln2_b + l * 1024, cv + 8192, cv + 9216, MIX, rowss, A.ple_norm_g + l * 1024, l == 0 ? (u16*)X : (u16*)nullptr}; run_gemm<HEAVY_ALIGN>(lds, XB, (const u16*)(ws + WS_WG + l * 2 * MiB), 1024, 1024, E, tid0); }
        if (l == 0) GSYNC();
    }
#ifdef PROBE_BARS
    for (int i = 0; i < PROBE_BARS; ++i) GSYNC();
#endif
}

extern "C" void kernel_launch(void* const* d_in, const int* in_sizes, int n_in, void* d_out, int out_size, void* d_ws, size_t ws_size, hipStream_t stream) {
    static int grid = 0;
    if (grid == 0) {
        if (n_in != 19 || out_size != MTOK * DMODEL || ws_size < WS_END) { fprintf(stderr, "kernel_launch: unexpected shapes (n_in %d, out %d, ws %zu)\n", n_in, out_size, ws_size); grid = -1; return; }
        int dev = 0, cus = 0, per_cu = 0;
        if (hipGetDevice(&dev) != hipSuccess || hipDeviceGetAttribute(&cus, hipDeviceAttributeMultiprocessorCount, dev) != hipSuccess) { grid = -1; return; }
        if (hipFuncSetAttribute((const void*)fwd_kernel, hipFuncAttributeMaxDynamicSharedMemorySize, LDS_BYTES) != hipSuccess) { fprintf(stderr, "kernel_launch: hipFuncSetAttribute failed\n"); grid = -1; return; }
        if (hipOccupancyMaxActiveBlocksPerMultiprocessor(&per_cu, (const void*)fwd_kernel, 512, LDS_BYTES) != hipSuccess || per_cu < 1) { fprintf(stderr, "kernel_launch: occupancy query says %d\n", per_cu); per_cu = 1; }
        (void)hipGetLastError();
        grid = cus * per_cu;
    }
    if (grid < 0) return;
    if (hipMemsetAsync((char*)d_ws, 0, WS_BAR + 16384, stream) != hipSuccess) { fprintf(stderr, "kernel_launch: memset failed\n"); return; }
    Args a{};
    const float** f = (const float**)&a;
    for (int i = 0; i < 19; ++i) f[i] = (const float*)d_in[i];
    a.out = (float*)d_out; a.ws = (unsigned char*)d_ws;
    void* args[] = {&a};
    hipError_t e = hipLaunchCooperativeKernel((const void*)fwd_kernel, dim3(grid), dim3(512), args, LDS_BYTES, stream);
    if (e != hipSuccess) fprintf(stderr, "cooperative launch failed: %s (grid %d)\n", hipGetErrorString(e), grid);
}
```

```cpp
#include <hip/hip_runtime.h>
#include <hip/hip_cooperative_groups.h>
#include <cstdio>
#include <cstdint>
namespace cg = cooperative_groups;
namespace pg8 {
#define PG8_LAS __attribute__((address_space(3)))
typedef unsigned short bf16_t;
typedef short bf16x8 __attribute__((ext_vector_type(8)));
typedef float f32x4 __attribute__((ext_vector_type(4)));
typedef unsigned u32x4 __attribute__((ext_vector_type(4)));
constexpr int BM = 256, BK = 64, HALF = 128, HTB = HALF * BK * 2  , STAGE_BYTES = 8 * HTB, NXCD = 8, WGM = 8;

__host__ __device__ __forceinline__ int lds_byte(int r, int c) { const int st = (r >> 4) * 2 + (c >> 5), rr = r & 15, cc = c & 31, ob = rr * 64 + cc * 2; return st * 1024 + (ob ^ (((ob >> 9) & 1) << 5)); }
__host__ __device__ __forceinline__ void stage_rc(int b, int& R, int& C) { const int st = b / 1024, sb = b % 1024, swz = sb ^ (((sb >> 9) & 1) << 5); R = (st >> 1) * 16 + swz / 64; C = (st & 1) * 32 + (swz % 64) / 2; }
__host__ __device__ __forceinline__ int perm32(int rho) { const int n = rho >> 4, i = rho & 15; return 8 * (i >> 2) + 4 * n + (i & 3); }

struct Unit { int pm, pn; };
struct Gemm { const bf16_t* A; const bf16_t* Bt; int M, N, K; };

struct StaticOrder {
    int nM, nN, nwg, G, c;
    __host__ __device__ void init(int M, int N, int G_, int c_) { nM = M / BM; nN = N / BM; nwg = nM * nN; G = G_; c = c_; }
    __host__ __device__ bool next(int i, Unit& u) const {
        const long L = (long)i * G + c; if (L >= nwg) return false;
        int wgid = (int)L; { const int q = nwg / NXCD, r = nwg % NXCD, xcd = wgid % NXCD, off = wgid / NXCD; wgid = (xcd < r ? xcd * (q + 1) : r * (q + 1) + (xcd - r) * q) + off; }
        const int nig = WGM * nN, gid = wgid / nig, fm = gid * WGM, gsz = (nM - fm) < WGM ? (nM - fm) : WGM;
        u.pm = fm + ((wgid % nig) % gsz); u.pn = (wgid % nig) / gsz; return true;
    }
    __device__ __forceinline__ void a_ready(const Unit&) const {}
    __device__ __forceinline__ void done(const Unit&) const {}
};

__device__ __forceinline__ unsigned cvt_pk_bf16(float lo, float hi) { unsigned r; asm volatile("v_cvt_pk_bf16_f32 %0, %1, %2" : "=v"(r) : "v"(lo), "v"(hi)); return r; }
typedef float f32x2 __attribute__((ext_vector_type(2)));
template <class Epi, class Sched, bool ALIGN_EPI = false, bool SP2 = false>
__device__ __forceinline__ void gemm_phase(PG8_LAS unsigned char* lds, const Gemm g, const Sched& S, const Epi& E, const int tid_in) {
    const int tid = tid_in, wid = __builtin_amdgcn_readfirstlane(tid >> 6), lane = tid & 63, wr = wid >> 2, wc = wid & 3, fr = lane & 15, fq = lane >> 4;
    const int K = g.K, nt = K / BK;
    unsigned voffA[2], voffB[2];
#pragma unroll
    for (int i = 0; i < 2; ++i) { int R, C; stage_rc(tid * 16 + i * 8192, R, C); const int Rb = Epi::PERM ? ((R & ~31) + perm32(R & 31)) : R;
        voffA[i] = (unsigned)(R * K + C) * 2u; voffB[i] = (unsigned)(Rb * K + C) * 2u; }
    const size_t kstep = (size_t)(BK * 2);
    const size_t hstep = (size_t)HALF * K * 2;
    const size_t tstep = 2 * hstep;
    const unsigned ldsw = (unsigned)wid * 1024u;
    const int aoff = lds_byte(wr * 64 + fr, fq * 8), boff = lds_byte(wc * 32 + fr, fq * 8);
#define PG8_SA(b, h) (((b) * 2 + (h)) * HTB)
#define PG8_SB(b, h) ((4 + (b) * 2 + (h)) * HTB)
#define PG8_STAGE(bufoff, gbase, voff) do { _Pragma("unroll") for (int _i = 0; _i < 2; ++_i) \
        __builtin_amdgcn_global_load_lds((const unsigned*)((const char*)(gbase) + (voff)[_i]), (PG8_LAS unsigned*)(lds + (bufoff) + ldsw + _i * 8192), 16, 0, 0); } while (0)
#define PG8_LDA(dst, b, h) do { _Pragma("unroll") for (int m = 0; m < 4; ++m) _Pragma("unroll") for (int k = 0; k < 2; ++k) dst[m][k] = *(const PG8_LAS bf16x8*)(lds + PG8_SA(b, h) + aoff + m * 2048 + k * 1024); } while (0)
#define PG8_LDB(dst, b, h) do { _Pragma("unroll") for (int n = 0; n < 2; ++n) _Pragma("unroll") for (int k = 0; k < 2; ++k) dst[n][k] = *(const PG8_LAS bf16x8*)(lds + PG8_SB(b, h) + boff + n * 2048 + k * 1024); } while (0)
#define PG8_MMA(ai, bj, At, Bt) do { __builtin_amdgcn_s_setprio(1); _Pragma("unroll") for (int m = 0; m < 4; ++m) _Pragma("unroll") for (int n = 0; n < 2; ++n) _Pragma("unroll") for (int k = 0; k < 2; ++k) \
        acc[ai][bj][m][n] = __builtin_amdgcn_mfma_f32_16x16x32_bf16(Bt[n][k], At[m][k], acc[ai][bj][m][n], 0, 0, 0); __builtin_amdgcn_s_setprio(0); } while (0)
#define PG8_WAIT_V(n) asm volatile("s_waitcnt vmcnt(" #n ")" ::: "memory")
#define PG8_WAIT_L(n) asm volatile("s_waitcnt lgkmcnt(" #n ")" ::: "memory")
#define PG8_BAR __builtin_amdgcn_s_barrier()
#define PG8_SCHED __builtin_amdgcn_sched_barrier(0)
    Unit cur, nxt; int ui = 0;
    if (!S.next(0, cur)) return;
    f32x4 acc[2][2][4][2];
#pragma unroll
    for (int a = 0; a < 2; ++a)
#pragma unroll
        for (int b = 0; b < 2; ++b)
#pragma unroll
            for (int m = 0; m < 4; ++m)
#pragma unroll
                for (int n = 0; n < 2; ++n) acc[a][b][m][n] = (f32x4){0.f, 0.f, 0.f, 0.f};
    bf16x8 At[4][2], B0[2][2], B1[2][2];
    const char* cA = (const char*)g.A + (size_t)cur.pm * tstep; const char* cB = (const char*)g.Bt + (size_t)cur.pn * tstep;
    S.a_ready(cur);
    if constexpr (SP2) {
        PG8_STAGE(PG8_SB(0, 0), cB, voffB); PG8_STAGE(PG8_SB(0, 1), cB + hstep, voffB); PG8_STAGE(PG8_SA(0, 0), cA, voffA); PG8_STAGE(PG8_SA(0, 1), cA + hstep, voffA);
        if (wr == 1) PG8_BAR;
        PG8_WAIT_V(2); PG8_BAR;
        PG8_STAGE(PG8_SB(1, 0), cB + kstep, voffB); PG8_STAGE(PG8_SA(1, 0), cA + kstep, voffA); PG8_STAGE(PG8_SB(1, 1), cB + hstep + kstep, voffB);
        PG8_WAIT_V(6); PG8_BAR;
    } else {
        PG8_STAGE(PG8_SB(0, 0), cB, voffB); PG8_STAGE(PG8_SA(0, 0), cA, voffA); PG8_STAGE(PG8_SB(0, 1), cB + hstep, voffB); PG8_STAGE(PG8_SA(0, 1), cA + hstep, voffA);
        if (wr == 1) PG8_BAR;
        PG8_WAIT_V(4); PG8_BAR;
        PG8_STAGE(PG8_SB(1, 0), cB + kstep, voffB); PG8_STAGE(PG8_SA(1, 0), cA + kstep, voffA); PG8_STAGE(PG8_SB(1, 1), cB + hstep + kstep, voffB);
        PG8_WAIT_V(6); PG8_BAR;
    }
    for (;;) {
        const bool has_next = S.next(ui + 1, nxt);
        const char* nA = has_next ? (const char*)g.A + (size_t)nxt.pm * tstep : cA; const char* nB = has_next ? (const char*)g.Bt + (size_t)nxt.pn * tstep : cB;
        for (int t = 0; t < nt; t += 2) {
            const bool last = (t == nt - 2);
            const char* a1 = cA + (size_t)(t + 1) * kstep;
            const char* a2 = last ? nA : cA + (size_t)(t + 2) * kstep; const char* b2 = last ? nB : cB + (size_t)(t + 2) * kstep;
            const char* a3 = a2 + kstep; const char* b3 = b2 + kstep;
            if (last && has_next) S.a_ready(nxt);
            if constexpr (SP2) {
            PG8_LDB(B0, 0, 0); PG8_LDB(B1, 0, 1); PG8_SCHED; PG8_LDA(At, 0, 0); PG8_STAGE(PG8_SA(1, 1), a1 + hstep, voffA);
            PG8_WAIT_V(8); PG8_WAIT_L(0); PG8_BAR; PG8_MMA(0, 0, At, B0); PG8_MMA(0, 1, At, B1); PG8_BAR; PG8_SCHED;
            PG8_LDA(At, 0, 1); PG8_STAGE(PG8_SB(0, 0), b2, voffB); PG8_STAGE(PG8_SB(0, 1), b2 + hstep, voffB); PG8_STAGE(PG8_SA(0, 0), a2, voffA);
            PG8_WAIT_V(8); PG8_WAIT_L(0); PG8_BAR; PG8_MMA(1, 0, At, B0); PG8_MMA(1, 1, At, B1); PG8_BAR; PG8_SCHED;
            PG8_LDB(B0, 1, 0); PG8_LDB(B1, 1, 1); PG8_SCHED; PG8_LDA(At, 1, 0); PG8_STAGE(PG8_SA(0, 1), a2 + hstep, voffA);
            PG8_WAIT_V(8); PG8_WAIT_L(0); PG8_BAR; PG8_MMA(0, 0, At, B0); PG8_MMA(0, 1, At, B1); PG8_BAR; PG8_SCHED;
            PG8_LDA(At, 1, 1); PG8_STAGE(PG8_SB(1, 0), b3, voffB); PG8_STAGE(PG8_SB(1, 1), b3 + hstep, voffB); PG8_STAGE(PG8_SA(1, 0), a3, voffA);
            PG8_WAIT_V(8); PG8_WAIT_L(0); PG8_BAR; PG8_MMA(1, 0, At, B0); PG8_MMA(1, 1, At, B1); PG8_BAR; PG8_SCHED;
            } else {
            PG8_LDB(B0, 0, 0); PG8_SCHED; PG8_LDA(At, 0, 0); PG8_STAGE(PG8_SA(1, 1), a1 + hstep, voffA);
            PG8_WAIT_L(8); PG8_BAR; PG8_WAIT_L(0); PG8_MMA(0, 0, At, B0); PG8_BAR; PG8_SCHED;
            PG8_LDB(B1, 0, 1); PG8_STAGE(PG8_SB(0, 0), b2, voffB);
            PG8_BAR; PG8_WAIT_L(0); PG8_MMA(0, 1, At, B1); PG8_BAR;
            PG8_LDA(At, 0, 1); PG8_STAGE(PG8_SA(0, 0), a2, voffA);
            PG8_BAR; PG8_WAIT_L(0); PG8_MMA(1, 0, At, B0); PG8_BAR; PG8_SCHED;
            PG8_STAGE(PG8_SB(0, 1), b2 + hstep, voffB);
            PG8_WAIT_V(6); PG8_BAR; PG8_MMA(1, 1, At, B1); PG8_BAR;
            PG8_LDB(B0, 1, 0); PG8_SCHED; PG8_LDA(At, 1, 0); PG8_STAGE(PG8_SA(0, 1), a2 + hstep, voffA);
            PG8_WAIT_L(8); PG8_BAR; PG8_WAIT_L(0); PG8_MMA(0, 0, At, B0); PG8_BAR; PG8_SCHED;
            PG8_LDB(B1, 1, 1); PG8_STAGE(PG8_SB(1, 0), b3, voffB);
            PG8_BAR; PG8_WAIT_L(0); PG8_MMA(0, 1, At, B1); PG8_BAR;
            PG8_LDA(At, 1, 1); PG8_STAGE(PG8_SA(1, 0), a3, voffA);
            PG8_BAR; PG8_WAIT_L(0); PG8_MMA(1, 0, At, B0); PG8_BAR; PG8_SCHED;
            PG8_STAGE(PG8_SB(1, 1), b3 + hstep, voffB);
            PG8_WAIT_V(6); PG8_BAR; PG8_MMA(1, 1, At, B1); PG8_BAR;
            }
        }
        if constexpr (ALIGN_EPI) { if (wr == 0) PG8_BAR; }
        if constexpr (!Epi::AFTER_DRAIN) { E(acc, cur, wr, wc, fr, fq); S.done(cur); }
        if (!has_next) break;
#pragma unroll
        for (int a = 0; a < 2; ++a)
#pragma unroll
            for (int b = 0; b < 2; ++b)
#pragma unroll
                for (int m = 0; m < 4; ++m)
#pragma unroll
                    for (int n = 0; n < 2; ++n) acc[a][b][m][n] = (f32x4){0.f, 0.f, 0.f, 0.f};
        cur = nxt; cA = nA; cB = nB; ++ui;
        if constexpr (ALIGN_EPI) { if (wr == 1) PG8_BAR; }
    }
    PG8_WAIT_V(0);
    if constexpr (!ALIGN_EPI) { if (wr == 0) PG8_BAR; }
    PG8_BAR;
    if constexpr (Epi::AFTER_DRAIN) { E.fused(acc, cur, wr, wc, fr, fq, lds, wid, lane); S.done(cur); }
#undef PG8_SA
#undef PG8_SB
#undef PG8_STAGE
#undef PG8_LDA
#undef PG8_LDB
#undef PG8_MMA
#undef PG8_WAIT_V
#undef PG8_WAIT_L
#undef PG8_BAR
#undef PG8_SCHED
}
}
namespace pg8 {
__device__ __forceinline__ float shx(float v, int m, int lane) { return __builtin_bit_cast(float, __builtin_amdgcn_ds_bpermute((lane ^ m) << 2, __builtin_bit_cast(int, v))); }
constexpr float QSCALE = 0.125f * 1.4426950408889634f;
struct EpiStore {
    static constexpr bool PERM = true, AFTER_DRAIN = false;
    bf16_t* O; int ldc; int act; int rope_cols; int scale_cols; const float* cs;
    const float* st; const float* c1; const float* c2;
    __device__ __forceinline__ void operator()(f32x4 (&acc)[2][2][4][2], const Unit& u, int wr, int wc, int fr, int fq) const {
        { int ln_; asm volatile("v_mbcnt_lo_u32_b32 %0, -1, 0\n\tv_mbcnt_hi_u32_b32 %0, -1, %0" : "=v"(ln_)); fr = ln_ & 15; fq = ln_ >> 4; }
        const int row0 = u.pm * BM + wr * 64 + fr; const int colt = u.pn * BM;
        const int col0 = colt + wc * 32 + 8 * fq;
        if (colt < rope_cols && (wc & 1) == 0) {
            const float sgn = fq == 0 ? -1.f : 1.f; const int lane = fq * 16 + fr;
            const int fqc = fq & 1;
#pragma unroll
            for (int ai = 0; ai < 2; ++ai)
#pragma unroll
                for (int m = 0; m < 4; ++m) {
                    const int pos = (row0 + ai * HALF + m * 16) & 8191;
                    const float* cp = cs + pos * 8;
#pragma unroll
                    for (int n = 0; n < 2; ++n) {
                        const f32x4 cv = *(const f32x4*)(cp + 4 * n), sv = *(const f32x4*)(cp + 65536 + 4 * n);
#pragma unroll
                        for (int bj = 0; bj < 2; ++bj)
#pragma unroll
                            for (int e = 0; e < 4; ++e) {
                                const float v = acc[ai][bj][m][n][e]; const float pv = shx(v, 16, lane);
                                const float nv = v * cv[e] + sgn * pv * sv[e];
                                acc[ai][bj][m][n][e] = (fq < 2) ? nv : v;
                            }
                        asm volatile("" ::: "memory");
                    }
                }
            (void)fqc;
        }
        if (st) {
            float muv[2][4], rsv[2][4];
#pragma unroll
            for (int ai = 0; ai < 2; ++ai)
#pragma unroll
                for (int m = 0; m < 4; ++m) { const int row = row0 + ai * HALF + m * 16; const f32x2 sv = *(const f32x2*)(st + 2 * row); muv[ai][m] = sv.x; rsv[ai][m] = sv.y; }
#pragma unroll
            for (int ai = 0; ai < 2; ++ai)
#pragma unroll
                for (int m = 0; m < 4; ++m) { const float mu = muv[ai][m] * (1.f / 1024.f); rsv[ai][m] = __builtin_amdgcn_rsqf(rsv[ai][m] * (1.f / 1024.f) - mu * mu + 1e-5f); muv[ai][m] = mu; }
#pragma unroll
            for (int bj = 0; bj < 2; ++bj) {
                const f32x4 c1a = *(const f32x4*)(c1 + col0 + bj * HALF), c1b = *(const f32x4*)(c1 + col0 + bj * HALF + 4), c2a = *(const f32x4*)(c2 + col0 + bj * HALF), c2b = *(const f32x4*)(c2 + col0 + bj * HALF + 4);
#pragma unroll
                for (int ai = 0; ai < 2; ++ai)
#pragma unroll
                    for (int m = 0; m < 4; ++m) { const float mu = muv[ai][m], rstd = rsv[ai][m];
                        acc[ai][bj][m][0] = (acc[ai][bj][m][0] - mu * c1a) * rstd + c2a; acc[ai][bj][m][1] = (acc[ai][bj][m][1] - mu * c1b) * rstd + c2b; }
            }
        }
        const float sc = (colt < scale_cols) ? QSCALE : 1.f;
#pragma unroll
        for (int ai = 0; ai < 2; ++ai)
#pragma unroll
            for (int m = 0; m < 4; ++m) { bf16_t* rowp = O + (size_t)(row0 + ai * HALF + m * 16) * ldc + col0;
#pragma unroll
                for (int bj = 0; bj < 2; ++bj) { f32x4 v0 = acc[ai][bj][m][0], v1 = acc[ai][bj][m][1];
                    if (act == 1) {
#pragma unroll
                        for (int e = 0; e < 4; ++e) { float a = fmaxf(v0[e], 0.f), b = fmaxf(v1[e], 0.f); v0[e] = a * a; v1[e] = b * b; } }
                    v0 = v0 * sc; v1 = v1 * sc; u32x4 w; w.x = cvt_pk_bf16(v0[0], v0[1]); w.y = cvt_pk_bf16(v0[2], v0[3]); w.z = cvt_pk_bf16(v1[0], v1[1]); w.w = cvt_pk_bf16(v1[2], v1[3]);
                    *(u32x4*)(rowp + bj * HALF) = w; } }
    }
};
struct EpiResid {
    static constexpr bool PERM = true, AFTER_DRAIN = false;
    const bf16_t* xinb; bf16_t* outb; const float* st_in; const float* g; const float* b; float* st_out;
    __device__ __forceinline__ void operator()(f32x4 (&acc)[2][2][4][2], const Unit& u, int wr, int wc, int fr, int fq) const {
        { int ln_; asm volatile("v_mbcnt_lo_u32_b32 %0, -1, 0\n\tv_mbcnt_hi_u32_b32 %0, -1, %0" : "=v"(ln_)); fr = ln_ & 15; fq = ln_ >> 4; }
        const int lane = fq * 16 + fr;
        const int col0 = u.pn * BM + wc * 32 + 8 * fq;
        f32x4 gv[2][2], bv[2][2];
        if (st_in) {
#pragma unroll
            for (int bj = 0; bj < 2; ++bj)
#pragma unroll
                for (int n = 0; n < 2; ++n) { gv[bj][n] = *(const f32x4*)(g + col0 + bj * HALF + n * 4); bv[bj][n] = *(const f32x4*)(b + col0 + bj * HALF + n * 4); } }
#pragma unroll
        for (int ai = 0; ai < 2; ++ai) {
            const int rowa = u.pm * BM + ai * HALF + wr * 64 + fr;
            float mu[4], rstd[4];
            u32x4 xw[4][2];
#pragma unroll
            for (int m = 0; m < 4; ++m)
#pragma unroll
                for (int bj = 0; bj < 2; ++bj) xw[m][bj] = *(const u32x4*)(xinb + (size_t)(rowa + m * 16) * 1024 + col0 + bj * HALF);
#pragma unroll
            for (int m = 0; m < 4; ++m) { mu[m] = 0.f; rstd[m] = 1.f;
                if (st_in) { const f32x2 sv = *(const f32x2*)(st_in + 2 * (rowa + m * 16)); mu[m] = sv.x * (1.f / 1024.f); rstd[m] = __builtin_amdgcn_rsqf(sv.y * (1.f / 1024.f) - mu[m] * mu[m] + 1e-5f); } }
#pragma unroll
            for (int m = 0; m < 4; ++m) { const int row = rowa + m * 16; const size_t off = (size_t)row * 1024 + col0;
                float s1 = 0.f, s2 = 0.f;
#pragma unroll
                for (int bj = 0; bj < 2; ++bj) { const u32x4 w0 = xw[m][bj];
                    f32x4 xa = {__uint_as_float(w0.x << 16), __uint_as_float(w0.x & 0xffff0000u), __uint_as_float(w0.y << 16), __uint_as_float(w0.y & 0xffff0000u)};
                    f32x4 xb2 = {__uint_as_float(w0.z << 16), __uint_as_float(w0.z & 0xffff0000u), __uint_as_float(w0.w << 16), __uint_as_float(w0.w & 0xffff0000u)};
                    if (st_in) { xa = (xa - mu[m]) * rstd[m] * gv[bj][0] + bv[bj][0]; xb2 = (xb2 - mu[m]) * rstd[m] * gv[bj][1] + bv[bj][1]; }
                    const f32x4 ya = xa * 1.4142135623730951f + acc[ai][bj][m][0], yb2 = xb2 * 1.4142135623730951f + acc[ai][bj][m][1];
                    u32x4 w; w.x = cvt_pk_bf16(ya[0], ya[1]); w.y = cvt_pk_bf16(ya[2], ya[3]); w.z = cvt_pk_bf16(yb2[0], yb2[1]); w.w = cvt_pk_bf16(yb2[2], yb2[3]);
                    *(u32x4*)(outb + off + bj * HALF) = w;
                    s1 += ((ya[0] + ya[1]) + (ya[2] + ya[3])) + ((yb2[0] + yb2[1]) + (yb2[2] + yb2[3]));
                    s2 += ((ya[0] * ya[0] + ya[1] * ya[1]) + (ya[2] * ya[2] + ya[3] * ya[3])) + ((yb2[0] * yb2[0] + yb2[1] * yb2[1]) + (yb2[2] * yb2[2] + yb2[3] * yb2[3])); }
                s1 += shx(s1, 16, lane); s1 += shx(s1, 32, lane); s2 += shx(s2, 16, lane); s2 += shx(s2, 32, lane);
                if (fq == 0 && st_out) { atomicAdd(st_out + 2 * row, s1); atomicAdd(st_out + 2 * row + 1, s2); } }
            asm volatile("" ::: "memory");
        }
    }
};
struct EpiE {
    static constexpr bool PERM = true, AFTER_DRAIN = false;
    bf16_t* O; float* rowss;
    __device__ __forceinline__ void operator()(f32x4 (&acc)[2][2][4][2], const Unit& u, int wr, int wc, int fr, int fq) const {
        { int ln_; asm volatile("v_mbcnt_lo_u32_b32 %0, -1, 0\n\tv_mbcnt_hi_u32_b32 %0, -1, %0" : "=v"(ln_)); fr = ln_ & 15; fq = ln_ >> 4; }
        const int row0 = u.pm * BM + wr * 64 + fr; const int col0 = u.pn * BM + wc * 32 + 8 * fq; const int lane = fq * 16 + fr;
#pragma unroll
        for (int ai = 0; ai < 2; ++ai)
#pragma unroll
            for (int m = 0; m < 4; ++m) { const int row = row0 + ai * HALF + m * 16; bf16_t* rowp = O + (size_t)row * 1024 + col0; float ss = 0.f;
#pragma unroll
                for (int bj = 0; bj < 2; ++bj) { const f32x4 v0 = acc[ai][bj][m][0], v1 = acc[ai][bj][m][1];
                    ss += (v0[0] * v0[0] + v0[1] * v0[1]) + (v0[2] * v0[2] + v0[3] * v0[3]) + (v1[0] * v1[0] + v1[1] * v1[1]) + (v1[2] * v1[2] + v1[3] * v1[3]);
                    u32x4 w; w.x = cvt_pk_bf16(v0[0], v0[1]); w.y = cvt_pk_bf16(v0[2], v0[3]); w.z = cvt_pk_bf16(v1[0], v1[1]); w.w = cvt_pk_bf16(v1[2], v1[3]);
                    *(u32x4*)(rowp + bj * HALF) = w; }
                ss += shx(ss, 16, lane); ss += shx(ss, 32, lane);
                if (fq == 0) atomicAdd(rowss + row, ss); }
    }
};
struct EpiGate {
    static constexpr bool PERM = true, AFTER_DRAIN = false;
    float* x; const bf16_t* yb; const float* st; const float* g2; const float* b2; const float* c1; const float* c2; const bf16_t* E; const float* rowss; const float* gp; bf16_t* xb;
    __device__ __forceinline__ void operator()(f32x4 (&acc)[2][2][4][2], const Unit& u, int wr, int wc, int fr, int fq) const {
        { int ln_; asm volatile("v_mbcnt_lo_u32_b32 %0, -1, 0\n\tv_mbcnt_hi_u32_b32 %0, -1, %0" : "=v"(ln_)); fr = ln_ & 15; fq = ln_ >> 4; }
        const int col0 = u.pn * BM + wc * 32 + 8 * fq;
#pragma unroll
        for (int ai = 0; ai < 2; ++ai)
#pragma unroll
        for (int mp = 0; mp < 2; ++mp) {
            const int rowa = u.pm * BM + ai * HALF + wr * 64 + mp * 32 + fr;
            u32x4 yw[2][2], ew[2][2]; float mu[2], rstd[2], rs[2];
#pragma unroll
            for (int m = 0; m < 2; ++m)
#pragma unroll
                for (int bj = 0; bj < 2; ++bj) { const size_t o2 = (size_t)(rowa + m * 16) * 1024 + col0 + bj * HALF; yw[m][bj] = *(const u32x4*)(yb + o2); ew[m][bj] = *(const u32x4*)(E + o2); }
#pragma unroll
            for (int m = 0; m < 2; ++m) { const int row = rowa + m * 16; const f32x2 sv = *(const f32x2*)(st + 2 * row); rs[m] = rowss[row]; mu[m] = sv.x; rstd[m] = sv.y; }
#pragma unroll
            for (int m = 0; m < 2; ++m) { rs[m] = __builtin_amdgcn_rsqf(rs[m] * (1.0f / 1024.0f) + 1e-5f); mu[m] *= (1.f / 1024.f); rstd[m] = __builtin_amdgcn_rsqf(rstd[m] * (1.f / 1024.f) - mu[m] * mu[m] + 1e-5f); }
#pragma unroll
            for (int bj = 0; bj < 2; ++bj) { const int c = col0 + bj * HALF;
                f32x4 gv[2], g2v[2], b2v[2], c1v[2], c2v[2];
#pragma unroll
                for (int n = 0; n < 2; ++n) { gv[n] = *(const f32x4*)(gp + c + 4 * n); g2v[n] = *(const f32x4*)(g2 + c + 4 * n); b2v[n] = *(const f32x4*)(b2 + c + 4 * n); c1v[n] = *(const f32x4*)(c1 + c + 4 * n); c2v[n] = *(const f32x4*)(c2 + c + 4 * n); }
#pragma unroll
                for (int m = 0; m < 2; ++m) { const size_t o2 = (size_t)(rowa + m * 16) * 1024 + c; f32x4 o[2];
#pragma unroll
                    for (int n = 0; n < 2; ++n) {
                        const unsigned y0 = n ? yw[m][bj].z : yw[m][bj].x, y1 = n ? yw[m][bj].w : yw[m][bj].y, e0 = n ? ew[m][bj].z : ew[m][bj].x, e1 = n ? ew[m][bj].w : ew[m][bj].y;
                        const f32x4 yv = {__uint_as_float(y0 << 16), __uint_as_float(y0 & 0xffff0000u), __uint_as_float(y1 << 16), __uint_as_float(y1 & 0xffff0000u)};
                        const f32x4 ef = {__uint_as_float(e0 << 16), __uint_as_float(e0 & 0xffff0000u), __uint_as_float(e1 << 16), __uint_as_float(e1 & 0xffff0000u)};
                        const f32x4 xv = (yv - mu[m]) * rstd[m] * g2v[n] + b2v[n];
                        const f32x4 a = (acc[ai][bj][2 * mp + m][n] - mu[m] * c1v[n]) * rstd[m] + c2v[n];
#pragma unroll
                        for (int e = 0; e < 4; ++e) o[n][e] = xv[e] + ef[e] * rs[m] * gv[n][e] * __builtin_amdgcn_rcpf(1.f + __expf(-a[e])); }
                    if (x) { *(f32x4*)(x + o2) = o[0]; *(f32x4*)(x + o2 + 4) = o[1]; }
                    if (xb) { u32x4 w; w.x = cvt_pk_bf16(o[0][0], o[0][1]); w.y = cvt_pk_bf16(o[0][2], o[0][3]); w.z = cvt_pk_bf16(o[1][0], o[1][1]); w.w = cvt_pk_bf16(o[1][2], o[1][3]); *(u32x4*)(xb + o2) = w; } } }
            asm volatile("" ::: "memory");
        }
    }
};
}
#define PG8_SP2 true
#define PG8_ALIGN true
#include <hip/hip_bf16.h>
#include <cmath>
namespace attn_body {
using bf16=__hip_bfloat16;
using bf16x8=__attribute__((ext_vector_type(8)))short;
using s16x4=__attribute__((ext_vector_type(4)))short;
using f32x16=__attribute__((ext_vector_type(16)))float;
using u32x4=__attribute__((ext_vector_type(4)))unsigned;
constexpr int SEQ=8192,D=64,DM=3584,DMO=1024;
constexpr int NW=8,QBLK=32,QB=QBLK*NW,KVBLK=64,NQB=SEQ/QB;
constexpr int ATTN_PITCH=DM, ATTN_UNIT_ROWS=QB;
__device__ __forceinline__ int crow(int r,int hi){return (r&3)+8*(r>>2)+4*hi;}
#define SBAR() __builtin_amdgcn_sched_barrier(0)
__device__ __forceinline__ void cmask(f32x16&p0,f32x16&p1,int jb,int qrel,int hi){
  const float NEG=-INFINITY; int kb=64*jb+4*hi;
  #pragma unroll
  for(int r=0;r<16;++r){int kv=kb+(r&3)+8*(r>>2); if(kv>qrel)p0[r]=NEG; if(kv+32>qrel)p1[r]=NEG;}
}

constexpr int NSLOT=3, SLOTB=8192;
constexpr int LDS_K=0, LDS_V=NSLOT*SLOTB, LDS_WS=2*NSLOT*SLOTB, LDS_OST=LDS_WS+NW*64*4, LDS_BYTES=LDS_OST+NW*4096;
constexpr float C2=0.125f*1.4426950408889634f;
__device__ __forceinline__ void glds16(const void*gsrc,unsigned lds_dst){unsigned keep;
  asm volatile("s_mov_b32 %0, m0\n\ts_mov_b32 m0, %2\n\ts_nop 0\n\tglobal_load_lds_dwordx4 %1, off\n\ts_mov_b32 m0, %0":"=&s"(keep):"v"(gsrc),"s"(lds_dst):"memory");}
__device__ __forceinline__ float max3f(float a,float b,float c){float r;asm("v_max3_f32 %0, %1, %2, %3":"=v"(r):"v"(a),"v"(b),"v"(c));return r;}
__device__ __forceinline__ float max2f(float a,float b){float r;asm("v_max_f32_e32 %0, %1, %2":"=v"(r):"v"(a),"v"(b));return r;}
__device__ __forceinline__ float fadd_s(float a,float b){float r;asm("v_add_f32_e32 %0, %1, %2":"=v"(r):"v"(a),"v"(b));return r;}
__device__ __forceinline__ float fsub_s(float a,float b){float r;asm("v_sub_f32_e32 %0, %1, %2":"=v"(r):"v"(a),"v"(b));return r;}
typedef float f32x2_t __attribute__((ext_vector_type(2))); typedef __bf16 bf16x2_t __attribute__((ext_vector_type(2)));
__device__ __forceinline__ unsigned cvtpk_s(float lo,float hi){f32x2_t v={lo,hi};bf16x2_t b=__builtin_convertvector(v,bf16x2_t);return __builtin_bit_cast(unsigned,b);}
#define WAIT_BAR(N) asm volatile("s_waitcnt vmcnt(" #N ") lgkmcnt(0)\n\ts_barrier":::"memory")

__device__ __forceinline__ void qkt(f32x16&p0,f32x16&p1,const char*Kslot,const bf16x8*qr,const f32x16&negm,int r32,int hi){
  const char*kb=Kslot+hi*1024+r32*16;
  #pragma unroll
  for(int d0=0;d0<4;++d0){
    const bf16x8 b0=*reinterpret_cast<const bf16x8*>(kb+d0*2048);
    const bf16x8 b1=*reinterpret_cast<const bf16x8*>(kb+d0*2048+512);
    if(d0==0){p0=__builtin_amdgcn_mfma_f32_32x32x16_bf16(b0,qr[0],negm,0,0,0);p1=__builtin_amdgcn_mfma_f32_32x32x16_bf16(b1,qr[0],negm,0,0,0);}
    else{p0=__builtin_amdgcn_mfma_f32_32x32x16_bf16(b0,qr[d0],p0,0,0,0);p1=__builtin_amdgcn_mfma_f32_32x32x16_bf16(b1,qr[d0],p1,0,0,0);}}
}
typedef __attribute__((address_space(3))) const char* lds_cptr;
typedef short v4i16_t __attribute__((ext_vector_type(4)));
__device__ __forceinline__ void kload8(bf16x8*kf,lds_cptr kp){
  kf[0]=*(const __attribute__((address_space(3))) bf16x8*)(kp);      kf[1]=*(const __attribute__((address_space(3))) bf16x8*)(kp+512);
  kf[2]=*(const __attribute__((address_space(3))) bf16x8*)(kp+2048); kf[3]=*(const __attribute__((address_space(3))) bf16x8*)(kp+2560);
  kf[4]=*(const __attribute__((address_space(3))) bf16x8*)(kp+4096); kf[5]=*(const __attribute__((address_space(3))) bf16x8*)(kp+4608);
  kf[6]=*(const __attribute__((address_space(3))) bf16x8*)(kp+6144); kf[7]=*(const __attribute__((address_space(3))) bf16x8*)(kp+6656);
}
__device__ __forceinline__ void kload2(bf16x8*kf,lds_cptr kp,int j){ kf[2*j]=*(const __attribute__((address_space(3))) bf16x8*)(kp+j*2048); kf[2*j+1]=*(const __attribute__((address_space(3))) bf16x8*)(kp+j*2048+512); }
__device__ __forceinline__ s16x4 vtr(lds_cptr p){ return __builtin_bit_cast(s16x4,__builtin_amdgcn_ds_read_tr16_b64_v4i16((__attribute__((address_space(3))) v4i16_t*)p)); }
__device__ __forceinline__ float rowmax(const f32x16&p0,const f32x16&p1){
  float a=max3f(p0[0],p0[1],p1[0]),b=max3f(p0[2],p0[3],p1[1]);a=max3f(a,p1[2],p1[3]);
  #pragma unroll
  for(int r=4;r<16;r+=4){a=max3f(a,p0[r],p0[r+1]);b=max3f(b,p0[r+2],p0[r+3]);a=max3f(a,p1[r],p1[r+1]);b=max3f(b,p1[r+2],p1[r+3]);}
  const float m=max2f(a,b);
  auto rr=__builtin_amdgcn_permlane32_swap(__float_as_uint(m),__float_as_uint(m),false,false);
  return max2f(__uint_as_float(rr[0]),__uint_as_float(rr[1]));
}
__device__ __forceinline__ void pv(f32x16*o,int vb,bf16x8 pa0,bf16x8 pa1,bf16x8 pa2,bf16x8 pa3){
  #pragma unroll
  for(int d0=0;d0<2;++d0){s16x4 lo[4],hi[4];
    #pragma unroll
    for(int ks=0;ks<4;++ks){
      asm volatile("ds_read_b64_tr_b16 %0,%1 offset:%c2":"=&v"(lo[ks]):"v"(vb),"i"(d0*4096+ks*1024):"memory");
      asm volatile("ds_read_b64_tr_b16 %0,%1 offset:%c2":"=&v"(hi[ks]):"v"(vb),"i"(d0*4096+ks*1024+512):"memory");}
    asm volatile("s_waitcnt lgkmcnt(0)":::"memory");SBAR();
    #define PK(k) (bf16x8){lo[k][0],lo[k][1],lo[k][2],lo[k][3],hi[k][0],hi[k][1],hi[k][2],hi[k][3]}
    o[d0]=__builtin_amdgcn_mfma_f32_32x32x16_bf16(pa0,PK(0),o[d0],0,0,0);
    o[d0]=__builtin_amdgcn_mfma_f32_32x32x16_bf16(pa1,PK(1),o[d0],0,0,0);
    o[d0]=__builtin_amdgcn_mfma_f32_32x32x16_bf16(pa2,PK(2),o[d0],0,0,0);
    o[d0]=__builtin_amdgcn_mfma_f32_32x32x16_bf16(pa3,PK(3),o[d0],0,0,0);
    #undef PK
  }
}

#ifndef ATTN_STORE16
#define ATTN_STORE16(p,v) (*(u32x4*)(p)=(v))
#endif
template<int THRL> __device__ __forceinline__ void attn_unit(int b,int colq,int colk,int colv,int colo,int qb,const bf16*Q,const bf16*__restrict__ K,const bf16*__restrict__ V,bf16*O,char*shm,const int tid_in){
  const int tid=tid_in,lane=tid&63,r32=lane&31,hi=lane>>5; const int wid=__builtin_amdgcn_readfirstlane(tid>>6);
  const long rowbase=(long)b*SEQ; const int q0=qb*QB;
  const bf16*Qw=Q+(rowbase+q0+wid*QBLK)*DM+colq;
  const bf16*Kh=K+rowbase*DM+colk,*Vh=V+rowbase*DM+colv;
  const unsigned lds0=(unsigned)(uintptr_t)shm;
  float*wsf=(float*)(shm+LDS_WS)+wid*64;
  const bf16*ksrc=Kh+(long)lane*DM+wid*8;
  const bf16*vsrc=Vh+(long)(16*(wid&3)+(lane>>2))*DM+(wid>>2)*32+(lane&3)*8;
  const unsigned kdst=lds0+LDS_K+wid*1024, vdst=lds0+LDS_V+wid*1024;
  #define DMA_K(t,slot) glds16(ksrc+(long)(t)*KVBLK*DM,(unsigned)__builtin_amdgcn_readfirstlane(kdst+(slot)))
  #define DMA_V(t,slot) glds16(vsrc+(long)(t)*KVBLK*DM,(unsigned)__builtin_amdgcn_readfirstlane(vdst+(slot)))
  const int vb0=(int)(lds0+LDS_V)+((lane>>4)&1)*32+(lane&3)*8+(4*hi+((lane&15)>>2))*64;
  const char*Kbase=shm+LDS_K; bf16x8 kf[8];
  const lds_cptr shm3=(lds_cptr)shm; const lds_cptr kp0=shm3+LDS_K+hi*1024+r32*16; const lds_cptr vp0=shm3+LDS_V+((lane>>4)&1)*32+(lane&3)*8+(4*hi+((lane&15)>>2))*64;
  const int NT=(q0+QB)/KVBLK;
  DMA_K(0,0);DMA_V(0,0);DMA_K(1,SLOTB);
  bf16x8 qr[4];
  #pragma unroll
  for(int d0=0;d0<4;++d0)qr[d0]=*reinterpret_cast<const bf16x8*>(&Qw[(long)r32*DM+d0*16+hi*8]);
  float mhat=0.f,l_reg=0.f;f32x16 o[2];o[0]=f32x16{};o[1]=f32x16{};f32x16 negm=f32x16{};asm volatile("":"+v"(negm));
  const int qrel=wid*QBLK+r32;
  #define CMASK(P0,P1,t) do{int jb_=(t)-(NT-4); if(jb_>=0)cmask(P0,P1,jb_,qrel,hi);}while(0)
  bool resc=false;
  #define START(P0,P1) do{ const float rm=rowmax(P0,P1); resc=false; \
    { const float dl=rm; mhat=fadd_s(mhat,dl); \
      _Pragma("unroll") for(int r=0;r<16;++r){P0[r]=fsub_s(P0[r],dl);P1[r]=fsub_s(P1[r],dl);} \
      _Pragma("unroll") for(int r=0;r<16;++r)negm[r]=-mhat; asm volatile("":"+v"(negm)); } \
    _Pragma("unroll") for(int r=0;r<16;++r)P0[r]=__builtin_amdgcn_exp2f(P0[r]); }while(0)
  #define RESC() do{ if(resc){ asm volatile("s_waitcnt lgkmcnt(0)":::"memory"); \
      _Pragma("unroll") for(int d_=0;d_<2;++d_) _Pragma("unroll") for(int r=0;r<16;++r)o[d_][r]*=wsf[crow(r,hi)]; } }while(0)
  f32x16 pA0,pA1,pB0,pB1;
  int sl_prev=0,sl_cur=0,sl_next=SLOTB;
  #define ROT() do{sl_prev=sl_cur;sl_cur=sl_next;sl_next=(sl_next==(NSLOT-1)*SLOTB)?0:sl_next+SLOTB;}while(0)
  DMA_K(2,2*SLOTB);
  WAIT_BAR(3);
  qkt(pA0,pA1,Kbase,qr,negm,r32,hi);asm volatile("s_nop 15\n\ts_nop 7":"+v"(pA0),"+v"(pA1));CMASK(pA0,pA1,0);
  START(pA0,pA1);
  _Pragma("unroll") for(int r=0;r<16;++r)pA1[r]=__builtin_amdgcn_exp2f(pA1[r]);
  WAIT_BAR(0);
  DMA_K(3,0);DMA_V(1,SLOTB);
  ROT();
  kload8(kf,kp0+sl_cur);
  WAIT_BAR(2);
  s16x4 vlo[8],vhi[8]; u32x4 pw0,pw1,pw2,pw3;
  #define PKW(P,B) cvtpk_s(P[B],P[B+1])
  #define PAF(k) __builtin_bit_cast(bf16x8,pw##k)
  #define VFR(i) (bf16x8){vlo[i][0],vlo[i][1],vlo[i][2],vlo[i][3],vhi[i][0],vhi[i][1],vhi[i][2],vhi[i][3]}
  #define PIN(x) asm volatile("":"+v"(x))
  #define MX3(a,b,c) __builtin_fmaxf(__builtin_fmaxf((a),(b)),(c))
  #define GAPA(MF,A0,A1,A2,A3,W0,W1,PW) do{ MF; sacc+=A0; sacc+=A1; sacc+=A2; sacc+=A3; PIN(sacc); W0; W1; PIN(PW); SBAR(); }while(0)
  #define EX(v) __builtin_amdgcn_exp2f(v)
  #define GAPB(MF,X,B) do{ MF; X[B]=EX(X[B]); X[B+1]=EX(X[B+1]); X[B+2]=EX(X[B+2]); X[B+3]=EX(X[B+3]); PIN(X); SBAR(); }while(0)
  #define VRD(i) do{ vlo[i]=vtr(vp_+(((i)>>2)*4096+((i)&3)*1024)); vhi[i]=vtr(vp_+(((i)>>2)*4096+((i)&3)*1024+512)); }while(0)
  #define KRD(G,j) do{ if(G){ kload2(kf,kp0+sl_next,j); SBAR(); } }while(0)
  #define STEP(C0,C1,P0,P1,t,GK,GV,GL) do{ SBAR(); \
    const lds_cptr vp_=vp0+sl_prev; \
    VRD(0); SBAR(); float sacc=(P0[0]+P0[1]); \
    GAPA(C0=__builtin_amdgcn_mfma_f32_32x32x16_bf16(kf[0],qr[0],negm,0,0,0), P0[2],P0[3],P0[4],P0[5],     pw0[0]=PKW(P0,0), pw0[1]=PKW(P0,2), pw0); \
    VRD(4); SBAR(); GAPA(C1=__builtin_amdgcn_mfma_f32_32x32x16_bf16(kf[1],qr[0],negm,0,0,0), P0[6],P0[7],P0[8],P0[9],     pw0[2]=PKW(P0,4), pw0[3]=PKW(P0,6), pw0); \
    VRD(1); SBAR(); GAPA(C0=__builtin_amdgcn_mfma_f32_32x32x16_bf16(kf[2],qr[1],C0,0,0,0),   P0[10],P0[11],P0[12],P0[13], pw1[0]=PKW(P0,8), pw1[1]=PKW(P0,10), pw1); \
    VRD(5); SBAR(); GAPA(C1=__builtin_amdgcn_mfma_f32_32x32x16_bf16(kf[3],qr[1],C1,0,0,0),   P0[14],P0[15],P1[0],P1[1],   pw1[2]=PKW(P0,12),pw1[3]=PKW(P0,14), pw1); \
    VRD(2); SBAR(); GAPA(C0=__builtin_amdgcn_mfma_f32_32x32x16_bf16(kf[4],qr[2],C0,0,0,0),   P1[2],P1[3],P1[4],P1[5],     pw2[0]=PKW(P1,0), pw2[1]=PKW(P1,2), pw2); \
    VRD(6); SBAR(); GAPA(C1=__builtin_amdgcn_mfma_f32_32x32x16_bf16(kf[5],qr[2],C1,0,0,0),   P1[6],P1[7],P1[8],P1[9],     pw2[2]=PKW(P1,4), pw2[3]=PKW(P1,6), pw2); \
    VRD(3); SBAR(); GAPA(C0=__builtin_amdgcn_mfma_f32_32x32x16_bf16(kf[6],qr[3],C0,0,0,0),   P1[10],P1[11],P1[12],P1[13], pw3[0]=PKW(P1,8), pw3[1]=PKW(P1,10), pw3); \
    VRD(7); SBAR(); GAPA(C1=__builtin_amdgcn_mfma_f32_32x32x16_bf16(kf[7],qr[3],C1,0,0,0),   P1[14],P1[15],0.f,0.f,       pw3[2]=PKW(P1,12),pw3[3]=PKW(P1,14), pw3); \
    l_reg+=sacc; \
    if(GK){DMA_K((t)+3,sl_cur);} if(GV){DMA_V((t)+1,sl_next);} \
    CMASK(C0,C1,t); \
    { float a=MX3(C0[0],C0[1],C1[0]),b=MX3(C0[2],C0[3],C1[1]); a=MX3(a,C1[2],C1[3]); \
      _Pragma("unroll") for(int r=4;r<16;r+=4){a=MX3(a,C0[r],C0[r+1]);b=MX3(b,C0[r+2],C0[r+3]);a=MX3(a,C1[r],C1[r+1]);b=MX3(b,C1[r+2],C1[r+3]);} \
      float rm=__builtin_fmaxf(a,b); { auto rr=__builtin_amdgcn_permlane32_swap(__float_as_uint(rm),__float_as_uint(rm),false,false); rm=__builtin_fmaxf(__uint_as_float(rr[0]),__uint_as_float(rr[1])); } \
      resc=false; \
      if(__builtin_expect(__any(rm>(float)THRL),0)){ const float dl=__builtin_fmaxf(rm,0.f); mhat+=dl; \
        _Pragma("unroll") for(int r=0;r<16;++r){C0[r]-=dl;C1[r]-=dl;} \
        _Pragma("unroll") for(int r=0;r<16;++r)negm[r]=-mhat; asm volatile("":"+v"(negm)); \
        const float f=__builtin_amdgcn_exp2f(-dl); l_reg*=f; if(hi==0)wsf[r32]=f; resc=true; } } \
    SBAR(); \
    GAPB(o[0]=__builtin_amdgcn_mfma_f32_32x32x16_bf16(PAF(0),VFR(0),o[0],0,0,0), C0,0); \
    GAPB(o[1]=__builtin_amdgcn_mfma_f32_32x32x16_bf16(PAF(0),VFR(4),o[1],0,0,0), C0,4); \
    KRD(GL,0); GAPB(o[0]=__builtin_amdgcn_mfma_f32_32x32x16_bf16(PAF(1),VFR(1),o[0],0,0,0), C0,8); \
    KRD(GL,1); GAPB(o[1]=__builtin_amdgcn_mfma_f32_32x32x16_bf16(PAF(1),VFR(5),o[1],0,0,0), C0,12); \
    KRD(GL,2); GAPB(o[0]=__builtin_amdgcn_mfma_f32_32x32x16_bf16(PAF(2),VFR(2),o[0],0,0,0), C1,0); \
    KRD(GL,3); GAPB(o[1]=__builtin_amdgcn_mfma_f32_32x32x16_bf16(PAF(2),VFR(6),o[1],0,0,0), C1,4); \
    GAPB(o[0]=__builtin_amdgcn_mfma_f32_32x32x16_bf16(PAF(3),VFR(3),o[0],0,0,0), C1,8); \
    GAPB(o[1]=__builtin_amdgcn_mfma_f32_32x32x16_bf16(PAF(3),VFR(7),o[1],0,0,0), C1,12); \
    }while(0)
  int t=1;
  #undef CMASK
  #define CMASK(P0,P1,t) do{}while(0)
  for(;t+5<NT;t+=2){
    STEP(pB0,pB1,pA0,pA1,t,true,true,true);     WAIT_BAR(2); RESC(); ROT();
    STEP(pA0,pA1,pB0,pB1,t+1,true,true,true);   WAIT_BAR(2); RESC(); ROT();
  }
  #undef CMASK
  #define CMASK(P0,P1,t) do{int jb_=(t)-(NT-4); if(jb_>=0)cmask(P0,P1,jb_,qrel,hi);}while(0)
  #define ENDW(tt) do{ if((tt)+3<NT){WAIT_BAR(2);} else if((tt)+2<NT){WAIT_BAR(1);} else {WAIT_BAR(0);} }while(0)
  for(;t+1<NT;t+=2){
    STEP(pB0,pB1,pA0,pA1,t,(t+3<NT),(t+1<NT),(t+1<NT));       ENDW(t);   RESC(); ROT();
    STEP(pA0,pA1,pB0,pB1,t+1,(t+4<NT),(t+2<NT),(t+2<NT));     ENDW(t+1); RESC(); ROT();
  }
  STEP(pB0,pB1,pA0,pA1,NT-1,false,false,false); RESC();
  { float sacc=pB0[0]+pB0[1]; _Pragma("unroll") for(int r=2;r<16;++r)sacc+=pB0[r]; _Pragma("unroll") for(int r=0;r<16;++r)sacc+=pB1[r]; l_reg+=sacc;
    pw0=(u32x4){PKW(pB0,0),PKW(pB0,2),PKW(pB0,4),PKW(pB0,6)};pw1=(u32x4){PKW(pB0,8),PKW(pB0,10),PKW(pB0,12),PKW(pB0,14)};pw2=(u32x4){PKW(pB1,0),PKW(pB1,2),PKW(pB1,4),PKW(pB1,6)};pw3=(u32x4){PKW(pB1,8),PKW(pB1,10),PKW(pB1,12),PKW(pB1,14)};
    SBAR(); pv(o,vb0+sl_cur,PAF(0),PAF(1),PAF(2),PAF(3)); }
  #undef PKW
  #undef PAF
  #undef VFR
  #undef PIN
  #undef MX3
  #undef GAPA
  #undef GAPB
  #undef EX
  #undef VRD
  #undef KRD
  #undef STEP
  #undef ENDW
  {auto rr=__builtin_amdgcn_permlane32_swap(__float_as_uint(l_reg),__float_as_uint(l_reg),false,false);l_reg=__uint_as_float(rr[0])+__uint_as_float(rr[1]);}
  if(hi==0)wsf[32+r32]=l_reg;asm volatile("s_waitcnt lgkmcnt(0)":::"memory");
  float rli[16];
  #pragma unroll
  for(int r=0;r<16;++r)rli[r]=__builtin_amdgcn_rcpf(wsf[32+crow(r,hi)]);
  bf16*Ow=O+(rowbase+q0+wid*QBLK)*DMO+colo;
  { bf16*stg=(bf16*)(shm+LDS_OST)+wid*2048;
    #pragma unroll
    for(int r=0;r<16;++r){const int orow=crow(r,hi);
      #pragma unroll
      for(int d0=0;d0<2;++d0)stg[orow*64+d0*32+r32]=__float2bfloat16(o[d0][r]*rli[r]);}
    asm volatile("s_waitcnt lgkmcnt(0)":::"memory");
    #pragma unroll
    for(int i=0;i<4;++i){const int row=i*8+(lane>>3),ch=lane&7; const u32x4 v=*(const u32x4*)(stg+row*64+ch*8); ATTN_STORE16(Ow+(long)row*DMO+ch*8,v);} }
  asm volatile("s_waitcnt lgkmcnt(0)\n\ts_barrier":::"memory");
  #undef DMA_K
  #undef DMA_V
  #undef CMASK
  #undef START
  #undef RESC
  #undef ROT
}
constexpr int ATTN_LDS_BYTES=LDS_BYTES;
#undef SBAR
#undef WAIT_BAR
}
#define LAS __attribute__((address_space(3)))
typedef unsigned short u16;
typedef unsigned v4u __attribute__((ext_vector_type(4)));
typedef unsigned v2u __attribute__((ext_vector_type(2)));
typedef float f32x4 __attribute__((ext_vector_type(4)));
typedef short bf16x8 __attribute__((ext_vector_type(8)));
typedef short s16x4 __attribute__((ext_vector_type(4)));
typedef float f32x16 __attribute__((ext_vector_type(16)));
typedef float f32x2_t __attribute__((ext_vector_type(2)));
typedef __bf16 bf16x2_t __attribute__((ext_vector_type(2)));

constexpr int MTOK = 32768, SEQL = 8192, DMODEL = 1024, FFD = 4096, NIN0 = 3584, NIN1 = 3072, PLE = 256;
constexpr float LN_EPS = 1e-5f;
constexpr float ALPHA = 1.4142135623730951f;
constexpr size_t MiB = 1u << 20;
constexpr size_t WS_CVEC = 0;
constexpr size_t WS_STATS = 62 * MiB;
constexpr size_t WS_ROWSS = 63 * MiB;
constexpr size_t WS_BAR = 256 * 1024;
constexpr size_t WS_MISC = 512 * 1024;
constexpr size_t WS_CS = 1 * MiB;
constexpr size_t WS_WIN0 = 2 * MiB, WS_WOUT0 = 9 * MiB, WS_WIN1 = 11 * MiB, WS_WOUT1 = 17 * MiB, WS_W1 = 19 * MiB  , WS_W2 = 35 * MiB  , WS_WP = 51 * MiB  , WS_WG = 52 * MiB  ;
constexpr size_t WS_LSE = 56 * MiB;
constexpr size_t WS_XB = 64 * MiB, WS_MIX = 128 * MiB, WS_HB = 192 * MiB, WS_AUX = 448 * MiB, WS_END = 512 * MiB;
constexpr size_t WS_HGS = 416 * MiB, WS_HGD = 432 * MiB;
constexpr size_t WS_OB1 = 384 * MiB;
constexpr int LDS_BYTES = 147456;

__device__ __forceinline__ unsigned f2bf(float f) { unsigned u = __builtin_bit_cast(unsigned, f); return (u + 0x7fffu + ((u >> 16) & 1u)) >> 16; }
__device__ __forceinline__ unsigned pk2(float lo, float hi) { f32x2_t v = {lo, hi}; bf16x2_t b = __builtin_convertvector(v, bf16x2_t); return __builtin_bit_cast(unsigned, b); }
__device__ __forceinline__ float bf2f(unsigned v) { return __uint_as_float(v << 16); }
__device__ __forceinline__ float bflo(unsigned w) { return __uint_as_float(w << 16); }
__device__ __forceinline__ float bfhi(unsigned w) { return __uint_as_float(w & 0xffff0000u); }
__device__ __forceinline__ float shx(float v, int m, int lane) { return __builtin_bit_cast(float, __builtin_amdgcn_ds_bpermute((lane ^ m) << 2, __builtin_bit_cast(int, v))); }
__device__ __forceinline__ float wave_sum(float v, int lane) {
#pragma unroll
    for (int o = 1; o < 64; o <<= 1) v += shx(v, o, lane);
    return v;
}
__device__ __forceinline__ int crow(int reg, int h) { return (reg & 3) + 8 * (reg >> 2) + 4 * h; }
#define MFMA32(a, b, c) __builtin_amdgcn_mfma_f32_32x32x16_bf16((a), (b), (c), 0, 0, 0)
__device__ __forceinline__ bf16x8 pack8(const f32x16& x, int base) {
    v4u p; p.x = pk2(x[base], x[base + 1]); p.y = pk2(x[base + 2], x[base + 3]); p.z = pk2(x[base + 4], x[base + 5]); p.w = pk2(x[base + 6], x[base + 7]);
    return __builtin_bit_cast(bf16x8, p);
}
typedef short v4i16_t __attribute__((ext_vector_type(4)));
__device__ __forceinline__ s16x4 trrd(LAS unsigned char* p) { return __builtin_bit_cast(s16x4, __builtin_amdgcn_ds_read_tr16_b64_v4i16((LAS v4i16_t*)p)); }
__device__ __forceinline__ bf16x8 trfrag(LAS unsigned char* img, int pitch, int row_lo, int hi_delta, int col0, int lane) {
    const int i16 = lane & 15, q = i16 >> 2, p = i16 & 3, g16 = (lane >> 4) & 1;
    LAS unsigned char* a = img + (row_lo + q) * pitch + (col0 + 16 * g16 + 4 * p) * 2;
    const s16x4 lo = trrd(a), hi = trrd(a + hi_delta * pitch);
    return (bf16x8){lo[0], lo[1], lo[2], lo[3], hi[0], hi[1], hi[2], hi[3]};
}

struct Args {
    const float *x, *p, *ev_w_in, *ev_w_out, *da_lambda, *da_subln_g, *hg_lb_logits, *hg_norm_g, *od_w_in, *od_w_out, *ln1_g, *ln1_b, *ffn_w1, *ffn_w2, *ln2_g, *ln2_b, *ple_w_proj, *ple_w_gate, *ple_norm_g;
    float* out; unsigned char* ws;
};

__device__ __forceinline__ void p0_transpose_item(const float* W, int K, int N, u16* WT, LAS float* scr, int item, int lane, const float* gk = nullptr, const float* bk = nullptr, float* c1 = nullptr, float* c2 = nullptr) {
    const int nblk = N / 32, kb = item / nblk, nb = item % nblk, k0 = 64 * kb, n0 = 32 * nb;
#pragma unroll 8
    for (int i = 0; i < 32; ++i) { const int kk = 2 * i + (lane >> 5); scr[kk * 33 + (lane & 31)] = W[(size_t)(k0 + kk) * N + n0 + (lane & 31)]; }
    asm volatile("s_waitcnt lgkmcnt(0)" ::: "memory");
    const int c = lane & 7;
    float gs[8];
#pragma unroll
    for (int e = 0; e < 8; ++e) gs[e] = gk ? gk[k0 + 8 * c + e] : 1.f;
    if (gk) {
        const int n = lane & 31, kh = (lane >> 5) * 32; float s1 = 0.f, s2 = 0.f;
#pragma unroll 8
        for (int kk = 0; kk < 32; ++kk) { const float wv = scr[(kh + kk) * 33 + n]; s1 += gk[k0 + kh + kk] * wv; s2 += bk[k0 + kh + kk] * wv; }
        s1 += shx(s1, 32, lane); s2 += shx(s2, 32, lane);
        if (lane < 32) { atomicAdd(c1 + n0 + n, s1); atomicAdd(c2 + n0 + n, s2); }
    }
#pragma unroll
    for (int j = 0; j < 4; ++j) { const int n = (lane >> 3) + 8 * j; const LAS float* sp = scr + (8 * c) * 33 + n;
        v4u o; o.x = pk2(sp[0 * 33] * gs[0], sp[1 * 33] * gs[1]); o.y = pk2(sp[2 * 33] * gs[2], sp[3 * 33] * gs[3]); o.z = pk2(sp[4 * 33] * gs[4], sp[5 * 33] * gs[5]); o.w = pk2(sp[6 * 33] * gs[6], sp[7 * 33] * gs[7]);
        *(v4u*)(WT + (size_t)(n0 + n) * K + k0 + 8 * c) = o; }
    asm volatile("s_waitcnt lgkmcnt(0)" ::: "memory");
}
__device__ __forceinline__ void prologue(const Args& A, LAS unsigned char* lds, int gw, int NGW, int wave, int lane) {
    unsigned char* ws = A.ws;
    LAS float* scr = (LAS float*)(lds + wave * 16384);
    const int cnt[12] = {(1024 / 64) * (NIN0 / 32), 512, (1024 / 64) * (NIN1 / 32), 512, 2048, 2048, 2048, 2048, 128, 128, 512, 512};
    int total = 0;
#pragma unroll
    for (int i = 0; i < 12; ++i) total += cnt[i];
    for (int it = gw; it < total; it += NGW) {
        int r = it;
        if (r < cnt[0]) { p0_transpose_item(A.ev_w_in, 1024, NIN0, (u16*)(ws + WS_WIN0), scr, r, lane); continue; } r -= cnt[0];
        if (r < cnt[1]) { p0_transpose_item(A.ev_w_out, 1024, 1024, (u16*)(ws + WS_WOUT0), scr, r, lane); continue; } r -= cnt[1];
        if (r < cnt[2]) { p0_transpose_item(A.od_w_in, 1024, NIN1, (u16*)(ws + WS_WIN1), scr, r, lane); continue; } r -= cnt[2];
        if (r < cnt[3]) { p0_transpose_item(A.od_w_out, 1024, 1024, (u16*)(ws + WS_WOUT1), scr, r, lane); continue; } r -= cnt[3];
        if (r < 4096) { const int l = r >> 11; float* cv = (float*)(ws + WS_CVEC) + l * 10240; p0_transpose_item(A.ffn_w1 + (size_t)l * 1024 * 4096, 1024, 4096, (u16*)(ws + WS_W1 + l * 8 * MiB), scr, r & 2047, lane, A.ln1_g + l * 1024, A.ln1_b + l * 1024, cv, cv + 4096); continue; } r -= 4096;
        if (r < 4096) { const int l = r >> 11; p0_transpose_item(A.ffn_w2 + (size_t)l * 1024 * 4096, 4096, 1024, (u16*)(ws + WS_W2 + l * 8 * MiB), scr, r & 2047, lane); continue; } r -= 4096;
        if (r < 256) { const int l = r >> 7; p0_transpose_item(A.ple_w_proj + (size_t)l * 256 * 1024, 256, 1024, (u16*)(ws + WS_WP + l * (MiB / 2)), scr, r & 127, lane); continue; } r -= 256;
        { const int l = r >> 9; float* cv = (float*)(ws + WS_CVEC) + l * 10240 + 8192; p0_transpose_item(A.ple_w_gate + (size_t)l * 1024 * 1024, 1024, 1024, (u16*)(ws + WS_WG + l * 2 * MiB), scr, r & 511, lane, A.ln2_g + l * 1024, A.ln2_b + l * 1024, cv, cv + 1024); }
    }
    u16* XB = (u16*)(ws + WS_XB);
    for (int m = gw; m < MTOK; m += NGW) {
        const f32x4* xr = (const f32x4*)(A.x + (size_t)m * 1024) + lane; v2u* o = (v2u*)(XB + (size_t)m * 1024) + lane;
#pragma unroll
        for (int j = 0; j < 4; ++j) { const f32x4 v = xr[64 * j]; v2u w; w.x = pk2(v[0], v[1]); w.y = pk2(v[2], v[3]); o[64 * j] = w; }
    }
    { v4u* z = (v4u*)(ws + WS_STATS); for (int i = gw * 64 + lane; i < (int)((MiB + 256 * 1024) / 16); i += NGW * 64) z[i] = (v4u){0u, 0u, 0u, 0u}; }
    float* cs = (float*)(ws + WS_CS);
    for (int idx = gw * 64 + lane; idx < 65536; idx += NGW * 64) {
        const int pos = idx >> 3, e = idx & 7;
        double iv = 1.0;
#pragma unroll 1
        for (int k = 0; k < e; ++k) iv *= 0.19392274474868576;
        const float inv = (float)iv;
        const float angf = (float)pos * inv;
        double a = (double)angf; const double twopi = 6.283185307179586476925;
        const double kq = __builtin_rint(a / twopi); a -= kq * twopi;
        const double a2 = a * a; double sn = 0.0, cn = 0.0;
        double ts = a, tc = 1.0;
#pragma unroll 1
        for (int n = 0; n < 16; ++n) { cn += tc; sn += ts; tc *= -a2 / (double)((2 * n + 1) * (2 * n + 2)); ts *= -a2 / (double)((2 * n + 2) * (2 * n + 3)); }
        cs[idx] = (float)cn; cs[65536 + idx] = (float)sn;
    }
    float* misc = (float*)(ws + WS_MISC);
    for (int i = gw * 64 + lane; i < 512; i += NGW * 64) { const float l0 = A.hg_lb_logits[i], l1 = A.hg_lb_logits[512 + i]; misc[i] = 1.f / (1.f + __expf(l1 - l0)); }
}

__device__ __forceinline__ void ln_rows(float* X, u16* XBo, const float* g, const float* bta, float* rowss, const float* prow, u16* PBo, int gw, int NGW, int lane) {
    for (int m = gw; m < MTOK; m += NGW) {
        f32x4* xr = (f32x4*)(X + (size_t)m * 1024) + lane;
        f32x4 v[4]; float s = 0.f;
#pragma unroll
        for (int j = 0; j < 4; ++j) { v[j] = xr[64 * j]; s += (v[j][0] + v[j][1]) + (v[j][2] + v[j][3]); }
        const float mean = wave_sum(s, lane) * (1.f / 1024.f); float s2 = 0.f;
#pragma unroll
        for (int j = 0; j < 4; ++j) { v[j] = v[j] - mean; s2 += (v[j][0] * v[j][0] + v[j][1] * v[j][1]) + (v[j][2] * v[j][2] + v[j][3] * v[j][3]); }
        const float rstd = 1.f / sqrtf(wave_sum(s2, lane) * (1.f / 1024.f) + LN_EPS);
        v2u* o8 = (v2u*)(XBo + (size_t)m * 1024) + lane;
#pragma unroll
        for (int j = 0; j < 4; ++j) { const f32x4 gv = ((const f32x4*)g)[lane + 64 * j], bv = ((const f32x4*)bta)[lane + 64 * j];
            const f32x4 o = v[j] * rstd * gv + bv; xr[64 * j] = o; v2u w; w.x = pk2(o[0], o[1]); w.y = pk2(o[2], o[3]); o8[64 * j] = w; }
        if (rowss && lane == 0) rowss[m] = 0.f;
        if (prow) { const f32x4 pv = ((const f32x4*)(prow + (size_t)m * 256))[lane]; v2u w; w.x = pk2(pv[0], pv[1]); w.y = pk2(pv[2], pv[3]); ((v2u*)(PBo + (size_t)m * 256))[lane] = w; }
    }
}
__device__ __forceinline__ void p_rows(const float* prow, u16* PBo, int gw, int NGW, int lane) {
    for (int m = gw; m < MTOK; m += NGW) { const f32x4 pv = ((const f32x4*)(prow + (size_t)m * 256))[lane]; v2u w; w.x = pk2(pv[0], pv[1]); w.y = pk2(pv[2], pv[3]); ((v2u*)(PBo + (size_t)m * 256))[lane] = w; }
}
__device__ __forceinline__ void diff_combine_block(const u16* AUX, u16* MIX, const float* lam_p, const float* subg, size_t row0, int h, int tid) {
    const int lane = tid & 63;
    const float s01 = wave_sum(lam_p[lane] * lam_p[64 + lane], lane), s23 = wave_sum(lam_p[128 + lane] * lam_p[192 + lane], lane);
    const float lam = __expf(s01) - __expf(s23) + 0.2f;
    const int d0 = (tid & 15) * 8;
    float gv[8];
#pragma unroll
    for (int e = 0; e < 8; ++e) gv[e] = subg[d0 + e] * 0.8f;
#pragma unroll
    for (int it = 0; it < 8; ++it) {
        const size_t m = row0 + (tid >> 4) + 32 * it;
        const v4u a0 = *(const v4u*)(AUX + m * 1024 + h * 256 + d0), a1 = *(const v4u*)(AUX + m * 1024 + h * 256 + 128 + d0);
        float o[8];
        o[0] = bflo(a0.x) - lam * bflo(a1.x); o[1] = bfhi(a0.x) - lam * bfhi(a1.x); o[2] = bflo(a0.y) - lam * bflo(a1.y); o[3] = bfhi(a0.y) - lam * bfhi(a1.y);
        o[4] = bflo(a0.z) - lam * bflo(a1.z); o[5] = bfhi(a0.z) - lam * bfhi(a1.z); o[6] = bflo(a0.w) - lam * bflo(a1.w); o[7] = bfhi(a0.w) - lam * bfhi(a1.w);
        float ss = 0.f;
#pragma unroll
        for (int e = 0; e < 8; ++e) ss += o[e] * o[e];
        ss += shx(ss, 1, lane); ss += shx(ss, 2, lane); ss += shx(ss, 4, lane); ss += shx(ss, 8, lane);
        const float rs = __builtin_amdgcn_rsqf(ss * (1.f / 128.f) + LN_EPS);
        v4u w; w.x = pk2(o[0] * rs * gv[0], o[1] * rs * gv[1]); w.y = pk2(o[2] * rs * gv[2], o[3] * rs * gv[3]); w.z = pk2(o[4] * rs * gv[4], o[5] * rs * gv[5]); w.w = pk2(o[6] * rs * gv[6], o[7] * rs * gv[7]);
        *(v4u*)(MIX + m * 1024 + h * 128 + d0) = w;
    }
}
__device__ __forceinline__ void diff_combine(const u16* AUX, u16* MIX, const float* lam_p, const float* subg, int gw, int NGW, int lane) {
    const float s01 = wave_sum(lam_p[lane] * lam_p[64 + lane], lane), s23 = wave_sum(lam_p[128 + lane] * lam_p[192 + lane], lane);
    const float lam = __expf(s01) - __expf(s23) + 0.2f;
    const int h = lane >> 4, d0 = (lane & 15) * 8;
    float gv[8];
#pragma unroll
    for (int e = 0; e < 8; ++e) gv[e] = subg[d0 + e] * 0.8f;
    for (int m = gw; m < MTOK; m += NGW) {
        const v4u a0 = *(const v4u*)(AUX + (size_t)m * 1024 + h * 256 + d0), a1 = *(const v4u*)(AUX + (size_t)m * 1024 + h * 256 + 128 + d0);
        float o[8];
        o[0] = bflo(a0.x) - lam * bflo(a1.x); o[1] = bfhi(a0.x) - lam * bfhi(a1.x); o[2] = bflo(a0.y) - lam * bflo(a1.y); o[3] = bfhi(a0.y) - lam * bfhi(a1.y);
        o[4] = bflo(a0.z) - lam * bflo(a1.z); o[5] = bfhi(a0.z) - lam * bfhi(a1.z); o[6] = bflo(a0.w) - lam * bflo(a1.w); o[7] = bfhi(a0.w) - lam * bfhi(a1.w);
        float ss = 0.f;
#pragma unroll
        for (int e = 0; e < 8; ++e) ss += o[e] * o[e];
        ss += shx(ss, 1, lane); ss += shx(ss, 2, lane); ss += shx(ss, 4, lane); ss += shx(ss, 8, lane);
        const float rs = 1.f / sqrtf(ss * (1.f / 128.f) + LN_EPS);
        v4u w; w.x = pk2(o[0] * rs * gv[0], o[1] * rs * gv[1]); w.y = pk2(o[2] * rs * gv[2], o[3] * rs * gv[3]); w.z = pk2(o[4] * rs * gv[4], o[5] * rs * gv[5]); w.w = pk2(o[6] * rs * gv[6], o[7] * rs * gv[7]);
        *(v4u*)(MIX + (size_t)m * 1024 + h * 128 + d0) = w;
    }
}
namespace hg {
constexpr int P_QA = 272, P_QO = 264, P_TR = 320;
constexpr int O_QA = 0, O_KA = O_QA + 64 * P_QA, O_QO = O_KA + 64 * P_QA, O_KST = O_QO + 64 * P_QO, O_V = O_KST + 64 * P_TR, O_OST = O_V + 64 * P_TR, O_TOT = O_OST + 64 * 132 * 4, O_DEC = O_TOT + 2048, O_END = O_DEC + 512;
static_assert(O_END <= 131072, "hgrn lds");
template <bool OUT>
__device__ __forceinline__ void item(LAS unsigned char* L, const u16* __restrict__ H, int it, const float* __restrict__ lbv, float* Send, float* Drun, const float* __restrict__ outg, u16* MIX, const int tid, const float* Sst = nullptr) {
    const int  lane = tid & 63, w = __builtin_amdgcn_readfirstlane(tid >> 6), r = lane & 31, h = lane >> 5;
    const int tt = w & 1, vt = w >> 1;
    const int bh = it >> 4, run = it & 15, b = bh >> 2, hh = bh & 3;
    const int kd = tid & 127, seg = tid >> 7;
    const size_t row0 = (size_t)b * 8192 + (size_t)run * 512;
    const float lb = lbv[hh * 128 + kd];
    LAS float* TOT = (LAS float*)(L + O_TOT); LAS float* DEC = (LAS float*)(L + O_DEC); LAS float* OST = (LAS float*)(L + O_OST);
    f32x16 S[4];
#pragma unroll
    for (int k = 0; k < 4; ++k) S[k] = f32x16{};
    if (OUT && run > 0) {
        if (Sst) {
#pragma unroll
            for (int k = 0; k < 4; ++k)
#pragma unroll
                for (int i = 0; i < 16; ++i) S[k][i] = Sst[((((size_t)it * 4 + vt) * 4 + k) * 16 + i) * 64 + lane];
        } else {
            for (int rp = 0; rp < run; ++rp) { const int ip = bh * 16 + rp;
#pragma unroll
                for (int k = 0; k < 4; ++k)
#pragma unroll
                    for (int i = 0; i < 16; ++i) S[k][i] = Drun[ip * 128 + 32 * k + crow(i, h)] * S[k][i] + Send[((((size_t)ip * 4 + vt) * 4 + k) * 16 + i) * 64 + lane];
            }
        }
    }
    float bsum = 0.f;
    u16 nf[16], nq[16]; v4u nv[2]; v4u ng[2] = {{0u, 0u, 0u, 0u}, {0u, 0u, 0u, 0u}};
#define HG_ISSUE(rowc_) do { _Pragma("unroll") for (int i = 0; i < 16; ++i) { const u16* p = H + ((rowc_) + seg * 16 + i) * NIN0 + hh * 128 + kd; nf[i] = p[2048]; if (OUT) nq[i] = p[1536]; } \
        _Pragma("unroll") for (int n = 0; n < 2; ++n) { const int id = tid + 512 * n, t = id >> 4, c = id & 15; nv[n] = *(const v4u*)(H + ((rowc_) + t) * NIN0 + 2560 + hh * 128 + c * 8); } \
        if (OUT) { const u16* gp_ = H + ((rowc_) + (tid >> 3)) * NIN0 + 3072 + hh * 128 + (tid & 7) * 16; ng[0] = *(const v4u*)gp_; ng[1] = *(const v4u*)(gp_ + 8); } } while (0)
    HG_ISSUE(row0);
    for (int ch = 0; ch < 8; ++ch) {
        const size_t rowc = row0 + ch * 64;
        float fg[16], cs[16], hq[16];
#pragma unroll
        for (int i = 0; i < 16; ++i) { fg[i] = bf2f(nf[i]); if (OUT) hq[i] = bf2f(nq[i]); }
#pragma unroll
        for (int n = 0; n < 2; ++n) { const int id = tid + 512 * n, t = id >> 4, c = id & 15; *(LAS v4u*)(L + O_V + t * P_TR + c * 16) = nv[n]; }
        const v4u gc0 = ng[0], gc1 = ng[1];
        if (ch + 1 < 8) HG_ISSUE(rowc + 64);
        float runs = 0.f;
#pragma unroll
        for (int i = 0; i < 16; ++i) { const float sg = __builtin_amdgcn_rcpf(1.f + __expf(-fg[i])); const float f = lb + (1.f - lb) * sg; fg[i] = (1.f - lb) * (1.f - sg); runs += __logf(f); cs[i] = runs; }
        TOT[seg * 128 + kd] = runs;
        __syncthreads();
        const float t0 = TOT[kd], t1 = TOT[128 + kd], t2 = TOT[256 + kd], t3 = TOT[384 + kd];
        const float off = (seg > 0 ? t0 : 0.f) + (seg > 1 ? t1 : 0.f) + (seg > 2 ? t2 : 0.f);
        const float bmid = t0 + t1, blast = (t0 + t1) + (t2 + t3);
        const float elm = __expf(blast - bmid), em = __expf(bmid);
#pragma unroll
        for (int i = 0; i < 16; i += 2) {
            const int t = seg * 16 + i; float kst[2], qa[2], ka[2], qo[2];
#pragma unroll
            for (int u = 0; u < 2; ++u) { const float bi = off + cs[i + u];
                const float e1 = __expf(bi - bmid), e2 = __builtin_amdgcn_rcpf(e1); const float kk = fg[i + u];
                ka[u] = kk * e2; kst[u] = ka[u] * elm;
                if (OUT) { const float q = hq[i + u] * __builtin_amdgcn_rcpf(1.f + __expf(-hq[i + u])); qa[u] = q * e1; qo[u] = qa[u] * em; } }
            { const unsigned w = pk2(kst[0], kst[1]); *(LAS u16*)(L + O_KST + t * P_TR + kd * 2) = (u16)w; *(LAS u16*)(L + O_KST + (t + 1) * P_TR + kd * 2) = (u16)(w >> 16); }
            if (OUT) {
                { const unsigned w = pk2(qa[0], qa[1]); *(LAS u16*)(L + O_QA + t * P_QA + kd * 2) = (u16)w; *(LAS u16*)(L + O_QA + (t + 1) * P_QA + kd * 2) = (u16)(w >> 16); }
                { const unsigned w = pk2(ka[0], ka[1]); *(LAS u16*)(L + O_KA + t * P_QA + kd * 2) = (u16)w; *(LAS u16*)(L + O_KA + (t + 1) * P_QA + kd * 2) = (u16)(w >> 16); }
                { const unsigned w = pk2(qo[0], qo[1]); *(LAS u16*)(L + O_QO + t * P_QO + kd * 2) = (u16)w; *(LAS u16*)(L + O_QO + (t + 1) * P_QO + kd * 2) = (u16)(w >> 16); } }
        }
        if (seg == 0) { DEC[kd] = __expf(blast); bsum += blast; }
        __syncthreads();
        if (OUT) {
            f32x16 acc = f32x16{};
            for (int st = 0; st <= tt; ++st) {
                f32x16 X = f32x16{};
#pragma unroll
                for (int ks = 0; ks < 8; ++ks) { const bf16x8 a = *(LAS bf16x8*)(L + O_KA + (32 * st + r) * P_QA + (16 * ks + 8 * h) * 2); const bf16x8 bq = *(LAS bf16x8*)(L + O_QA + (32 * tt + r) * P_QA + (16 * ks + 8 * h) * 2); X = MFMA32(a, bq, X); }
                if (st == tt) {
#pragma unroll
                    for (int i = 0; i < 16; ++i) if (crow(i, h) > r) X[i] = 0.f; }
#pragma unroll
                for (int s2 = 0; s2 < 2; ++s2) { const bf16x8 pa = pack8(X, 8 * s2); const bf16x8 vf = trfrag(L + O_V, P_TR, 32 * st + 16 * s2 + 4 * h, 8, 32 * vt, lane); acc = MFMA32(pa, vf, acc); }
            }
#pragma unroll
            for (int k = 0; k < 4; ++k)
#pragma unroll
                for (int s2 = 0; s2 < 2; ++s2) {
                    LAS unsigned char* qp = L + O_QO + (32 * tt + r) * P_QO + (32 * k + 16 * s2 + 4 * h) * 2;
                    const s16x4 lo = *(LAS s16x4*)qp, hi = *(LAS s16x4*)(qp + 16);
                    const bf16x8 a2 = (bf16x8){lo[0], lo[1], lo[2], lo[3], hi[0], hi[1], hi[2], hi[3]};
                    acc = MFMA32(a2, pack8(S[k], 8 * s2), acc); }
#pragma unroll
            for (int i = 0; i < 16; ++i) OST[(32 * tt + crow(i, h)) * 132 + 32 * vt + r] = acc[i];
        }
#pragma unroll
        for (int k = 0; k < 4; ++k) {
#pragma unroll
            for (int i = 0; i < 16; ++i) S[k][i] *= DEC[32 * k + crow(i, h)];
#pragma unroll
            for (int ks = 0; ks < 4; ++ks) { const bf16x8 a = trfrag(L + O_KST, P_TR, 16 * ks + 8 * h, 4, 32 * k, lane); const bf16x8 bv = trfrag(L + O_V, P_TR, 16 * ks + 8 * h, 4, 32 * vt, lane); S[k] = MFMA32(a, bv, S[k]); }
        }
        __syncthreads();
        if (OUT) {
            const int t = tid >> 3, c8 = tid & 7; float o[16]; float ss = 0.f;
#pragma unroll
            for (int j = 0; j < 4; ++j) { const f32x4 v = *(LAS f32x4*)(OST + t * 132 + c8 * 16 + 4 * j); o[4 * j] = v[0]; o[4 * j + 1] = v[1]; o[4 * j + 2] = v[2]; o[4 * j + 3] = v[3]; ss += (v[0] * v[0] + v[1] * v[1]) + (v[2] * v[2] + v[3] * v[3]); }
            ss += shx(ss, 1, lane); ss += shx(ss, 2, lane); ss += shx(ss, 4, lane);
            const float rs = __builtin_amdgcn_rsqf(ss * (1.f / 128.f) + LN_EPS);
            u16* op = MIX + (rowc + t) * 1024 + 512 + hh * 128 + c8 * 16;
#pragma unroll
            for (int j = 0; j < 2; ++j) { const v4u gvv = j ? gc1 : gc0; const unsigned gw_[4] = {gvv.x, gvv.y, gvv.z, gvv.w}; unsigned ow[4];
#pragma unroll
                for (int e = 0; e < 4; ++e) { const float g0 = bflo(gw_[e]), g1 = bfhi(gw_[e]); const int c = 8 * j + 2 * e;
                    const float y0 = o[c] * rs * outg[c8 * 16 + c] * (g0 * __builtin_amdgcn_rcpf(1.f + __expf(-g0))), y1 = o[c + 1] * rs * outg[c8 * 16 + c + 1] * (g1 * __builtin_amdgcn_rcpf(1.f + __expf(-g1)));
                    ow[e] = pk2(y0, y1); }
                *(v4u*)(op + 8 * j) = (v4u){ow[0], ow[1], ow[2], ow[3]}; }
        }
    }
    if (!OUT) {
        if (tt == 0) {
#pragma unroll
            for (int k = 0; k < 4; ++k)
#pragma unroll
                for (int i = 0; i < 16; ++i) Send[((((size_t)it * 4 + vt) * 4 + k) * 16 + i) * 64 + lane] = S[k][i]; }
        if (seg == 0) Drun[it * 128 + kd] = __expf(bsum);
    }
}
__device__ __forceinline__ void scan(const float* __restrict__ Send, const float* __restrict__ Drun, float* Sst, int gtid, int nthreads) {
    for (int idx = gtid; idx < 16 * 16384; idx += nthreads) {
        const int bh = idx >> 14, e = idx & 16383, lane = e & 63, i = (e >> 6) & 15, k = (e >> 10) & 3;
        const int kd = 32 * k + crow(i, lane >> 5);
        float sv[15], dv[15];
#pragma unroll
        for (int r = 0; r < 15; ++r) { sv[r] = Send[(size_t)(bh * 16 + r) * 16384 + e]; dv[r] = Drun[(bh * 16 + r) * 128 + kd]; }
        float st = 0.f;
#pragma unroll
        for (int r = 0; r < 15; ++r) { st = dv[r] * st + sv[r]; Sst[(size_t)(bh * 16 + r + 1) * 16384 + e] = st; }
    }
}
}

__device__ __forceinline__ void dil_task(LAS unsigned char* Lw, const u16* __restrict__ QKV, int task, u16* OBg0, u16* OBg1, u16* OBg2, float* LSE, int lane) {
    const int r = lane & 31, h = lane >> 5;
    const int bh = task / 768, rem = task - bh * 768, g = rem >> 8, j = rem & 255;
    const int sh = 2 * g, res = j >> (8 - sh), qt = j & ((256 >> sh) - 1);
    const int b = bh >> 4, hd = bh & 15;
    const size_t rowb = (size_t)b * 8192;
    const int qpos = res + ((32 * qt + r) << sh);
    const u16* qp = QKV + (rowb + qpos) * NIN1 + hd * 64;
    bf16x8 qf[4];
#pragma unroll
    for (int ks = 0; ks < 4; ++ks) qf[ks] = *(const bf16x8*)(qp + 16 * ks + 8 * h);
    f32x16 X[5];
#pragma unroll
    for (int kb = 0; kb < 5; ++kb) {
        int ki = 32 * qt - 128 + 32 * kb + r; ki = ki < 0 ? 0 : ki;
        const u16* kp = QKV + (rowb + res + (ki << sh)) * NIN1 + 1024 + hd * 64;
        X[kb] = f32x16{};
#pragma unroll
        for (int ks = 0; ks < 4; ++ks) { const bf16x8 kf = *(const bf16x8*)(kp + 16 * ks + 8 * h); X[kb] = MFMA32(kf, qf[ks], X[kb]); }
    }
    float m = -INFINITY;
#pragma unroll
    for (int kb = 0; kb < 5; ++kb)
#pragma unroll
        for (int i = 0; i < 16; ++i) { const int c = crow(i, h); bool valid = (32 * qt - 128 + 32 * kb + c) >= 0;
            if (kb == 0) valid = valid && (c >= r);
            if (kb == 4) valid = valid && (c <= r);
            X[kb][i] = valid ? X[kb][i] : -INFINITY; m = fmaxf(m, X[kb][i]); }
    m = fmaxf(m, shx(m, 32, lane));
    float l = 0.f;
#pragma unroll
    for (int kb = 0; kb < 5; ++kb)
#pragma unroll
        for (int i = 0; i < 16; ++i) { X[kb][i] = __builtin_amdgcn_exp2f(X[kb][i] - m); l += X[kb][i]; }
    l += shx(l, 32, lane);
    f32x16 y[2]; y[0] = f32x16{}; y[1] = f32x16{};
#pragma unroll
    for (int kb = 0; kb < 5; ++kb) {
#pragma unroll
        for (int n = 0; n < 4; ++n) { const int id = lane + 64 * n, key = id >> 3, c = id & 7; int ki = 32 * qt - 128 + 32 * kb + key; ki = ki < 0 ? 0 : ki;
            const v4u v = *(const v4u*)(QKV + (rowb + res + (ki << sh)) * NIN1 + 2048 + hd * 64 + c * 8); *(LAS v4u*)(Lw + key * 192 + c * 16) = v; }
#pragma unroll
        for (int s2 = 0; s2 < 2; ++s2) { const bf16x8 pb = pack8(X[kb], 8 * s2);
#pragma unroll
            for (int dt = 0; dt < 2; ++dt) { const bf16x8 a = trfrag(Lw, 192, 16 * s2 + 4 * h, 8, 32 * dt, lane); y[dt] = MFMA32(a, pb, y[dt]); } }
    }
    const float inv = 1.f / l;
    u16* ob = (g == 0 ? OBg0 : g == 1 ? OBg1 : OBg2) + (rowb + qpos) * 1024 + hd * 64;
#pragma unroll
    for (int dt = 0; dt < 2; ++dt)
#pragma unroll
        for (int gq = 0; gq < 4; ++gq) { v2u w; w.x = pk2(y[dt][4 * gq] * inv, y[dt][4 * gq + 1] * inv); w.y = pk2(y[dt][4 * gq + 2] * inv, y[dt][4 * gq + 3] * inv); *(v2u*)(ob + 32 * dt + 8 * gq + 4 * h) = w; }
    if (h == 0) LSE[((size_t)g * MTOK + rowb + qpos) * 16 + hd] = (m + __log2f(l)) * 0.6931471805599453f;
}
namespace dl {
constexpr int KP = 144, VP = 192, O_K = 0, O_V = 384 * KP, O_END = O_V + 384 * VP;
static_assert(O_END <= 131072, "dilated lds");
struct Dec { int g, sh, res, i0, hd; size_t rowb; };
__device__ __forceinline__ Dec decode(int task) {
    Dec d; const int bh = task / 96, rem = task - bh * 96; d.g = rem >> 5; const int j = rem & 31;
    d.sh = 2 * d.g; d.res = j >> (5 - d.sh); d.i0 = 256 * (j & ((32 >> d.sh) - 1)); d.hd = bh & 15; d.rowb = (size_t)(bh >> 4) * 8192; return d;
}
__device__ __forceinline__ void issue(const u16* __restrict__ QKV, int task, int tid, v4u (&pk)[6], v4u (&pv)[6], bf16x8 (&qn)[4]) {
    const Dec d = decode(task); const int lane = tid & 63, w = tid >> 6, r = lane & 31, h = lane >> 5;
#pragma unroll
    for (int n = 0; n < 6; ++n) { const int id = tid + 512 * n, c = id >> 3, ch = id & 7; int ki = d.i0 - 128 + c; ki = ki < 0 ? 0 : ki;
        const u16* src = QKV + (d.rowb + d.res + (ki << d.sh)) * NIN1 + d.hd * 64 + ch * 8;
        pk[n] = *(const v4u*)(src + 1024); pv[n] = *(const v4u*)(src + 2048); }
    const u16* qp = QKV + (d.rowb + d.res + ((d.i0 + 32 * w + r) << d.sh)) * NIN1 + d.hd * 64;
#pragma unroll
    for (int ks = 0; ks < 4; ++ks) qn[ks] = *(const bf16x8*)(qp + 16 * ks + 8 * h);
}
__device__ __forceinline__ void phase(LAS unsigned char* L, const u16* __restrict__ QKV, u16* OBg0, u16* OBg1, u16* OBg2, float* LSE, int first, int stride, const int tid) {
    const int lane = tid & 63, w = __builtin_amdgcn_readfirstlane(tid >> 6), r = lane & 31, h = lane >> 5;
    const bool xl = (stride == 256); const int nround = xl ? 24 : (6144 - first + stride - 1) / stride;
    if (first >= 6144) return;
#define DL_TASK(k) (xl ? (((first >> 5) * 8 + (k) / 3) * 96 + ((k) % 3) * 32 + (first & 31)) : (first + (k) * stride))
    v4u pk[6], pv[6]; bf16x8 qn[4];
    issue(QKV, DL_TASK(0), tid, pk, pv, qn);
    for (int kr = 0; kr < nround; ++kr) {
        const int task = DL_TASK(kr);
        const Dec d = decode(task);
#pragma unroll
        for (int n = 0; n < 6; ++n) { const int id = tid + 512 * n, c = id >> 3, ch = id & 7; *(LAS v4u*)(L + O_K + c * KP + ch * 16) = pk[n]; *(LAS v4u*)(L + O_V + c * VP + ch * 16) = pv[n]; }
        bf16x8 qf[4];
#pragma unroll
        for (int ks = 0; ks < 4; ++ks) qf[ks] = qn[ks];
        __syncthreads();
        if (kr + 1 < nround) issue(QKV, DL_TASK(kr + 1), tid, pk, pv, qn);
        const int i0 = d.i0, g = d.g, sh = d.sh;
        const int qpos = d.res + ((i0 + 32 * w + r) << sh);
        f32x16 X[5];
#pragma unroll
        for (int kb = 0; kb < 5; ++kb) X[kb] = f32x16{};
        {
            LAS unsigned char* kbase = L + O_K + (32 * w + r) * KP + 8 * h * 2;
#pragma unroll
            for (int ks = 0; ks < 4; ++ks) {
                bf16x8 kf[5];
#pragma unroll
                for (int kb = 0; kb < 5; ++kb) kf[kb] = *(LAS bf16x8*)(kbase + 32 * kb * KP + 16 * ks * 2);
#pragma unroll
                for (int kb = 0; kb < 5; ++kb) X[kb] = MFMA32(kf[kb], qf[ks], X[kb]);
            }
        }
        float m = -INFINITY;
        const int kneg = 128 - i0 - 32 * w;
#pragma unroll
        for (int i = 0; i < 16; ++i) { const int c = crow(i, h);
            X[0][i] = (c >= r && c >= kneg) ? X[0][i] : -INFINITY; X[4][i] = (c <= r) ? X[4][i] : -INFINITY; }
        if (kneg > 32) {
#pragma unroll
            for (int kb = 1; kb < 4; ++kb)
#pragma unroll
                for (int i = 0; i < 16; ++i) X[kb][i] = (32 * kb + crow(i, h) >= kneg) ? X[kb][i] : -INFINITY;
        }
#pragma unroll
        for (int kb = 0; kb < 5; ++kb)
#pragma unroll
            for (int i = 0; i < 16; i += 2) m = fmaxf(m, fmaxf(X[kb][i], X[kb][i + 1]));
        m = fmaxf(m, shx(m, 32, lane));
        float l = 0.f;
#pragma unroll
        for (int kb = 0; kb < 5; ++kb)
#pragma unroll
            for (int i = 0; i < 16; ++i) { X[kb][i] = __builtin_amdgcn_exp2f(X[kb][i] - m); l += X[kb][i]; }
        l += shx(l, 32, lane);
        f32x16 y[2]; y[0] = f32x16{}; y[1] = f32x16{};
#pragma unroll
        for (int kb = 0; kb < 5; ++kb) {
            bf16x8 vf[2][2];
#pragma unroll
            for (int s2 = 0; s2 < 2; ++s2)
#pragma unroll
                for (int dt = 0; dt < 2; ++dt) vf[s2][dt] = trfrag(L + O_V, VP, 32 * w + 32 * kb + 16 * s2 + 4 * h, 8, 32 * dt, lane);
            const bf16x8 pb0 = pack8(X[kb], 0), pb1 = pack8(X[kb], 8);
            y[0] = MFMA32(vf[0][0], pb0, y[0]); y[1] = MFMA32(vf[0][1], pb0, y[1]); y[0] = MFMA32(vf[1][0], pb1, y[0]); y[1] = MFMA32(vf[1][1], pb1, y[1]);
        }
        const float inv = __builtin_amdgcn_rcpf(l);
        u16* ob = (g == 0 ? OBg0 : g == 1 ? OBg1 : OBg2) + (d.rowb + qpos) * 1024 + d.hd * 64;
#pragma unroll
        for (int dt = 0; dt < 2; ++dt)
#pragma unroll
            for (int gp = 0; gp < 2; ++gp) {
                const int ge = 2 * gp, go = 2 * gp + 1;
                unsigned e0 = pk2(y[dt][4 * ge] * inv, y[dt][4 * ge + 1] * inv), e1 = pk2(y[dt][4 * ge + 2] * inv, y[dt][4 * ge + 3] * inv);
                unsigned o0 = pk2(y[dt][4 * go] * inv, y[dt][4 * go + 1] * inv), o1 = pk2(y[dt][4 * go + 2] * inv, y[dt][4 * go + 3] * inv);
                const auto s0 = __builtin_amdgcn_permlane32_swap(e0, o0, false, false); const auto s1 = __builtin_amdgcn_permlane32_swap(e1, o1, false, false);
                const v4u wv = {s0[0], s1[0], s0[1], s1[1]};
                *(v4u*)(ob + 32 * dt + 8 * (2 * gp + h)) = wv; }
        if (h == 0) LSE[((size_t)g * MTOK + d.rowb + qpos) * 16 + d.hd] = (m + __log2f(l)) * 0.6931471805599453f;
        __syncthreads();
    }
}
}
__device__ __forceinline__ void dil_merge(const u16* OB0, const u16* OB1, const u16* OB2, const float* LSE, u16* MIX, int gw, int NGW, int lane) {
    const int hd = lane >> 2, dq = (lane & 3) * 16;
    for (int m = gw; m < MTOK; m += NGW) {
        const float l0 = LSE[((size_t)m) * 16 + hd], l1 = LSE[((size_t)MTOK + m) * 16 + hd], l2 = LSE[((size_t)2 * MTOK + m) * 16 + hd];
        const float mx = fmaxf(l0, fmaxf(l1, l2)); float w0 = __expf(l0 - mx), w1 = __expf(l1 - mx), w2 = __expf(l2 - mx); const float iz = 1.f / (w0 + w1 + w2); w0 *= iz; w1 *= iz; w2 *= iz;
        const size_t off = (size_t)m * 1024 + hd * 64 + dq;
#pragma unroll
        for (int j = 0; j < 2; ++j) { const v4u a = *(const v4u*)(OB0 + off + 8 * j), bq = *(const v4u*)(OB1 + off + 8 * j), c = *(const v4u*)(OB2 + off + 8 * j);
            const unsigned aw[4] = {a.x, a.y, a.z, a.w}, bw[4] = {bq.x, bq.y, bq.z, bq.w}, cw[4] = {c.x, c.y, c.z, c.w}; unsigned ow[4];
#pragma unroll
            for (int e = 0; e < 4; ++e) ow[e] = pk2(w0 * bflo(aw[e]) + w1 * bflo(bw[e]) + w2 * bflo(cw[e]), w0 * bfhi(aw[e]) + w1 * bfhi(bw[e]) + w2 * bfhi(cw[e]));
            *(v4u*)(MIX + off + 8 * j) = (v4u){ow[0], ow[1], ow[2], ow[3]}; }
    }
}
#ifndef HEAVY_ALIGN
#define HEAVY_ALIGN true
#endif
#ifndef REP_PRO
#define REP_PRO 1
#endif
#ifndef REP_P1
#define REP_P1 1
#endif
#ifndef REP_HGA
#define REP_HGA 1
#endif
#ifndef REP_HGC
#define REP_HGC 1
#endif
#ifndef REP_CMB
#define REP_CMB 1
#endif
#ifndef REP_DIL
#define REP_DIL 1
#endif
#ifndef REP_MRG
#define REP_MRG 1
#endif
#ifndef REP_P6
#define REP_P6 1
#endif
#ifndef REP_ATT
#define REP_ATT 1
#endif
#ifndef PH_LO
#define PH_LO 0
#endif
#ifndef PH_HI
#define PH_HI 100
#endif
__device__ __forceinline__ int fresh_lane() { int l; asm volatile("v_mbcnt_lo_u32_b32 %0, -1, 0\n\tv_mbcnt_hi_u32_b32 %0, -1, %0" : "=v"(l)); return l; }
__device__ __forceinline__ unsigned xcc_id() { return (unsigned)__builtin_amdgcn_s_getreg((3 << 11) | 20) & 0xFu; }
__device__ __forceinline__ unsigned bar_ld(unsigned* p) { return __hip_atomic_load(p, __ATOMIC_RELAXED, __HIP_MEMORY_SCOPE_AGENT); }
__device__ __forceinline__ unsigned bar_add(unsigned* p) { return __hip_atomic_fetch_add(p, 1u, __ATOMIC_RELAXED, __HIP_MEMORY_SCOPE_AGENT); }
__device__ __forceinline__ void grid_bar(unsigned* bar, unsigned k, unsigned x, unsigned nloc, unsigned nx, int wave0) {
    asm volatile("s_waitcnt vmcnt(0) lgkmcnt(0)" ::: "memory");
    __syncthreads();
    if (wave0 == 0) {
        const int ln = fresh_lane();
        if (ln == 0) {
            const unsigned old = bar_add(&bar[1024 + 64 * x]);
            if (old + 1u == k * nloc) {
                __builtin_amdgcn_fence(__ATOMIC_RELEASE, "agent");
                asm volatile("s_waitcnt vmcnt(0)" ::: "memory");
                const unsigned og = bar_add(&bar[3072]);
                if (og + 1u == k * nx) bar_add(&bar[3136]);
                else while (bar_ld(&bar[3136]) < k) __builtin_amdgcn_s_sleep(1);
                __builtin_amdgcn_fence(__ATOMIC_ACQUIRE, "agent");
                bar_add(&bar[2048 + 64 * x]);
                asm volatile("s_waitcnt vmcnt(0)" ::: "memory");
            } else {
                while (bar_ld(&bar[2048 + 64 * x]) < k) __builtin_amdgcn_s_sleep(1);
                __builtin_amdgcn_fence(__ATOMIC_ACQUIRE, "agent");
                asm volatile("s_waitcnt vmcnt(0)" ::: "memory");
            }
        }
    }
    __syncthreads();
}
template <bool ALIGN = true, class Epi>
__device__ __forceinline__ void run_gemm(LAS unsigned char* lds, const u16* A, const u16* Bt, int N, int K, const Epi& E, int tid) {
    asm volatile("" : "+v"(tid));
    pg8::Gemm g{A, Bt, MTOK, N, K}; int Gl = (int)gridDim.x, bxl = (int)blockIdx.x; asm volatile("" : "+s"(Gl), "+s"(bxl)); pg8::StaticOrder S; S.init(MTOK, N, Gl, bxl);
    pg8::gemm_phase<Epi, pg8::StaticOrder, ALIGN, PG8_SP2>(lds, g, S, E, tid);
}
__global__ void __launch_bounds__(512, 2) fwd_kernel(Args A) {
    extern __shared__ __attribute__((aligned(16))) unsigned char lds_raw[];
    LAS unsigned char* lds = (LAS unsigned char*)lds_raw;
    cg::grid_group grid = cg::this_grid();
    const int wave0 = __builtin_amdgcn_readfirstlane((int)threadIdx.x >> 6);
#define tid0 (wave0 * 64 + fresh_lane())
    const int G = gridDim.x, bx = blockIdx.x;
    const int vcu = (G % 8 == 0) ? (bx % 8) * (G / 8) + bx / 8 : bx;
    const int NGW = G * 8;
#define PHASE_IDS() int tid = tid0; asm volatile("" : "+v"(tid)); const int lane = tid & 63, wave = __builtin_amdgcn_readfirstlane(tid >> 6), gw = bx * 8 + wave; (void)lane; (void)gw;
    unsigned char* ws = A.ws;
    float* rowss0 = (float*)(ws + WS_ROWSS); float* stats0 = (float*)(ws + WS_STATS); const float* cvec0 = (const float*)(ws + WS_CVEC); const float* lbv = (const float*)(ws + WS_MISC); const float* cs = (const float*)(ws + WS_CS);
    u16* XB = (u16*)(ws + WS_XB); u16* MIX = (u16*)(ws + WS_MIX); u16* HB = (u16*)(ws + WS_HB); u16* AUX = (u16*)(ws + WS_AUX);
    float* HGS = (float*)(ws + WS_HGS); float* HGD = (float*)(ws + WS_HGD); float* LSE = (float*)(ws + WS_LSE); u16* OB1 = (u16*)(ws + WS_OB1);
    float* X = A.out;
    unsigned* barw = (unsigned*)(ws + WS_BAR); unsigned nbar = 0;
    const unsigned myx = xcc_id();
    if (threadIdx.x == 0) bar_add(&barw[64 * myx]);
    unsigned nloc = 1, nxc = 1;
#define GSYNC() do { ++nbar; grid_bar(barw, nbar, myx, nloc, nxc, wave0); } while (0)

    for (int rep_ = 0; rep_ < REP_PRO; ++rep_) { { PHASE_IDS(); prologue(A, lds, gw, NGW, wave, lane); } }
    grid.sync();
    { unsigned cnt = 0, mine = 0;
#pragma unroll
      for (unsigned jx = 0; jx < 16; ++jx) { const unsigned c = bar_ld(&barw[64 * jx]); cnt += (c > 0u) ? 1u : 0u; mine = (jx == myx) ? c : mine; }
      nloc = (unsigned)__builtin_amdgcn_readfirstlane((int)mine); nxc = (unsigned)__builtin_amdgcn_readfirstlane((int)cnt); }

    for (int l = 0; l < 2; ++l) {
        const u16* Ain = (l == 0) ? XB : (const u16*)X;
        if (l == 0) {
            for (int rep_ = 0; rep_ < REP_P1; ++rep_) { { pg8::EpiStore E{HB, NIN0, 0, 1024, 512, cs, nullptr, nullptr, nullptr}; run_gemm(lds, Ain, (const u16*)(ws + WS_WIN0), NIN0, 1024, E, tid0); } }
            GSYNC();
#ifndef NO_HGA
            for (int rep_ = 0; rep_ < REP_HGA; ++rep_) { for (int it = vcu; it < 256; it += G) { PHASE_IDS(); hg::item<false>(lds, HB, it, lbv, HGS, HGD, nullptr, nullptr, tid); } }
#endif
            GSYNC();
#ifndef NO_HGC
            for (int rep_ = 0; rep_ < REP_HGC; ++rep_) { for (int it = vcu; it < 256; it += G) { PHASE_IDS(); hg::item<true>(lds, HB, it, lbv, HGS, HGD, A.hg_norm_g, MIX, tid); } }
#endif
            __syncthreads();
            int Ga = G; asm volatile("" : "+s"(Ga));
            for (int rep_ = 0; rep_ < REP_ATT; ++rep_)
            for (int gi = vcu; gi < 512; gi += Ga) {
                int bhd, qb;
                if (Ga == 256) { bhd = vcu >> 4; const int j = vcu & 15; qb = (gi < 256) ? 31 - j : j; }
                else { bhd = gi >> 5; qb = 31 - (gi & 31); }
                const int b = bhd >> 2, hh = bhd & 3;
                for (int sub = 0; sub < 4; ++sub) {
                    int tidA = tid0; asm volatile("" : "+v"(tidA));
                    const int c = sub >> 1, half = sub & 1, vh = hh * 4 + sub;
#ifndef NO_ATTN
                    attn_body::attn_unit<8>(b, (2 * hh + c) * 64, 512 + (2 * hh + c) * 64, 1024 + hh * 128 + half * 64, vh * 64, qb,
                                            (const attn_body::bf16*)HB, (const attn_body::bf16*)HB, (const attn_body::bf16*)HB, (attn_body::bf16*)AUX, (char*)lds_raw, tidA);
#endif
                }
                asm volatile("s_waitcnt vmcnt(0)" ::: "memory");
                __syncthreads();
                { PHASE_IDS(); diff_combine_block(AUX, MIX, A.da_lambda, A.da_subln_g, (size_t)b * 8192 + (size_t)qb * 256, hh, tid); }
            }
            GSYNC();
        } else {
            { pg8::EpiStore E{HB, NIN1, 0, 2048, 1024, cs, nullptr, nullptr, nullptr}; run_gemm(lds, Ain, (const u16*)(ws + WS_WIN1), NIN1, 1024, E, tid0); }
            GSYNC();
#ifndef NO_DIL
            for (int rep_ = 0; rep_ < REP_DIL; ++rep_) { { PHASE_IDS(); dl::phase(lds, HB, AUX, OB1, XB, LSE, vcu, G, tid); } }
#endif
            GSYNC();
            for (int rep_ = 0; rep_ < REP_MRG; ++rep_) { { PHASE_IDS(); dil_merge(AUX, OB1, XB, LSE, MIX, gw, NGW, lane); } }
            GSYNC();
        }
        float* rowss = rowss0 + (size_t)l * MTOK; float* st1 = stats0 + (size_t)(2 * l) * MTOK * 2; float* st2 = stats0 + (size_t)(2 * l + 1) * MTOK * 2; const float* cv = cvec0 + l * 10240;
        { PHASE_IDS(); p_rows(A.p + (size_t)l * MTOK * PLE, AUX, gw, NGW, lane); }
        { pg8::EpiResid E{Ain, XB, nullptr, nullptr, nullptr, st1}; run_gemm<HEAVY_ALIGN>(lds, MIX, (const u16*)(ws + (l == 0 ? WS_WOUT0 : WS_WOUT1)), 1024, 1024, E, tid0); }
#ifdef PROBE_OUTP
        for (int q_ = 0; q_ < PROBE_OUTP; ++q_) { pg8::EpiStore E{HB + (size_t)64 * MiB, 1024, 0, 0, 0, cs, nullptr, nullptr, nullptr}; run_gemm(lds, MIX, (const u16*)(ws + WS_WOUT0), 1024, 1024, E, tid0); }
#endif
#ifdef PROBE_RESID
        { pg8::EpiResid E{XB, HB + (size_t)64 * MiB, st1, A.ln1_g, A.ln1_b, PROBE_RESID == 2 ? (float*)nullptr : (float*)(HB + (size_t)96 * MiB)}; run_gemm(lds, MIX, (const u16*)(ws + WS_WOUT0), 1024, 1024, E, tid0); }
#endif
        GSYNC();
        for (int rep_ = 0; rep_ < REP_P6; ++rep_) { pg8::EpiStore E{HB, FFD, 1, 0, 0, cs, st1, cv, cv + 4096}; run_gemm(lds, XB, (const u16*)(ws + WS_W1 + l * 8 * MiB), FFD, 1024, E, tid0); }
        { pg8::EpiE E{MIX, rowss}; run_gemm(lds, AUX, (const u16*)(ws + WS_WP + l * (MiB / 2)), 1024, PLE, E, tid0); }
        GSYNC();
#ifdef PROBE_EGEMM
        for (int q_ = 0; q_ < PROBE_EGEMM; ++q_) { pg8::EpiE E{AUX, (float*)(ws + WS_LSE)}; run_gemm(lds, AUX, (const u16*)(ws + WS_WP + l * (MiB / 2)), 1024, PLE, E, tid0); }
#endif
#ifdef PROBE_FFN2
        { pg8::EpiStore E{AUX, 1024, 0, 0, 0, cs, nullptr, nullptr, nullptr}; run_gemm(lds, HB, (const u16*)(ws + WS_W2 + l * 8 * MiB), 1024, FFD, E, tid0); }
#endif
        { pg8::EpiResid E{XB, XB, st1, A.ln1_g + l * 1024, A.ln1_b + l * 1024, st2}; run_gemm<HEAVY_ALIGN>(lds, HB, (const u16*)(ws + WS_W2 + l * 8 * MiB), 1024, FFD, E, tid0); }
        GSYNC();
        { pg8::EpiGate E{l == 0 ? (float*)nullptr : X, XB, st2, A.ln2_g + l * 1024, A.ln2_b + l * 1024, cv + 8192, cv + 9216, MIX, rowss, A.ple_norm_g + l * 1024, l == 0 ? (u16*)X : (u16*)nullptr}; run_gemm<HEAVY_ALIGN>(lds, XB, (const u16*)(ws + WS_WG + l * 2 * MiB), 1024, 1024, E, tid0); }
        if (l == 0) GSYNC();
    }
#ifdef PROBE_BARS
    for (int i = 0; i < PROBE_BARS; ++i) GSYNC();
#endif
}

extern "C" void kernel_launch(void* const* d_in, const int* in_sizes, int n_in, void* d_out, int out_size, void* d_ws, size_t ws_size, hipStream_t stream) {
    static int grid = 0;
    if (grid == 0) {
        if (n_in != 19 || out_size != MTOK * DMODEL || ws_size < WS_END) { fprintf(stderr, "kernel_launch: unexpected shapes (n_in %d, out %d, ws %zu)\n", n_in, out_size, ws_size); grid = -1; return; }
        int dev = 0, cus = 0, per_cu = 0;
        if (hipGetDevice(&dev) != hipSuccess || hipDeviceGetAttribute(&cus, hipDeviceAttributeMultiprocessorCount, dev) != hipSuccess) { grid = -1; return; }
        if (hipFuncSetAttribute((const void*)fwd_kernel, hipFuncAttributeMaxDynamicSharedMemorySize, LDS_BYTES) != hipSuccess) { fprintf(stderr, "kernel_launch: hipFuncSetAttribute failed\n"); grid = -1; return; }
        if (hipOccupancyMaxActiveBlocksPerMultiprocessor(&per_cu, (const void*)fwd_kernel, 512, LDS_BYTES) != hipSuccess || per_cu < 1) { fprintf(stderr, "kernel_launch: occupancy query says %d\n", per_cu); per_cu = 1; }
        (void)hipGetLastError();
        grid = cus * per_cu;
    }
    if (grid < 0) return;
    if (hipMemsetAsync((char*)d_ws, 0, WS_BAR + 16384, stream) != hipSuccess) { fprintf(stderr, "kernel_launch: memset failed\n"); return; }
    Args a{};
    const float** f = (const float**)&a;
    for (int i = 0; i < 19; ++i) f[i] = (const float*)d_in[i];
    a.out = (float*)d_out; a.ws = (unsigned char*)d_ws;
    void* args[] = {&a};
    hipError_t e = hipLaunchCooperativeKernel((const void*)fwd_kernel, dim3(grid), dim3(512), args, LDS_BYTES, stream);
    if (e != hipSuccess) fprintf(stderr, "cooperative launch failed: %s (grid %d)\n", hipGetErrorString(e), grid);
}
```

```cpp
#include <hip/hip_runtime.h>
#include <hip/hip_cooperative_groups.h>
#include <cstdio>
#include <cstdint>
namespace cg = cooperative_groups;
namespace pg8 {
#define PG8_LAS __attribute__((address_space(3)))
typedef unsigned short bf16_t;
typedef short bf16x8 __attribute__((ext_vector_type(8)));
typedef float f32x4 __attribute__((ext_vector_type(4)));
typedef unsigned u32x4 __attribute__((ext_vector_type(4)));
constexpr int BM = 256, BK = 64, HALF = 128, HTB = HALF * BK * 2  , STAGE_BYTES = 8 * HTB, NXCD = 8, WGM = 8;

__host__ __device__ __forceinline__ int lds_byte(int r, int c) { const int st = (r >> 4) * 2 + (c >> 5), rr = r & 15, cc = c & 31, ob = rr * 64 + cc * 2; return st * 1024 + (ob ^ (((ob >> 9) & 1) << 5)); }
__host__ __device__ __forceinline__ void stage_rc(int b, int& R, int& C) { const int st = b / 1024, sb = b % 1024, swz = sb ^ (((sb >> 9) & 1) << 5); R = (st >> 1) * 16 + swz / 64; C = (st & 1) * 32 + (swz % 64) / 2; }
__host__ __device__ __forceinline__ int perm32(int rho) { const int n = rho >> 4, i = rho & 15; return 8 * (i >> 2) + 4 * n + (i & 3); }

struct Unit { int pm, pn; };
struct Gemm { const bf16_t* A; const bf16_t* Bt; int M, N, K; };

struct StaticOrder {
    int nM, nN, nwg, G, c;
    __host__ __device__ void init(int M, int N, int G_, int c_) { nM = M / BM; nN = N / BM; nwg = nM * nN; G = G_; c = c_; }
    __host__ __device__ bool next(int i, Unit& u) const {
        const long L = (long)i * G + c; if (L >= nwg) return false;
        int wgid = (int)L; { const int q = nwg / NXCD, r = nwg % NXCD, xcd = wgid % NXCD, off = wgid / NXCD; wgid = (xcd < r ? xcd * (q + 1) : r * (q + 1) + (xcd - r) * q) + off; }
        const int nig = WGM * nN, gid = wgid / nig, fm = gid * WGM, gsz = (nM - fm) < WGM ? (nM - fm) : WGM;
        u.pm = fm + ((wgid % nig) % gsz); u.pn = (wgid % nig) / gsz; return true;
    }
    __device__ __forceinline__ void a_ready(const Unit&) const {}
    __device__ __forceinline__ void done(const Unit&) const {}
};

__device__ __forceinline__ unsigned cvt_pk_bf16(float lo, float hi) { unsigned r; asm volatile("v_cvt_pk_bf16_f32 %0, %1, %2" : "=v"(r) : "v"(lo), "v"(hi)); return r; }
typedef float f32x2 __attribute__((ext_vector_type(2)));
template <class Epi, class Sched, bool ALIGN_EPI = false, bool SP2 = false>
__device__ __forceinline__ void gemm_phase(PG8_LAS unsigned char* lds, const Gemm g, const Sched& S, const Epi& E, const int tid_in) {
    const int tid = tid_in, wid = __builtin_amdgcn_readfirstlane(tid >> 6), lane = tid & 63, wr = wid >> 2, wc = wid & 3, fr = lane & 15, fq = lane >> 4;
    const int K = g.K, nt = K / BK;
    unsigned voffA[2], voffB[2];
#pragma unroll
    for (int i = 0; i < 2; ++i) { int R, C; stage_rc(tid * 16 + i * 8192, R, C); const int Rb = Epi::PERM ? ((R & ~31) + perm32(R & 31)) : R;
        voffA[i] = (unsigned)(R * K + C) * 2u; voffB[i] = (unsigned)(Rb * K + C) * 2u; }
    const size_t kstep = (size_t)(BK * 2);
    const size_t hstep = (size_t)HALF * K * 2;
    const size_t tstep = 2 * hstep;
    const unsigned ldsw = (unsigned)wid * 1024u;
    const int aoff = lds_byte(wr * 64 + fr, fq * 8), boff = lds_byte(wc * 32 + fr, fq * 8);
#define PG8_SA(b, h) (((b) * 2 + (h)) * HTB)
#define PG8_SB(b, h) ((4 + (b) * 2 + (h)) * HTB)
#define PG8_STAGE(bufoff, gbase, voff) do { _Pragma("unroll") for (int _i = 0; _i < 2; ++_i) \
        __builtin_amdgcn_global_load_lds((const unsigned*)((const char*)(gbase) + (voff)[_i]), (PG8_LAS unsigned*)(lds + (bufoff) + ldsw + _i * 8192), 16, 0, 0); } while (0)
#define PG8_LDA(dst, b, h) do { _Pragma("unroll") for (int m = 0; m < 4; ++m) _Pragma("unroll") for (int k = 0; k < 2; ++k) dst[m][k] = *(const PG8_LAS bf16x8*)(lds + PG8_SA(b, h) + aoff + m * 2048 + k * 1024); } while (0)
#define PG8_LDB(dst, b, h) do { _Pragma("unroll") for (int n = 0; n < 2; ++n) _Pragma("unroll") for (int k = 0; k < 2; ++k) dst[n][k] = *(const PG8_LAS bf16x8*)(lds + PG8_SB(b, h) + boff + n * 2048 + k * 1024); } while (0)
#define PG8_MMA(ai, bj, At, Bt) do { __builtin_amdgcn_s_setprio(1); _Pragma("unroll") for (int m = 0; m < 4; ++m) _Pragma("unroll") for (int n = 0; n < 2; ++n) _Pragma("unroll") for (int k = 0; k < 2; ++k) \
        acc[ai][bj][m][n] = __builtin_amdgcn_mfma_f32_16x16x32_bf16(Bt[n][k], At[m][k], acc[ai][bj][m][n], 0, 0, 0); __builtin_amdgcn_s_setprio(0); } while (0)
#define PG8_WAIT_V(n) asm volatile("s_waitcnt vmcnt(" #n ")" ::: "memory")
#define PG8_WAIT_L(n) asm volatile("s_waitcnt lgkmcnt(" #n ")" ::: "memory")
#define PG8_BAR __builtin_amdgcn_s_barrier()
#define PG8_SCHED __builtin_amdgcn_sched_barrier(0)
    Unit cur, nxt; int ui = 0;
    if (!S.next(0, cur)) return;
    f32x4 acc[2][2][4][2];
#pragma unroll
    for (int a = 0; a < 2; ++a)
#pragma unroll
        for (int b = 0; b < 2; ++b)
#pragma unroll
            for (int m = 0; m < 4; ++m)
#pragma unroll
                for (int n = 0; n < 2; ++n) acc[a][b][m][n] = (f32x4){0.f, 0.f, 0.f, 0.f};
    bf16x8 At[4][2], B0[2][2], B1[2][2];
    const char* cA = (const char*)g.A + (size_t)cur.pm * tstep; const char* cB = (const char*)g.Bt + (size_t)cur.pn * tstep;
    S.a_ready(cur);
    if constexpr (SP2) {
        PG8_STAGE(PG8_SB(0, 0), cB, voffB); PG8_STAGE(PG8_SB(0, 1), cB + hstep, voffB); PG8_STAGE(PG8_SA(0, 0), cA, voffA); PG8_STAGE(PG8_SA(0, 1), cA + hstep, voffA);
        if (wr == 1) PG8_BAR;
        PG8_WAIT_V(2); PG8_BAR;
        PG8_STAGE(PG8_SB(1, 0), cB + kstep, voffB); PG8_STAGE(PG8_SA(1, 0), cA + kstep, voffA); PG8_STAGE(PG8_SB(1, 1), cB + hstep + kstep, voffB);
        PG8_WAIT_V(6); PG8_BAR;
    } else {
        PG8_STAGE(PG8_SB(0, 0), cB, voffB); PG8_STAGE(PG8_SA(0, 0), cA, voffA); PG8_STAGE(PG8_SB(0, 1), cB + hstep, voffB); PG8_STAGE(PG8_SA(0, 1), cA + hstep, voffA);
        if (wr == 1) PG8_BAR;
        PG8_WAIT_V(4); PG8_BAR;
        PG8_STAGE(PG8_SB(1, 0), cB + kstep, voffB); PG8_STAGE(PG8_SA(1, 0), cA + kstep, voffA); PG8_STAGE(PG8_SB(1, 1), cB + hstep + kstep, voffB);
        PG8_WAIT_V(6); PG8_BAR;
    }
    for (;;) {
        const bool has_next = S.next(ui + 1, nxt);
        const char* nA = has_next ? (const char*)g.A + (size_t)nxt.pm * tstep : cA; const char* nB = has_next ? (const char*)g.Bt + (size_t)nxt.pn * tstep : cB;
        for (int t = 0; t < nt; t += 2) {
            const bool last = (t == nt - 2);
            const char* a1 = cA + (size_t)(t + 1) * kstep;
            const char* a2 = last ? nA : cA + (size_t)(t + 2) * kstep; const char* b2 = last ? nB : cB + (size_t)(t + 2) * kstep;
            const char* a3 = a2 + kstep; const char* b3 = b2 + kstep;
            if (last && has_next) S.a_ready(nxt);
            if constexpr (SP2) {
            PG8_LDB(B0, 0, 0); PG8_LDB(B1, 0, 1); PG8_SCHED; PG8_LDA(At, 0, 0); PG8_STAGE(PG8_SA(1, 1), a1 + hstep, voffA);
            PG8_WAIT_V(8); PG8_WAIT_L(0); PG8_BAR; PG8_MMA(0, 0, At, B0); PG8_MMA(0, 1, At, B1); PG8_BAR; PG8_SCHED;
            PG8_LDA(At, 0, 1); PG8_STAGE(PG8_SB(0, 0), b2, voffB); PG8_STAGE(PG8_SB(0, 1), b2 + hstep, voffB); PG8_STAGE(PG8_SA(0, 0), a2, voffA);
            PG8_WAIT_V(8); PG8_WAIT_L(0); PG8_BAR; PG8_MMA(1, 0, At, B0); PG8_MMA(1, 1, At, B1); PG8_BAR; PG8_SCHED;
            PG8_LDB(B0, 1, 0); PG8_LDB(B1, 1, 1); PG8_SCHED; PG8_LDA(At, 1, 0); PG8_STAGE(PG8_SA(0, 1), a2 + hstep, voffA);
            PG8_WAIT_V(8); PG8_WAIT_L(0); PG8_BAR; PG8_MMA(0, 0, At, B0); PG8_MMA(0, 1, At, B1); PG8_BAR; PG8_SCHED;
            PG8_LDA(At, 1, 1); PG8_STAGE(PG8_SB(1, 0), b3, voffB); PG8_STAGE(PG8_SB(1, 1), b3 + hstep, voffB); PG8_STAGE(PG8_SA(1, 0), a3, voffA);
            PG8_WAIT_V(8); PG8_WAIT_L(0); PG8_BAR; PG8_MMA(1, 0, At, B0); PG8_MMA(1, 1, At, B1); PG8_BAR; PG8_SCHED;
            } else {
            PG8_LDB(B0, 0, 0); PG8_SCHED; PG8_LDA(At, 0, 0); PG8_STAGE(PG8_SA(1, 1), a1 + hstep, voffA);
            PG8_WAIT_L(8); PG8_BAR; PG8_WAIT_L(0); PG8_MMA(0, 0, At, B0); PG8_BAR; PG8_SCHED;
            PG8_LDB(B1, 0, 1); PG8_STAGE(PG8_SB(0, 0), b2, voffB);
            PG8_BAR; PG8_WAIT_L(0); PG8_MMA(0, 1, At, B1); PG8_BAR;
            PG8_LDA(At, 0, 1); PG8_STAGE(PG8_SA(0, 0), a2, voffA);
            PG8_BAR; PG8_WAIT_L(0); PG8_MMA(1, 0, At, B0); PG8_BAR; PG8_SCHED;
            PG8_STAGE(PG8_SB(0, 1), b2 + hstep, voffB);
            PG8_WAIT_V(6); PG8_BAR; PG8_MMA(1, 1, At, B1); PG8_BAR;
            PG8_LDB(B0, 1, 0); PG8_SCHED; PG8_LDA(At, 1, 0); PG8_STAGE(PG8_SA(0, 1), a2 + hstep, voffA);
            PG8_WAIT_L(8); PG8_BAR; PG8_WAIT_L(0); PG8_MMA(0, 0, At, B0); PG8_BAR; PG8_SCHED;
            PG8_LDB(B1, 1, 1); PG8_STAGE(PG8_SB(1, 0), b3, voffB);
            PG8_BAR; PG8_WAIT_L(0); PG8_MMA(0, 1, At, B1); PG8_BAR;
            PG8_LDA(At, 1, 1); PG8_STAGE(PG8_SA(1, 0), a3, voffA);
            PG8_BAR; PG8_WAIT_L(0); PG8_MMA(1, 0, At, B0); PG8_BAR; PG8_SCHED;
            PG8_STAGE(PG8_SB(1, 1), b3 + hstep, voffB);
            PG8_WAIT_V(6); PG8_BAR; PG8_MMA(1, 1, At, B1); PG8_BAR;
            }
        }
        if constexpr (ALIGN_EPI) { if (wr == 0) PG8_BAR; }
        if constexpr (!Epi::AFTER_DRAIN) { E(acc, cur, wr, wc, fr, fq); S.done(cur); }
        if (!has_next) break;
#pragma unroll
        for (int a = 0; a < 2; ++a)
#pragma unroll
            for (int b = 0; b < 2; ++b)
#pragma unroll
                for (int m = 0; m < 4; ++m)
#pragma unroll
                    for (int n = 0; n < 2; ++n) acc[a][b][m][n] = (f32x4){0.f, 0.f, 0.f, 0.f};
        cur = nxt; cA = nA; cB = nB; ++ui;
        if constexpr (ALIGN_EPI) { if (wr == 1) PG8_BAR; }
    }
    PG8_WAIT_V(0);
    if constexpr (!ALIGN_EPI) { if (wr == 0) PG8_BAR; }
    PG8_BAR;
    if constexpr (Epi::AFTER_DRAIN) { E.fused(acc, cur, wr, wc, fr, fq, lds, wid, lane); S.done(cur); }
#undef PG8_SA
#undef PG8_SB
#undef PG8_STAGE
#undef PG8_LDA
#undef PG8_LDB
#undef PG8_MMA
#undef PG8_WAIT_V
#undef PG8_WAIT_L
#undef PG8_BAR
#undef PG8_SCHED
}
}
namespace pg8 {
__device__ __forceinline__ float shx(float v, int m, int lane) { return __builtin_bit_cast(float, __builtin_amdgcn_ds_bpermute((lane ^ m) << 2, __builtin_bit_cast(int, v))); }
constexpr float QSCALE = 0.125f * 1.4426950408889634f;
struct EpiStore {
    static constexpr bool PERM = true, AFTER_DRAIN = false;
    bf16_t* O; int ldc; int act; int rope_cols; int scale_cols; const float* cs;
    const float* st; const float* c1; const float* c2;
    __device__ __forceinline__ void operator()(f32x4 (&acc)[2][2][4][2], const Unit& u, int wr, int wc, int fr, int fq) const {
        { int ln_; asm volatile("v_mbcnt_lo_u32_b32 %0, -1, 0\n\tv_mbcnt_hi_u32_b32 %0, -1, %0" : "=v"(ln_)); fr = ln_ & 15; fq = ln_ >> 4; }
        const int row0 = u.pm * BM + wr * 64 + fr; const int colt = u.pn * BM;
        const int col0 = colt + wc * 32 + 8 * fq;
        if (colt < rope_cols && (wc & 1) == 0) {
            const float sgn = fq == 0 ? -1.f : 1.f; const int lane = fq * 16 + fr;
            const int fqc = fq & 1;
#pragma unroll
            for (int ai = 0; ai < 2; ++ai)
#pragma unroll
                for (int m = 0; m < 4; ++m) {
                    const int pos = (row0 + ai * HALF + m * 16) & 8191;
                    const float* cp = cs + pos * 8;
#pragma unroll
                    for (int n = 0; n < 2; ++n) {
                        const f32x4 cv = *(const f32x4*)(cp + 4 * n), sv = *(const f32x4*)(cp + 65536 + 4 * n);
#pragma unroll
                        for (int bj = 0; bj < 2; ++bj)
#pragma unroll
                            for (int e = 0; e < 4; ++e) {
                                const float v = acc[ai][bj][m][n][e]; const float pv = shx(v, 16, lane);
                                const float nv = v * cv[e] + sgn * pv * sv[e];
                                acc[ai][bj][m][n][e] = (fq < 2) ? nv : v;
                            }
                        asm volatile("" ::: "memory");
                    }
                }
            (void)fqc;
        }
        if (st) {
            float muv[2][4], rsv[2][4];
#pragma unroll
            for (int ai = 0; ai < 2; ++ai)
#pragma unroll
                for (int m = 0; m < 4; ++m) { const int row = row0 + ai * HALF + m * 16; const f32x2 sv = *(const f32x2*)(st + 2 * row); muv[ai][m] = sv.x; rsv[ai][m] = sv.y; }
#pragma unroll
            for (int ai = 0; ai < 2; ++ai)
#pragma unroll
                for (int m = 0; m < 4; ++m) { const float mu = muv[ai][m] * (1.f / 1024.f); rsv[ai][m] = __builtin_amdgcn_rsqf(rsv[ai][m] * (1.f / 1024.f) - mu * mu + 1e-5f); muv[ai][m] = mu; }
#pragma unroll
            for (int bj = 0; bj < 2; ++bj) {
                const f32x4 c1a = *(const f32x4*)(c1 + col0 + bj * HALF), c1b = *(const f32x4*)(c1 + col0 + bj * HALF + 4), c2a = *(const f32x4*)(c2 + col0 + bj * HALF), c2b = *(const f32x4*)(c2 + col0 + bj * HALF + 4);
#pragma unroll
                for (int ai = 0; ai < 2; ++ai)
#pragma unroll
                    for (int m = 0; m < 4; ++m) { const float mu = muv[ai][m], rstd = rsv[ai][m];
                        acc[ai][bj][m][0] = (acc[ai][bj][m][0] - mu * c1a) * rstd + c2a; acc[ai][bj][m][1] = (acc[ai][bj][m][1] - mu * c1b) * rstd + c2b; }
            }
        }
        const float sc = (colt < scale_cols) ? QSCALE : 1.f;
#pragma unroll
        for (int ai = 0; ai < 2; ++ai)
#pragma unroll
            for (int m = 0; m < 4; ++m) { bf16_t* rowp = O + (size_t)(row0 + ai * HALF + m * 16) * ldc + col0;
#pragma unroll
                for (int bj = 0; bj < 2; ++bj) { f32x4 v0 = acc[ai][bj][m][0], v1 = acc[ai][bj][m][1];
                    if (act == 1) {
#pragma unroll
                        for (int e = 0; e < 4; ++e) { float a = fmaxf(v0[e], 0.f), b = fmaxf(v1[e], 0.f); v0[e] = a * a; v1[e] = b * b; } }
                    v0 = v0 * sc; v1 = v1 * sc; u32x4 w; w.x = cvt_pk_bf16(v0[0], v0[1]); w.y = cvt_pk_bf16(v0[2], v0[3]); w.z = cvt_pk_bf16(v1[0], v1[1]); w.w = cvt_pk_bf16(v1[2], v1[3]);
                    *(u32x4*)(rowp + bj * HALF) = w; } }
    }
};
struct EpiResid {
    static constexpr bool PERM = true, AFTER_DRAIN = false;
    const bf16_t* xinb; bf16_t* outb; const float* st_in; const float* g; const float* b; float* st_out;
    __device__ __forceinline__ void operator()(f32x4 (&acc)[2][2][4][2], const Unit& u, int wr, int wc, int fr, int fq) const {
        { int ln_; asm volatile("v_mbcnt_lo_u32_b32 %0, -1, 0\n\tv_mbcnt_hi_u32_b32 %0, -1, %0" : "=v"(ln_)); fr = ln_ & 15; fq = ln_ >> 4; }
        const int lane = fq * 16 + fr;
        const int col0 = u.pn * BM + wc * 32 + 8 * fq;
        f32x4 gv[2][2], bv[2][2];
        if (st_in) {
#pragma unroll
            for (int bj = 0; bj < 2; ++bj)
#pragma unroll
                for (int n = 0; n < 2; ++n) { gv[bj][n] = *(const f32x4*)(g + col0 + bj * HALF + n * 4); bv[bj][n] = *(const f32x4*)(b + col0 + bj * HALF + n * 4); } }
#pragma unroll
        for (int ai = 0; ai < 2; ++ai) {
            const int rowa = u.pm * BM + ai * HALF + wr * 64 + fr;
            float mu[4], rstd[4];
            u32x4 xw[4][2];
#pragma unroll
            for (int m = 0; m < 4; ++m)
#pragma unroll
                for (int bj = 0; bj < 2; ++bj) xw[m][bj] = *(const u32x4*)(xinb + (size_t)(rowa + m * 16) * 1024 + col0 + bj * HALF);
#pragma unroll
            for (int m = 0; m < 4; ++m) { mu[m] = 0.f; rstd[m] = 1.f;
                if (st_in) { const f32x2 sv = *(const f32x2*)(st_in + 2 * (rowa + m * 16)); mu[m] = sv.x * (1.f / 1024.f); rstd[m] = __builtin_amdgcn_rsqf(sv.y * (1.f / 1024.f) - mu[m] * mu[m] + 1e-5f); } }
#pragma unroll
            for (int m = 0; m < 4; ++m) { const int row = rowa + m * 16; const size_t off = (size_t)row * 1024 + col0;
                float s1 = 0.f, s2 = 0.f;
#pragma unroll
                for (int bj = 0; bj < 2; ++bj) { const u32x4 w0 = xw[m][bj];
                    f32x4 xa = {__uint_as_float(w0.x << 16), __uint_as_float(w0.x & 0xffff0000u), __uint_as_float(w0.y << 16), __uint_as_float(w0.y & 0xffff0000u)};
                    f32x4 xb2 = {__uint_as_float(w0.z << 16), __uint_as_float(w0.z & 0xffff0000u), __uint_as_float(w0.w << 16), __uint_as_float(w0.w & 0xffff0000u)};
                    if (st_in) { xa = (xa - mu[m]) * rstd[m] * gv[bj][0] + bv[bj][0]; xb2 = (xb2 - mu[m]) * rstd[m] * gv[bj][1] + bv[bj][1]; }
                    const f32x4 ya = xa * 1.4142135623730951f + acc[ai][bj][m][0], yb2 = xb2 * 1.4142135623730951f + acc[ai][bj][m][1];
                    u32x4 w; w.x = cvt_pk_bf16(ya[0], ya[1]); w.y = cvt_pk_bf16(ya[2], ya[3]); w.z = cvt_pk_bf16(yb2[0], yb2[1]); w.w = cvt_pk_bf16(yb2[2], yb2[3]);
                    *(u32x4*)(outb + off + bj * HALF) = w;
                    s1 += ((ya[0] + ya[1]) + (ya[2] + ya[3])) + ((yb2[0] + yb2[1]) + (yb2[2] + yb2[3]));
                    s2 += ((ya[0] * ya[0] + ya[1] * ya[1]) + (ya[2] * ya[2] + ya[3] * ya[3])) + ((yb2[0] * yb2[0] + yb2[1] * yb2[1]) + (yb2[2] * yb2[2] + yb2[3] * yb2[3])); }
                s1 += shx(s1, 16, lane); s1 += shx(s1, 32, lane); s2 += shx(s2, 16, lane); s2 += shx(s2, 32, lane);
                if (fq == 0 && st_out) { atomicAdd(st_out + 2 * row, s1); atomicAdd(st_out + 2 * row + 1, s2); } }
            asm volatile("" ::: "memory");
        }
    }
};
struct EpiE {
    static constexpr bool PERM = true, AFTER_DRAIN = false;
    bf16_t* O; float* rowss;
    __device__ __forceinline__ void operator()(f32x4 (&acc)[2][2][4][2], const Unit& u, int wr, int wc, int fr, int fq) const {
        { int ln_; asm volatile("v_mbcnt_lo_u32_b32 %0, -1, 0\n\tv_mbcnt_hi_u32_b32 %0, -1, %0" : "=v"(ln_)); fr = ln_ & 15; fq = ln_ >> 4; }
        const int row0 = u.pm * BM + wr * 64 + fr; const int col0 = u.pn * BM + wc * 32 + 8 * fq; const int lane = fq * 16 + fr;
#pragma unroll
        for (int ai = 0; ai < 2; ++ai)
#pragma unroll
            for (int m = 0; m < 4; ++m) { const int row = row0 + ai * HALF + m * 16; bf16_t* rowp = O + (size_t)row * 1024 + col0; float ss = 0.f;
#pragma unroll
                for (int bj = 0; bj < 2; ++bj) { const f32x4 v0 = acc[ai][bj][m][0], v1 = acc[ai][bj][m][1];
                    ss += (v0[0] * v0[0] + v0[1] * v0[1]) + (v0[2] * v0[2] + v0[3] * v0[3]) + (v1[0] * v1[0] + v1[1] * v1[1]) + (v1[2] * v1[2] + v1[3] * v1[3]);
                    u32x4 w; w.x = cvt_pk_bf16(v0[0], v0[1]); w.y = cvt_pk_bf16(v0[2], v0[3]); w.z = cvt_pk_bf16(v1[0], v1[1]); w.w = cvt_pk_bf16(v1[2], v1[3]);
                    *(u32x4*)(rowp + bj * HALF) = w; }
                ss += shx(ss, 16, lane); ss += shx(ss, 32, lane);
                if (fq == 0) atomicAdd(rowss + row, ss); }
    }
};
struct EpiGate {
    static constexpr bool PERM = true, AFTER_DRAIN = false;
    float* x; const bf16_t* yb; const float* st; const float* g2; const float* b2; const float* c1; const float* c2; const bf16_t* E; const float* rowss; const float* gp; bf16_t* xb;
    __device__ __forceinline__ void operator()(f32x4 (&acc)[2][2][4][2], const Unit& u, int wr, int wc, int fr, int fq) const {
        { int ln_; asm volatile("v_mbcnt_lo_u32_b32 %0, -1, 0\n\tv_mbcnt_hi_u32_b32 %0, -1, %0" : "=v"(ln_)); fr = ln_ & 15; fq = ln_ >> 4; }
        const int col0 = u.pn * BM + wc * 32 + 8 * fq;
#pragma unroll
        for (int ai = 0; ai < 2; ++ai)
#pragma unroll
        for (int mp = 0; mp < 2; ++mp) {
            const int rowa = u.pm * BM + ai * HALF + wr * 64 + mp * 32 + fr;
            u32x4 yw[2][2], ew[2][2]; float mu[2], rstd[2], rs[2];
#pragma unroll
            for (int m = 0; m < 2; ++m)
#pragma unroll
                for (int bj = 0; bj < 2; ++bj) { const size_t o2 = (size_t)(rowa + m * 16) * 1024 + col0 + bj * HALF; yw[m][bj] = *(const u32x4*)(yb + o2); ew[m][bj] = *(const u32x4*)(E + o2); }
#pragma unroll
            for (int m = 0; m < 2; ++m) { const int row = rowa + m * 16; const f32x2 sv = *(const f32x2*)(st + 2 * row); rs[m] = rowss[row]; mu[m] = sv.x; rstd[m] = sv.y; }
#pragma unroll
            for (int m = 0; m < 2; ++m) { rs[m] = __builtin_amdgcn_rsqf(rs[m] * (1.0f / 1024.0f) + 1e-5f); mu[m] *= (1.f / 1024.f); rstd[m] = __builtin_amdgcn_rsqf(rstd[m] * (1.f / 1024.f) - mu[m] * mu[m] + 1e-5f); }
#pragma unroll
            for (int bj = 0; bj < 2; ++bj) { const int c = col0 + bj * HALF;
                f32x4 gv[2], g2v[2], b2v[2], c1v[2], c2v[2];
#pragma unroll
                for (int n = 0; n < 2; ++n) { gv[n] = *(const f32x4*)(gp + c + 4 * n); g2v[n] = *(const f32x4*)(g2 + c + 4 * n); b2v[n] = *(const f32x4*)(b2 + c + 4 * n); c1v[n] = *(const f32x4*)(c1 + c + 4 * n); c2v[n] = *(const f32x4*)(c2 + c + 4 * n); }
#pragma unroll
                for (int m = 0; m < 2; ++m) { const size_t o2 = (size_t)(rowa + m * 16) * 1024 + c; f32x4 o[2];
#pragma unroll
                    for (int n = 0; n < 2; ++n) {
                        const unsigned y0 = n ? yw[m][bj].z : yw[m][bj].x, y1 = n ? yw[m][bj].w : yw[m][bj].y, e0 = n ? ew[m][bj].z : ew[m][bj].x, e1 = n ? ew[m][bj].w : ew[m][bj].y;
                        const f32x4 yv = {__uint_as_float(y0 << 16), __uint_as_float(y0 & 0xffff0000u), __uint_as_float(y1 << 16), __uint_as_float(y1 & 0xffff0000u)};
                        const f32x4 ef = {__uint_as_float(e0 << 16), __uint_as_float(e0 & 0xffff0000u), __uint_as_float(e1 << 16), __uint_as_float(e1 & 0xffff0000u)};
                        const f32x4 xv = (yv - mu[m]) * rstd[m] * g2v[n] + b2v[n];
                        const f32x4 a = (acc[ai][bj][2 * mp + m][n] - mu[m] * c1v[n]) * rstd[m] + c2v[n];
#pragma unroll
                        for (int e = 0; e < 4; ++e) o[n][e] = xv[e] + ef[e] * rs[m] * gv[n][e] * __builtin_amdgcn_rcpf(1.f + __expf(-a[e])); }
                    if (x) { *(f32x4*)(x + o2) = o[0]; *(f32x4*)(x + o2 + 4) = o[1]; }
                    if (xb) { u32x4 w; w.x = cvt_pk_bf16(o[0][0], o[0][1]); w.y = cvt_pk_bf16(o[0][2], o[0][3]); w.z = cvt_pk_bf16(o[1][0], o[1][1]); w.w = cvt_pk_bf16(o[1][2], o[1][3]); *(u32x4*)(xb + o2) = w; } } }
            asm volatile("" ::: "memory");
        }
    }
};
}
#define PG8_SP2 true
#define PG8_ALIGN true
#include <hip/hip_bf16.h>
#include <cmath>
namespace attn_body {
using bf16=__hip_bfloat16;
using bf16x8=__attribute__((ext_vector_type(8)))short;
using s16x4=__attribute__((ext_vector_type(4)))short;
using f32x16=__attribute__((ext_vector_type(16)))float;
using u32x4=__attribute__((ext_vector_type(4)))unsigned;
constexpr int SEQ=8192,D=64,DM=3584,DMO=1024;
constexpr int NW=8,QBLK=32,QB=QBLK*NW,KVBLK=64,NQB=SEQ/QB;
constexpr int ATTN_PITCH=DM, ATTN_UNIT_ROWS=QB;
__device__ __forceinline__ int crow(int r,int hi){return (r&3)+8*(r>>2)+4*hi;}
#define SBAR() __builtin_amdgcn_sched_barrier(0)
__device__ __forceinline__ void cmask(f32x16&p0,f32x16&p1,int jb,int qrel,int hi){
  const float NEG=-INFINITY; int kb=64*jb+4*hi;
  #pragma unroll
  for(int r=0;r<16;++r){int kv=kb+(r&3)+8*(r>>2); if(kv>qrel)p0[r]=NEG; if(kv+32>qrel)p1[r]=NEG;}
}

constexpr int NSLOT=3, SLOTB=8192;
constexpr int LDS_K=0, LDS_V=NSLOT*SLOTB, LDS_WS=2*NSLOT*SLOTB, LDS_OST=LDS_WS+NW*64*4, LDS_BYTES=LDS_OST+NW*4096;
constexpr float C2=0.125f*1.4426950408889634f;
__device__ __forceinline__ void glds16(const void*gsrc,unsigned lds_dst){unsigned keep;
  asm volatile("s_mov_b32 %0, m0\n\ts_mov_b32 m0, %2\n\ts_nop 0\n\tglobal_load_lds_dwordx4 %1, off\n\ts_mov_b32 m0, %0":"=&s"(keep):"v"(gsrc),"s"(lds_dst):"memory");}
__device__ __forceinline__ float max3f(float a,float b,float c){float r;asm("v_max3_f32 %0, %1, %2, %3":"=v"(r):"v"(a),"v"(b),"v"(c));return r;}
__device__ __forceinline__ float max2f(float a,float b){float r;asm("v_max_f32_e32 %0, %1, %2":"=v"(r):"v"(a),"v"(b));return r;}
__device__ __forceinline__ float fadd_s(float a,float b){float r;asm("v_add_f32_e32 %0, %1, %2":"=v"(r):"v"(a),"v"(b));return r;}
__device__ __forceinline__ float fsub_s(float a,float b){float r;asm("v_sub_f32_e32 %0, %1, %2":"=v"(r):"v"(a),"v"(b));return r;}
typedef float f32x2_t __attribute__((ext_vector_type(2))); typedef __bf16 bf16x2_t __attribute__((ext_vector_type(2)));
__device__ __forceinline__ unsigned cvtpk_s(float lo,float hi){f32x2_t v={lo,hi};bf16x2_t b=__builtin_convertvector(v,bf16x2_t);return __builtin_bit_cast(unsigned,b);}
#define WAIT_BAR(N) asm volatile("s_waitcnt vmcnt(" #N ") lgkmcnt(0)\n\ts_barrier":::"memory")

__device__ __forceinline__ void qkt(f32x16&p0,f32x16&p1,const char*Kslot,const bf16x8*qr,const f32x16&negm,int r32,int hi){
  const char*kb=Kslot+hi*1024+r32*16;
  #pragma unroll
  for(int d0=0;d0<4;++d0){
    const bf16x8 b0=*reinterpret_cast<const bf16x8*>(kb+d0*2048);
    const bf16x8 b1=*reinterpret_cast<const bf16x8*>(kb+d0*2048+512);
    if(d0==0){p0=__builtin_amdgcn_mfma_f32_32x32x16_bf16(b0,qr[0],negm,0,0,0);p1=__builtin_amdgcn_mfma_f32_32x32x16_bf16(b1,qr[0],negm,0,0,0);}
    else{p0=__builtin_amdgcn_mfma_f32_32x32x16_bf16(b0,qr[d0],p0,0,0,0);p1=__builtin_amdgcn_mfma_f32_32x32x16_bf16(b1,qr[d0],p1,0,0,0);}}
}
typedef __attribute__((address_space(3))) const char* lds_cptr;
typedef short v4i16_t __attribute__((ext_vector_type(4)));
__device__ __forceinline__ void kload8(bf16x8*kf,lds_cptr kp){
  kf[0]=*(const __attribute__((address_space(3))) bf16x8*)(kp);      kf[1]=*(const __attribute__((address_space(3))) bf16x8*)(kp+512);
  kf[2]=*(const __attribute__((address_space(3))) bf16x8*)(kp+2048); kf[3]=*(const __attribute__((address_space(3))) bf16x8*)(kp+2560);
  kf[4]=*(const __attribute__((address_space(3))) bf16x8*)(kp+4096); kf[5]=*(const __attribute__((address_space(3))) bf16x8*)(kp+4608);
  kf[6]=*(const __attribute__((address_space(3))) bf16x8*)(kp+6144); kf[7]=*(const __attribute__((address_space(3))) bf16x8*)(kp+6656);
}
__device__ __forceinline__ void kload2(bf16x8*kf,lds_cptr kp,int j){ kf[2*j]=*(const __attribute__((address_space(3))) bf16x8*)(kp+j*2048); kf[2*j+1]=*(const __attribute__((address_space(3))) bf16x8*)(kp+j*2048+512); }
__device__ __forceinline__ s16x4 vtr(lds_cptr p){ return __builtin_bit_cast(s16x4,__builtin_amdgcn_ds_read_tr16_b64_v4i16((__attribute__((address_space(3))) v4i16_t*)p)); }
__device__ __forceinline__ float rowmax(const f32x16&p0,const f32x16&p1){
  float a=max3f(p0[0],p0[1],p1[0]),b=max3f(p0[2],p0[3],p1[1]);a=max3f(a,p1[2],p1[3]);
  #pragma unroll
  for(int r=4;r<16;r+=4){a=max3f(a,p0[r],p0[r+1]);b=max3f(b,p0[r+2],p0[r+3]);a=max3f(a,p1[r],p1[r+1]);b=max3f(b,p1[r+2],p1[r+3]);}
  const float m=max2f(a,b);
  auto rr=__builtin_amdgcn_permlane32_swap(__float_as_uint(m),__float_as_uint(m),false,false);
  return max2f(__uint_as_float(rr[0]),__uint_as_float(rr[1]));
}
__device__ __forceinline__ void pv(f32x16*o,int vb,bf16x8 pa0,bf16x8 pa1,bf16x8 pa2,bf16x8 pa3){
  #pragma unroll
  for(int d0=0;d0<2;++d0){s16x4 lo[4],hi[4];
    #pragma unroll
    for(int ks=0;ks<4;++ks){
      asm volatile("ds_read_b64_tr_b16 %0,%1 offset:%c2":"=&v"(lo[ks]):"v"(vb),"i"(d0*4096+ks*1024):"memory");
      asm volatile("ds_read_b64_tr_b16 %0,%1 offset:%c2":"=&v"(hi[ks]):"v"(vb),"i"(d0*4096+ks*1024+512):"memory");}
    asm volatile("s_waitcnt lgkmcnt(0)":::"memory");SBAR();
    #define PK(k) (bf16x8){lo[k][0],lo[k][1],lo[k][2],lo[k][3],hi[k][0],hi[k][1],hi[k][2],hi[k][3]}
    o[d0]=__builtin_amdgcn_mfma_f32_32x32x16_bf16(pa0,PK(0),o[d0],0,0,0);
    o[d0]=__builtin_amdgcn_mfma_f32_32x32x16_bf16(pa1,PK(1),o[d0],0,0,0);
    o[d0]=__builtin_amdgcn_mfma_f32_32x32x16_bf16(pa2,PK(2),o[d0],0,0,0);
    o[d0]=__builtin_amdgcn_mfma_f32_32x32x16_bf16(pa3,PK(3),o[d0],0,0,0);
    #undef PK
  }
}

#ifndef ATTN_STORE16
#define ATTN_STORE16(p,v) (*(u32x4*)(p)=(v))
#endif
template<int THRL> __device__ __forceinline__ void attn_unit(int b,int colq,int colk,int colv,int colo,int qb,const bf16*Q,const bf16*__restrict__ K,const bf16*__restrict__ V,bf16*O,char*shm,const int tid_in){
  const int tid=tid_in,lane=tid&63,r32=lane&31,hi=lane>>5; const int wid=__builtin_amdgcn_readfirstlane(tid>>6);
  const long rowbase=(long)b*SEQ; const int q0=qb*QB;
  const bf16*Qw=Q+(rowbase+q0+wid*QBLK)*DM+colq;
  const bf16*Kh=K+rowbase*DM+colk,*Vh=V+rowbase*DM+colv;
  const unsigned lds0=(unsigned)(uintptr_t)shm;
  float*wsf=(float*)(shm+LDS_WS)+wid*64;
  const bf16*ksrc=Kh+(long)lane*DM+wid*8;
  const bf16*vsrc=Vh+(long)(16*(wid&3)+(lane>>2))*DM+(wid>>2)*32+(lane&3)*8;
  const unsigned kdst=lds0+LDS_K+wid*1024, vdst=lds0+LDS_V+wid*1024;
  #define DMA_K(t,slot) glds16(ksrc+(long)(t)*KVBLK*DM,(unsigned)__builtin_amdgcn_readfirstlane(kdst+(slot)))
  #define DMA_V(t,slot) glds16(vsrc+(long)(t)*KVBLK*DM,(unsigned)__builtin_amdgcn_readfirstlane(vdst+(slot)))
  const int vb0=(int)(lds0+LDS_V)+((lane>>4)&1)*32+(lane&3)*8+(4*hi+((lane&15)>>2))*64;
  const char*Kbase=shm+LDS_K; bf16x8 kf[8];
  const lds_cptr shm3=(lds_cptr)shm; const lds_cptr kp0=shm3+LDS_K+hi*1024+r32*16; const lds_cptr vp0=shm3+LDS_V+((lane>>4)&1)*32+(lane&3)*8+(4*hi+((lane&15)>>2))*64;
  const int NT=(q0+QB)/KVBLK;
  DMA_K(0,0);DMA_V(0,0);DMA_K(1,SLOTB);
  bf16x8 qr[4];
  #pragma unroll
  for(int d0=0;d0<4;++d0)qr[d0]=*reinterpret_cast<const bf16x8*>(&Qw[(long)r32*DM+d0*16+hi*8]);
  float mhat=0.f,l_reg=0.f;f32x16 o[2];o[0]=f32x16{};o[1]=f32x16{};f32x16 negm=f32x16{};asm volatile("":"+v"(negm));
  const int qrel=wid*QBLK+r32;
  #define CMASK(P0,P1,t) do{int jb_=(t)-(NT-4); if(jb_>=0)cmask(P0,P1,jb_,qrel,hi);}while(0)
  bool resc=false;
  #define START(P0,P1) do{ const float rm=rowmax(P0,P1); resc=false; \
    { const float dl=rm; mhat=fadd_s(mhat,dl); \
      _Pragma("unroll") for(int r=0;r<16;++r){P0[r]=fsub_s(P0[r],dl);P1[r]=fsub_s(P1[r],dl);} \
      _Pragma("unroll") for(int r=0;r<16;++r)negm[r]=-mhat; asm volatile("":"+v"(negm)); } \
    _Pragma("unroll") for(int r=0;r<16;++r)P0[r]=__builtin_amdgcn_exp2f(P0[r]); }while(0)
  #define RESC() do{ if(resc){ asm volatile("s_waitcnt lgkmcnt(0)":::"memory"); \
      _Pragma("unroll") for(int d_=0;d_<2;++d_) _Pragma("unroll") for(int r=0;r<16;++r)o[d_][r]*=wsf[crow(r,hi)]; } }while(0)
  f32x16 pA0,pA1,pB0,pB1;
  int sl_prev=0,sl_cur=0,sl_next=SLOTB;
  #define ROT() do{sl_prev=sl_cur;sl_cur=sl_next;sl_next=(sl_next==(NSLOT-1)*SLOTB)?0:sl_next+SLOTB;}while(0)
  DMA_K(2,2*SLOTB);
  WAIT_BAR(3);
  qkt(pA0,pA1,Kbase,qr,negm,r32,hi);asm volatile("s_nop 15\n\ts_nop 7":"+v"(pA0),"+v"(pA1));CMASK(pA0,pA1,0);
  START(pA0,pA1);
  _Pragma("unroll") for(int r=0;r<16;++r)pA1[r]=__builtin_amdgcn_exp2f(pA1[r]);
  WAIT_BAR(0);
  DMA_K(3,0);DMA_V(1,SLOTB);
  ROT();
  kload8(kf,kp0+sl_cur);
  WAIT_BAR(2);
  s16x4 vlo[8],vhi[8]; u32x4 pw0,pw1,pw2,pw3;
  #define PKW(P,B) cvtpk_s(P[B],P[B+1])
  #define PAF(k) __builtin_bit_cast(bf16x8,pw##k)
  #define VFR(i) (bf16x8){vlo[i][0],vlo[i][1],vlo[i][2],vlo[i][3],vhi[i][0],vhi[i][1],vhi[i][2],vhi[i][3]}
  #define PIN(x) asm volatile("":"+v"(x))
  #define MX3(a,b,c) __builtin_fmaxf(__builtin_fmaxf((a),(b)),(c))
  #define GAPA(MF,A0,A1,A2,A3,W0,W1,PW) do{ MF; sacc+=A0; sacc+=A1; sacc+=A2; sacc+=A3; PIN(sacc); W0; W1; PIN(PW); SBAR(); }while(0)
  #define EX(v) __builtin_amdgcn_exp2f(v)
  #define GAPB(MF,X,B) do{ MF; X[B]=EX(X[B]); X[B+1]=EX(X[B+1]); X[B+2]=EX(X[B+2]); X[B+3]=EX(X[B+3]); PIN(X); SBAR(); }while(0)
  #define VRD(i) do{ vlo[i]=vtr(vp_+(((i)>>2)*4096+((i)&3)*1024)); vhi[i]=vtr(vp_+(((i)>>2)*4096+((i)&3)*1024+512)); }while(0)
  #define KRD(G,j) do{ if(G){ kload2(kf,kp0+sl_next,j); SBAR(); } }while(0)
  #define STEP(C0,C1,P0,P1,t,GK,GV,GL) do{ SBAR(); \
    const lds_cptr vp_=vp0+sl_prev; \
    VRD(0); SBAR(); float sacc=(P0[0]+P0[1]); \
    GAPA(C0=__builtin_amdgcn_mfma_f32_32x32x16_bf16(kf[0],qr[0],negm,0,0,0), P0[2],P0[3],P0[4],P0[5],     pw0[0]=PKW(P0,0), pw0[1]=PKW(P0,2), pw0); \
    VRD(4); SBAR(); GAPA(C1=__builtin_amdgcn_mfma_f32_32x32x16_bf16(kf[1],qr[0],negm,0,0,0), P0[6],P0[7],P0[8],P0[9],     pw0[2]=PKW(P0,4), pw0[3]=PKW(P0,6), pw0); \
    VRD(1); SBAR(); GAPA(C0=__builtin_amdgcn_mfma_f32_32x32x16_bf16(kf[2],qr[1],C0,0,0,0),   P0[10],P0[11],P0[12],P0[13], pw1[0]=PKW(P0,8), pw1[1]=PKW(P0,10), pw1); \
    VRD(5); SBAR(); GAPA(C1=__builtin_amdgcn_mfma_f32_32x32x16_bf16(kf[3],qr[1],C1,0,0,0),   P0[14],P0[15],P1[0],P1[1],   pw1[2]=PKW(P0,12),pw1[3]=PKW(P0,14), pw1); \
    VRD(2); SBAR(); GAPA(C0=__builtin_amdgcn_mfma_f32_32x32x16_bf16(kf[4],qr[2],C0,0,0,0),   P1[2],P1[3],P1[4],P1[5],     pw2[0]=PKW(P1,0), pw2[1]=PKW(P1,2), pw2); \
    VRD(6); SBAR(); GAPA(C1=__builtin_amdgcn_mfma_f32_32x32x16_bf16(kf[5],qr[2],C1,0,0,0),   P1[6],P1[7],P1[8],P1[9],     pw2[2]=PKW(P1,4), pw2[3]=PKW(P1,6), pw2); \
    VRD(3); SBAR(); GAPA(C0=__builtin_amdgcn_mfma_f32_32x32x16_bf16(kf[6],qr[3],C0,0,0,0),   P1[10],P1[11],P1[12],P1[13], pw3[0]=PKW(P1,8), pw3[1]=PKW(P1,10), pw3); \
    VRD(7); SBAR(); GAPA(C1=__builtin_amdgcn_mfma_f32_32x32x16_bf16(kf[7],qr[3],C1,0,0,0),   P1[14],P1[15],0.f,0.f,       pw3[2]=PKW(P1,12),pw3[3]=PKW(P1,14), pw3); \
    l_reg+=sacc; \
    if(GK){DMA_K((t)+3,sl_cur);} if(GV){DMA_V((t)+1,sl_next);} \
    CMASK(C0,C1,t); \
    { float a=MX3(C0[0],C0[1],C1[0]),b=MX3(C0[2],C0[3],C1[1]); a=MX3(a,C1[2],C1[3]); \
      _Pragma("unroll") for(int r=4;r<16;r+=4){a=MX3(a,C0[r],C0[r+1]);b=MX3(b,C0[r+2],C0[r+3]);a=MX3(a,C1[r],C1[r+1]);b=MX3(b,C1[r+2],C1[r+3]);} \
      float rm=__builtin_fmaxf(a,b); { auto rr=__builtin_amdgcn_permlane32_swap(__float_as_uint(rm),__float_as_uint(rm),false,false); rm=__builtin_fmaxf(__uint_as_float(rr[0]),__uint_as_float(rr[1])); } \
      resc=false; \
      if(__builtin_expect(__any(rm>(float)THRL),0)){ const float dl=__builtin_fmaxf(rm,0.f); mhat+=dl; \
        _Pragma("unroll") for(int r=0;r<16;++r){C0[r]-=dl;C1[r]-=dl;} \
        _Pragma("unroll") for(int r=0;r<16;++r)negm[r]=-mhat; asm volatile("":"+v"(negm)); \
        const float f=__builtin_amdgcn_exp2f(-dl); l_reg*=f; if(hi==0)wsf[r32]=f; resc=true; } } \
    SBAR(); \
    GAPB(o[0]=__builtin_amdgcn_mfma_f32_32x32x16_bf16(PAF(0),VFR(0),o[0],0,0,0), C0,0); \
    GAPB(o[1]=__builtin_amdgcn_mfma_f32_32x32x16_bf16(PAF(0),VFR(4),o[1],0,0,0), C0,4); \
    KRD(GL,0); GAPB(o[0]=__builtin_amdgcn_mfma_f32_32x32x16_bf16(PAF(1),VFR(1),o[0],0,0,0), C0,8); \
    KRD(GL,1); GAPB(o[1]=__builtin_amdgcn_mfma_f32_32x32x16_bf16(PAF(1),VFR(5),o[1],0,0,0), C0,12); \
    KRD(GL,2); GAPB(o[0]=__builtin_amdgcn_mfma_f32_32x32x16_bf16(PAF(2),VFR(2),o[0],0,0,0), C1,0); \
    KRD(GL,3); GAPB(o[1]=__builtin_amdgcn_mfma_f32_32x32x16_bf16(PAF(2),VFR(6),o[1],0,0,0), C1,4); \
    GAPB(o[0]=__builtin_amdgcn_mfma_f32_32x32x16_bf16(PAF(3),VFR(3),o[0],0,0,0), C1,8); \
    GAPB(o[1]=__builtin_amdgcn_mfma_f32_32x32x16_bf16(PAF(3),VFR(7),o[1],0,0,0), C1,12); \
    }while(0)
  int t=1;
  #undef CMASK
  #define CMASK(P0,P1,t) do{}while(0)
  for(;t+5<NT;t+=2){
    STEP(pB0,pB1,pA0,pA1,t,true,true,true);     WAIT_BAR(2); RESC(); ROT();
    STEP(pA0,pA1,pB0,pB1,t+1,true,true,true);   WAIT_BAR(2); RESC(); ROT();
  }
  #undef CMASK
  #define CMASK(P0,P1,t) do{int jb_=(t)-(NT-4); if(jb_>=0)cmask(P0,P1,jb_,qrel,hi);}while(0)
  #define ENDW(tt) do{ if((tt)+3<NT){WAIT_BAR(2);} else if((tt)+2<NT){WAIT_BAR(1);} else {WAIT_BAR(0);} }while(0)
  for(;t+1<NT;t+=2){
    STEP(pB0,pB1,pA0,pA1,t,(t+3<NT),(t+1<NT),(t+1<NT));       ENDW(t);   RESC(); ROT();
    STEP(pA0,pA1,pB0,pB1,t+1,(t+4<NT),(t+2<NT),(t+2<NT));     ENDW(t+1); RESC(); ROT();
  }
  STEP(pB0,pB1,pA0,pA1,NT-1,false,false,false); RESC();
  { float sacc=pB0[0]+pB0[1]; _Pragma("unroll") for(int r=2;r<16;++r)sacc+=pB0[r]; _Pragma("unroll") for(int r=0;r<16;++r)sacc+=pB1[r]; l_reg+=sacc;
    pw0=(u32x4){PKW(pB0,0),PKW(pB0,2),PKW(pB0,4),PKW(pB0,6)};pw1=(u32x4){PKW(pB0,8),PKW(pB0,10),PKW(pB0,12),PKW(pB0,14)};pw2=(u32x4){PKW(pB1,0),PKW(pB1,2),PKW(pB1,4),PKW(pB1,6)};pw3=(u32x4){PKW(pB1,8),PKW(pB1,10),PKW(pB1,12),PKW(pB1,14)};
    SBAR(); pv(o,vb0+sl_cur,PAF(0),PAF(1),PAF(2),PAF(3)); }
  #undef PKW
  #undef PAF
  #undef VFR
  #undef PIN
  #undef MX3
  #undef GAPA
  #undef GAPB
  #undef EX
  #undef VRD
  #undef KRD
  #undef STEP
  #undef ENDW
  {auto rr=__builtin_amdgcn_permlane32_swap(__float_as_uint(l_reg),__float_as_uint(l_reg),false,false);l_reg=__uint_as_float(rr[0])+__uint_as_float(rr[1]);}
  if(hi==0)wsf[32+r32]=l_reg;asm volatile("s_waitcnt lgkmcnt(0)":::"memory");
  float rli[16];
  #pragma unroll
  for(int r=0;r<16;++r)rli[r]=__builtin_amdgcn_rcpf(wsf[32+crow(r,hi)]);
  bf16*Ow=O+(rowbase+q0+wid*QBLK)*DMO+colo;
  { bf16*stg=(bf16*)(shm+LDS_OST)+wid*2048;
    #pragma unroll
    for(int r=0;r<16;++r){const int orow=crow(r,hi);
      #pragma unroll
      for(int d0=0;d0<2;++d0)stg[orow*64+d0*32+r32]=__float2bfloat16(o[d0][r]*rli[r]);}
    asm volatile("s_waitcnt lgkmcnt(0)":::"memory");
    #pragma unroll
    for(int i=0;i<4;++i){const int row=i*8+(lane>>3),ch=lane&7; const u32x4 v=*(const u32x4*)(stg+row*64+ch*8); ATTN_STORE16(Ow+(long)row*DMO+ch*8,v);} }
  asm volatile("s_waitcnt lgkmcnt(0)\n\ts_barrier":::"memory");
  #undef DMA_K
  #undef DMA_V
  #undef CMASK
  #undef START
  #undef RESC
  #undef ROT
}
constexpr int ATTN_LDS_BYTES=LDS_BYTES;
#undef SBAR
#undef WAIT_BAR
}
#define LAS __attribute__((address_space(3)))
typedef unsigned short u16;
typedef unsigned v4u __attribute__((ext_vector_type(4)));
typedef unsigned v2u __attribute__((ext_vector_type(2)));
typedef float f32x4 __attribute__((ext_vector_type(4)));
typedef short bf16x8 __attribute__((ext_vector_type(8)));
typedef short s16x4 __attribute__((ext_vector_type(4)));
typedef float f32x16 __attribute__((ext_vector_type(16)));
typedef float f32x2_t __attribute__((ext_vector_type(2)));
typedef __bf16 bf16x2_t __attribute__((ext_vector_type(2)));

constexpr int MTOK = 32768, SEQL = 8192, DMODEL = 1024, FFD = 4096, NIN0 = 3584, NIN1 = 3072, PLE = 256;
constexpr float LN_EPS = 1e-5f;
constexpr float ALPHA = 1.4142135623730951f;
constexpr size_t MiB = 1u << 20;
constexpr size_t WS_CVEC = 0;
constexpr size_t WS_STATS = 62 * MiB;
constexpr size_t WS_ROWSS = 63 * MiB;
constexpr size_t WS_BAR = 256 * 1024;
constexpr size_t WS_MISC = 512 * 1024;
constexpr size_t WS_CS = 1 * MiB;
constexpr size_t WS_WIN0 = 2 * MiB, WS_WOUT0 = 9 * MiB, WS_WIN1 = 11 * MiB, WS_WOUT1 = 17 * MiB, WS_W1 = 19 * MiB  , WS_W2 = 35 * MiB  , WS_WP = 51 * MiB  , WS_WG = 52 * MiB  ;
constexpr size_t WS_LSE = 56 * MiB;
constexpr size_t WS_XB = 64 * MiB, WS_MIX = 128 * MiB, WS_HB = 192 * MiB, WS_AUX = 448 * MiB, WS_END = 512 * MiB;
constexpr size_t WS_HGS = 416 * MiB, WS_HGD = 432 * MiB;
constexpr size_t WS_OB1 = 384 * MiB;
constexpr int LDS_BYTES = 147456;

__device__ __forceinline__ unsigned f2bf(float f) { unsigned u = __builtin_bit_cast(unsigned, f); return (u + 0x7fffu + ((u >> 16) & 1u)) >> 16; }
__device__ __forceinline__ unsigned pk2(float lo, float hi) { f32x2_t v = {lo, hi}; bf16x2_t b = __builtin_convertvector(v, bf16x2_t); return __builtin_bit_cast(unsigned, b); }
__device__ __forceinline__ float bf2f(unsigned v) { return __uint_as_float(v << 16); }
__device__ __forceinline__ float bflo(unsigned w) { return __uint_as_float(w << 16); }
__device__ __forceinline__ float bfhi(unsigned w) { return __uint_as_float(w & 0xffff0000u); }
__device__ __forceinline__ float shx(float v, int m, int lane) { return __builtin_bit_cast(float, __builtin_amdgcn_ds_bpermute((lane ^ m) << 2, __builtin_bit_cast(int, v))); }
__device__ __forceinline__ float wave_sum(float v, int lane) {
#pragma unroll
    for (int o = 1; o < 64; o <<= 1) v += shx(v, o, lane);
    return v;
}
__device__ __forceinline__ int crow(int reg, int h) { return (reg & 3) + 8 * (reg >> 2) + 4 * h; }
#define MFMA32(a, b, c) __builtin_amdgcn_mfma_f32_32x32x16_bf16((a), (b), (c), 0, 0, 0)
__device__ __forceinline__ bf16x8 pack8(const f32x16& x, int base) {
    v4u p; p.x = pk2(x[base], x[base + 1]); p.y = pk2(x[base + 2], x[base + 3]); p.z = pk2(x[base + 4], x[base + 5]); p.w = pk2(x[base + 6], x[base + 7]);
    return __builtin_bit_cast(bf16x8, p);
}
typedef short v4i16_t __attribute__((ext_vector_type(4)));
__device__ __forceinline__ s16x4 trrd(LAS unsigned char* p) { return __builtin_bit_cast(s16x4, __builtin_amdgcn_ds_read_tr16_b64_v4i16((LAS v4i16_t*)p)); }
__device__ __forceinline__ bf16x8 trfrag(LAS unsigned char* img, int pitch, int row_lo, int hi_delta, int col0, int lane) {
    const int i16 = lane & 15, q = i16 >> 2, p = i16 & 3, g16 = (lane >> 4) & 1;
    LAS unsigned char* a = img + (row_lo + q) * pitch + (col0 + 16 * g16 + 4 * p) * 2;
    const s16x4 lo = trrd(a), hi = trrd(a + hi_delta * pitch);
    return (bf16x8){lo[0], lo[1], lo[2], lo[3], hi[0], hi[1], hi[2], hi[3]};
}

struct Args {
    const float *x, *p, *ev_w_in, *ev_w_out, *da_lambda, *da_subln_g, *hg_lb_logits, *hg_norm_g, *od_w_in, *od_w_out, *ln1_g, *ln1_b, *ffn_w1, *ffn_w2, *ln2_g, *ln2_b, *ple_w_proj, *ple_w_gate, *ple_norm_g;
    float* out; unsigned char* ws;
};

__device__ __forceinline__ void p0_transpose_item(const float* W, int K, int N, u16* WT, LAS float* scr, int item, int lane, const float* gk = nullptr, const float* bk = nullptr, float* c1 = nullptr, float* c2 = nullptr) {
    const int nblk = N / 32, kb = item / nblk, nb = item % nblk, k0 = 64 * kb, n0 = 32 * nb;
#pragma unroll 8
    for (int i = 0; i < 32; ++i) { const int kk = 2 * i + (lane >> 5); scr[kk * 33 + (lane & 31)] = W[(size_t)(k0 + kk) * N + n0 + (lane & 31)]; }
    asm volatile("s_waitcnt lgkmcnt(0)" ::: "memory");
    const int c = lane & 7;
    float gs[8];
#pragma unroll
    for (int e = 0; e < 8; ++e) gs[e] = gk ? gk[k0 + 8 * c + e] : 1.f;
    if (gk) {
        const int n = lane & 31, kh = (lane >> 5) * 32; float s1 = 0.f, s2 = 0.f;
#pragma unroll 8
        for (int kk = 0; kk < 32; ++kk) { const float wv = scr[(kh + kk) * 33 + n]; s1 += gk[k0 + kh + kk] * wv; s2 += bk[k0 + kh + kk] * wv; }
        s1 += shx(s1, 32, lane); s2 += shx(s2, 32, lane);
        if (lane < 32) { atomicAdd(c1 + n0 + n, s1); atomicAdd(c2 + n0 + n, s2); }
    }
#pragma unroll
    for (int j = 0; j < 4; ++j) { const int n = (lane >> 3) + 8 * j; const LAS float* sp = scr + (8 * c) * 33 + n;
        v4u o; o.x = pk2(sp[0 * 33] * gs[0], sp[1 * 33] * gs[1]); o.y = pk2(sp[2 * 33] * gs[2], sp[3 * 33] * gs[3]); o.z = pk2(sp[4 * 33] * gs[4], sp[5 * 33] * gs[5]); o.w = pk2(sp[6 * 33] * gs[6], sp[7 * 33] * gs[7]);
        *(v4u*)(WT + (size_t)(n0 + n) * K + k0 + 8 * c) = o; }
    asm volatile("s_waitcnt lgkmcnt(0)" ::: "memory");
}
__device__ __forceinline__ void prologue(const Args& A, LAS unsigned char* lds, int gw, int NGW, int wave, int lane) {
    unsigned char* ws = A.ws;
    LAS float* scr = (LAS float*)(lds + wave * 16384);
    const int cnt[12] = {(1024 / 64) * (NIN0 / 32), 512, (1024 / 64) * (NIN1 / 32), 512, 2048, 2048, 2048, 2048, 128, 128, 512, 512};
    int total = 0;
#pragma unroll
    for (int i = 0; i < 12; ++i) total += cnt[i];
    for (int it = gw; it < total; it += NGW) {
        int r = it;
        if (r < cnt[0]) { p0_transpose_item(A.ev_w_in, 1024, NIN0, (u16*)(ws + WS_WIN0), scr, r, lane); continue; } r -= cnt[0];
        if (r < cnt[1]) { p0_transpose_item(A.ev_w_out, 1024, 1024, (u16*)(ws + WS_WOUT0), scr, r, lane); continue; } r -= cnt[1];
        if (r < cnt[2]) { p0_transpose_item(A.od_w_in, 1024, NIN1, (u16*)(ws + WS_WIN1), scr, r, lane); continue; } r -= cnt[2];
        if (r < cnt[3]) { p0_transpose_item(A.od_w_out, 1024, 1024, (u16*)(ws + WS_WOUT1), scr, r, lane); continue; } r -= cnt[3];
        if (r < 4096) { const int l = r >> 11; float* cv = (float*)(ws + WS_CVEC) + l * 10240; p0_transpose_item(A.ffn_w1 + (size_t)l * 1024 * 4096, 1024, 4096, (u16*)(ws + WS_W1 + l * 8 * MiB), scr, r & 2047, lane, A.ln1_g + l * 1024, A.ln1_b + l * 1024, cv, cv + 4096); continue; } r -= 4096;
        if (r < 4096) { const int l = r >> 11; p0_transpose_item(A.ffn_w2 + (size_t)l * 1024 * 4096, 4096, 1024, (u16*)(ws + WS_W2 + l * 8 * MiB), scr, r & 2047, lane); continue; } r -= 4096;
        if (r < 256) { const int l = r >> 7; p0_transpose_item(A.ple_w_proj + (size_t)l * 256 * 1024, 256, 1024, (u16*)(ws + WS_WP + l * (MiB / 2)), scr, r & 127, lane); continue; } r -= 256;
        { const int l = r >> 9; float* cv = (float*)(ws + WS_CVEC) + l * 10240 + 8192; p0_transpose_item(A.ple_w_gate + (size_t)l * 1024 * 1024, 1024, 1024, (u16*)(ws + WS_WG + l * 2 * MiB), scr, r & 511, lane, A.ln2_g + l * 1024, A.ln2_b + l * 1024, cv, cv + 1024); }
    }
    u16* XB = (u16*)(ws + WS_XB);
    for (int m = gw; m < MTOK; m += NGW) {
        const f32x4* xr = (const f32x4*)(A.x + (size_t)m * 1024) + lane; v2u* o = (v2u*)(XB + (size_t)m * 1024) + lane;
#pragma unroll
        for (int j = 0; j < 4; ++j) { const f32x4 v = xr[64 * j]; v2u w; w.x = pk2(v[0], v[1]); w.y = pk2(v[2], v[3]); o[64 * j] = w; }
    }
    { v4u* z = (v4u*)(ws + WS_STATS); for (int i = gw * 64 + lane; i < (int)((MiB + 256 * 1024) / 16); i += NGW * 64) z[i] = (v4u){0u, 0u, 0u, 0u}; }
    float* cs = (float*)(ws + WS_CS);
    for (int idx = gw * 64 + lane; idx < 65536; idx += NGW * 64) {
        const int pos = idx >> 3, e = idx & 7;
        double iv = 1.0;
#pragma unroll 1
        for (int k = 0; k < e; ++k) iv *= 0.19392274474868576;
        const float inv = (float)iv;
        const float angf = (float)pos * inv;
        double a = (double)angf; const double twopi = 6.283185307179586476925;
        const double kq = __builtin_rint(a / twopi); a -= kq * twopi;
        const double a2 = a * a; double sn = 0.0, cn = 0.0;
        double ts = a, tc = 1.0;
#pragma unroll 1
        for (int n = 0; n < 16; ++n) { cn += tc; sn += ts; tc *= -a2 / (double)((2 * n + 1) * (2 * n + 2)); ts *= -a2 / (double)((2 * n + 2) * (2 * n + 3)); }
        cs[idx] = (float)cn; cs[65536 + idx] = (float)sn;
    }
    float* misc = (float*)(ws + WS_MISC);
    for (int i = gw * 64 + lane; i < 512; i += NGW * 64) { const float l0 = A.hg_lb_logits[i], l1 = A.hg_lb_logits[512 + i]; misc[i] = 1.f / (1.f + __expf(l1 - l0)); }
}

__device__ __forceinline__ void ln_rows(float* X, u16* XBo, const float* g, const float* bta, float* rowss, const float* prow, u16* PBo, int gw, int NGW, int lane) {
    for (int m = gw; m < MTOK; m += NGW) {
        f32x4* xr = (f32x4*)(X + (size_t)m * 1024) + lane;
        f32x4 v[4]; float s = 0.f;
#pragma unroll
        for (int j = 0; j < 4; ++j) { v[j] = xr[64 * j]; s += (v[j][0] + v[j][1]) + (v[j][2] + v[j][3]); }
        const float mean = wave_sum(s, lane) * (1.f / 1024.f); float s2 = 0.f;
#pragma unroll
        for (int j = 0; j < 4; ++j) { v[j] = v[j] - mean; s2 += (v[j][0] * v[j][0] + v[j][1] * v[j][1]) + (v[j][2] * v[j][2] + v[j][3] * v[j][3]); }
        const float rstd = 1.f / sqrtf(wave_sum(s2, lane) * (1.f / 1024.f) + LN_EPS);
        v2u* o8 = (v2u*)(XBo + (size_t)m * 1024) + lane;
#pragma unroll
        for (int j = 0; j < 4; ++j) { const f32x4 gv = ((const f32x4*)g)[lane + 64 * j], bv = ((const f32x4*)bta)[lane + 64 * j];
            const f32x4 o = v[j] * rstd * gv + bv; xr[64 * j] = o; v2u w; w.x = pk2(o[0], o[1]); w.y = pk2(o[2], o[3]); o8[64 * j] = w; }
        if (rowss && lane == 0) rowss[m] = 0.f;
        if (prow) { const f32x4 pv = ((const f32x4*)(prow + (size_t)m * 256))[lane]; v2u w; w.x = pk2(pv[0], pv[1]); w.y = pk2(pv[2], pv[3]); ((v2u*)(PBo + (size_t)m * 256))[lane] = w; }
    }
}
__device__ __forceinline__ void p_rows(const float* prow, u16* PBo, int gw, int NGW, int lane) {
    for (int m = gw; m < MTOK; m += NGW) { const f32x4 pv = ((const f32x4*)(prow + (size_t)m * 256))[lane]; v2u w; w.x = pk2(pv[0], pv[1]); w.y = pk2(pv[2], pv[3]); ((v2u*)(PBo + (size_t)m * 256))[lane] = w; }
}
__device__ __forceinline__ void diff_combine_block(const u16* AUX, u16* MIX, const float* lam_p, const float* subg, size_t row0, int h, int tid) {
    const int lane = tid & 63;
    const float s01 = wave_sum(lam_p[lane] * lam_p[64 + lane], lane), s23 = wave_sum(lam_p[128 + lane] * lam_p[192 + lane], lane);
    const float lam = __expf(s01) - __expf(s23) + 0.2f;
    const int d0 = (tid & 15) * 8;
    float gv[8];
#pragma unroll
    for (int e = 0; e < 8; ++e) gv[e] = subg[d0 + e] * 0.8f;
#pragma unroll
    for (int it = 0; it < 8; ++it) {
        const size_t m = row0 + (tid >> 4) + 32 * it;
        const v4u a0 = *(const v4u*)(AUX + m * 1024 + h * 256 + d0), a1 = *(const v4u*)(AUX + m * 1024 + h * 256 + 128 + d0);
        float o[8];
        o[0] = bflo(a0.x) - lam * bflo(a1.x); o[1] = bfhi(a0.x) - lam * bfhi(a1.x); o[2] = bflo(a0.y) - lam * bflo(a1.y); o[3] = bfhi(a0.y) - lam * bfhi(a1.y);
        o[4] = bflo(a0.z) - lam * bflo(a1.z); o[5] = bfhi(a0.z) - lam * bfhi(a1.z); o[6] = bflo(a0.w) - lam * bflo(a1.w); o[7] = bfhi(a0.w) - lam * bfhi(a1.w);
        float ss = 0.f;
#pragma unroll
        for (int e = 0; e < 8; ++e) ss += o[e] * o[e];
        ss += shx(ss, 1, lane); ss += shx(ss, 2, lane); ss += shx(ss, 4, lane); ss += shx(ss, 8, lane);
        const float rs = __builtin_amdgcn_rsqf(ss * (1.f / 128.f) + LN_EPS);
        v4u w; w.x = pk2(o[0] * rs * gv[0], o[1] * rs * gv[1]); w.y = pk2(o[2] * rs * gv[2], o[3] * rs * gv[3]); w.z = pk2(o[4] * rs * gv[4], o[5] * rs * gv[5]); w.w = pk2(o[6] * rs * gv[6], o[7] * rs * gv[7]);
        *(v4u*)(MIX + m * 1024 + h * 128 + d0) = w;
    }
}
__device__ __forceinline__ void diff_combine(const u16* AUX, u16* MIX, const float* lam_p, const float* subg, int gw, int NGW, int lane) {
    const float s01 = wave_sum(lam_p[lane] * lam_p[64 + lane], lane), s23 = wave_sum(lam_p[128 + lane] * lam_p[192 + lane], lane);
    const float lam = __expf(s01) - __expf(s23) + 0.2f;
    const int h = lane >> 4, d0 = (lane & 15) * 8;
    float gv[8];
#pragma unroll
    for (int e = 0; e < 8; ++e) gv[e] = subg[d0 + e] * 0.8f;
    for (int m = gw; m < MTOK; m += NGW) {
        const v4u a0 = *(const v4u*)(AUX + (size_t)m * 1024 + h * 256 + d0), a1 = *(const v4u*)(AUX + (size_t)m * 1024 + h * 256 + 128 + d0);
        float o[8];
        o[0] = bflo(a0.x) - lam * bflo(a1.x); o[1] = bfhi(a0.x) - lam * bfhi(a1.x); o[2] = bflo(a0.y) - lam * bflo(a1.y); o[3] = bfhi(a0.y) - lam * bfhi(a1.y);
        o[4] = bflo(a0.z) - lam * bflo(a1.z); o[5] = bfhi(a0.z) - lam * bfhi(a1.z); o[6] = bflo(a0.w) - lam * bflo(a1.w); o[7] = bfhi(a0.w) - lam * bfhi(a1.w);
        float ss = 0.f;
#pragma unroll
        for (int e = 0; e < 8; ++e) ss += o[e] * o[e];
        ss += shx(ss, 1, lane); ss += shx(ss, 2, lane); ss += shx(ss, 4, lane); ss += shx(ss, 8, lane);
        const float rs = 1.f / sqrtf(ss * (1.f / 128.f) + LN_EPS);
        v4u w; w.x = pk2(o[0] * rs * gv[0], o[1] * rs * gv[1]); w.y = pk2(o[2] * rs * gv[2], o[3] * rs * gv[3]); w.z = pk2(o[4] * rs * gv[4], o[5] * rs * gv[5]); w.w = pk2(o[6] * rs * gv[6], o[7] * rs * gv[7]);
        *(v4u*)(MIX + (size_t)m * 1024 + h * 128 + d0) = w;
    }
}
namespace hg {
constexpr int P_QA = 272, P_QO = 264, P_TR = 320;
constexpr int O_QA = 0, O_KA = O_QA + 64 * P_QA, O_QO = O_KA + 64 * P_QA, O_KST = O_QO + 64 * P_QO, O_V = O_KST + 64 * P_TR, O_OST = O_V + 64 * P_TR, O_TOT = O_OST + 64 * 132 * 4, O_DEC = O_TOT + 2048, O_END = O_DEC + 512;
static_assert(O_END <= 131072, "hgrn lds");
template <bool OUT>
__device__ __forceinline__ void item(LAS unsigned char* L, const u16* __restrict__ H, int it, const float* __restrict__ lbv, float* Send, float* Drun, const float* __restrict__ outg, u16* MIX, const int tid, const float* Sst = nullptr) {
    const int  lane = tid & 63, w = __builtin_amdgcn_readfirstlane(tid >> 6), r = lane & 31, h = lane >> 5;
    const int tt = w & 1, vt = w >> 1;
    const int bh = it >> 4, run = it & 15, b = bh >> 2, hh = bh & 3;
    const int kd = tid & 127, seg = tid >> 7;
    const size_t row0 = (size_t)b * 8192 + (size_t)run * 512;
    const float lb = lbv[hh * 128 + kd];
    LAS float* TOT = (LAS float*)(L + O_TOT); LAS float* DEC = (LAS float*)(L + O_DEC); LAS float* OST = (LAS float*)(L + O_OST);
    f32x16 S[4];
#pragma unroll
    for (int k = 0; k < 4; ++k) S[k] = f32x16{};
    if (OUT && run > 0) {
        if (Sst) {
#pragma unroll
            for (int k = 0; k < 4; ++k)
#pragma unroll
                for (int i = 0; i < 16; ++i) S[k][i] = Sst[((((size_t)it * 4 + vt) * 4 + k) * 16 + i) * 64 + lane];
        } else {
            for (int rp = 0; rp < run; ++rp) { const int ip = bh * 16 + rp;
#pragma unroll
                for (int k = 0; k < 4; ++k)
#pragma unroll
                    for (int i = 0; i < 16; ++i) S[k][i] = Drun[ip * 128 + 32 * k + crow(i, h)] * S[k][i] + Send[((((size_t)ip * 4 + vt) * 4 + k) * 16 + i) * 64 + lane];
            }
        }
    }
    float bsum = 0.f;
    u16 nf[16], nq[16]; v4u nv[2]; v4u ng[2] = {{0u, 0u, 0u, 0u}, {0u, 0u, 0u, 0u}};
#define HG_ISSUE(rowc_) do { _Pragma("unroll") for (int i = 0; i < 16; ++i) { const u16* p = H + ((rowc_) + seg * 16 + i) * NIN0 + hh * 128 + kd; nf[i] = p[2048]; if (OUT) nq[i] = p[1536]; } \
        _Pragma("unroll") for (int n = 0; n < 2; ++n) { const int id = tid + 512 * n, t = id >> 4, c = id & 15; nv[n] = *(const v4u*)(H + ((rowc_) + t) * NIN0 + 2560 + hh * 128 + c * 8); } \
        if (OUT) { const u16* gp_ = H + ((rowc_) + (tid >> 3)) * NIN0 + 3072 + hh * 128 + (tid & 7) * 16; ng[0] = *(const v4u*)gp_; ng[1] = *(const v4u*)(gp_ + 8); } } while (0)
    HG_ISSUE(row0);
    for (int ch = 0; ch < 8; ++ch) {
        const size_t rowc = row0 + ch * 64;
        float fg[16], cs[16], hq[16];
#pragma unroll
        for (int i = 0; i < 16; ++i) { fg[i] = bf2f(nf[i]); if (OUT) hq[i] = bf2f(nq[i]); }
#pragma unroll
        for (int n = 0; n < 2; ++n) { const int id = tid + 512 * n, t = id >> 4, c = id & 15; *(LAS v4u*)(L + O_V + t * P_TR + c * 16) = nv[n]; }
        const v4u gc0 = ng[0], gc1 = ng[1];
        if (ch + 1 < 8) HG_ISSUE(rowc + 64);
        float runs = 0.f;
#pragma unroll
        for (int i = 0; i < 16; ++i) { const float sg = __builtin_amdgcn_rcpf(1.f + __expf(-fg[i])); const float f = lb + (1.f - lb) * sg; fg[i] = (1.f - lb) * (1.f - sg); runs += __logf(f); cs[i] = runs; }
        TOT[seg * 128 + kd] = runs;
        __syncthreads();
        const float t0 = TOT[kd], t1 = TOT[128 + kd], t2 = TOT[256 + kd], t3 = TOT[384 + kd];
        const float off = (seg > 0 ? t0 : 0.f) + (seg > 1 ? t1 : 0.f) + (seg > 2 ? t2 : 0.f);
        const float bmid = t0 + t1, blast = (t0 + t1) + (t2 + t3);
        const float elm = __expf(blast - bmid), em = __expf(bmid);
#pragma unroll
        for (int i = 0; i < 16; i += 2) {
            const int t = seg * 16 + i; float kst[2], qa[2], ka[2], qo[2];
#pragma unroll
            for (int u = 0; u < 2; ++u) { const float bi = off + cs[i + u];
                const float e1 = __expf(bi - bmid), e2 = __builtin_amdgcn_rcpf(e1); const float kk = fg[i + u];
                ka[u] = kk * e2; kst[u] = ka[u] * elm;
                if (OUT) { const float q = hq[i + u] * __builtin_amdgcn_rcpf(1.f + __expf(-hq[i + u])); qa[u] = q * e1; qo[u] = qa[u] * em; } }
            { const unsigned w = pk2(kst[0], kst[1]); *(LAS u16*)(L + O_KST + t * P_TR + kd * 2) = (u16)w; *(LAS u16*)(L + O_KST + (t + 1) * P_TR + kd * 2) = (u16)(w >> 16); }
            if (OUT) {
                { const unsigned w = pk2(qa[0], qa[1]); *(LAS u16*)(L + O_QA + t * P_QA + kd * 2) = (u16)w; *(LAS u16*)(L + O_QA + (t + 1) * P_QA + kd * 2) = (u16)(w >> 16); }
                { const unsigned w = pk2(ka[0], ka[1]); *(LAS u16*)(L + O_KA + t * P_QA + kd * 2) = (u16)w; *(LAS u16*)(L + O_KA + (t + 1) * P_QA + kd * 2) = (u16)(w >> 16); }
                { const unsigned w = pk2(qo[0], qo[1]); *(LAS u16*)(L + O_QO + t * P_QO + kd * 2) = (u16)w; *(LAS u16*)(L + O_QO + (t + 1) * P_QO + kd * 2) = (u16)(w >> 16); } }
        }
        if (seg == 0) { DEC[kd] = __expf(blast); bsum += blast; }
        __syncthreads();
        if (OUT) {
            f32x16 acc = f32x16{};
            for (int st = 0; st <= tt; ++st) {
                f32x16 X = f32x16{};
#pragma unroll
                for (int ks = 0; ks < 8; ++ks) { const bf16x8 a = *(LAS bf16x8*)(L + O_KA + (32 * st + r) * P_QA + (16 * ks + 8 * h) * 2); const bf16x8 bq = *(LAS bf16x8*)(L + O_QA + (32 * tt + r) * P_QA + (16 * ks + 8 * h) * 2); X = MFMA32(a, bq, X); }
                if (st == tt) {
#pragma unroll
                    for (int i = 0; i < 16; ++i) if (crow(i, h) > r) X[i] = 0.f; }
#pragma unroll
                for (int s2 = 0; s2 < 2; ++s2) { const bf16x8 pa = pack8(X, 8 * s2); const bf16x8 vf = trfrag(L + O_V, P_TR, 32 * st + 16 * s2 + 4 * h, 8, 32 * vt, lane); acc = MFMA32(pa, vf, acc); }
            }
#pragma unroll
            for (int k = 0; k < 4; ++k)
#pragma unroll
                for (int s2 = 0; s2 < 2; ++s2) {
                    LAS unsigned char* qp = L + O_QO + (32 * tt + r) * P_QO + (32 * k + 16 * s2 + 4 * h) * 2;
                    const s16x4 lo = *(LAS s16x4*)qp, hi = *(LAS s16x4*)(qp + 16);
                    const bf16x8 a2 = (bf16x8){lo[0], lo[1], lo[2], lo[3], hi[0], hi[1], hi[2], hi[3]};
                    acc = MFMA32(a2, pack8(S[k], 8 * s2), acc); }
#pragma unroll
            for (int i = 0; i < 16; ++i) OST[(32 * tt + crow(i, h)) * 132 + 32 * vt + r] = acc[i];
        }
#pragma unroll
        for (int k = 0; k < 4; ++k) {
#pragma unroll
            for (int i = 0; i < 16; ++i) S[k][i] *= DEC[32 * k + crow(i, h)];
#pragma unroll
            for (int ks = 0; ks < 4; ++ks) { const bf16x8 a = trfrag(L + O_KST, P_TR, 16 * ks + 8 * h, 4, 32 * k, lane); const bf16x8 bv = trfrag(L + O_V, P_TR, 16 * ks + 8 * h, 4, 32 * vt, lane); S[k] = MFMA32(a, bv, S[k]); }
        }
        __syncthreads();
        if (OUT) {
            const int t = tid >> 3, c8 = tid & 7; float o[16]; float ss = 0.f;
#pragma unroll
            for (int j = 0; j < 4; ++j) { const f32x4 v = *(LAS f32x4*)(OST + t * 132 + c8 * 16 + 4 * j); o[4 * j] = v[0]; o[4 * j + 1] = v[1]; o[4 * j + 2] = v[2]; o[4 * j + 3] = v[3]; ss += (v[0] * v[0] + v[1] * v[1]) + (v[2] * v[2] + v[3] * v[3]); }
            ss += shx(ss, 1, lane); ss += shx(ss, 2, lane); ss += shx(ss, 4, lane);
            const float rs = __builtin_amdgcn_rsqf(ss * (1.f / 128.f) + LN_EPS);
            u16* op = MIX + (rowc + t) * 1024 + 512 + hh * 128 + c8 * 16;
#pragma unroll
            for (int j = 0; j < 2; ++j) { const v4u gvv = j ? gc1 : gc0; const unsigned gw_[4] = {gvv.x, gvv.y, gvv.z, gvv.w}; unsigned ow[4];
#pragma unroll
                for (int e = 0; e < 4; ++e) { const float g0 = bflo(gw_[e]), g1 = bfhi(gw_[e]); const int c = 8 * j + 2 * e;
                    const float y0 = o[c] * rs * outg[c8 * 16 + c] * (g0 * __builtin_amdgcn_rcpf(1.f + __expf(-g0))), y1 = o[c + 1] * rs * outg[c8 * 16 + c + 1] * (g1 * __builtin_amdgcn_rcpf(1.f + __expf(-g1)));
                    ow[e] = pk2(y0, y1); }
                *(v4u*)(op + 8 * j) = (v4u){ow[0], ow[1], ow[2], ow[3]}; }
        }
    }
    if (!OUT) {
        if (tt == 0) {
#pragma unroll
            for (int k = 0; k < 4; ++k)
#pragma unroll
                for (int i = 0; i < 16; ++i) Send[((((size_t)it * 4 + vt) * 4 + k) * 16 + i) * 64 + lane] = S[k][i]; }
        if (seg == 0) Drun[it * 128 + kd] = __expf(bsum);
    }
}
__device__ __forceinline__ void scan(const float* __restrict__ Send, const float* __restrict__ Drun, float* Sst, int gtid, int nthreads) {
    for (int idx = gtid; idx < 16 * 16384; idx += nthreads) {
        const int bh = idx >> 14, e = idx & 16383, lane = e & 63, i = (e >> 6) & 15, k = (e >> 10) & 3;
        const int kd = 32 * k + crow(i, lane >> 5);
        float sv[15], dv[15];
#pragma unroll
        for (int r = 0; r < 15; ++r) { sv[r] = Send[(size_t)(bh * 16 + r) * 16384 + e]; dv[r] = Drun[(bh * 16 + r) * 128 + kd]; }
        float st = 0.f;
#pragma unroll
        for (int r = 0; r < 15; ++r) { st = dv[r] * st + sv[r]; Sst[(size_t)(bh * 16 + r + 1) * 16384 + e] = st; }
    }
}
}

__device__ __forceinline__ void dil_task(LAS unsigned char* Lw, const u16* __restrict__ QKV, int task, u16* OBg0, u16* OBg1, u16* OBg2, float* LSE, int lane) {
    const int r = lane & 31, h = lane >> 5;
    const int bh = task / 768, rem = task - bh * 768, g = rem >> 8, j = rem & 255;
    const int sh = 2 * g, res = j >> (8 - sh), qt = j & ((256 >> sh) - 1);
    const int b = bh >> 4, hd = bh & 15;
    const size_t rowb = (size_t)b * 8192;
    const int qpos = res + ((32 * qt + r) << sh);
    const u16* qp = QKV + (rowb + qpos) * NIN1 + hd * 64;
    bf16x8 qf[4];
#pragma unroll
    for (int ks = 0; ks < 4; ++ks) qf[ks] = *(const bf16x8*)(qp + 16 * ks + 8 * h);
    f32x16 X[5];
#pragma unroll
    for (int kb = 0; kb < 5; ++kb) {
        int ki = 32 * qt - 128 + 32 * kb + r; ki = ki < 0 ? 0 : ki;
        const u16* kp = QKV + (rowb + res + (ki << sh)) * NIN1 + 1024 + hd * 64;
        X[kb] = f32x16{};
#pragma unroll
        for (int ks = 0; ks < 4; ++ks) { const bf16x8 kf = *(const bf16x8*)(kp + 16 * ks + 8 * h); X[kb] = MFMA32(kf, qf[ks], X[kb]); }
    }
    float m = -INFINITY;
#pragma unroll
    for (int kb = 0; kb < 5; ++kb)
#pragma unroll
        for (int i = 0; i < 16; ++i) { const int c = crow(i, h); bool valid = (32 * qt - 128 + 32 * kb + c) >= 0;
            if (kb == 0) valid = valid && (c >= r);
            if (kb == 4) valid = valid && (c <= r);
            X[kb][i] = valid ? X[kb][i] : -INFINITY; m = fmaxf(m, X[kb][i]); }
    m = fmaxf(m, shx(m, 32, lane));
    float l = 0.f;
#pragma unroll
    for (int kb = 0; kb < 5; ++kb)
#pragma unroll
        for (int i = 0; i < 16; ++i) { X[kb][i] = __builtin_amdgcn_exp2f(X[kb][i] - m); l += X[kb][i]; }
    l += shx(l, 32, lane);
    f32x16 y[2]; y[0] = f32x16{}; y[1] = f32x16{};
#pragma unroll
    for (int kb = 0; kb < 5; ++kb) {
#pragma unroll
        for (int n = 0; n < 4; ++n) { const int id = lane + 64 * n, key = id >> 3, c = id & 7; int ki = 32 * qt - 128 + 32 * kb + key; ki = ki < 0 ? 0 : ki;
            const v4u v = *(const v4u*)(QKV + (rowb + res + (ki << sh)) * NIN1 + 2048 + hd * 64 + c * 8); *(LAS v4u*)(Lw + key * 192 + c * 16) = v; }
#pragma unroll
        for (int s2 = 0; s2 < 2; ++s2) { const bf16x8 pb = pack8(X[kb], 8 * s2);
#pragma unroll
            for (int dt = 0; dt < 2; ++dt) { const bf16x8 a = trfrag(Lw, 192, 16 * s2 + 4 * h, 8, 32 * dt, lane); y[dt] = MFMA32(a, pb, y[dt]); } }
    }
    const float inv = 1.f / l;
    u16* ob = (g == 0 ? OBg0 : g == 1 ? OBg1 : OBg2) + (rowb + qpos) * 1024 + hd * 64;
#pragma unroll
    for (int dt = 0; dt < 2; ++dt)
#pragma unroll
        for (int gq = 0; gq < 4; ++gq) { v2u w; w.x = pk2(y[dt][4 * gq] * inv, y[dt][4 * gq + 1] * inv); w.y = pk2(y[dt][4 * gq + 2] * inv, y[dt][4 * gq + 3] * inv); *(v2u*)(ob + 32 * dt + 8 * gq + 4 * h) = w; }
    if (h == 0) LSE[((size_t)g * MTOK + rowb + qpos) * 16 + hd] = (m + __log2f(l)) * 0.6931471805599453f;
}
namespace dl {
constexpr int KP = 144, VP = 192, O_K = 0, O_V = 384 * KP, O_END = O_V + 384 * VP;
static_assert(O_END <= 131072, "dilated lds");
struct Dec { int g, sh, res, i0, hd; size_t rowb; };
__device__ __forceinline__ Dec decode(int task) {
    Dec d; const int bh = task / 96, rem = task - bh * 96; d.g = rem >> 5; const int j = rem & 31;
    d.sh = 2 * d.g; d.res = j >> (5 - d.sh); d.i0 = 256 * (j & ((32 >> d.sh) - 1)); d.hd = bh & 15; d.rowb = (size_t)(bh >> 4) * 8192; return d;
}
__device__ __forceinline__ void issue(const u16* __restrict__ QKV, int task, int tid, v4u (&pk)[6], v4u (&pv)[6], bf16x8 (&qn)[4]) {
    const Dec d = decode(task); const int lane = tid & 63, w = tid >> 6, r = lane & 31, h = lane >> 5;
#pragma unroll
    for (int n = 0; n < 6; ++n) { const int id = tid + 512 * n, c = id >> 3, ch = id & 7; int ki = d.i0 - 128 + c; ki = ki < 0 ? 0 : ki;
        const u16* src = QKV + (d.rowb + d.res + (ki << d.sh)) * NIN1 + d.hd * 64 + ch * 8;
        pk[n] = *(const v4u*)(src + 1024); pv[n] = *(const v4u*)(src + 2048); }
    const u16* qp = QKV + (d.rowb + d.res + ((d.i0 + 32 * w + r) << d.sh)) * NIN1 + d.hd * 64;
#pragma unroll
    for (int ks = 0; ks < 4; ++ks) qn[ks] = *(const bf16x8*)(qp + 16 * ks + 8 * h);
}
__device__ __forceinline__ void phase(LAS unsigned char* L, const u16* __restrict__ QKV, u16* OBg0, u16* OBg1, u16* OBg2, float* LSE, int first, int stride, const int tid) {
    const int lane = tid & 63, w = __builtin_amdgcn_readfirstlane(tid >> 6), r = lane & 31, h = lane >> 5;
    const bool xl = (stride == 256); const int nround = xl ? 24 : (6144 - first + stride - 1) / stride;
    if (first >= 6144) return;
#define DL_TASK(k) (xl ? (((first >> 5) * 8 + (k) / 3) * 96 + ((k) % 3) * 32 + (first & 31)) : (first + (k) * stride))
    v4u pk[6], pv[6]; bf16x8 qn[4];
    issue(QKV, DL_TASK(0), tid, pk, pv, qn);
    for (int kr = 0; kr < nround; ++kr) {
        const int task = DL_TASK(kr);
        const Dec d = decode(task);
#pragma unroll
        for (int n = 0; n < 6; ++n) { const int id = tid + 512 * n, c = id >> 3, ch = id & 7; *(LAS v4u*)(L + O_K + c * KP + ch * 16) = pk[n]; *(LAS v4u*)(L + O_V + c * VP + ch * 16) = pv[n]; }
        bf16x8 qf[4];
#pragma unroll
        for (int ks = 0; ks < 4; ++ks) qf[ks] = qn[ks];
        __syncthreads();
        if (kr + 1 < nround) issue(QKV, DL_TASK(kr + 1), tid, pk, pv, qn);
        const int i0 = d.i0, g = d.g, sh = d.sh;
        const int qpos = d.res + ((i0 + 32 * w + r) << sh);
        f32x16 X[5];
#pragma unroll
        for (int kb = 0; kb < 5; ++kb) X[kb] = f32x16{};
        {
            LAS unsigned char* kbase = L + O_K + (32 * w + r) * KP + 8 * h * 2;
#pragma unroll
            for (int ks = 0; ks < 4; ++ks) {
                bf16x8 kf[5];
#pragma unroll
                for (int kb = 0; kb < 5; ++kb) kf[kb] = *(LAS bf16x8*)(kbase + 32 * kb * KP + 16 * ks * 2);
#pragma unroll
                for (int kb = 0; kb < 5; ++kb) X[kb] = MFMA32(kf[kb], qf[ks], X[kb]);
            }
        }
        float m = -INFINITY;
        const int kneg = 128 - i0 - 32 * w;
#pragma unroll
        for (int i = 0; i < 16; ++i) { const int c = crow(i, h);
            X[0][i] = (c >= r && c >= kneg) ? X[0][i] : -INFINITY; X[4][i] = (c <= r) ? X[4][i] : -INFINITY; }
        if (kneg > 32) {
#pragma unroll
            for (int kb = 1; kb < 4; ++kb)
#pragma unroll
                for (int i = 0; i < 16; ++i) X[kb][i] = (32 * kb + crow(i, h) >= kneg) ? X[kb][i] : -INFINITY;
        }
#pragma unroll
        for (int kb = 0; kb < 5; ++kb)
#pragma unroll
            for (int i = 0; i < 16; i += 2) m = fmaxf(m, fmaxf(X[kb][i], X[kb][i + 1]));
        m = fmaxf(m, shx(m, 32, lane));
        float l = 0.f;
#pragma unroll
        for (int kb = 0; kb < 5; ++kb)
#pragma unroll
            for (int i = 0; i < 16; ++i) { X[kb][i] = __builtin_amdgcn_exp2f(X[kb][i] - m); l += X[kb][i]; }
        l += shx(l, 32, lane);
        f32x16 y[2]; y[0] = f32x16{}; y[1] = f32x16{};
#pragma unroll
        for (int kb = 0; kb < 5; ++kb) {
            bf16x8 vf[2][2];
#pragma unroll
            for (int s2 = 0; s2 < 2; ++s2)
#pragma unroll
                for (int dt = 0; dt < 2; ++dt) vf[s2][dt] = trfrag(L + O_V, VP, 32 * w + 32 * kb + 16 * s2 + 4 * h, 8, 32 * dt, lane);
            const bf16x8 pb0 = pack8(X[kb], 0), pb1 = pack8(X[kb], 8);
            y[0] = MFMA32(vf[0][0], pb0, y[0]); y[1] = MFMA32(vf[0][1], pb0, y[1]); y[0] = MFMA32(vf[1][0], pb1, y[0]); y[1] = MFMA32(vf[1][1], pb1, y[1]);
        }
        const float inv = __builtin_amdgcn_rcpf(l);
        u16* ob = (g == 0 ? OBg0 : g == 1 ? OBg1 : OBg2) + (d.rowb + qpos) * 1024 + d.hd * 64;
#pragma unroll
        for (int dt = 0; dt < 2; ++dt)
#pragma unroll
            for (int gp = 0; gp < 2; ++gp) {
                const int ge = 2 * gp, go = 2 * gp + 1;
                unsigned e0 = pk2(y[dt][4 * ge] * inv, y[dt][4 * ge + 1] * inv), e1 = pk2(y[dt][4 * ge + 2] * inv, y[dt][4 * ge + 3] * inv);
                unsigned o0 = pk2(y[dt][4 * go] * inv, y[dt][4 * go + 1] * inv), o1 = pk2(y[dt][4 * go + 2] * inv, y[dt][4 * go + 3] * inv);
                const auto s0 = __builtin_amdgcn_permlane32_swap(e0, o0, false, false); const auto s1 = __builtin_amdgcn_permlane32_swap(e1, o1, false, false);
                const v4u wv = {s0[0], s1[0], s0[1], s1[1]};
                *(v4u*)(ob + 32 * dt + 8 * (2 * gp + h)) = wv; }
        if (h == 0) LSE[((size_t)g * MTOK + d.rowb + qpos) * 16 + d.hd] = (m + __log2f(l)) * 0.6931471805599453f;
        __syncthreads();
    }
}
}
__device__ __forceinline__ void dil_merge(const u16* OB0, const u16* OB1, const u16* OB2, const float* LSE, u16* MIX, int gw, int NGW, int lane) {
    const int hd = lane >> 2, dq = (lane & 3) * 16;
    for (int m = gw; m < MTOK; m += NGW) {
        const float l0 = LSE[((size_t)m) * 16 + hd], l1 = LSE[((size_t)MTOK + m) * 16 + hd], l2 = LSE[((size_t)2 * MTOK + m) * 16 + hd];
        const float mx = fmaxf(l0, fmaxf(l1, l2)); float w0 = __expf(l0 - mx), w1 = __expf(l1 - mx), w2 = __expf(l2 - mx); const float iz = 1.f / (w0 + w1 + w2); w0 *= iz; w1 *= iz; w2 *= iz;
        const size_t off = (size_t)m * 1024 + hd * 64 + dq;
#pragma unroll
        for (int j = 0; j < 2; ++j) { const v4u a = *(const v4u*)(OB0 + off + 8 * j), bq = *(const v4u*)(OB1 + off + 8 * j), c = *(const v4u*)(OB2 + off + 8 * j);
            const unsigned aw[4] = {a.x, a.y, a.z, a.w}, bw[4] = {bq.x, bq.y, bq.z, bq.w}, cw[4] = {c.x, c.y, c.z, c.w}; unsigned ow[4];
#pragma unroll
            for (int e = 0; e < 4; ++e) ow[e] = pk2(w0 * bflo(aw[e]) + w1 * bflo(bw[e]) + w2 * bflo(cw[e]), w0 * bfhi(aw[e]) + w1 * bfhi(bw[e]) + w2 * bfhi(cw[e]));
            *(v4u*)(MIX + off + 8 * j) = (v4u){ow[0], ow[1], ow[2], ow[3]}; }
    }
}
#ifndef ATT_ORDER
#define ATT_ORDER 2
#endif
#ifndef PROBE_A
#define PROBE_A MIX
#endif
#ifndef PROBE_B
#define PROBE_B WS_WOUT0
#endif
#ifndef PROBE_M
#define PROBE_M MTOK
#endif
#ifndef HEAVY_ALIGN
#define HEAVY_ALIGN true
#endif
#ifndef REP_PRO
#define REP_PRO 1
#endif
#ifndef REP_P1
#define REP_P1 1
#endif
#ifndef REP_HGA
#define REP_HGA 1
#endif
#ifndef REP_HGC
#define REP_HGC 1
#endif
#ifndef REP_CMB
#define REP_CMB 1
#endif
#ifndef REP_DIL
#define REP_DIL 1
#endif
#ifndef REP_MRG
#define REP_MRG 1
#endif
#ifndef REP_P6
#define REP_P6 1
#endif
#ifndef REP_ATT
#define REP_ATT 1
#endif
#ifndef PH_LO
#define PH_LO 0
#endif
#ifndef PH_HI
#define PH_HI 100
#endif
__device__ __forceinline__ int fresh_lane() { int l; asm volatile("v_mbcnt_lo_u32_b32 %0, -1, 0\n\tv_mbcnt_hi_u32_b32 %0, -1, %0" : "=v"(l)); return l; }
__device__ __forceinline__ unsigned xcc_id() { return (unsigned)__builtin_amdgcn_s_getreg((3 << 11) | 20) & 0xFu; }
__device__ __forceinline__ unsigned bar_ld(unsigned* p) { return __hip_atomic_load(p, __ATOMIC_RELAXED, __HIP_MEMORY_SCOPE_AGENT); }
__device__ __forceinline__ unsigned bar_add(unsigned* p) { return __hip_atomic_fetch_add(p, 1u, __ATOMIC_RELAXED, __HIP_MEMORY_SCOPE_AGENT); }
__device__ __forceinline__ void grid_bar(unsigned* bar, unsigned k, unsigned x, unsigned nloc, unsigned nx, int wave0) {
    asm volatile("s_waitcnt vmcnt(0) lgkmcnt(0)" ::: "memory");
    __syncthreads();
    if (wave0 == 0) {
        const int ln = fresh_lane();
        if (ln == 0) {
            const unsigned old = bar_add(&bar[1024 + 64 * x]);
            if (old + 1u == k * nloc) {
                __builtin_amdgcn_fence(__ATOMIC_RELEASE, "agent");
                asm volatile("s_waitcnt vmcnt(0)" ::: "memory");
                const unsigned og = bar_add(&bar[3072]);
                if (og + 1u == k * nx) bar_add(&bar[3136]);
                else while (bar_ld(&bar[3136]) < k) __builtin_amdgcn_s_sleep(1);
                __builtin_amdgcn_fence(__ATOMIC_ACQUIRE, "agent");
                bar_add(&bar[2048 + 64 * x]);
                asm volatile("s_waitcnt vmcnt(0)" ::: "memory");
            } else {
                while (bar_ld(&bar[2048 + 64 * x]) < k) __builtin_amdgcn_s_sleep(1);
                __builtin_amdgcn_fence(__ATOMIC_ACQUIRE, "agent");
                asm volatile("s_waitcnt vmcnt(0)" ::: "memory");
            }
        }
    }
    __syncthreads();
}
template <bool ALIGN = true, class Epi>
__device__ __forceinline__ void run_gemm(LAS unsigned char* lds, const u16* A, const u16* Bt, int N, int K, const Epi& E, int tid, int Mrows = MTOK) {
    asm volatile("" : "+v"(tid));
    pg8::Gemm g{A, Bt, Mrows, N, K}; int Gl = (int)gridDim.x, bxl = (int)blockIdx.x; asm volatile("" : "+s"(Gl), "+s"(bxl)); pg8::StaticOrder S; S.init(Mrows, N, Gl, bxl);
    pg8::gemm_phase<Epi, pg8::StaticOrder, ALIGN, PG8_SP2>(lds, g, S, E, tid);
}
__global__ void __launch_bounds__(512, 2) fwd_kernel(Args A) {
    extern __shared__ __attribute__((aligned(16))) unsigned char lds_raw[];
    LAS unsigned char* lds = (LAS unsigned char*)lds_raw;
    cg::grid_group grid = cg::this_grid();
    const int wave0 = __builtin_amdgcn_readfirstlane((int)threadIdx.x >> 6);
#define tid0 (wave0 * 64 + fresh_lane())
    const int G = gridDim.x, bx = blockIdx.x;
    const int vcu = (G % 8 == 0) ? (bx % 8) * (G / 8) + bx / 8 : bx;
    const int NGW = G * 8;
#define PHASE_IDS() int tid = tid0; asm volatile("" : "+v"(tid)); const int lane = tid & 63, wave = __builtin_amdgcn_readfirstlane(tid >> 6), gw = bx * 8 + wave; (void)lane; (void)gw;
    unsigned char* ws = A.ws;
    float* rowss0 = (float*)(ws + WS_ROWSS); float* stats0 = (float*)(ws + WS_STATS); const float* cvec0 = (const float*)(ws + WS_CVEC); const float* lbv = (const float*)(ws + WS_MISC); const float* cs = (const float*)(ws + WS_CS);
    u16* XB = (u16*)(ws + WS_XB); u16* MIX = (u16*)(ws + WS_MIX); u16* HB = (u16*)(ws + WS_HB); u16* AUX = (u16*)(ws + WS_AUX);
    float* HGS = (float*)(ws + WS_HGS); float* HGD = (float*)(ws + WS_HGD); float* LSE = (float*)(ws + WS_LSE); u16* OB1 = (u16*)(ws + WS_OB1);
    float* X = A.out;
    unsigned* barw = (unsigned*)(ws + WS_BAR); unsigned nbar = 0;
    const unsigned myx = xcc_id();
    if (threadIdx.x == 0) bar_add(&barw[64 * myx]);
    unsigned nloc = 1, nxc = 1;
#define GSYNC() do { ++nbar; grid_bar(barw, nbar, myx, nloc, nxc, wave0); } while (0)

    for (int rep_ = 0; rep_ < REP_PRO; ++rep_) { { PHASE_IDS(); prologue(A, lds, gw, NGW, wave, lane); } }
    grid.sync();
    { unsigned cnt = 0, mine = 0;
#pragma unroll
      for (unsigned jx = 0; jx < 16; ++jx) { const unsigned c = bar_ld(&barw[64 * jx]); cnt += (c > 0u) ? 1u : 0u; mine = (jx == myx) ? c : mine; }
      nloc = (unsigned)__builtin_amdgcn_readfirstlane((int)mine); nxc = (unsigned)__builtin_amdgcn_readfirstlane((int)cnt); }

    for (int l = 0; l < 2; ++l) {
        const u16* Ain = (l == 0) ? XB : (const u16*)X;
        if (l == 0) {
            for (int rep_ = 0; rep_ < REP_P1; ++rep_) { { pg8::EpiStore E{HB, NIN0, 0, 1024, 512, cs, nullptr, nullptr, nullptr}; run_gemm(lds, Ain, (const u16*)(ws + WS_WIN0), NIN0, 1024, E, tid0); } }
            GSYNC();
#ifndef NO_HGA
            for (int rep_ = 0; rep_ < REP_HGA; ++rep_) { for (int it = vcu; it < 256; it += G) { PHASE_IDS(); hg::item<false>(lds, HB, it, lbv, HGS, HGD, nullptr, nullptr, tid); } }
#endif
            GSYNC();
#ifndef NO_HGC
            for (int rep_ = 0; rep_ < REP_HGC; ++rep_) { for (int it = vcu; it < 256; it += G) { PHASE_IDS(); hg::item<true>(lds, HB, it, lbv, HGS, HGD, A.hg_norm_g, MIX, tid); } }
#endif
            __syncthreads();
            int Ga = G; asm volatile("" : "+s"(Ga));
#if ATT_ORDER == 2
            for (int rep_ = 0; rep_ < REP_ATT; ++rep_) {
                const int bhd = (Ga == 256) ? (vcu >> 4) : 0, jq = vcu & 15; const int b = bhd >> 2, hh = bhd & 3;
                if (Ga == 256) {
                    for (int sub = 0; sub < 4; ++sub)
                        for (int grp = 0; grp < 2; ++grp) {
                            int tidA = tid0; asm volatile("" : "+v"(tidA));
                            const int c = sub >> 1, half = sub & 1, vh = hh * 4 + sub, qb = grp ? jq : 31 - jq;
                            attn_body::attn_unit<8>(b, (2 * hh + c) * 64, 512 + (2 * hh + c) * 64, 1024 + hh * 128 + half * 64, vh * 64, qb,
                                                    (const attn_body::bf16*)HB, (const attn_body::bf16*)HB, (const attn_body::bf16*)HB, (attn_body::bf16*)AUX, (char*)lds_raw, tidA);
                        }
                    asm volatile("s_waitcnt vmcnt(0)" ::: "memory");
                    __syncthreads();
                    for (int grp = 0; grp < 2; ++grp) { PHASE_IDS(); diff_combine_block(AUX, MIX, A.da_lambda, A.da_subln_g, (size_t)b * 8192 + (size_t)(grp ? jq : 31 - jq) * 256, hh, tid); }
                }
            }
            if (Ga != 256)
#endif
            for (int rep_ = 0; rep_ < REP_ATT; ++rep_)
            for (int gi = vcu; gi < 512; gi += Ga) {
                int bhd, qb;
#if ATT_ORDER == 1
                if (Ga == 256) { const int j = vcu & 31; if (gi < 256) { bhd = 2 * (vcu >> 5); qb = 31 - j; } else { bhd = 2 * (vcu >> 5) + 1; qb = j; } }
#else
                if (Ga == 256) { bhd = vcu >> 4; const int j = vcu & 15; qb = (gi < 256) ? 31 - j : j; }
#endif
                else { bhd = gi >> 5; qb = 31 - (gi & 31); }
                const int b = bhd >> 2, hh = bhd & 3;
                for (int sub = 0; sub < 4; ++sub) {
                    int tidA = tid0; asm volatile("" : "+v"(tidA));
                    const int c = sub >> 1, half = sub & 1, vh = hh * 4 + sub;
#ifndef NO_ATTN
                    attn_body::attn_unit<8>(b, (2 * hh + c) * 64, 512 + (2 * hh + c) * 64, 1024 + hh * 128 + half * 64, vh * 64, qb,
                                            (const attn_body::bf16*)HB, (const attn_body::bf16*)HB, (const attn_body::bf16*)HB, (attn_body::bf16*)AUX, (char*)lds_raw, tidA);
#endif
                }
                asm volatile("s_waitcnt vmcnt(0)" ::: "memory");
                __syncthreads();
                { PHASE_IDS(); diff_combine_block(AUX, MIX, A.da_lambda, A.da_subln_g, (size_t)b * 8192 + (size_t)qb * 256, hh, tid); }
            }
            GSYNC();
        } else {
            { pg8::EpiStore E{HB, NIN1, 0, 2048, 1024, cs, nullptr, nullptr, nullptr}; run_gemm(lds, Ain, (const u16*)(ws + WS_WIN1), NIN1, 1024, E, tid0); }
            GSYNC();
#ifndef NO_DIL
            for (int rep_ = 0; rep_ < REP_DIL; ++rep_) { { PHASE_IDS(); dl::phase(lds, HB, AUX, OB1, XB, LSE, vcu, G, tid); } }
#endif
            GSYNC();
            for (int rep_ = 0; rep_ < REP_MRG; ++rep_) { { PHASE_IDS(); dil_merge(AUX, OB1, XB, LSE, MIX, gw, NGW, lane); } }
            GSYNC();
        }
        float* rowss = rowss0 + (size_t)l * MTOK; float* st1 = stats0 + (size_t)(2 * l) * MTOK * 2; float* st2 = stats0 + (size_t)(2 * l + 1) * MTOK * 2; const float* cv = cvec0 + l * 10240;
        { PHASE_IDS(); p_rows(A.p + (size_t)l * MTOK * PLE, AUX, gw, NGW, lane); }
        { pg8::EpiResid E{Ain, XB, nullptr, nullptr, nullptr, st1}; run_gemm<HEAVY_ALIGN>(lds, MIX, (const u16*)(ws + (l == 0 ? WS_WOUT0 : WS_WOUT1)), 1024, 1024, E, tid0); }
#ifdef PROBE_OUTP
        for (int q_ = 0; q_ < PROBE_OUTP; ++q_) { pg8::EpiStore E{HB + (size_t)64 * MiB, 1024, 0, 0, 0, cs, nullptr, nullptr, nullptr}; run_gemm(lds, PROBE_A, (const u16*)(ws + PROBE_B), 1024, 1024, E, tid0, PROBE_M); }
#endif
#ifdef PROBE_RESID
        { pg8::EpiResid E{XB, HB + (size_t)64 * MiB, st1, A.ln1_g, A.ln1_b, PROBE_RESID == 2 ? (float*)nullptr : (float*)(HB + (size_t)96 * MiB)}; run_gemm(lds, MIX, (const u16*)(ws + WS_WOUT0), 1024, 1024, E, tid0); }
#endif
        GSYNC();
        for (int rep_ = 0; rep_ < REP_P6; ++rep_) { pg8::EpiStore E{HB, FFD, 1, 0, 0, cs, st1, cv, cv + 4096}; run_gemm(lds, XB, (const u16*)(ws + WS_W1 + l * 8 * MiB), FFD, 1024, E, tid0); }
        { pg8::EpiE E{MIX, rowss}; run_gemm(lds, AUX, (const u16*)(ws + WS_WP + l * (MiB / 2)), 1024, PLE, E, tid0); }
        GSYNC();
#ifdef PROBE_EGEMM
        for (int q_ = 0; q_ < PROBE_EGEMM; ++q_) { pg8::EpiE E{AUX, (float*)(ws + WS_LSE)}; run_gemm(lds, AUX, (const u16*)(ws + WS_WP + l * (MiB / 2)), 1024, PLE, E, tid0); }
#endif
#ifdef PROBE_FFN2
        { pg8::EpiStore E{AUX, 1024, 0, 0, 0, cs, nullptr, nullptr, nullptr}; run_gemm(lds, HB, (const u16*)(ws + WS_W2 + l * 8 * MiB), 1024, FFD, E, tid0); }
#endif
        { pg8::EpiResid E{XB, XB, st1, A.ln1_g + l * 1024, A.ln1_b + l * 1024, st2}; run_gemm<HEAVY_ALIGN>(lds, HB, (const u16*)(ws + WS_W2 + l * 8 * MiB), 1024, FFD, E, tid0); }
        GSYNC();
        { pg8::EpiGate E{l == 0 ? (float*)nullptr : X, XB, st2, A.ln2_g + l * 1024, A.ln2_b + l * 1024, cv + 8192, cv + 9216, MIX, rowss, A.ple_norm_g + l * 1024, l == 0 ? (u16*)X : (u16*)nullptr}; run_gemm<HEAVY_ALIGN>(lds, XB, (const u16*)(ws + WS_WG + l * 2 * MiB), 1024, 1024, E, tid0); }
        if (l == 0) GSYNC();
    }
#ifdef PROBE_BARS
    for (int i = 0; i < PROBE_BARS; ++i) GSYNC();
#endif
}

extern "C" void kernel_launch(void* const* d_in, const int* in_sizes, int n_in, void* d_out, int out_size, void* d_ws, size_t ws_size, hipStream_t stream) {
    static int grid = 0;
    if (grid == 0) {
        if (n_in != 19 || out_size != MTOK * DMODEL || ws_size < WS_END) { fprintf(stderr, "kernel_launch: unexpected shapes (n_in %d, out %d, ws %zu)\n", n_in, out_size, ws_size); grid = -1; return; }
        int dev = 0, cus = 0, per_cu = 0;
        if (hipGetDevice(&dev) != hipSuccess || hipDeviceGetAttribute(&cus, hipDeviceAttributeMultiprocessorCount, dev) != hipSuccess) { grid = -1; return; }
        if (hipFuncSetAttribute((const void*)fwd_kernel, hipFuncAttributeMaxDynamicSharedMemorySize, LDS_BYTES) != hipSuccess) { fprintf(stderr, "kernel_launch: hipFuncSetAttribute failed\n"); grid = -1; return; }
        if (hipOccupancyMaxActiveBlocksPerMultiprocessor(&per_cu, (const void*)fwd_kernel, 512, LDS_BYTES) != hipSuccess || per_cu < 1) { fprintf(stderr, "kernel_launch: occupancy query says %d\n", per_cu); per_cu = 1; }
        (void)hipGetLastError();
        grid = cus * per_cu;
    }
    if (grid < 0) return;
    if (hipMemsetAsync((char*)d_ws, 0, WS_BAR + 16384, stream) != hipSuccess) { fprintf(stderr, "kernel_launch: memset failed\n"); return; }
    Args a{};
    const float** f = (const float**)&a;
    for (int i = 0; i < 19; ++i) f[i] = (const float*)d_in[i];
    a.out = (float*)d_out; a.ws = (unsigned char*)d_ws;
    void* args[] = {&a};
    hipError_t e = hipLaunchCooperativeKernel((const void*)fwd_kernel, dim3(grid), dim3(512), args, LDS_BYTES, stream);
    if (e != hipSuccess) fprintf(stderr, "cooperative launch failed: %s (grid %d)\n", hipGetErrorString(e), grid);
}
```

```cpp
#include <hip/hip_runtime.h>
#include <hip/hip_cooperative_groups.h>
#include <cstdio>
#include <cstdint>
namespace cg = cooperative_groups;
namespace pg8 {
#define PG8_LAS __attribute__((address_space(3)))
typedef unsigned short bf16_t;
typedef short bf16x8 __attribute__((ext_vector_type(8)));
typedef float f32x4 __attribute__((ext_vector_type(4)));
typedef unsigned u32x4 __attribute__((ext_vector_type(4)));
constexpr int BM = 256, BK = 64, HALF = 128, HTB = HALF * BK * 2  , STAGE_BYTES = 8 * HTB, NXCD = 8, WGM = 8;

__host__ __device__ __forceinline__ int lds_byte(int r, int c) { const int st = (r >> 4) * 2 + (c >> 5), rr = r & 15, cc = c & 31, ob = rr * 64 + cc * 2; return st * 1024 + (ob ^ (((ob >> 9) & 1) << 5)); }
__host__ __device__ __forceinline__ void stage_rc(int b, int& R, int& C) { const int st = b / 1024, sb = b % 1024, swz = sb ^ (((sb >> 9) & 1) << 5); R = (st >> 1) * 16 + swz / 64; C = (st & 1) * 32 + (swz % 64) / 2; }
__host__ __device__ __forceinline__ int perm32(int rho) { const int n = rho >> 4, i = rho & 15; return 8 * (i >> 2) + 4 * n + (i & 3); }

struct Unit { int pm, pn; };
struct Gemm { const bf16_t* A; const bf16_t* Bt; int M, N, K; };

struct StaticOrder {
    int nM, nN, nwg, G, c;
    __host__ __device__ void init(int M, int N, int G_, int c_) { nM = M / BM; nN = N / BM; nwg = nM * nN; G = G_; c = c_; }
    __host__ __device__ bool next(int i, Unit& u) const {
        const long L = (long)i * G + c; if (L >= nwg) return false;
        int wgid = (int)L; { const int q = nwg / NXCD, r = nwg % NXCD, xcd = wgid % NXCD, off = wgid / NXCD; wgid = (xcd < r ? xcd * (q + 1) : r * (q + 1) + (xcd - r) * q) + off; }
        const int nig = WGM * nN, gid = wgid / nig, fm = gid * WGM, gsz = (nM - fm) < WGM ? (nM - fm) : WGM;
        u.pm = fm + ((wgid % nig) % gsz); u.pn = (wgid % nig) / gsz; return true;
    }
    __device__ __forceinline__ void a_ready(const Unit&) const {}
    __device__ __forceinline__ void done(const Unit&) const {}
};

__device__ __forceinline__ unsigned cvt_pk_bf16(float lo, float hi) { unsigned r; asm volatile("v_cvt_pk_bf16_f32 %0, %1, %2" : "=v"(r) : "v"(lo), "v"(hi)); return r; }
typedef float f32x2 __attribute__((ext_vector_type(2)));
template <class Epi, class Sched, bool ALIGN_EPI = false, bool SP2 = false>
__device__ __forceinline__ void gemm_phase(PG8_LAS unsigned char* lds, const Gemm g, const Sched& S, const Epi& E, const int tid_in) {
    const int tid = tid_in, wid = __builtin_amdgcn_readfirstlane(tid >> 6), lane = tid & 63, wr = wid >> 2, wc = wid & 3, fr = lane & 15, fq = lane >> 4;
    const int K = g.K, nt = K / BK;
    unsigned voffA[2], voffB[2];
#pragma unroll
    for (int i = 0; i < 2; ++i) { int R, C; stage_rc(tid * 16 + i * 8192, R, C); const int Rb = Epi::PERM ? ((R & ~31) + perm32(R & 31)) : R;
        voffA[i] = (unsigned)(R * K + C) * 2u; voffB[i] = (unsigned)(Rb * K + C) * 2u; }
    const size_t kstep = (size_t)(BK * 2);
    const size_t hstep = (size_t)HALF * K * 2;
    const size_t tstep = 2 * hstep;
    const unsigned ldsw = (unsigned)wid * 1024u;
    const int aoff = lds_byte(wr * 64 + fr, fq * 8), boff = lds_byte(wc * 32 + fr, fq * 8);
#define PG8_SA(b, h) (((b) * 2 + (h)) * HTB)
#define PG8_SB(b, h) ((4 + (b) * 2 + (h)) * HTB)
#define PG8_STAGE(bufoff, gbase, voff) do { _Pragma("unroll") for (int _i = 0; _i < 2; ++_i) \
        __builtin_amdgcn_global_load_lds((const unsigned*)((const char*)(gbase) + (voff)[_i]), (PG8_LAS unsigned*)(lds + (bufoff) + ldsw + _i * 8192), 16, 0, 0); } while (0)
#define PG8_LDA(dst, b, h) do { _Pragma("unroll") for (int m = 0; m < 4; ++m) _Pragma("unroll") for (int k = 0; k < 2; ++k) dst[m][k] = *(const PG8_LAS bf16x8*)(lds + PG8_SA(b, h) + aoff + m * 2048 + k * 1024); } while (0)
#define PG8_LDB(dst, b, h) do { _Pragma("unroll") for (int n = 0; n < 2; ++n) _Pragma("unroll") for (int k = 0; k < 2; ++k) dst[n][k] = *(const PG8_LAS bf16x8*)(lds + PG8_SB(b, h) + boff + n * 2048 + k * 1024); } while (0)
#define PG8_MMA(ai, bj, At, Bt) do { __builtin_amdgcn_s_setprio(1); _Pragma("unroll") for (int m = 0; m < 4; ++m) _Pragma("unroll") for (int n = 0; n < 2; ++n) _Pragma("unroll") for (int k = 0; k < 2; ++k) \
        acc[ai][bj][m][n] = __builtin_amdgcn_mfma_f32_16x16x32_bf16(Bt[n][k], At[m][k], acc[ai][bj][m][n], 0, 0, 0); __builtin_amdgcn_s_setprio(0); } while (0)
#define PG8_WAIT_V(n) asm volatile("s_waitcnt vmcnt(" #n ")" ::: "memory")
#define PG8_WAIT_L(n) asm volatile("s_waitcnt lgkmcnt(" #n ")" ::: "memory")
#define PG8_BAR __builtin_amdgcn_s_barrier()
#define PG8_SCHED __builtin_amdgcn_sched_barrier(0)
    Unit cur, nxt; int ui = 0;
    if (!S.next(0, cur)) return;
    f32x4 acc[2][2][4][2];
#pragma unroll
    for (int a = 0; a < 2; ++a)
#pragma unroll
        for (int b = 0; b < 2; ++b)
#pragma unroll
            for (int m = 0; m < 4; ++m)
#pragma unroll
                for (int n = 0; n < 2; ++n) acc[a][b][m][n] = (f32x4){0.f, 0.f, 0.f, 0.f};
    bf16x8 At[4][2], B0[2][2], B1[2][2];
    const char* cA = (const char*)g.A + (size_t)cur.pm * tstep; const char* cB = (const char*)g.Bt + (size_t)cur.pn * tstep;
    S.a_ready(cur);
    if constexpr (SP2) {
        PG8_STAGE(PG8_SB(0, 0), cB, voffB); PG8_STAGE(PG8_SB(0, 1), cB + hstep, voffB); PG8_STAGE(PG8_SA(0, 0), cA, voffA); PG8_STAGE(PG8_SA(0, 1), cA + hstep, voffA);
        if (wr == 1) PG8_BAR;
        PG8_WAIT_V(2); PG8_BAR;
        PG8_STAGE(PG8_SB(1, 0), cB + kstep, voffB); PG8_STAGE(PG8_SA(1, 0), cA + kstep, voffA); PG8_STAGE(PG8_SB(1, 1), cB + hstep + kstep, voffB);
        PG8_WAIT_V(6); PG8_BAR;
    } else {
        PG8_STAGE(PG8_SB(0, 0), cB, voffB); PG8_STAGE(PG8_SA(0, 0), cA, voffA); PG8_STAGE(PG8_SB(0, 1), cB + hstep, voffB); PG8_STAGE(PG8_SA(0, 1), cA + hstep, voffA);
        if (wr == 1) PG8_BAR;
        PG8_WAIT_V(4); PG8_BAR;
        PG8_STAGE(PG8_SB(1, 0), cB + kstep, voffB); PG8_STAGE(PG8_SA(1, 0), cA + kstep, voffA); PG8_STAGE(PG8_SB(1, 1), cB + hstep + kstep, voffB);
        PG8_WAIT_V(6); PG8_BAR;
    }
    for (;;) {
        const bool has_next = S.next(ui + 1, nxt);
        const char* nA = has_next ? (const char*)g.A + (size_t)nxt.pm * tstep : cA; const char* nB = has_next ? (const char*)g.Bt + (size_t)nxt.pn * tstep : cB;
        for (int t = 0; t < nt; t += 2) {
            const bool last = (t == nt - 2);
            const char* a1 = cA + (size_t)(t + 1) * kstep;
            const char* a2 = last ? nA : cA + (size_t)(t + 2) * kstep; const char* b2 = last ? nB : cB + (size_t)(t + 2) * kstep;
            const char* a3 = a2 + kstep; const char* b3 = b2 + kstep;
            if (last && has_next) S.a_ready(nxt);
            if constexpr (SP2) {
            PG8_LDB(B0, 0, 0); PG8_LDB(B1, 0, 1); PG8_SCHED; PG8_LDA(At, 0, 0); PG8_STAGE(PG8_SA(1, 1), a1 + hstep, voffA);
            PG8_WAIT_V(8); PG8_WAIT_L(0); PG8_BAR; PG8_MMA(0, 0, At, B0); PG8_MMA(0, 1, At, B1); PG8_BAR; PG8_SCHED;
            PG8_LDA(At, 0, 1); PG8_STAGE(PG8_SB(0, 0), b2, voffB); PG8_STAGE(PG8_SB(0, 1), b2 + hstep, voffB); PG8_STAGE(PG8_SA(0, 0), a2, voffA);
            PG8_WAIT_V(8); PG8_WAIT_L(0); PG8_BAR; PG8_MMA(1, 0, At, B0); PG8_MMA(1, 1, At, B1); PG8_BAR; PG8_SCHED;
            PG8_LDB(B0, 1, 0); PG8_LDB(B1, 1, 1); PG8_SCHED; PG8_LDA(At, 1, 0); PG8_STAGE(PG8_SA(0, 1), a2 + hstep, voffA);
            PG8_WAIT_V(8); PG8_WAIT_L(0); PG8_BAR; PG8_MMA(0, 0, At, B0); PG8_MMA(0, 1, At, B1); PG8_BAR; PG8_SCHED;
            PG8_LDA(At, 1, 1); PG8_STAGE(PG8_SB(1, 0), b3, voffB); PG8_STAGE(PG8_SB(1, 1), b3 + hstep, voffB); PG8_STAGE(PG8_SA(1, 0), a3, voffA);
            PG8_WAIT_V(8); PG8_WAIT_L(0); PG8_BAR; PG8_MMA(1, 0, At, B0); PG8_MMA(1, 1, At, B1); PG8_BAR; PG8_SCHED;
            } else {
            PG8_LDB(B0, 0, 0); PG8_SCHED; PG8_LDA(At, 0, 0); PG8_STAGE(PG8_SA(1, 1), a1 + hstep, voffA);
            PG8_WAIT_L(8); PG8_BAR; PG8_WAIT_L(0); PG8_MMA(0, 0, At, B0); PG8_BAR; PG8_SCHED;
            PG8_LDB(B1, 0, 1); PG8_STAGE(PG8_SB(0, 0), b2, voffB);
            PG8_BAR; PG8_WAIT_L(0); PG8_MMA(0, 1, At, B1); PG8_BAR;
            PG8_LDA(At, 0, 1); PG8_STAGE(PG8_SA(0, 0), a2, voffA);
            PG8_BAR; PG8_WAIT_L(0); PG8_MMA(1, 0, At, B0); PG8_BAR; PG8_SCHED;
            PG8_STAGE(PG8_SB(0, 1), b2 + hstep, voffB);
            PG8_WAIT_V(6); PG8_BAR; PG8_MMA(1, 1, At, B1); PG8_BAR;
            PG8_LDB(B0, 1, 0); PG8_SCHED; PG8_LDA(At, 1, 0); PG8_STAGE(PG8_SA(0, 1), a2 + hstep, voffA);
            PG8_WAIT_L(8); PG8_BAR; PG8_WAIT_L(0); PG8_MMA(0, 0, At, B0); PG8_BAR; PG8_SCHED;
            PG8_LDB(B1, 1, 1); PG8_STAGE(PG8_SB(1, 0), b3, voffB);
            PG8_BAR; PG8_WAIT_L(0); PG8_MMA(0, 1, At, B1); PG8_BAR;
            PG8_LDA(At, 1, 1); PG8_STAGE(PG8_SA(1, 0), a3, voffA);
            PG8_BAR; PG8_WAIT_L(0); PG8_MMA(1, 0, At, B0); PG8_BAR; PG8_SCHED;
            PG8_STAGE(PG8_SB(1, 1), b3 + hstep, voffB);
            PG8_WAIT_V(6); PG8_BAR; PG8_MMA(1, 1, At, B1); PG8_BAR;
            }
        }
        if constexpr (ALIGN_EPI) { if (wr == 0) PG8_BAR; }
        if constexpr (!Epi::AFTER_DRAIN) { E(acc, cur, wr, wc, fr, fq); S.done(cur); }
        if (!has_next) break;
#pragma unroll
        for (int a = 0; a < 2; ++a)
#pragma unroll
            for (int b = 0; b < 2; ++b)
#pragma unroll
                for (int m = 0; m < 4; ++m)
#pragma unroll
                    for (int n = 0; n < 2; ++n) acc[a][b][m][n] = (f32x4){0.f, 0.f, 0.f, 0.f};
        cur = nxt; cA = nA; cB = nB; ++ui;
        if constexpr (ALIGN_EPI) { if (wr == 1) PG8_BAR; }
    }
    PG8_WAIT_V(0);
    if constexpr (!ALIGN_EPI) { if (wr == 0) PG8_BAR; }
    PG8_BAR;
    if constexpr (Epi::AFTER_DRAIN) { E.fused(acc, cur, wr, wc, fr, fq, lds, wid, lane); S.done(cur); }
#undef PG8_SA
#undef PG8_SB
#undef PG8_STAGE
#undef PG8_LDA
#undef PG8_LDB
#undef PG8_MMA
#undef PG8_WAIT_V
#undef PG8_WAIT_L
#undef PG8_BAR
#undef PG8_SCHED
}
}
namespace pg8 {
__device__ __forceinline__ float shx(float v, int m, int lane) { return __builtin_bit_cast(float, __builtin_amdgcn_ds_bpermute((lane ^ m) << 2, __builtin_bit_cast(int, v))); }
constexpr float QSCALE = 0.125f * 1.4426950408889634f;
struct EpiStore {
    static constexpr bool PERM = true, AFTER_DRAIN = false;
    bf16_t* O; int ldc; int act; int rope_cols; int scale_cols; const float* cs;
    const float* st; const float* c1; const float* c2;
    __device__ __forceinline__ void operator()(f32x4 (&acc)[2][2][4][2], const Unit& u, int wr, int wc, int fr, int fq) const {
        { int ln_; asm volatile("v_mbcnt_lo_u32_b32 %0, -1, 0\n\tv_mbcnt_hi_u32_b32 %0, -1, %0" : "=v"(ln_)); fr = ln_ & 15; fq = ln_ >> 4; }
        const int row0 = u.pm * BM + wr * 64 + fr; const int colt = u.pn * BM;
        const int col0 = colt + wc * 32 + 8 * fq;
        if (colt < rope_cols && (wc & 1) == 0) {
            const float sgn = fq == 0 ? -1.f : 1.f; const int lane = fq * 16 + fr;
            const int fqc = fq & 1;
#pragma unroll
            for (int ai = 0; ai < 2; ++ai)
#pragma unroll
                for (int m = 0; m < 4; ++m) {
                    const int pos = (row0 + ai * HALF + m * 16) & 8191;
                    const float* cp = cs + pos * 8;
#pragma unroll
                    for (int n = 0; n < 2; ++n) {
                        const f32x4 cv = *(const f32x4*)(cp + 4 * n), sv = *(const f32x4*)(cp + 65536 + 4 * n);
#pragma unroll
                        for (int bj = 0; bj < 2; ++bj)
#pragma unroll
                            for (int e = 0; e < 4; ++e) {
                                const float v = acc[ai][bj][m][n][e]; const float pv = shx(v, 16, lane);
                                const float nv = v * cv[e] + sgn * pv * sv[e];
                                acc[ai][bj][m][n][e] = (fq < 2) ? nv : v;
                            }
                        asm volatile("" ::: "memory");
                    }
                }
            (void)fqc;
        }
        if (st) {
            float muv[2][4], rsv[2][4];
#pragma unroll
            for (int ai = 0; ai < 2; ++ai)
#pragma unroll
                for (int m = 0; m < 4; ++m) { const int row = row0 + ai * HALF + m * 16; const f32x2 sv = *(const f32x2*)(st + 2 * row); muv[ai][m] = sv.x; rsv[ai][m] = sv.y; }
#pragma unroll
            for (int ai = 0; ai < 2; ++ai)
#pragma unroll
                for (int m = 0; m < 4; ++m) { const float mu = muv[ai][m] * (1.f / 1024.f); rsv[ai][m] = __builtin_amdgcn_rsqf(rsv[ai][m] * (1.f / 1024.f) - mu * mu + 1e-5f); muv[ai][m] = mu; }
#pragma unroll
            for (int bj = 0; bj < 2; ++bj) {
                const f32x4 c1a = *(const f32x4*)(c1 + col0 + bj * HALF), c1b = *(const f32x4*)(c1 + col0 + bj * HALF + 4), c2a = *(const f32x4*)(c2 + col0 + bj * HALF), c2b = *(const f32x4*)(c2 + col0 + bj * HALF + 4);
#pragma unroll
                for (int ai = 0; ai < 2; ++ai)
#pragma unroll
                    for (int m = 0; m < 4; ++m) { const float mu = muv[ai][m], rstd = rsv[ai][m];
                        acc[ai][bj][m][0] = (acc[ai][bj][m][0] - mu * c1a) * rstd + c2a; acc[ai][bj][m][1] = (acc[ai][bj][m][1] - mu * c1b) * rstd + c2b; }
            }
        }
        const float sc = (colt < scale_cols) ? QSCALE : 1.f;
#pragma unroll
        for (int ai = 0; ai < 2; ++ai)
#pragma unroll
            for (int m = 0; m < 4; ++m) { bf16_t* rowp = O + (size_t)(row0 + ai * HALF + m * 16) * ldc + col0;
#pragma unroll
                for (int bj = 0; bj < 2; ++bj) { f32x4 v0 = acc[ai][bj][m][0], v1 = acc[ai][bj][m][1];
                    if (act == 1) {
#pragma unroll
                        for (int e = 0; e < 4; ++e) { float a = fmaxf(v0[e], 0.f), b = fmaxf(v1[e], 0.f); v0[e] = a * a; v1[e] = b * b; } }
                    v0 = v0 * sc; v1 = v1 * sc; u32x4 w; w.x = cvt_pk_bf16(v0[0], v0[1]); w.y = cvt_pk_bf16(v0[2], v0[3]); w.z = cvt_pk_bf16(v1[0], v1[1]); w.w = cvt_pk_bf16(v1[2], v1[3]);
                    *(u32x4*)(rowp + bj * HALF) = w; } }
    }
};
struct EpiResid {
    static constexpr bool PERM = true, AFTER_DRAIN = false;
    const bf16_t* xinb; bf16_t* outb; const float* st_in; const float* g; const float* b; float* st_out;
    __device__ __forceinline__ void operator()(f32x4 (&acc)[2][2][4][2], const Unit& u, int wr, int wc, int fr, int fq) const {
        { int ln_; asm volatile("v_mbcnt_lo_u32_b32 %0, -1, 0\n\tv_mbcnt_hi_u32_b32 %0, -1, %0" : "=v"(ln_)); fr = ln_ & 15; fq = ln_ >> 4; }
        const int lane = fq * 16 + fr;
        const int col0 = u.pn * BM + wc * 32 + 8 * fq;
        f32x4 gv[2][2], bv[2][2];
        if (st_in) {
#pragma unroll
            for (int bj = 0; bj < 2; ++bj)
#pragma unroll
                for (int n = 0; n < 2; ++n) { gv[bj][n] = *(const f32x4*)(g + col0 + bj * HALF + n * 4); bv[bj][n] = *(const f32x4*)(b + col0 + bj * HALF + n * 4); } }
#pragma unroll
        for (int ai = 0; ai < 2; ++ai) {
            const int rowa = u.pm * BM + ai * HALF + wr * 64 + fr;
            float mu[4], rstd[4];
            u32x4 xw[4][2];
#pragma unroll
            for (int m = 0; m < 4; ++m)
#pragma unroll
                for (int bj = 0; bj < 2; ++bj) xw[m][bj] = *(const u32x4*)(xinb + (size_t)(rowa + m * 16) * 1024 + col0 + bj * HALF);
#pragma unroll
            for (int m = 0; m < 4; ++m) { mu[m] = 0.f; rstd[m] = 1.f;
                if (st_in) { const f32x2 sv = *(const f32x2*)(st_in + 2 * (rowa + m * 16)); mu[m] = sv.x * (1.f / 1024.f); rstd[m] = __builtin_amdgcn_rsqf(sv.y * (1.f / 1024.f) - mu[m] * mu[m] + 1e-5f); } }
#pragma unroll
            for (int m = 0; m < 4; ++m) { const int row = rowa + m * 16; const size_t off = (size_t)row * 1024 + col0;
                float s1 = 0.f, s2 = 0.f;
#pragma unroll
                for (int bj = 0; bj < 2; ++bj) { const u32x4 w0 = xw[m][bj];
                    f32x4 xa = {__uint_as_float(w0.x << 16), __uint_as_float(w0.x & 0xffff0000u), __uint_as_float(w0.y << 16), __uint_as_float(w0.y & 0xffff0000u)};
                    f32x4 xb2 = {__uint_as_float(w0.z << 16), __uint_as_float(w0.z & 0xffff0000u), __uint_as_float(w0.w << 16), __uint_as_float(w0.w & 0xffff0000u)};
                    if (st_in) { xa = (xa - mu[m]) * rstd[m] * gv[bj][0] + bv[bj][0]; xb2 = (xb2 - mu[m]) * rstd[m] * gv[bj][1] + bv[bj][1]; }
                    const f32x4 ya = xa * 1.4142135623730951f + acc[ai][bj][m][0], yb2 = xb2 * 1.4142135623730951f + acc[ai][bj][m][1];
                    u32x4 w; w.x = cvt_pk_bf16(ya[0], ya[1]); w.y = cvt_pk_bf16(ya[2], ya[3]); w.z = cvt_pk_bf16(yb2[0], yb2[1]); w.w = cvt_pk_bf16(yb2[2], yb2[3]);
                    *(u32x4*)(outb + off + bj * HALF) = w;
                    s1 += ((ya[0] + ya[1]) + (ya[2] + ya[3])) + ((yb2[0] + yb2[1]) + (yb2[2] + yb2[3]));
                    s2 += ((ya[0] * ya[0] + ya[1] * ya[1]) + (ya[2] * ya[2] + ya[3] * ya[3])) + ((yb2[0] * yb2[0] + yb2[1] * yb2[1]) + (yb2[2] * yb2[2] + yb2[3] * yb2[3])); }
                s1 += shx(s1, 16, lane); s1 += shx(s1, 32, lane); s2 += shx(s2, 16, lane); s2 += shx(s2, 32, lane);
                if (fq == 0 && st_out) { atomicAdd(st_out + 2 * row, s1); atomicAdd(st_out + 2 * row + 1, s2); } }
            asm volatile("" ::: "memory");
        }
    }
};
struct EpiE {
    static constexpr bool PERM = true, AFTER_DRAIN = false;
    bf16_t* O; float* rowss;
    __device__ __forceinline__ void operator()(f32x4 (&acc)[2][2][4][2], const Unit& u, int wr, int wc, int fr, int fq) const {
        { int ln_; asm volatile("v_mbcnt_lo_u32_b32 %0, -1, 0\n\tv_mbcnt_hi_u32_b32 %0, -1, %0" : "=v"(ln_)); fr = ln_ & 15; fq = ln_ >> 4; }
        const int row0 = u.pm * BM + wr * 64 + fr; const int col0 = u.pn * BM + wc * 32 + 8 * fq; const int lane = fq * 16 + fr;
#pragma unroll
        for (int ai = 0; ai < 2; ++ai)
#pragma unroll
            for (int m = 0; m < 4; ++m) { const int row = row0 + ai * HALF + m * 16; bf16_t* rowp = O + (size_t)row * 1024 + col0; float ss = 0.f;
#pragma unroll
                for (int bj = 0; bj < 2; ++bj) { const f32x4 v0 = acc[ai][bj][m][0], v1 = acc[ai][bj][m][1];
                    ss += (v0[0] * v0[0] + v0[1] * v0[1]) + (v0[2] * v0[2] + v0[3] * v0[3]) + (v1[0] * v1[0] + v1[1] * v1[1]) + (v1[2] * v1[2] + v1[3] * v1[3]);
                    u32x4 w; w.x = cvt_pk_bf16(v0[0], v0[1]); w.y = cvt_pk_bf16(v0[2], v0[3]); w.z = cvt_pk_bf16(v1[0], v1[1]); w.w = cvt_pk_bf16(v1[2], v1[3]);
                    *(u32x4*)(rowp + bj * HALF) = w; }
                ss += shx(ss, 16, lane); ss += shx(ss, 32, lane);
                if (fq == 0) atomicAdd(rowss + row, ss); }
    }
};
struct EpiGate {
    static constexpr bool PERM = true, AFTER_DRAIN = false;
    float* x; const bf16_t* yb; const float* st; const float* g2; const float* b2; const float* c1; const float* c2; const bf16_t* E; const float* rowss; const float* gp; bf16_t* xb;
    __device__ __forceinline__ void operator()(f32x4 (&acc)[2][2][4][2], const Unit& u, int wr, int wc, int fr, int fq) const {
        { int ln_; asm volatile("v_mbcnt_lo_u32_b32 %0, -1, 0\n\tv_mbcnt_hi_u32_b32 %0, -1, %0" : "=v"(ln_)); fr = ln_ & 15; fq = ln_ >> 4; }
        const int col0 = u.pn * BM + wc * 32 + 8 * fq;
#pragma unroll
        for (int ai = 0; ai < 2; ++ai)
#pragma unroll
        for (int mp = 0; mp < 2; ++mp) {
            const int rowa = u.pm * BM + ai * HALF + wr * 64 + mp * 32 + fr;
            u32x4 yw[2][2], ew[2][2]; float mu[2], rstd[2], rs[2];
#pragma unroll
            for (int m = 0; m < 2; ++m)
#pragma unroll
                for (int bj = 0; bj < 2; ++bj) { const size_t o2 = (size_t)(rowa + m * 16) * 1024 + col0 + bj * HALF; yw[m][bj] = *(const u32x4*)(yb + o2); ew[m][bj] = *(const u32x4*)(E + o2); }
#pragma unroll
            for (int m = 0; m < 2; ++m) { const int row = rowa + m * 16; const f32x2 sv = *(const f32x2*)(st + 2 * row); rs[m] = rowss[row]; mu[m] = sv.x; rstd[m] = sv.y; }
#pragma unroll
            for (int m = 0; m < 2; ++m) { rs[m] = __builtin_amdgcn_rsqf(rs[m] * (1.0f / 1024.0f) + 1e-5f); mu[m] *= (1.f / 1024.f); rstd[m] = __builtin_amdgcn_rsqf(rstd[m] * (1.f / 1024.f) - mu[m] * mu[m] + 1e-5f); }
#pragma unroll
            for (int bj = 0; bj < 2; ++bj) { const int c = col0 + bj * HALF;
                f32x4 gv[2], g2v[2], b2v[2], c1v[2], c2v[2];
#pragma unroll
                for (int n = 0; n < 2; ++n) { gv[n] = *(const f32x4*)(gp + c + 4 * n); g2v[n] = *(const f32x4*)(g2 + c + 4 * n); b2v[n] = *(const f32x4*)(b2 + c + 4 * n); c1v[n] = *(const f32x4*)(c1 + c + 4 * n); c2v[n] = *(const f32x4*)(c2 + c + 4 * n); }
#pragma unroll
                for (int m = 0; m < 2; ++m) { const size_t o2 = (size_t)(rowa + m * 16) * 1024 + c; f32x4 o[2];
#pragma unroll
                    for (int n = 0; n < 2; ++n) {
                        const unsigned y0 = n ? yw[m][bj].z : yw[m][bj].x, y1 = n ? yw[m][bj].w : yw[m][bj].y, e0 = n ? ew[m][bj].z : ew[m][bj].x, e1 = n ? ew[m][bj].w : ew[m][bj].y;
                        const f32x4 yv = {__uint_as_float(y0 << 16), __uint_as_float(y0 & 0xffff0000u), __uint_as_float(y1 << 16), __uint_as_float(y1 & 0xffff0000u)};
                        const f32x4 ef = {__uint_as_float(e0 << 16), __uint_as_float(e0 & 0xffff0000u), __uint_as_float(e1 << 16), __uint_as_float(e1 & 0xffff0000u)};
                        const f32x4 xv = (yv - mu[m]) * rstd[m] * g2v[n] + b2v[n];
                        const f32x4 a = (acc[ai][bj][2 * mp + m][n] - mu[m] * c1v[n]) * rstd[m] + c2v[n];
#pragma unroll
                        for (int e = 0; e < 4; ++e) o[n][e] = xv[e] + ef[e] * rs[m] * gv[n][e] * __builtin_amdgcn_rcpf(1.f + __expf(-a[e])); }
                    if (x) { *(f32x4*)(x + o2) = o[0]; *(f32x4*)(x + o2 + 4) = o[1]; }
                    if (xb) { u32x4 w; w.x = cvt_pk_bf16(o[0][0], o[0][1]); w.y = cvt_pk_bf16(o[0][2], o[0][3]); w.z = cvt_pk_bf16(o[1][0], o[1][1]); w.w = cvt_pk_bf16(o[1][2], o[1][3]); *(u32x4*)(xb + o2) = w; } } }
            asm volatile("" ::: "memory");
        }
    }
};
}
#define PG8_SP2 true
#define PG8_ALIGN true
#include <hip/hip_bf16.h>
#include <cmath>
namespace attn_body {
using bf16=__hip_bfloat16;
using bf16x8=__attribute__((ext_vector_type(8)))short;
using s16x4=__attribute__((ext_vector_type(4)))short;
using f32x16=__attribute__((ext_vector_type(16)))float;
using u32x4=__attribute__((ext_vector_type(4)))unsigned;
constexpr int SEQ=8192,D=64,DM=3584,DMO=1024;
constexpr int NW=8,QBLK=32,QB=QBLK*NW,KVBLK=64,NQB=SEQ/QB;
constexpr int ATTN_PITCH=DM, ATTN_UNIT_ROWS=QB;
__device__ __forceinline__ int crow(int r,int hi){return (r&3)+8*(r>>2)+4*hi;}
#define SBAR() __builtin_amdgcn_sched_barrier(0)
__device__ __forceinline__ void cmask(f32x16&p0,f32x16&p1,int jb,int qrel,int hi){
  const float NEG=-INFINITY; int kb=64*jb+4*hi;
  #pragma unroll
  for(int r=0;r<16;++r){int kv=kb+(r&3)+8*(r>>2); if(kv>qrel)p0[r]=NEG; if(kv+32>qrel)p1[r]=NEG;}
}

constexpr int NSLOT=3, SLOTB=8192;
constexpr int LDS_K=0, LDS_V=NSLOT*SLOTB, LDS_WS=2*NSLOT*SLOTB, LDS_OST=LDS_WS+NW*64*4, LDS_BYTES=LDS_OST+NW*4096;
constexpr float C2=0.125f*1.4426950408889634f;
__device__ __forceinline__ void glds16(const void*gsrc,unsigned lds_dst){unsigned keep;
  asm volatile("s_mov_b32 %0, m0\n\ts_mov_b32 m0, %2\n\ts_nop 0\n\tglobal_load_lds_dwordx4 %1, off\n\ts_mov_b32 m0, %0":"=&s"(keep):"v"(gsrc),"s"(lds_dst):"memory");}
__device__ __forceinline__ float max3f(float a,float b,float c){float r;asm("v_max3_f32 %0, %1, %2, %3":"=v"(r):"v"(a),"v"(b),"v"(c));return r;}
__device__ __forceinline__ float max2f(float a,float b){float r;asm("v_max_f32_e32 %0, %1, %2":"=v"(r):"v"(a),"v"(b));return r;}
__device__ __forceinline__ float fadd_s(float a,float b){float r;asm("v_add_f32_e32 %0, %1, %2":"=v"(r):"v"(a),"v"(b));return r;}
__device__ __forceinline__ float fsub_s(float a,float b){float r;asm("v_sub_f32_e32 %0, %1, %2":"=v"(r):"v"(a),"v"(b));return r;}
typedef float f32x2_t __attribute__((ext_vector_type(2))); typedef __bf16 bf16x2_t __attribute__((ext_vector_type(2)));
__device__ __forceinline__ unsigned cvtpk_s(float lo,float hi){f32x2_t v={lo,hi};bf16x2_t b=__builtin_convertvector(v,bf16x2_t);return __builtin_bit_cast(unsigned,b);}
#define WAIT_BAR(N) asm volatile("s_waitcnt vmcnt(" #N ") lgkmcnt(0)\n\ts_barrier":::"memory")

__device__ __forceinline__ void qkt(f32x16&p0,f32x16&p1,const char*Kslot,const bf16x8*qr,const f32x16&negm,int r32,int hi){
  const char*kb=Kslot+hi*1024+r32*16;
  #pragma unroll
  for(int d0=0;d0<4;++d0){
    const bf16x8 b0=*reinterpret_cast<const bf16x8*>(kb+d0*2048);
    const bf16x8 b1=*reinterpret_cast<const bf16x8*>(kb+d0*2048+512);
    if(d0==0){p0=__builtin_amdgcn_mfma_f32_32x32x16_bf16(b0,qr[0],negm,0,0,0);p1=__builtin_amdgcn_mfma_f32_32x32x16_bf16(b1,qr[0],negm,0,0,0);}
    else{p0=__builtin_amdgcn_mfma_f32_32x32x16_bf16(b0,qr[d0],p0,0,0,0);p1=__builtin_amdgcn_mfma_f32_32x32x16_bf16(b1,qr[d0],p1,0,0,0);}}
}
typedef __attribute__((address_space(3))) const char* lds_cptr;
typedef short v4i16_t __attribute__((ext_vector_type(4)));
__device__ __forceinline__ void kload8(bf16x8*kf,lds_cptr kp){
  kf[0]=*(const __attribute__((address_space(3))) bf16x8*)(kp);      kf[1]=*(const __attribute__((address_space(3))) bf16x8*)(kp+512);
  kf[2]=*(const __attribute__((address_space(3))) bf16x8*)(kp+2048); kf[3]=*(const __attribute__((address_space(3))) bf16x8*)(kp+2560);
  kf[4]=*(const __attribute__((address_space(3))) bf16x8*)(kp+4096); kf[5]=*(const __attribute__((address_space(3))) bf16x8*)(kp+4608);
  kf[6]=*(const __attribute__((address_space(3))) bf16x8*)(kp+6144); kf[7]=*(const __attribute__((address_space(3))) bf16x8*)(kp+6656);
}
__device__ __forceinline__ void kload2(bf16x8*kf,lds_cptr kp,int j){ kf[2*j]=*(const __attribute__((address_space(3))) bf16x8*)(kp+j*2048); kf[2*j+1]=*(const __attribute__((address_space(3))) bf16x8*)(kp+j*2048+512); }
__device__ __forceinline__ s16x4 vtr(lds_cptr p){ return __builtin_bit_cast(s16x4,__builtin_amdgcn_ds_read_tr16_b64_v4i16((__attribute__((address_space(3))) v4i16_t*)p)); }
__device__ __forceinline__ float rowmax(const f32x16&p0,const f32x16&p1){
  float a=max3f(p0[0],p0[1],p1[0]),b=max3f(p0[2],p0[3],p1[1]);a=max3f(a,p1[2],p1[3]);
  #pragma unroll
  for(int r=4;r<16;r+=4){a=max3f(a,p0[r],p0[r+1]);b=max3f(b,p0[r+2],p0[r+3]);a=max3f(a,p1[r],p1[r+1]);b=max3f(b,p1[r+2],p1[r+3]);}
  const float m=max2f(a,b);
  auto rr=__builtin_amdgcn_permlane32_swap(__float_as_uint(m),__float_as_uint(m),false,false);
  return max2f(__uint_as_float(rr[0]),__uint_as_float(rr[1]));
}
__device__ __forceinline__ void pv(f32x16*o,int vb,bf16x8 pa0,bf16x8 pa1,bf16x8 pa2,bf16x8 pa3){
  #pragma unroll
  for(int d0=0;d0<2;++d0){s16x4 lo[4],hi[4];
    #pragma unroll
    for(int ks=0;ks<4;++ks){
      asm volatile("ds_read_b64_tr_b16 %0,%1 offset:%c2":"=&v"(lo[ks]):"v"(vb),"i"(d0*4096+ks*1024):"memory");
      asm volatile("ds_read_b64_tr_b16 %0,%1 offset:%c2":"=&v"(hi[ks]):"v"(vb),"i"(d0*4096+ks*1024+512):"memory");}
    asm volatile("s_waitcnt lgkmcnt(0)":::"memory");SBAR();
    #define PK(k) (bf16x8){lo[k][0],lo[k][1],lo[k][2],lo[k][3],hi[k][0],hi[k][1],hi[k][2],hi[k][3]}
    o[d0]=__builtin_amdgcn_mfma_f32_32x32x16_bf16(pa0,PK(0),o[d0],0,0,0);
    o[d0]=__builtin_amdgcn_mfma_f32_32x32x16_bf16(pa1,PK(1),o[d0],0,0,0);
    o[d0]=__builtin_amdgcn_mfma_f32_32x32x16_bf16(pa2,PK(2),o[d0],0,0,0);
    o[d0]=__builtin_amdgcn_mfma_f32_32x32x16_bf16(pa3,PK(3),o[d0],0,0,0);
    #undef PK
  }
}

#ifndef ATTN_STORE16
#define ATTN_STORE16(p,v) (*(u32x4*)(p)=(v))
#endif
template<int THRL> __device__ __forceinline__ void attn_unit(int b,int colq,int colk,int colv,int colo,int qb,const bf16*Q,const bf16*__restrict__ K,const bf16*__restrict__ V,bf16*O,char*shm,const int tid_in){
  const int tid=tid_in,lane=tid&63,r32=lane&31,hi=lane>>5; const int wid=__builtin_amdgcn_readfirstlane(tid>>6);
  const long rowbase=(long)b*SEQ; const int q0=qb*QB;
  const bf16*Qw=Q+(rowbase+q0+wid*QBLK)*DM+colq;
  const bf16*Kh=K+rowbase*DM+colk,*Vh=V+rowbase*DM+colv;
  const unsigned lds0=(unsigned)(uintptr_t)shm;
  float*wsf=(float*)(shm+LDS_WS)+wid*64;
  const bf16*ksrc=Kh+(long)lane*DM+wid*8;
  const bf16*vsrc=Vh+(long)(16*(wid&3)+(lane>>2))*DM+(wid>>2)*32+(lane&3)*8;
  const unsigned kdst=lds0+LDS_K+wid*1024, vdst=lds0+LDS_V+wid*1024;
  #define DMA_K(t,slot) glds16(ksrc+(long)(t)*KVBLK*DM,(unsigned)__builtin_amdgcn_readfirstlane(kdst+(slot)))
  #define DMA_V(t,slot) glds16(vsrc+(long)(t)*KVBLK*DM,(unsigned)__builtin_amdgcn_readfirstlane(vdst+(slot)))
  const int vb0=(int)(lds0+LDS_V)+((lane>>4)&1)*32+(lane&3)*8+(4*hi+((lane&15)>>2))*64;
  const char*Kbase=shm+LDS_K; bf16x8 kf[8];
  const lds_cptr shm3=(lds_cptr)shm; const lds_cptr kp0=shm3+LDS_K+hi*1024+r32*16; const lds_cptr vp0=shm3+LDS_V+((lane>>4)&1)*32+(lane&3)*8+(4*hi+((lane&15)>>2))*64;
  const int NT=(q0+QB)/KVBLK;
  DMA_K(0,0);DMA_V(0,0);DMA_K(1,SLOTB);
  bf16x8 qr[4];
  #pragma unroll
  for(int d0=0;d0<4;++d0)qr[d0]=*reinterpret_cast<const bf16x8*>(&Qw[(long)r32*DM+d0*16+hi*8]);
  float mhat=0.f,l_reg=0.f;f32x16 o[2];o[0]=f32x16{};o[1]=f32x16{};f32x16 negm=f32x16{};asm volatile("":"+v"(negm));
  const int qrel=wid*QBLK+r32;
  #define CMASK(P0,P1,t) do{int jb_=(t)-(NT-4); if(jb_>=0)cmask(P0,P1,jb_,qrel,hi);}while(0)
  bool resc=false;
  #define START(P0,P1) do{ const float rm=rowmax(P0,P1); resc=false; \
    { const float dl=rm; mhat=fadd_s(mhat,dl); \
      _Pragma("unroll") for(int r=0;r<16;++r){P0[r]=fsub_s(P0[r],dl);P1[r]=fsub_s(P1[r],dl);} \
      _Pragma("unroll") for(int r=0;r<16;++r)negm[r]=-mhat; asm volatile("":"+v"(negm)); } \
    _Pragma("unroll") for(int r=0;r<16;++r)P0[r]=__builtin_amdgcn_exp2f(P0[r]); }while(0)
  #define RESC() do{ if(resc){ asm volatile("s_waitcnt lgkmcnt(0)":::"memory"); \
      _Pragma("unroll") for(int d_=0;d_<2;++d_) _Pragma("unroll") for(int r=0;r<16;++r)o[d_][r]*=wsf[crow(r,hi)]; } }while(0)
  f32x16 pA0,pA1,pB0,pB1;
  int sl_prev=0,sl_cur=0,sl_next=SLOTB;
  #define ROT() do{sl_prev=sl_cur;sl_cur=sl_next;sl_next=(sl_next==(NSLOT-1)*SLOTB)?0:sl_next+SLOTB;}while(0)
  DMA_K(2,2*SLOTB);
  WAIT_BAR(3);
  qkt(pA0,pA1,Kbase,qr,negm,r32,hi);asm volatile("s_nop 15\n\ts_nop 7":"+v"(pA0),"+v"(pA1));CMASK(pA0,pA1,0);
  START(pA0,pA1);
  _Pragma("unroll") for(int r=0;r<16;++r)pA1[r]=__builtin_amdgcn_exp2f(pA1[r]);
  WAIT_BAR(0);
  DMA_K(3,0);DMA_V(1,SLOTB);
  ROT();
  kload8(kf,kp0+sl_cur);
  WAIT_BAR(2);
  s16x4 vlo[8],vhi[8]; u32x4 pw0,pw1,pw2,pw3;
  #define PKW(P,B) cvtpk_s(P[B],P[B+1])
  #define PAF(k) __builtin_bit_cast(bf16x8,pw##k)
  #define VFR(i) (bf16x8){vlo[i][0],vlo[i][1],vlo[i][2],vlo[i][3],vhi[i][0],vhi[i][1],vhi[i][2],vhi[i][3]}
  #define PIN(x) asm volatile("":"+v"(x))
  #define MX3(a,b,c) __builtin_fmaxf(__builtin_fmaxf((a),(b)),(c))
  #define GAPA(MF,A0,A1,A2,A3,W0,W1,PW) do{ MF; sacc+=A0; sacc+=A1; sacc+=A2; sacc+=A3; PIN(sacc); W0; W1; PIN(PW); SBAR(); }while(0)
  #define EX(v) __builtin_amdgcn_exp2f(v)
  #define GAPB(MF,X,B) do{ MF; X[B]=EX(X[B]); X[B+1]=EX(X[B+1]); X[B+2]=EX(X[B+2]); X[B+3]=EX(X[B+3]); PIN(X); SBAR(); }while(0)
  #define VRD(i) do{ vlo[i]=vtr(vp_+(((i)>>2)*4096+((i)&3)*1024)); vhi[i]=vtr(vp_+(((i)>>2)*4096+((i)&3)*1024+512)); }while(0)
  #define KRD(G,j) do{ if(G){ kload2(kf,kp0+sl_next,j); SBAR(); } }while(0)
  #define STEP(C0,C1,P0,P1,t,GK,GV,GL) do{ SBAR(); \
    const lds_cptr vp_=vp0+sl_prev; \
    VRD(0); SBAR(); float sacc=(P0[0]+P0[1]); \
    GAPA(C0=__builtin_amdgcn_mfma_f32_32x32x16_bf16(kf[0],qr[0],negm,0,0,0), P0[2],P0[3],P0[4],P0[5],     pw0[0]=PKW(P0,0), pw0[1]=PKW(P0,2), pw0); \
    VRD(4); SBAR(); GAPA(C1=__builtin_amdgcn_mfma_f32_32x32x16_bf16(kf[1],qr[0],negm,0,0,0), P0[6],P0[7],P0[8],P0[9],     pw0[2]=PKW(P0,4), pw0[3]=PKW(P0,6), pw0); \
    VRD(1); SBAR(); GAPA(C0=__builtin_amdgcn_mfma_f32_32x32x16_bf16(kf[2],qr[1],C0,0,0,0),   P0[10],P0[11],P0[12],P0[13], pw1[0]=PKW(P0,8), pw1[1]=PKW(P0,10), pw1); \
    VRD(5); SBAR(); GAPA(C1=__builtin_amdgcn_mfma_f32_32x32x16_bf16(kf[3],qr[1],C1,0,0,0),   P0[14],P0[15],P1[0],P1[1],   pw1[2]=PKW(P0,12),pw1[3]=PKW(P0,14), pw1); \
    VRD(2); SBAR(); GAPA(C0=__builtin_amdgcn_mfma_f32_32x32x16_bf16(kf[4],qr[2],C0,0,0,0),   P1[2],P1[3],P1[4],P1[5],     pw2[0]=PKW(P1,0), pw2[1]=PKW(P1,2), pw2); \
    VRD(6); SBAR(); GAPA(C1=__builtin_amdgcn_mfma_f32_32x32x16_bf16(kf[5],qr[2],C1,0,0,0),   P1[6],P1[7],P1[8],P1[9],     pw2[2]=PKW(P1,4), pw2[3]=PKW(P1,6), pw2); \
    VRD(3); SBAR(); GAPA(C0=__builtin_amdgcn_mfma_f32_32x32x16_bf16(kf[6],qr[3],C0,0,0,0),   P1[10],P1[11],P1[12],P1[13], pw3[0]=PKW(P1,8), pw3[1]=PKW(P1,10), pw3); \
    VRD(7); SBAR(); GAPA(C1=__builtin_amdgcn_mfma_f32_32x32x16_bf16(kf[7],qr[3],C1,0,0,0),   P1[14],P1[15],0.f,0.f,       pw3[2]=PKW(P1,12),pw3[3]=PKW(P1,14), pw3); \
    l_reg+=sacc; \
    if(GK){DMA_K((t)+3,sl_cur);} if(GV){DMA_V((t)+1,sl_next);} \
    CMASK(C0,C1,t); \
    { float a=MX3(C0[0],C0[1],C1[0]),b=MX3(C0[2],C0[3],C1[1]); a=MX3(a,C1[2],C1[3]); \
      _Pragma("unroll") for(int r=4;r<16;r+=4){a=MX3(a,C0[r],C0[r+1]);b=MX3(b,C0[r+2],C0[r+3]);a=MX3(a,C1[r],C1[r+1]);b=MX3(b,C1[r+2],C1[r+3]);} \
      float rm=__builtin_fmaxf(a,b); { auto rr=__builtin_amdgcn_permlane32_swap(__float_as_uint(rm),__float_as_uint(rm),false,false); rm=__builtin_fmaxf(__uint_as_float(rr[0]),__uint_as_float(rr[1])); } \
      resc=false; \
      if(__builtin_expect(__any(rm>(float)THRL),0)){ const float dl=__builtin_fmaxf(rm,0.f); mhat+=dl; \
        _Pragma("unroll") for(int r=0;r<16;++r){C0[r]-=dl;C1[r]-=dl;} \
        _Pragma("unroll") for(int r=0;r<16;++r)negm[r]=-mhat; asm volatile("":"+v"(negm)); \
        const float f=__builtin_amdgcn_exp2f(-dl); l_reg*=f; if(hi==0)wsf[r32]=f; resc=true; } } \
    SBAR(); \
    GAPB(o[0]=__builtin_amdgcn_mfma_f32_32x32x16_bf16(PAF(0),VFR(0),o[0],0,0,0), C0,0); \
    GAPB(o[1]=__builtin_amdgcn_mfma_f32_32x32x16_bf16(PAF(0),VFR(4),o[1],0,0,0), C0,4); \
    KRD(GL,0); GAPB(o[0]=__builtin_amdgcn_mfma_f32_32x32x16_bf16(PAF(1),VFR(1),o[0],0,0,0), C0,8); \
    KRD(GL,1); GAPB(o[1]=__builtin_amdgcn_mfma_f32_32x32x16_bf16(PAF(1),VFR(5),o[1],0,0,0), C0,12); \
    KRD(GL,2); GAPB(o[0]=__builtin_amdgcn_mfma_f32_32x32x16_bf16(PAF(2),VFR(2),o[0],0,0,0), C1,0); \
    KRD(GL,3); GAPB(o[1]=__builtin_amdgcn_mfma_f32_32x32x16_bf16(PAF(2),VFR(6),o[1],0,0,0), C1,4); \
    GAPB(o[0]=__builtin_amdgcn_mfma_f32_32x32x16_bf16(PAF(3),VFR(3),o[0],0,0,0), C1,8); \
    GAPB(o[1]=__builtin_amdgcn_mfma_f32_32x32x16_bf16(PAF(3),VFR(7),o[1],0,0,0), C1,12); \
    }while(0)
  int t=1;
  #undef CMASK
  #define CMASK(P0,P1,t) do{}while(0)
  for(;t+5<NT;t+=2){
    STEP(pB0,pB1,pA0,pA1,t,true,true,true);     WAIT_BAR(2); RESC(); ROT();
    STEP(pA0,pA1,pB0,pB1,t+1,true,true,true);   WAIT_BAR(2); RESC(); ROT();
  }
  #undef CMASK
  #define CMASK(P0,P1,t) do{int jb_=(t)-(NT-4); if(jb_>=0)cmask(P0,P1,jb_,qrel,hi);}while(0)
  #define ENDW(tt) do{ if((tt)+3<NT){WAIT_BAR(2);} else if((tt)+2<NT){WAIT_BAR(1);} else {WAIT_BAR(0);} }while(0)
  for(;t+1<NT;t+=2){
    STEP(pB0,pB1,pA0,pA1,t,(t+3<NT),(t+1<NT),(t+1<NT));       ENDW(t);   RESC(); ROT();
    STEP(pA0,pA1,pB0,pB1,t+1,(t+4<NT),(t+2<NT),(t+2<NT));     ENDW(t+1); RESC(); ROT();
  }
  STEP(pB0,pB1,pA0,pA1,NT-1,false,false,false); RESC();
  { float sacc=pB0[0]+pB0[1]; _Pragma("unroll") for(int r=2;r<16;++r)sacc+=pB0[r]; _Pragma("unroll") for(int r=0;r<16;++r)sacc+=pB1[r]; l_reg+=sacc;
    pw0=(u32x4){PKW(pB0,0),PKW(pB0,2),PKW(pB0,4),PKW(pB0,6)};pw1=(u32x4){PKW(pB0,8),PKW(pB0,10),PKW(pB0,12),PKW(pB0,14)};pw2=(u32x4){PKW(pB1,0),PKW(pB1,2),PKW(pB1,4),PKW(pB1,6)};pw3=(u32x4){PKW(pB1,8),PKW(pB1,10),PKW(pB1,12),PKW(pB1,14)};
    SBAR(); pv(o,vb0+sl_cur,PAF(0),PAF(1),PAF(2),PAF(3)); }
  #undef PKW
  #undef PAF
  #undef VFR
  #undef PIN
  #undef MX3
  #undef GAPA
  #undef GAPB
  #undef EX
  #undef VRD
  #undef KRD
  #undef STEP
  #undef ENDW
  {auto rr=__builtin_amdgcn_permlane32_swap(__float_as_uint(l_reg),__float_as_uint(l_reg),false,false);l_reg=__uint_as_float(rr[0])+__uint_as_float(rr[1]);}
  if(hi==0)wsf[32+r32]=l_reg;asm volatile("s_waitcnt lgkmcnt(0)":::"memory");
  float rli[16];
  #pragma unroll
  for(int r=0;r<16;++r)rli[r]=__builtin_amdgcn_rcpf(wsf[32+crow(r,hi)]);
  bf16*Ow=O+(rowbase+q0+wid*QBLK)*DMO+colo;
  { bf16*stg=(bf16*)(shm+LDS_OST)+wid*2048;
    #pragma unroll
    for(int r=0;r<16;++r){const int orow=crow(r,hi);
      #pragma unroll
      for(int d0=0;d0<2;++d0)stg[orow*64+d0*32+r32]=__float2bfloat16(o[d0][r]*rli[r]);}
    asm volatile("s_waitcnt lgkmcnt(0)":::"memory");
    #pragma unroll
    for(int i=0;i<4;++i){const int row=i*8+(lane>>3),ch=lane&7; const u32x4 v=*(const u32x4*)(stg+row*64+ch*8); ATTN_STORE16(Ow+(long)row*DMO+ch*8,v);} }
  asm volatile("s_waitcnt lgkmcnt(0)\n\ts_barrier":::"memory");
  #undef DMA_K
  #undef DMA_V
  #undef CMASK
  #undef START
  #undef RESC
  #undef ROT
}
constexpr int ATTN_LDS_BYTES=LDS_BYTES;
#undef SBAR
#undef WAIT_BAR
}
#define LAS __attribute__((address_space(3)))
typedef unsigned short u16;
typedef unsigned v4u __attribute__((ext_vector_type(4)));
typedef unsigned v2u __attribute__((ext_vector_type(2)));
typedef float f32x4 __attribute__((ext_vector_type(4)));
typedef short bf16x8 __attribute__((ext_vector_type(8)));
typedef short s16x4 __attribute__((ext_vector_type(4)));
typedef float f32x16 __attribute__((ext_vector_type(16)));
typedef float f32x2_t __attribute__((ext_vector_type(2)));
typedef __bf16 bf16x2_t __attribute__((ext_vector_type(2)));

constexpr int MTOK = 32768, SEQL = 8192, DMODEL = 1024, FFD = 4096, NIN0 = 3584, NIN1 = 3072, PLE = 256;
constexpr float LN_EPS = 1e-5f;
constexpr float ALPHA = 1.4142135623730951f;
constexpr size_t MiB = 1u << 20;
constexpr size_t WS_CVEC = 0;
constexpr size_t WS_STATS = 62 * MiB;
constexpr size_t WS_ROWSS = 63 * MiB;
constexpr size_t WS_BAR = 256 * 1024;
constexpr size_t WS_MISC = 512 * 1024;
constexpr size_t WS_CS = 1 * MiB;
constexpr size_t WS_WIN0 = 2 * MiB, WS_WOUT0 = 9 * MiB, WS_WIN1 = 11 * MiB, WS_WOUT1 = 17 * MiB, WS_W1 = 19 * MiB  , WS_W2 = 35 * MiB  , WS_WP = 51 * MiB  , WS_WG = 52 * MiB  ;
constexpr size_t WS_LSE = 56 * MiB;
constexpr size_t WS_XB = 64 * MiB, WS_MIX = 128 * MiB, WS_HB = 192 * MiB, WS_AUX = 448 * MiB, WS_END = 512 * MiB;
constexpr size_t WS_HGS = 416 * MiB, WS_HGD = 432 * MiB;
constexpr size_t WS_OB1 = 384 * MiB;
constexpr int LDS_BYTES = 147456;

__device__ __forceinline__ unsigned f2bf(float f) { unsigned u = __builtin_bit_cast(unsigned, f); return (u + 0x7fffu + ((u >> 16) & 1u)) >> 16; }
__device__ __forceinline__ unsigned pk2(float lo, float hi) { f32x2_t v = {lo, hi}; bf16x2_t b = __builtin_convertvector(v, bf16x2_t); return __builtin_bit_cast(unsigned, b); }
__device__ __forceinline__ float bf2f(unsigned v) { return __uint_as_float(v << 16); }
__device__ __forceinline__ float bflo(unsigned w) { return __uint_as_float(w << 16); }
__device__ __forceinline__ float bfhi(unsigned w) { return __uint_as_float(w & 0xffff0000u); }
__device__ __forceinline__ float shx(float v, int m, int lane) { return __builtin_bit_cast(float, __builtin_amdgcn_ds_bpermute((lane ^ m) << 2, __builtin_bit_cast(int, v))); }
__device__ __forceinline__ float wave_sum(float v, int lane) {
#pragma unroll
    for (int o = 1; o < 64; o <<= 1) v += shx(v, o, lane);
    return v;
}
__device__ __forceinline__ int crow(int reg, int h) { return (reg & 3) + 8 * (reg >> 2) + 4 * h; }
#define MFMA32(a, b, c) __builtin_amdgcn_mfma_f32_32x32x16_bf16((a), (b), (c), 0, 0, 0)
__device__ __forceinline__ bf16x8 pack8(const f32x16& x, int base) {
    v4u p; p.x = pk2(x[base], x[base + 1]); p.y = pk2(x[base + 2], x[base + 3]); p.z = pk2(x[base + 4], x[base + 5]); p.w = pk2(x[base + 6], x[base + 7]);
    return __builtin_bit_cast(bf16x8, p);
}
typedef short v4i16_t __attribute__((ext_vector_type(4)));
__device__ __forceinline__ s16x4 trrd(LAS unsigned char* p) { return __builtin_bit_cast(s16x4, __builtin_amdgcn_ds_read_tr16_b64_v4i16((LAS v4i16_t*)p)); }
__device__ __forceinline__ bf16x8 trfrag(LAS unsigned char* img, int pitch, int row_lo, int hi_delta, int col0, int lane) {
    const int i16 = lane & 15, q = i16 >> 2, p = i16 & 3, g16 = (lane >> 4) & 1;
    LAS unsigned char* a = img + (row_lo + q) * pitch + (col0 + 16 * g16 + 4 * p) * 2;
    const s16x4 lo = trrd(a), hi = trrd(a + hi_delta * pitch);
    return (bf16x8){lo[0], lo[1], lo[2], lo[3], hi[0], hi[1], hi[2], hi[3]};
}

struct Args {
    const float *x, *p, *ev_w_in, *ev_w_out, *da_lambda, *da_subln_g, *hg_lb_logits, *hg_norm_g, *od_w_in, *od_w_out, *ln1_g, *ln1_b, *ffn_w1, *ffn_w2, *ln2_g, *ln2_b, *ple_w_proj, *ple_w_gate, *ple_norm_g;
    float* out; unsigned char* ws;
};

__device__ __forceinline__ void p0_transpose_item(const float* W, int K, int N, u16* WT, LAS float* scr, int item, int lane, const float* gk = nullptr, const float* bk = nullptr, float* c1 = nullptr, float* c2 = nullptr) {
    const int nblk = N / 32, kb = item / nblk, nb = item % nblk, k0 = 64 * kb, n0 = 32 * nb;
#pragma unroll 8
    for (int i = 0; i < 32; ++i) { const int kk = 2 * i + (lane >> 5); scr[kk * 33 + (lane & 31)] = W[(size_t)(k0 + kk) * N + n0 + (lane & 31)]; }
    asm volatile("s_waitcnt lgkmcnt(0)" ::: "memory");
    const int c = lane & 7;
    float gs[8];
#pragma unroll
    for (int e = 0; e < 8; ++e) gs[e] = gk ? gk[k0 + 8 * c + e] : 1.f;
    if (gk) {
        const int n = lane & 31, kh = (lane >> 5) * 32; float s1 = 0.f, s2 = 0.f;
#pragma unroll 8
        for (int kk = 0; kk < 32; ++kk) { const float wv = scr[(kh + kk) * 33 + n]; s1 += gk[k0 + kh + kk] * wv; s2 += bk[k0 + kh + kk] * wv; }
        s1 += shx(s1, 32, lane); s2 += shx(s2, 32, lane);
        if (lane < 32) { atomicAdd(c1 + n0 + n, s1); atomicAdd(c2 + n0 + n, s2); }
    }
#pragma unroll
    for (int j = 0; j < 4; ++j) { const int n = (lane >> 3) + 8 * j; const LAS float* sp = scr + (8 * c) * 33 + n;
        v4u o; o.x = pk2(sp[0 * 33] * gs[0], sp[1 * 33] * gs[1]); o.y = pk2(sp[2 * 33] * gs[2], sp[3 * 33] * gs[3]); o.z = pk2(sp[4 * 33] * gs[4], sp[5 * 33] * gs[5]); o.w = pk2(sp[6 * 33] * gs[6], sp[7 * 33] * gs[7]);
        *(v4u*)(WT + (size_t)(n0 + n) * K + k0 + 8 * c) = o; }
    asm volatile("s_waitcnt lgkmcnt(0)" ::: "memory");
}
__device__ __forceinline__ void prologue(const Args& A, LAS unsigned char* lds, int gw, int NGW, int wave, int lane) {
    unsigned char* ws = A.ws;
    LAS float* scr = (LAS float*)(lds + wave * 16384);
    const int cnt[12] = {(1024 / 64) * (NIN0 / 32), 512, (1024 / 64) * (NIN1 / 32), 512, 2048, 2048, 2048, 2048, 128, 128, 512, 512};
    int total = 0;
#pragma unroll
    for (int i = 0; i < 12; ++i) total += cnt[i];
    for (int it = gw; it < total; it += NGW) {
        int r = it;
        if (r < cnt[0]) { p0_transpose_item(A.ev_w_in, 1024, NIN0, (u16*)(ws + WS_WIN0), scr, r, lane); continue; } r -= cnt[0];
        if (r < cnt[1]) { p0_transpose_item(A.ev_w_out, 1024, 1024, (u16*)(ws + WS_WOUT0), scr, r, lane); continue; } r -= cnt[1];
        if (r < cnt[2]) { p0_transpose_item(A.od_w_in, 1024, NIN1, (u16*)(ws + WS_WIN1), scr, r, lane); continue; } r -= cnt[2];
        if (r < cnt[3]) { p0_transpose_item(A.od_w_out, 1024, 1024, (u16*)(ws + WS_WOUT1), scr, r, lane); continue; } r -= cnt[3];
        if (r < 4096) { const int l = r >> 11; float* cv = (float*)(ws + WS_CVEC) + l * 10240; p0_transpose_item(A.ffn_w1 + (size_t)l * 1024 * 4096, 1024, 4096, (u16*)(ws + WS_W1 + l * 8 * MiB), scr, r & 2047, lane, A.ln1_g + l * 1024, A.ln1_b + l * 1024, cv, cv + 4096); continue; } r -= 4096;
        if (r < 4096) { const int l = r >> 11; p0_transpose_item(A.ffn_w2 + (size_t)l * 1024 * 4096, 4096, 1024, (u16*)(ws + WS_W2 + l * 8 * MiB), scr, r & 2047, lane); continue; } r -= 4096;
        if (r < 256) { const int l = r >> 7; p0_transpose_item(A.ple_w_proj + (size_t)l * 256 * 1024, 256, 1024, (u16*)(ws + WS_WP + l * (MiB / 2)), scr, r & 127, lane); continue; } r -= 256;
        { const int l = r >> 9; float* cv = (float*)(ws + WS_CVEC) + l * 10240 + 8192; p0_transpose_item(A.ple_w_gate + (size_t)l * 1024 * 1024, 1024, 1024, (u16*)(ws + WS_WG + l * 2 * MiB), scr, r & 511, lane, A.ln2_g + l * 1024, A.ln2_b + l * 1024, cv, cv + 1024); }
    }
    u16* XB = (u16*)(ws + WS_XB);
    for (int m = gw; m < MTOK; m += NGW) {
        const f32x4* xr = (const f32x4*)(A.x + (size_t)m * 1024) + 2 * lane; v4u* o = (v4u*)(XB + (size_t)m * 1024) + lane;
#pragma unroll
        for (int j = 0; j < 2; ++j) { const f32x4 v = xr[128 * j], v2 = xr[128 * j + 1]; v4u w; w.x = pk2(v[0], v[1]); w.y = pk2(v[2], v[3]); w.z = pk2(v2[0], v2[1]); w.w = pk2(v2[2], v2[3]); o[64 * j] = w; }
    }
    { v4u* z = (v4u*)(ws + WS_STATS); for (int i = gw * 64 + lane; i < (int)((MiB + 256 * 1024) / 16); i += NGW * 64) z[i] = (v4u){0u, 0u, 0u, 0u}; }
    float* cs = (float*)(ws + WS_CS);
    for (int idx = gw * 64 + lane; idx < 65536; idx += NGW * 64) {
        const int pos = idx >> 3, e = idx & 7;
        double iv = 1.0;
#pragma unroll 1
        for (int k = 0; k < e; ++k) iv *= 0.19392274474868576;
        const float inv = (float)iv;
        const float angf = (float)pos * inv;
        double a = (double)angf; const double twopi = 6.283185307179586476925;
        const double kq = __builtin_rint(a / twopi); a -= kq * twopi;
        const double a2 = a * a; double sn = 0.0, cn = 0.0;
        double ts = a, tc = 1.0;
#pragma unroll 1
        for (int n = 0; n < 16; ++n) { cn += tc; sn += ts; tc *= -a2 / (double)((2 * n + 1) * (2 * n + 2)); ts *= -a2 / (double)((2 * n + 2) * (2 * n + 3)); }
        cs[idx] = (float)cn; cs[65536 + idx] = (float)sn;
    }
    float* misc = (float*)(ws + WS_MISC);
    for (int i = gw * 64 + lane; i < 512; i += NGW * 64) { const float l0 = A.hg_lb_logits[i], l1 = A.hg_lb_logits[512 + i]; misc[i] = 1.f / (1.f + __expf(l1 - l0)); }
}

__device__ __forceinline__ void ln_rows(float* X, u16* XBo, const float* g, const float* bta, float* rowss, const float* prow, u16* PBo, int gw, int NGW, int lane) {
    for (int m = gw; m < MTOK; m += NGW) {
        f32x4* xr = (f32x4*)(X + (size_t)m * 1024) + lane;
        f32x4 v[4]; float s = 0.f;
#pragma unroll
        for (int j = 0; j < 4; ++j) { v[j] = xr[64 * j]; s += (v[j][0] + v[j][1]) + (v[j][2] + v[j][3]); }
        const float mean = wave_sum(s, lane) * (1.f / 1024.f); float s2 = 0.f;
#pragma unroll
        for (int j = 0; j < 4; ++j) { v[j] = v[j] - mean; s2 += (v[j][0] * v[j][0] + v[j][1] * v[j][1]) + (v[j][2] * v[j][2] + v[j][3] * v[j][3]); }
        const float rstd = 1.f / sqrtf(wave_sum(s2, lane) * (1.f / 1024.f) + LN_EPS);
        v2u* o8 = (v2u*)(XBo + (size_t)m * 1024) + lane;
#pragma unroll
        for (int j = 0; j < 4; ++j) { const f32x4 gv = ((const f32x4*)g)[lane + 64 * j], bv = ((const f32x4*)bta)[lane + 64 * j];
            const f32x4 o = v[j] * rstd * gv + bv; xr[64 * j] = o; v2u w; w.x = pk2(o[0], o[1]); w.y = pk2(o[2], o[3]); o8[64 * j] = w; }
        if (rowss && lane == 0) rowss[m] = 0.f;
        if (prow) { const f32x4 pv = ((const f32x4*)(prow + (size_t)m * 256))[lane]; v2u w; w.x = pk2(pv[0], pv[1]); w.y = pk2(pv[2], pv[3]); ((v2u*)(PBo + (size_t)m * 256))[lane] = w; }
    }
}
__device__ __forceinline__ void p_rows(const float* prow, u16* PBo, int gw, int NGW, int lane) {
    for (int m = gw; m < MTOK; m += NGW) { const f32x4 pv = ((const f32x4*)(prow + (size_t)m * 256))[lane]; v2u w; w.x = pk2(pv[0], pv[1]); w.y = pk2(pv[2], pv[3]); ((v2u*)(PBo + (size_t)m * 256))[lane] = w; }
}
__device__ __forceinline__ void p_rows2(const float* prow, u16* PBo, int gw, int NGW, int lane) {
    for (int m = gw; m < 2 * MTOK; m += NGW) {
        if (lane < 32) { const f32x4 a = ((const f32x4*)(prow + (size_t)m * 256))[2 * lane], b = ((const f32x4*)(prow + (size_t)m * 256))[2 * lane + 1];
            v4u w; w.x = pk2(a[0], a[1]); w.y = pk2(a[2], a[3]); w.z = pk2(b[0], b[1]); w.w = pk2(b[2], b[3]); ((v4u*)(PBo + (size_t)m * 256))[lane] = w; }
    }
}
__device__ __forceinline__ void diff_combine_block(const u16* AUX, u16* MIX, const float* lam_p, const float* subg, size_t row0, int h, int tid) {
    const int lane = tid & 63;
    const float s01 = wave_sum(lam_p[lane] * lam_p[64 + lane], lane), s23 = wave_sum(lam_p[128 + lane] * lam_p[192 + lane], lane);
    const float lam = __expf(s01) - __expf(s23) + 0.2f;
    const int d0 = (tid & 15) * 8;
    float gv[8];
#pragma unroll
    for (int e = 0; e < 8; ++e) gv[e] = subg[d0 + e] * 0.8f;
#pragma unroll
    for (int it = 0; it < 8; ++it) {
        const size_t m = row0 + (tid >> 4) + 32 * it;
        const v4u a0 = *(const v4u*)(AUX + m * 1024 + h * 256 + d0), a1 = *(const v4u*)(AUX + m * 1024 + h * 256 + 128 + d0);
        float o[8];
        o[0] = bflo(a0.x) - lam * bflo(a1.x); o[1] = bfhi(a0.x) - lam * bfhi(a1.x); o[2] = bflo(a0.y) - lam * bflo(a1.y); o[3] = bfhi(a0.y) - lam * bfhi(a1.y);
        o[4] = bflo(a0.z) - lam * bflo(a1.z); o[5] = bfhi(a0.z) - lam * bfhi(a1.z); o[6] = bflo(a0.w) - lam * bflo(a1.w); o[7] = bfhi(a0.w) - lam * bfhi(a1.w);
        float ss = 0.f;
#pragma unroll
        for (int e = 0; e < 8; ++e) ss += o[e] * o[e];
        ss += shx(ss, 1, lane); ss += shx(ss, 2, lane); ss += shx(ss, 4, lane); ss += shx(ss, 8, lane);
        const float rs = __builtin_amdgcn_rsqf(ss * (1.f / 128.f) + LN_EPS);
        v4u w; w.x = pk2(o[0] * rs * gv[0], o[1] * rs * gv[1]); w.y = pk2(o[2] * rs * gv[2], o[3] * rs * gv[3]); w.z = pk2(o[4] * rs * gv[4], o[5] * rs * gv[5]); w.w = pk2(o[6] * rs * gv[6], o[7] * rs * gv[7]);
        *(v4u*)(MIX + m * 1024 + h * 128 + d0) = w;
    }
}
__device__ __forceinline__ void diff_combine(const u16* AUX, u16* MIX, const float* lam_p, const float* subg, int gw, int NGW, int lane) {
    const float s01 = wave_sum(lam_p[lane] * lam_p[64 + lane], lane), s23 = wave_sum(lam_p[128 + lane] * lam_p[192 + lane], lane);
    const float lam = __expf(s01) - __expf(s23) + 0.2f;
    const int h = lane >> 4, d0 = (lane & 15) * 8;
    float gv[8];
#pragma unroll
    for (int e = 0; e < 8; ++e) gv[e] = subg[d0 + e] * 0.8f;
    for (int m = gw; m < MTOK; m += NGW) {
        const v4u a0 = *(const v4u*)(AUX + (size_t)m * 1024 + h * 256 + d0), a1 = *(const v4u*)(AUX + (size_t)m * 1024 + h * 256 + 128 + d0);
        float o[8];
        o[0] = bflo(a0.x) - lam * bflo(a1.x); o[1] = bfhi(a0.x) - lam * bfhi(a1.x); o[2] = bflo(a0.y) - lam * bflo(a1.y); o[3] = bfhi(a0.y) - lam * bfhi(a1.y);
        o[4] = bflo(a0.z) - lam * bflo(a1.z); o[5] = bfhi(a0.z) - lam * bfhi(a1.z); o[6] = bflo(a0.w) - lam * bflo(a1.w); o[7] = bfhi(a0.w) - lam * bfhi(a1.w);
        float ss = 0.f;
#pragma unroll
        for (int e = 0; e < 8; ++e) ss += o[e] * o[e];
        ss += shx(ss, 1, lane); ss += shx(ss, 2, lane); ss += shx(ss, 4, lane); ss += shx(ss, 8, lane);
        const float rs = 1.f / sqrtf(ss * (1.f / 128.f) + LN_EPS);
        v4u w; w.x = pk2(o[0] * rs * gv[0], o[1] * rs * gv[1]); w.y = pk2(o[2] * rs * gv[2], o[3] * rs * gv[3]); w.z = pk2(o[4] * rs * gv[4], o[5] * rs * gv[5]); w.w = pk2(o[6] * rs * gv[6], o[7] * rs * gv[7]);
        *(v4u*)(MIX + (size_t)m * 1024 + h * 128 + d0) = w;
    }
}
namespace hg {
constexpr int P_QA = 272, P_QO = 264, P_TR = 320;
constexpr int O_QA = 0, O_KA = O_QA + 64 * P_QA, O_QO = O_KA + 64 * P_QA, O_KST = O_QO + 64 * P_QO, O_V = O_KST + 64 * P_TR, O_OST = O_V + 64 * P_TR, O_TOT = O_OST + 64 * 132 * 4, O_DEC = O_TOT + 2048, O_END = O_DEC + 512;
static_assert(O_END <= 131072, "hgrn lds");
template <bool OUT>
__device__ __forceinline__ void item(LAS unsigned char* L, const u16* __restrict__ H, int it, const float* __restrict__ lbv, float* Send, float* Drun, const float* __restrict__ outg, u16* MIX, const int tid, const float* Sst = nullptr) {
    const int  lane = tid & 63, w = __builtin_amdgcn_readfirstlane(tid >> 6), r = lane & 31, h = lane >> 5;
    const int tt = w & 1, vt = w >> 1;
    const int bh = it >> 4, run = it & 15, b = bh >> 2, hh = bh & 3;
    const int kd = tid & 127, seg = tid >> 7;
    const size_t row0 = (size_t)b * 8192 + (size_t)run * 512;
    const float lb = lbv[hh * 128 + kd];
    LAS float* TOT = (LAS float*)(L + O_TOT); LAS float* DEC = (LAS float*)(L + O_DEC); LAS float* OST = (LAS float*)(L + O_OST);
    f32x16 S[4];
#pragma unroll
    for (int k = 0; k < 4; ++k) S[k] = f32x16{};
    if (OUT && run > 0) {
        if (Sst) {
#pragma unroll
            for (int k = 0; k < 4; ++k)
#pragma unroll
                for (int i = 0; i < 16; ++i) S[k][i] = Sst[((((size_t)it * 4 + vt) * 4 + k) * 16 + i) * 64 + lane];
        } else {
            for (int rp = 0; rp < run; ++rp) { const int ip = bh * 16 + rp;
#pragma unroll
                for (int k = 0; k < 4; ++k)
#pragma unroll
                    for (int i = 0; i < 16; ++i) S[k][i] = Drun[ip * 128 + 32 * k + crow(i, h)] * S[k][i] + Send[((((size_t)ip * 4 + vt) * 4 + k) * 16 + i) * 64 + lane];
            }
        }
    }
    float bsum = 0.f;
    u16 nf[16], nq[16]; v4u nv[2]; v4u ng[2] = {{0u, 0u, 0u, 0u}, {0u, 0u, 0u, 0u}};
#define HG_ISSUE(rowc_) do { _Pragma("unroll") for (int i = 0; i < 16; ++i) { const u16* p = H + ((rowc_) + seg * 16 + i) * NIN0 + hh * 128 + kd; nf[i] = p[2048]; if (OUT) nq[i] = p[1536]; } \
        _Pragma("unroll") for (int n = 0; n < 2; ++n) { const int id = tid + 512 * n, t = id >> 4, c = id & 15; nv[n] = *(const v4u*)(H + ((rowc_) + t) * NIN0 + 2560 + hh * 128 + c * 8); } \
        if (OUT) { const u16* gp_ = H + ((rowc_) + (tid >> 3)) * NIN0 + 3072 + hh * 128 + (tid & 7) * 16; ng[0] = *(const v4u*)gp_; ng[1] = *(const v4u*)(gp_ + 8); } } while (0)
    HG_ISSUE(row0);
    for (int ch = 0; ch < 8; ++ch) {
        const size_t rowc = row0 + ch * 64;
        float fg[16], cs[16], hq[16];
#pragma unroll
        for (int i = 0; i < 16; ++i) { fg[i] = bf2f(nf[i]); if (OUT) hq[i] = bf2f(nq[i]); }
#pragma unroll
        for (int n = 0; n < 2; ++n) { const int id = tid + 512 * n, t = id >> 4, c = id & 15; *(LAS v4u*)(L + O_V + t * P_TR + c * 16) = nv[n]; }
        const v4u gc0 = ng[0], gc1 = ng[1];
        if (ch + 1 < 8) HG_ISSUE(rowc + 64);
        float runs = 0.f;
#pragma unroll
        for (int i = 0; i < 16; ++i) { const float sg = __builtin_amdgcn_rcpf(1.f + __expf(-fg[i])); const float f = lb + (1.f - lb) * sg; fg[i] = (1.f - lb) * (1.f - sg); runs += __logf(f); cs[i] = runs; }
        TOT[seg * 128 + kd] = runs;
        __syncthreads();
        const float t0 = TOT[kd], t1 = TOT[128 + kd], t2 = TOT[256 + kd], t3 = TOT[384 + kd];
        const float off = (seg > 0 ? t0 : 0.f) + (seg > 1 ? t1 : 0.f) + (seg > 2 ? t2 : 0.f);
        const float bmid = t0 + t1, blast = (t0 + t1) + (t2 + t3);
        const float elm = __expf(blast - bmid), em = __expf(bmid);
#pragma unroll
        for (int i = 0; i < 16; i += 2) {
            const int t = seg * 16 + i; float kst[2], qa[2], ka[2], qo[2];
#pragma unroll
            for (int u = 0; u < 2; ++u) { const float bi = off + cs[i + u];
                const float e1 = __expf(bi - bmid), e2 = __builtin_amdgcn_rcpf(e1); const float kk = fg[i + u];
                ka[u] = kk * e2; kst[u] = ka[u] * elm;
                if (OUT) { const float q = hq[i + u] * __builtin_amdgcn_rcpf(1.f + __expf(-hq[i + u])); qa[u] = q * e1; qo[u] = qa[u] * em; } }
            { const unsigned w = pk2(kst[0], kst[1]); *(LAS u16*)(L + O_KST + t * P_TR + kd * 2) = (u16)w; *(LAS u16*)(L + O_KST + (t + 1) * P_TR + kd * 2) = (u16)(w >> 16); }
            if (OUT) {
                { const unsigned w = pk2(qa[0], qa[1]); *(LAS u16*)(L + O_QA + t * P_QA + kd * 2) = (u16)w; *(LAS u16*)(L + O_QA + (t + 1) * P_QA + kd * 2) = (u16)(w >> 16); }
                { const unsigned w = pk2(ka[0], ka[1]); *(LAS u16*)(L + O_KA + t * P_QA + kd * 2) = (u16)w; *(LAS u16*)(L + O_KA + (t + 1) * P_QA + kd * 2) = (u16)(w >> 16); }
                { const unsigned w = pk2(qo[0], qo[1]); *(LAS u16*)(L + O_QO + t * P_QO + kd * 2) = (u16)w; *(LAS u16*)(L + O_QO + (t + 1) * P_QO + kd * 2) = (u16)(w >> 16); } }
        }
        if (seg == 0) { DEC[kd] = __expf(blast); bsum += blast; }
        __syncthreads();
        if (OUT) {
            f32x16 acc = f32x16{};
            for (int st = 0; st <= tt; ++st) {
                f32x16 X = f32x16{};
#pragma unroll
                for (int ks = 0; ks < 8; ++ks) { const bf16x8 a = *(LAS bf16x8*)(L + O_KA + (32 * st + r) * P_QA + (16 * ks + 8 * h) * 2); const bf16x8 bq = *(LAS bf16x8*)(L + O_QA + (32 * tt + r) * P_QA + (16 * ks + 8 * h) * 2); X = MFMA32(a, bq, X); }
                if (st == tt) {
#pragma unroll
                    for (int i = 0; i < 16; ++i) if (crow(i, h) > r) X[i] = 0.f; }
#pragma unroll
                for (int s2 = 0; s2 < 2; ++s2) { const bf16x8 pa = pack8(X, 8 * s2); const bf16x8 vf = trfrag(L + O_V, P_TR, 32 * st + 16 * s2 + 4 * h, 8, 32 * vt, lane); acc = MFMA32(pa, vf, acc); }
            }
#pragma unroll
            for (int k = 0; k < 4; ++k)
#pragma unroll
                for (int s2 = 0; s2 < 2; ++s2) {
                    LAS unsigned char* qp = L + O_QO + (32 * tt + r) * P_QO + (32 * k + 16 * s2 + 4 * h) * 2;
                    const s16x4 lo = *(LAS s16x4*)qp, hi = *(LAS s16x4*)(qp + 16);
                    const bf16x8 a2 = (bf16x8){lo[0], lo[1], lo[2], lo[3], hi[0], hi[1], hi[2], hi[3]};
                    acc = MFMA32(a2, pack8(S[k], 8 * s2), acc); }
#pragma unroll
            for (int i = 0; i < 16; ++i) OST[(32 * tt + crow(i, h)) * 132 + 32 * vt + r] = acc[i];
        }
#pragma unroll
        for (int k = 0; k < 4; ++k) {
#pragma unroll
            for (int i = 0; i < 16; ++i) S[k][i] *= DEC[32 * k + crow(i, h)];
#pragma unroll
            for (int ks = 0; ks < 4; ++ks) { const bf16x8 a = trfrag(L + O_KST, P_TR, 16 * ks + 8 * h, 4, 32 * k, lane); const bf16x8 bv = trfrag(L + O_V, P_TR, 16 * ks + 8 * h, 4, 32 * vt, lane); S[k] = MFMA32(a, bv, S[k]); }
        }
        __syncthreads();
        if (OUT) {
            const int t = tid >> 3, c8 = tid & 7; float o[16]; float ss = 0.f;
#pragma unroll
            for (int j = 0; j < 4; ++j) { const f32x4 v = *(LAS f32x4*)(OST + t * 132 + c8 * 16 + 4 * j); o[4 * j] = v[0]; o[4 * j + 1] = v[1]; o[4 * j + 2] = v[2]; o[4 * j + 3] = v[3]; ss += (v[0] * v[0] + v[1] * v[1]) + (v[2] * v[2] + v[3] * v[3]); }
            ss += shx(ss, 1, lane); ss += shx(ss, 2, lane); ss += shx(ss, 4, lane);
            const float rs = __builtin_amdgcn_rsqf(ss * (1.f / 128.f) + LN_EPS);
            u16* op = MIX + (rowc + t) * 1024 + 512 + hh * 128 + c8 * 16;
#pragma unroll
            for (int j = 0; j < 2; ++j) { const v4u gvv = j ? gc1 : gc0; const unsigned gw_[4] = {gvv.x, gvv.y, gvv.z, gvv.w}; unsigned ow[4];
#pragma unroll
                for (int e = 0; e < 4; ++e) { const float g0 = bflo(gw_[e]), g1 = bfhi(gw_[e]); const int c = 8 * j + 2 * e;
                    const float y0 = o[c] * rs * outg[c8 * 16 + c] * (g0 * __builtin_amdgcn_rcpf(1.f + __expf(-g0))), y1 = o[c + 1] * rs * outg[c8 * 16 + c + 1] * (g1 * __builtin_amdgcn_rcpf(1.f + __expf(-g1)));
                    ow[e] = pk2(y0, y1); }
                *(v4u*)(op + 8 * j) = (v4u){ow[0], ow[1], ow[2], ow[3]}; }
        }
    }
    if (!OUT) {
        if (tt == 0) {
#pragma unroll
            for (int k = 0; k < 4; ++k)
#pragma unroll
                for (int i = 0; i < 16; ++i) Send[((((size_t)it * 4 + vt) * 4 + k) * 16 + i) * 64 + lane] = S[k][i]; }
        if (seg == 0) Drun[it * 128 + kd] = __expf(bsum);
    }
}
__device__ __forceinline__ void scan(const float* __restrict__ Send, const float* __restrict__ Drun, float* Sst, int gtid, int nthreads) {
    for (int idx = gtid; idx < 16 * 16384; idx += nthreads) {
        const int bh = idx >> 14, e = idx & 16383, lane = e & 63, i = (e >> 6) & 15, k = (e >> 10) & 3;
        const int kd = 32 * k + crow(i, lane >> 5);
        float sv[15], dv[15];
#pragma unroll
        for (int r = 0; r < 15; ++r) { sv[r] = Send[(size_t)(bh * 16 + r) * 16384 + e]; dv[r] = Drun[(bh * 16 + r) * 128 + kd]; }
        float st = 0.f;
#pragma unroll
        for (int r = 0; r < 15; ++r) { st = dv[r] * st + sv[r]; Sst[(size_t)(bh * 16 + r + 1) * 16384 + e] = st; }
    }
}
}

__device__ __forceinline__ void dil_task(LAS unsigned char* Lw, const u16* __restrict__ QKV, int task, u16* OBg0, u16* OBg1, u16* OBg2, float* LSE, int lane) {
    const int r = lane & 31, h = lane >> 5;
    const int bh = task / 768, rem = task - bh * 768, g = rem >> 8, j = rem & 255;
    const int sh = 2 * g, res = j >> (8 - sh), qt = j & ((256 >> sh) - 1);
    const int b = bh >> 4, hd = bh & 15;
    const size_t rowb = (size_t)b * 8192;
    const int qpos = res + ((32 * qt + r) << sh);
    const u16* qp = QKV + (rowb + qpos) * NIN1 + hd * 64;
    bf16x8 qf[4];
#pragma unroll
    for (int ks = 0; ks < 4; ++ks) qf[ks] = *(const bf16x8*)(qp + 16 * ks + 8 * h);
    f32x16 X[5];
#pragma unroll
    for (int kb = 0; kb < 5; ++kb) {
        int ki = 32 * qt - 128 + 32 * kb + r; ki = ki < 0 ? 0 : ki;
        const u16* kp = QKV + (rowb + res + (ki << sh)) * NIN1 + 1024 + hd * 64;
        X[kb] = f32x16{};
#pragma unroll
        for (int ks = 0; ks < 4; ++ks) { const bf16x8 kf = *(const bf16x8*)(kp + 16 * ks + 8 * h); X[kb] = MFMA32(kf, qf[ks], X[kb]); }
    }
    float m = -INFINITY;
#pragma unroll
    for (int kb = 0; kb < 5; ++kb)
#pragma unroll
        for (int i = 0; i < 16; ++i) { const int c = crow(i, h); bool valid = (32 * qt - 128 + 32 * kb + c) >= 0;
            if (kb == 0) valid = valid && (c >= r);
            if (kb == 4) valid = valid && (c <= r);
            X[kb][i] = valid ? X[kb][i] : -INFINITY; m = fmaxf(m, X[kb][i]); }
    m = fmaxf(m, shx(m, 32, lane));
    float l = 0.f;
#pragma unroll
    for (int kb = 0; kb < 5; ++kb)
#pragma unroll
        for (int i = 0; i < 16; ++i) { X[kb][i] = __builtin_amdgcn_exp2f(X[kb][i] - m); l += X[kb][i]; }
    l += shx(l, 32, lane);
    f32x16 y[2]; y[0] = f32x16{}; y[1] = f32x16{};
#pragma unroll
    for (int kb = 0; kb < 5; ++kb) {
#pragma unroll
        for (int n = 0; n < 4; ++n) { const int id = lane + 64 * n, key = id >> 3, c = id & 7; int ki = 32 * qt - 128 + 32 * kb + key; ki = ki < 0 ? 0 : ki;
            const v4u v = *(const v4u*)(QKV + (rowb + res + (ki << sh)) * NIN1 + 2048 + hd * 64 + c * 8); *(LAS v4u*)(Lw + key * 192 + c * 16) = v; }
#pragma unroll
        for (int s2 = 0; s2 < 2; ++s2) { const bf16x8 pb = pack8(X[kb], 8 * s2);
#pragma unroll
            for (int dt = 0; dt < 2; ++dt) { const bf16x8 a = trfrag(Lw, 192, 16 * s2 + 4 * h, 8, 32 * dt, lane); y[dt] = MFMA32(a, pb, y[dt]); } }
    }
    const float inv = 1.f / l;
    u16* ob = (g == 0 ? OBg0 : g == 1 ? OBg1 : OBg2) + (rowb + qpos) * 1024 + hd * 64;
#pragma unroll
    for (int dt = 0; dt < 2; ++dt)
#pragma unroll
        for (int gq = 0; gq < 4; ++gq) { v2u w; w.x = pk2(y[dt][4 * gq] * inv, y[dt][4 * gq + 1] * inv); w.y = pk2(y[dt][4 * gq + 2] * inv, y[dt][4 * gq + 3] * inv); *(v2u*)(ob + 32 * dt + 8 * gq + 4 * h) = w; }
    if (h == 0) LSE[((size_t)g * MTOK + rowb + qpos) * 16 + hd] = (m + __log2f(l)) * 0.6931471805599453f;
}
namespace dl {
constexpr int KP = 144, VP = 192, O_K = 0, O_V = 384 * KP, O_END = O_V + 384 * VP;
static_assert(O_END <= 131072, "dilated lds");
struct Dec { int g, sh, res, i0, hd; size_t rowb; };
__device__ __forceinline__ Dec decode(int task) {
    Dec d; const int bh = task / 96, rem = task - bh * 96; d.g = rem >> 5; const int j = rem & 31;
    d.sh = 2 * d.g; d.res = j >> (5 - d.sh); d.i0 = 256 * (j & ((32 >> d.sh) - 1)); d.hd = bh & 15; d.rowb = (size_t)(bh >> 4) * 8192; return d;
}
__device__ __forceinline__ void issue(const u16* __restrict__ QKV, int task, int tid, v4u (&pk)[6], v4u (&pv)[6], bf16x8 (&qn)[4]) {
    const Dec d = decode(task); const int lane = tid & 63, w = tid >> 6, r = lane & 31, h = lane >> 5;
#pragma unroll
    for (int n = 0; n < 6; ++n) { const int id = tid + 512 * n, c = id >> 3, ch = id & 7; int ki = d.i0 - 128 + c; ki = ki < 0 ? 0 : ki;
        const u16* src = QKV + (d.rowb + d.res + (ki << d.sh)) * NIN1 + d.hd * 64 + ch * 8;
        pk[n] = *(const v4u*)(src + 1024); pv[n] = *(const v4u*)(src + 2048); }
    const u16* qp = QKV + (d.rowb + d.res + ((d.i0 + 32 * w + r) << d.sh)) * NIN1 + d.hd * 64;
#pragma unroll
    for (int ks = 0; ks < 4; ++ks) qn[ks] = *(const bf16x8*)(qp + 16 * ks + 8 * h);
}
__device__ __forceinline__ void phase(LAS unsigned char* L, const u16* __restrict__ QKV, u16* OBg0, u16* OBg1, u16* OBg2, float* LSE, int first, int stride, const int tid) {
    const int lane = tid & 63, w = __builtin_amdgcn_readfirstlane(tid >> 6), r = lane & 31, h = lane >> 5;
    const bool xl = (stride == 256); const int nround = xl ? 24 : (6144 - first + stride - 1) / stride;
    if (first >= 6144) return;
#define DL_TASK(k) (xl ? (((first >> 5) * 8 + (k) / 3) * 96 + ((k) % 3) * 32 + (first & 31)) : (first + (k) * stride))
    v4u pk[6], pv[6]; bf16x8 qn[4];
    issue(QKV, DL_TASK(0), tid, pk, pv, qn);
    for (int kr = 0; kr < nround; ++kr) {
        const int task = DL_TASK(kr);
        const Dec d = decode(task);
#pragma unroll
        for (int n = 0; n < 6; ++n) { const int id = tid + 512 * n, c = id >> 3, ch = id & 7; *(LAS v4u*)(L + O_K + c * KP + ch * 16) = pk[n]; *(LAS v4u*)(L + O_V + c * VP + ch * 16) = pv[n]; }
        bf16x8 qf[4];
#pragma unroll
        for (int ks = 0; ks < 4; ++ks) qf[ks] = qn[ks];
        __syncthreads();
        if (kr + 1 < nround) issue(QKV, DL_TASK(kr + 1), tid, pk, pv, qn);
        const int i0 = d.i0, g = d.g, sh = d.sh;
        const int qpos = d.res + ((i0 + 32 * w + r) << sh);
        f32x16 X[5];
#pragma unroll
        for (int kb = 0; kb < 5; ++kb) X[kb] = f32x16{};
        {
            LAS unsigned char* kbase = L + O_K + (32 * w + r) * KP + 8 * h * 2;
#pragma unroll
            for (int ks = 0; ks < 4; ++ks) {
                bf16x8 kf[5];
#pragma unroll
                for (int kb = 0; kb < 5; ++kb) kf[kb] = *(LAS bf16x8*)(kbase + 32 * kb * KP + 16 * ks * 2);
#pragma unroll
                for (int kb = 0; kb < 5; ++kb) X[kb] = MFMA32(kf[kb], qf[ks], X[kb]);
            }
        }
        float m = -INFINITY;
        const int kneg = 128 - i0 - 32 * w;
#pragma unroll
        for (int i = 0; i < 16; ++i) { const int c = crow(i, h);
            X[0][i] = (c >= r && c >= kneg) ? X[0][i] : -INFINITY; X[4][i] = (c <= r) ? X[4][i] : -INFINITY; }
        if (kneg > 32) {
#pragma unroll
            for (int kb = 1; kb < 4; ++kb)
#pragma unroll
                for (int i = 0; i < 16; ++i) X[kb][i] = (32 * kb + crow(i, h) >= kneg) ? X[kb][i] : -INFINITY;
        }
#pragma unroll
        for (int kb = 0; kb < 5; ++kb)
#pragma unroll
            for (int i = 0; i < 16; i += 2) m = fmaxf(m, fmaxf(X[kb][i], X[kb][i + 1]));
        m = fmaxf(m, shx(m, 32, lane));
        float l = 0.f;
#pragma unroll
        for (int kb = 0; kb < 5; ++kb)
#pragma unroll
            for (int i = 0; i < 16; ++i) { X[kb][i] = __builtin_amdgcn_exp2f(X[kb][i] - m); l += X[kb][i]; }
        l += shx(l, 32, lane);
        f32x16 y[2]; y[0] = f32x16{}; y[1] = f32x16{};
#pragma unroll
        for (int kb = 0; kb < 5; ++kb) {
            bf16x8 vf[2][2];
#pragma unroll
            for (int s2 = 0; s2 < 2; ++s2)
#pragma unroll
                for (int dt = 0; dt < 2; ++dt) vf[s2][dt] = trfrag(L + O_V, VP, 32 * w + 32 * kb + 16 * s2 + 4 * h, 8, 32 * dt, lane);
            const bf16x8 pb0 = pack8(X[kb], 0), pb1 = pack8(X[kb], 8);
            y[0] = MFMA32(vf[0][0], pb0, y[0]); y[1] = MFMA32(vf[0][1], pb0, y[1]); y[0] = MFMA32(vf[1][0], pb1, y[0]); y[1] = MFMA32(vf[1][1], pb1, y[1]);
        }
        const float inv = __builtin_amdgcn_rcpf(l);
        u16* ob = (g == 0 ? OBg0 : g == 1 ? OBg1 : OBg2) + (d.rowb + qpos) * 1024 + d.hd * 64;
#pragma unroll
        for (int dt = 0; dt < 2; ++dt)
#pragma unroll
            for (int gp = 0; gp < 2; ++gp) {
                const int ge = 2 * gp, go = 2 * gp + 1;
                unsigned e0 = pk2(y[dt][4 * ge] * inv, y[dt][4 * ge + 1] * inv), e1 = pk2(y[dt][4 * ge + 2] * inv, y[dt][4 * ge + 3] * inv);
                unsigned o0 = pk2(y[dt][4 * go] * inv, y[dt][4 * go + 1] * inv), o1 = pk2(y[dt][4 * go + 2] * inv, y[dt][4 * go + 3] * inv);
                const auto s0 = __builtin_amdgcn_permlane32_swap(e0, o0, false, false); const auto s1 = __builtin_amdgcn_permlane32_swap(e1, o1, false, false);
                const v4u wv = {s0[0], s1[0], s0[1], s1[1]};
                *(v4u*)(ob + 32 * dt + 8 * (2 * gp + h)) = wv; }
        if (h == 0) LSE[((size_t)g * MTOK + d.rowb + qpos) * 16 + d.hd] = (m + __log2f(l)) * 0.6931471805599453f;
        __syncthreads();
    }
}
}
__device__ __forceinline__ void dil_merge(const u16* OB0, const u16* OB1, const u16* OB2, const float* LSE, u16* MIX, int gw, int NGW, int lane) {
    const int hd = lane >> 2, dq = (lane & 3) * 16;
    for (int m = gw; m < MTOK; m += NGW) {
        const float l0 = LSE[((size_t)m) * 16 + hd], l1 = LSE[((size_t)MTOK + m) * 16 + hd], l2 = LSE[((size_t)2 * MTOK + m) * 16 + hd];
        const float mx = fmaxf(l0, fmaxf(l1, l2)); float w0 = __expf(l0 - mx), w1 = __expf(l1 - mx), w2 = __expf(l2 - mx); const float iz = 1.f / (w0 + w1 + w2); w0 *= iz; w1 *= iz; w2 *= iz;
        const size_t off = (size_t)m * 1024 + hd * 64 + dq;
#pragma unroll
        for (int j = 0; j < 2; ++j) { const v4u a = *(const v4u*)(OB0 + off + 8 * j), bq = *(const v4u*)(OB1 + off + 8 * j), c = *(const v4u*)(OB2 + off + 8 * j);
            const unsigned aw[4] = {a.x, a.y, a.z, a.w}, bw[4] = {bq.x, bq.y, bq.z, bq.w}, cw[4] = {c.x, c.y, c.z, c.w}; unsigned ow[4];
#pragma unroll
            for (int e = 0; e < 4; ++e) ow[e] = pk2(w0 * bflo(aw[e]) + w1 * bflo(bw[e]) + w2 * bflo(cw[e]), w0 * bfhi(aw[e]) + w1 * bfhi(bw[e]) + w2 * bfhi(cw[e]));
            *(v4u*)(MIX + off + 8 * j) = (v4u){ow[0], ow[1], ow[2], ow[3]}; }
    }
}
#ifndef PROBE_SP2
#define PROBE_SP2 true
#endif
#ifndef LIGHT_ALIGN
#define LIGHT_ALIGN true
#endif
#ifndef PROBE_PAIR
#define PROBE_PAIR 0
#endif
#ifndef ATT_ORDER
#define ATT_ORDER 2
#endif
#ifndef PROBE_A
#define PROBE_A MIX
#endif
#ifndef PROBE_B
#define PROBE_B WS_WOUT0
#endif
#ifndef PROBE_M
#define PROBE_M MTOK
#endif
#ifndef HEAVY_ALIGN
#define HEAVY_ALIGN true
#endif
#ifndef REP_PRO
#define REP_PRO 1
#endif
#ifndef REP_P1
#define REP_P1 1
#endif
#ifndef REP_HGA
#define REP_HGA 1
#endif
#ifndef REP_HGC
#define REP_HGC 1
#endif
#ifndef REP_CMB
#define REP_CMB 1
#endif
#ifndef REP_DIL
#define REP_DIL 1
#endif
#ifndef REP_MRG
#define REP_MRG 1
#endif
#ifndef REP_P6
#define REP_P6 1
#endif
#ifndef REP_ATT
#define REP_ATT 1
#endif
#ifndef PH_LO
#define PH_LO 0
#endif
#ifndef PH_HI
#define PH_HI 100
#endif
__device__ __forceinline__ int fresh_lane() { int l; asm volatile("v_mbcnt_lo_u32_b32 %0, -1, 0\n\tv_mbcnt_hi_u32_b32 %0, -1, %0" : "=v"(l)); return l; }
__device__ __forceinline__ unsigned xcc_id() { return (unsigned)__builtin_amdgcn_s_getreg((3 << 11) | 20) & 0xFu; }
__device__ __forceinline__ unsigned bar_ld(unsigned* p) { return __hip_atomic_load(p, __ATOMIC_RELAXED, __HIP_MEMORY_SCOPE_AGENT); }
__device__ __forceinline__ unsigned bar_add(unsigned* p) { return __hip_atomic_fetch_add(p, 1u, __ATOMIC_RELAXED, __HIP_MEMORY_SCOPE_AGENT); }
__device__ __forceinline__ void grid_bar(unsigned* bar, unsigned k, unsigned x, unsigned nloc, unsigned nx, int wave0) {
    asm volatile("s_waitcnt vmcnt(0) lgkmcnt(0)" ::: "memory");
    __syncthreads();
    if (wave0 == 0) {
        const int ln = fresh_lane();
        if (ln == 0) {
            const unsigned old = bar_add(&bar[1024 + 64 * x]);
            if (old + 1u == k * nloc) {
                __builtin_amdgcn_fence(__ATOMIC_RELEASE, "agent");
                asm volatile("s_waitcnt vmcnt(0)" ::: "memory");
                const unsigned og = bar_add(&bar[3072]);
                if (og + 1u == k * nx) bar_add(&bar[3136]);
                else while (bar_ld(&bar[3136]) < k) __builtin_amdgcn_s_sleep(1);
                __builtin_amdgcn_fence(__ATOMIC_ACQUIRE, "agent");
                bar_add(&bar[2048 + 64 * x]);
                asm volatile("s_waitcnt vmcnt(0)" ::: "memory");
            } else {
                while (bar_ld(&bar[2048 + 64 * x]) < k) __builtin_amdgcn_s_sleep(1);
                __builtin_amdgcn_fence(__ATOMIC_ACQUIRE, "agent");
                asm volatile("s_waitcnt vmcnt(0)" ::: "memory");
            }
        }
    }
    __syncthreads();
}
struct PairOrder {
    int v;
    __device__ __forceinline__ bool next(int i, pg8::Unit& u) const { if (i >= 2) return false; u.pm = v >> 1; u.pn = 2 * (v & 1) + i; return true; }
    __device__ __forceinline__ void a_ready(const pg8::Unit&) const {}
    __device__ __forceinline__ void done(const pg8::Unit&) const {}
};
template <bool ALIGN = true, class Epi>
__device__ __forceinline__ void run_gemm_pair(LAS unsigned char* lds, const u16* A, const u16* Bt, int K, const Epi& E, int tid, int vcu) {
    asm volatile("" : "+v"(tid));
    int vl = vcu; asm volatile("" : "+s"(vl));
    pg8::Gemm g{A, Bt, MTOK, 1024, K}; PairOrder S{vl};
    pg8::gemm_phase<Epi, PairOrder, ALIGN, PG8_SP2>(lds, g, S, E, tid);
}
template <bool ALIGN = true, bool SP2 = true, class Epi>
__device__ __forceinline__ void run_gemm(LAS unsigned char* lds, const u16* A, const u16* Bt, int N, int K, const Epi& E, int tid, int Mrows = MTOK) {
    asm volatile("" : "+v"(tid));
    pg8::Gemm g{A, Bt, Mrows, N, K}; int Gl = (int)gridDim.x, bxl = (int)blockIdx.x; asm volatile("" : "+s"(Gl), "+s"(bxl)); pg8::StaticOrder S; S.init(Mrows, N, Gl, bxl);
    pg8::gemm_phase<Epi, pg8::StaticOrder, ALIGN, SP2>(lds, g, S, E, tid);
}
__global__ void __launch_bounds__(512, 2) fwd_kernel(Args A) {
    extern __shared__ __attribute__((aligned(16))) unsigned char lds_raw[];
    LAS unsigned char* lds = (LAS unsigned char*)lds_raw;
    cg::grid_group grid = cg::this_grid();
    const int wave0 = __builtin_amdgcn_readfirstlane((int)threadIdx.x >> 6);
#define tid0 (wave0 * 64 + fresh_lane())
    const int G = gridDim.x, bx = blockIdx.x;
    const int vcu = (G % 8 == 0) ? (bx % 8) * (G / 8) + bx / 8 : bx;
    const int NGW = G * 8;
#define PHASE_IDS() int tid = tid0; asm volatile("" : "+v"(tid)); const int lane = tid & 63, wave = __builtin_amdgcn_readfirstlane(tid >> 6), gw = bx * 8 + wave; (void)lane; (void)gw;
    unsigned char* ws = A.ws;
    float* rowss0 = (float*)(ws + WS_ROWSS); float* stats0 = (float*)(ws + WS_STATS); const float* cvec0 = (const float*)(ws + WS_CVEC); const float* lbv = (const float*)(ws + WS_MISC); const float* cs = (const float*)(ws + WS_CS);
    u16* XB = (u16*)(ws + WS_XB); u16* MIX = (u16*)(ws + WS_MIX); u16* HB = (u16*)(ws + WS_HB); u16* AUX = (u16*)(ws + WS_AUX);
    float* HGS = (float*)(ws + WS_HGS); float* HGD = (float*)(ws + WS_HGD); float* LSE = (float*)(ws + WS_LSE); u16* OB1 = (u16*)(ws + WS_OB1);
    float* X = A.out;
    u16* PBall = (u16*)((unsigned char*)A.out + 64 * MiB);
    unsigned* barw = (unsigned*)(ws + WS_BAR); unsigned nbar = 0;
    const unsigned myx = xcc_id();
    if (threadIdx.x == 0) bar_add(&barw[64 * myx]);
    unsigned nloc = 1, nxc = 1;
#define GSYNC() do { ++nbar; grid_bar(barw, nbar, myx, nloc, nxc, wave0); } while (0)

    for (int rep_ = 0; rep_ < REP_PRO; ++rep_) { { PHASE_IDS(); prologue(A, lds, gw, NGW, wave, lane); p_rows2(A.p, PBall, gw, NGW, lane); } }
    grid.sync();
    { unsigned cnt = 0, mine = 0;
#pragma unroll
      for (unsigned jx = 0; jx < 16; ++jx) { const unsigned c = bar_ld(&barw[64 * jx]); cnt += (c > 0u) ? 1u : 0u; mine = (jx == myx) ? c : mine; }
      nloc = (unsigned)__builtin_amdgcn_readfirstlane((int)mine); nxc = (unsigned)__builtin_amdgcn_readfirstlane((int)cnt); }

    for (int l = 0; l < 2; ++l) {
        const u16* Ain = (l == 0) ? XB : (const u16*)X;
        if (l == 0) {
            for (int rep_ = 0; rep_ < REP_P1; ++rep_) { { pg8::EpiStore E{HB, NIN0, 0, 1024, 512, cs, nullptr, nullptr, nullptr}; run_gemm(lds, Ain, (const u16*)(ws + WS_WIN0), NIN0, 1024, E, tid0); } }
            GSYNC();
#ifndef NO_HGA
            for (int rep_ = 0; rep_ < REP_HGA; ++rep_) { for (int it = vcu; it < 256; it += G) { PHASE_IDS(); hg::item<false>(lds, HB, it, lbv, HGS, HGD, nullptr, nullptr, tid); } }
#endif
            GSYNC();
#ifndef NO_HGC
            for (int rep_ = 0; rep_ < REP_HGC; ++rep_) { for (int it = vcu; it < 256; it += G) { PHASE_IDS(); hg::item<true>(lds, HB, it, lbv, HGS, HGD, A.hg_norm_g, MIX, tid); } }
#endif
            __syncthreads();
            int Ga = G; asm volatile("" : "+s"(Ga));
#if ATT_ORDER == 2
            for (int rep_ = 0; rep_ < REP_ATT; ++rep_) {
                const int bhd = (Ga == 256) ? (vcu >> 4) : 0, jq = vcu & 15; const int b = bhd >> 2, hh = bhd & 3;
                if (Ga == 256) {
                    for (int sub = 0; sub < 4; ++sub)
                        for (int grp = 0; grp < 2; ++grp) {
                            int tidA = tid0; asm volatile("" : "+v"(tidA));
                            const int c = sub >> 1, half = sub & 1, vh = hh * 4 + sub, qb = grp ? jq : 31 - jq;
                            attn_body::attn_unit<8>(b, (2 * hh + c) * 64, 512 + (2 * hh + c) * 64, 1024 + hh * 128 + half * 64, vh * 64, qb,
                                                    (const attn_body::bf16*)HB, (const attn_body::bf16*)HB, (const attn_body::bf16*)HB, (attn_body::bf16*)AUX, (char*)lds_raw, tidA);
                        }
                    asm volatile("s_waitcnt vmcnt(0)" ::: "memory");
                    __syncthreads();
                    for (int grp = 0; grp < 2; ++grp) { PHASE_IDS(); diff_combine_block(AUX, MIX, A.da_lambda, A.da_subln_g, (size_t)b * 8192 + (size_t)(grp ? jq : 31 - jq) * 256, hh, tid); }
                }
            }
            if (Ga != 256)
#endif
            for (int rep_ = 0; rep_ < REP_ATT; ++rep_)
            for (int gi = vcu; gi < 512; gi += Ga) {
                int bhd, qb;
#if ATT_ORDER == 1
                if (Ga == 256) { const int j = vcu & 31; if (gi < 256) { bhd = 2 * (vcu >> 5); qb = 31 - j; } else { bhd = 2 * (vcu >> 5) + 1; qb = j; } }
#else
                if (Ga == 256) { bhd = vcu >> 4; const int j = vcu & 15; qb = (gi < 256) ? 31 - j : j; }
#endif
                else { bhd = gi >> 5; qb = 31 - (gi & 31); }
                const int b = bhd >> 2, hh = bhd & 3;
                for (int sub = 0; sub < 4; ++sub) {
                    int tidA = tid0; asm volatile("" : "+v"(tidA));
                    const int c = sub >> 1, half = sub & 1, vh = hh * 4 + sub;
#ifndef NO_ATTN
                    attn_body::attn_unit<8>(b, (2 * hh + c) * 64, 512 + (2 * hh + c) * 64, 1024 + hh * 128 + half * 64, vh * 64, qb,
                                            (const attn_body::bf16*)HB, (const attn_body::bf16*)HB, (const attn_body::bf16*)HB, (attn_body::bf16*)AUX, (char*)lds_raw, tidA);
#endif
                }
                asm volatile("s_waitcnt vmcnt(0)" ::: "memory");
                __syncthreads();
                { PHASE_IDS(); diff_combine_block(AUX, MIX, A.da_lambda, A.da_subln_g, (size_t)b * 8192 + (size_t)qb * 256, hh, tid); }
            }
            GSYNC();
        } else {
            { pg8::EpiStore E{HB, NIN1, 0, 2048, 1024, cs, nullptr, nullptr, nullptr}; run_gemm(lds, Ain, (const u16*)(ws + WS_WIN1), NIN1, 1024, E, tid0); }
            GSYNC();
#ifndef NO_DIL
            for (int rep_ = 0; rep_ < REP_DIL; ++rep_) { { PHASE_IDS(); dl::phase(lds, HB, AUX, OB1, XB, LSE, vcu, G, tid); } }
#endif
            GSYNC();
            for (int rep_ = 0; rep_ < REP_MRG; ++rep_) { { PHASE_IDS(); dil_merge(AUX, OB1, XB, LSE, MIX, gw, NGW, lane); } }
            GSYNC();
        }
        float* rowss = rowss0 + (size_t)l * MTOK; float* st1 = stats0 + (size_t)(2 * l) * MTOK * 2; float* st2 = stats0 + (size_t)(2 * l + 1) * MTOK * 2; const float* cv = cvec0 + l * 10240;
        { pg8::EpiResid E{Ain, XB, nullptr, nullptr, nullptr, st1}; run_gemm<HEAVY_ALIGN>(lds, MIX, (const u16*)(ws + (l == 0 ? WS_WOUT0 : WS_WOUT1)), 1024, 1024, E, tid0); }
#ifdef PROBE_OUTP
        for (int q_ = 0; q_ < PROBE_OUTP; ++q_) { pg8::EpiStore E{HB + (size_t)64 * MiB, 1024, 0, 0, 0, cs, nullptr, nullptr, nullptr}; if (PROBE_PAIR && G == 256) run_gemm_pair(lds, PROBE_A, (const u16*)(ws + PROBE_B), 1024, E, tid0, vcu); else run_gemm<true, PROBE_SP2>(lds, PROBE_A, (const u16*)(ws + PROBE_B), 1024, 1024, E, tid0, PROBE_M); }
#endif
#ifdef PROBE_RESID
        { pg8::EpiResid E{XB, HB + (size_t)64 * MiB, st1, A.ln1_g, A.ln1_b, PROBE_RESID == 2 ? (float*)nullptr : (float*)(HB + (size_t)96 * MiB)}; run_gemm(lds, MIX, (const u16*)(ws + WS_WOUT0), 1024, 1024, E, tid0); }
#endif
        GSYNC();
        for (int rep_ = 0; rep_ < REP_P6; ++rep_) { pg8::EpiStore E{HB, FFD, 1, 0, 0, cs, st1, cv, cv + 4096}; run_gemm<LIGHT_ALIGN>(lds, XB, (const u16*)(ws + WS_W1 + l * 8 * MiB), FFD, 1024, E, tid0); }
        { pg8::EpiE E{MIX, rowss}; run_gemm(lds, PBall + (size_t)l * MTOK * PLE, (const u16*)(ws + WS_WP + l * (MiB / 2)), 1024, PLE, E, tid0); }
        GSYNC();
#ifdef PROBE_EGEMM
        for (int q_ = 0; q_ < PROBE_EGEMM; ++q_) { pg8::EpiE E{AUX, (float*)(ws + WS_LSE)}; run_gemm(lds, AUX, (const u16*)(ws + WS_WP + l * (MiB / 2)), 1024, PLE, E, tid0); }
#endif
#ifdef PROBE_FFN2
        { pg8::EpiStore E{AUX, 1024, 0, 0, 0, cs, nullptr, nullptr, nullptr}; run_gemm(lds, HB, (const u16*)(ws + WS_W2 + l * 8 * MiB), 1024, FFD, E, tid0); }
#endif
        { pg8::EpiResid E{XB, XB, st1, A.ln1_g + l * 1024, A.ln1_b + l * 1024, st2}; run_gemm<HEAVY_ALIGN>(lds, HB, (const u16*)(ws + WS_W2 + l * 8 * MiB), 1024, FFD, E, tid0); }
        GSYNC();
        { pg8::EpiGate E{l == 0 ? (float*)nullptr : X, XB, st2, A.ln2_g + l * 1024, A.ln2_b + l * 1024, cv + 8192, cv + 9216, MIX, rowss, A.ple_norm_g + l * 1024, l == 0 ? (u16*)X : (u16*)nullptr}; run_gemm<HEAVY_ALIGN>(lds, XB, (const u16*)(ws + WS_WG + l * 2 * MiB), 1024, 1024, E, tid0); }
        if (l == 0) GSYNC();
    }
#ifdef PROBE_BARS
    for (int i = 0; i < PROBE_BARS; ++i) GSYNC();
#endif
}

extern "C" void kernel_launch(void* const* d_in, const int* in_sizes, int n_in, void* d_out, int out_size, void* d_ws, size_t ws_size, hipStream_t stream) {
    static int grid = 0;
    if (grid == 0) {
        if (n_in != 19 || out_size != MTOK * DMODEL || ws_size < WS_END) { fprintf(stderr, "kernel_launch: unexpected shapes (n_in %d, out %d, ws %zu)\n", n_in, out_size, ws_size); grid = -1; return; }
        int dev = 0, cus = 0, per_cu = 0;
        if (hipGetDevice(&dev) != hipSuccess || hipDeviceGetAttribute(&cus, hipDeviceAttributeMultiprocessorCount, dev) != hipSuccess) { grid = -1; return; }
        if (hipFuncSetAttribute((const void*)fwd_kernel, hipFuncAttributeMaxDynamicSharedMemorySize, LDS_BYTES) != hipSuccess) { fprintf(stderr, "kernel_launch: hipFuncSetAttribute failed\n"); grid = -1; return; }
        if (hipOccupancyMaxActiveBlocksPerMultiprocessor(&per_cu, (const void*)fwd_kernel, 512, LDS_BYTES) != hipSuccess || per_cu < 1) { fprintf(stderr, "kernel_launch: occupancy query says %d\n", per_cu); per_cu = 1; }
        (void)hipGetLastError();
        grid = cus * per_cu;
    }
    if (grid < 0) return;
    if (hipMemsetAsync((char*)d_ws, 0, WS_BAR + 16384, stream) != hipSuccess) { fprintf(stderr, "kernel_launch: memset failed\n"); return; }
    Args a{};
    const float** f = (const float**)&a;
    for (int i = 0; i < 19; ++i) f[i] = (const float*)d_in[i];
    a.out = (float*)d_out; a.ws = (unsigned char*)d_ws;
    void* args[] = {&a};
    hipError_t e = hipLaunchCooperativeKernel((const void*)fwd_kernel, dim3(grid), dim3(512), args, LDS_BYTES, stream);
    if (e != hipSuccess) fprintf(stderr, "cooperative launch failed: %s (grid %d)\n", hipGetErrorString(e), grid);
}
```

```cpp
#include <hip/hip_runtime.h>
#include <hip/hip_cooperative_groups.h>
#include <cstdio>
#include <cstdint>
namespace cg = cooperative_groups;
namespace pg8 {
#define PG8_LAS __attribute__((address_space(3)))
typedef unsigned short bf16_t;
typedef short bf16x8 __attribute__((ext_vector_type(8)));
typedef float f32x4 __attribute__((ext_vector_type(4)));
typedef unsigned u32x4 __attribute__((ext_vector_type(4)));
constexpr int BM = 256, BK = 64, HALF = 128, HTB = HALF * BK * 2  , STAGE_BYTES = 8 * HTB, NXCD = 8, WGM = 8;

__host__ __device__ __forceinline__ int lds_byte(int r, int c) { const int st = (r >> 4) * 2 + (c >> 5), rr = r & 15, cc = c & 31, ob = rr * 64 + cc * 2; return st * 1024 + (ob ^ (((ob >> 9) & 1) << 5)); }
__host__ __device__ __forceinline__ void stage_rc(int b, int& R, int& C) { const int st = b / 1024, sb = b % 1024, swz = sb ^ (((sb >> 9) & 1) << 5); R = (st >> 1) * 16 + swz / 64; C = (st & 1) * 32 + (swz % 64) / 2; }
__host__ __device__ __forceinline__ int perm32(int rho) { const int n = rho >> 4, i = rho & 15; return 8 * (i >> 2) + 4 * n + (i & 3); }

struct Unit { int pm, pn; };
struct Gemm { const bf16_t* A; const bf16_t* Bt; int M, N, K; };

struct StaticOrder {
    int nM, nN, nwg, G, c;
    __host__ __device__ void init(int M, int N, int G_, int c_) { nM = M / BM; nN = N / BM; nwg = nM * nN; G = G_; c = c_; }
    __host__ __device__ bool next(int i, Unit& u) const {
        const long L = (long)i * G + c; if (L >= nwg) return false;
        int wgid = (int)L; { const int q = nwg / NXCD, r = nwg % NXCD, xcd = wgid % NXCD, off = wgid / NXCD; wgid = (xcd < r ? xcd * (q + 1) : r * (q + 1) + (xcd - r) * q) + off; }
        const int nig = WGM * nN, gid = wgid / nig, fm = gid * WGM, gsz = (nM - fm) < WGM ? (nM - fm) : WGM;
        u.pm = fm + ((wgid % nig) % gsz); u.pn = (wgid % nig) / gsz; return true;
    }
    __device__ __forceinline__ void a_ready(const Unit&) const {}
    __device__ __forceinline__ void done(const Unit&) const {}
};

__device__ __forceinline__ unsigned cvt_pk_bf16(float lo, float hi) { unsigned r; asm volatile("v_cvt_pk_bf16_f32 %0, %1, %2" : "=v"(r) : "v"(lo), "v"(hi)); return r; }
typedef float f32x2 __attribute__((ext_vector_type(2)));
template <class Epi, class Sched, bool ALIGN_EPI = false, bool SP2 = false>
__device__ __forceinline__ void gemm_phase(PG8_LAS unsigned char* lds, const Gemm g, const Sched& S, const Epi& E, const int tid_in) {
    const int tid = tid_in, wid = __builtin_amdgcn_readfirstlane(tid >> 6), lane = tid & 63, wr = wid >> 2, wc = wid & 3, fr = lane & 15, fq = lane >> 4;
    const int K = g.K, nt = K / BK;
    unsigned voffA[2], voffB[2];
#pragma unroll
    for (int i = 0; i < 2; ++i) { int R, C; stage_rc(tid * 16 + i * 8192, R, C); const int Rb = Epi::WIDE ? (64 * (R >> 5) + perm32(R & 31)) : (Epi::PERM ? ((R & ~31) + perm32(R & 31)) : R);
        voffA[i] = (unsigned)(R * K + C) * 2u; voffB[i] = (unsigned)(Rb * K + C) * 2u; }
    const size_t kstep = (size_t)(BK * 2);
    const size_t hstepB = Epi::WIDE ? (size_t)32 * K * 2 : (size_t)HALF * K * 2;
    const size_t hstep = (size_t)HALF * K * 2;
    const size_t tstep = 2 * hstep;
    const unsigned ldsw = (unsigned)wid * 1024u;
    const int aoff = lds_byte(wr * 64 + fr, fq * 8), boff = lds_byte(wc * 32 + fr, fq * 8);
#define PG8_SA(b, h) (((b) * 2 + (h)) * HTB)
#define PG8_SB(b, h) ((4 + (b) * 2 + (h)) * HTB)
#define PG8_STAGE(bufoff, gbase, voff) do { _Pragma("unroll") for (int _i = 0; _i < 2; ++_i) \
        __builtin_amdgcn_global_load_lds((const unsigned*)((const char*)(gbase) + (voff)[_i]), (PG8_LAS unsigned*)(lds + (bufoff) + ldsw + _i * 8192), 16, 0, 0); } while (0)
#define PG8_LDA(dst, b, h) do { _Pragma("unroll") for (int m = 0; m < 4; ++m) _Pragma("unroll") for (int k = 0; k < 2; ++k) dst[m][k] = *(const PG8_LAS bf16x8*)(lds + PG8_SA(b, h) + aoff + m * 2048 + k * 1024); } while (0)
#define PG8_LDB(dst, b, h) do { _Pragma("unroll") for (int n = 0; n < 2; ++n) _Pragma("unroll") for (int k = 0; k < 2; ++k) dst[n][k] = *(const PG8_LAS bf16x8*)(lds + PG8_SB(b, h) + boff + n * 2048 + k * 1024); } while (0)
#define PG8_MMA(ai, bj, At, Bt) do { __builtin_amdgcn_s_setprio(1); _Pragma("unroll") for (int m = 0; m < 4; ++m) _Pragma("unroll") for (int n = 0; n < 2; ++n) _Pragma("unroll") for (int k = 0; k < 2; ++k) \
        acc[ai][bj][m][n] = __builtin_amdgcn_mfma_f32_16x16x32_bf16(Bt[n][k], At[m][k], acc[ai][bj][m][n], 0, 0, 0); __builtin_amdgcn_s_setprio(0); } while (0)
#define PG8_WAIT_V(n) asm volatile("s_waitcnt vmcnt(" #n ")" ::: "memory")
#define PG8_WAIT_L(n) asm volatile("s_waitcnt lgkmcnt(" #n ")" ::: "memory")
#define PG8_BAR __builtin_amdgcn_s_barrier()
#define PG8_SCHED __builtin_amdgcn_sched_barrier(0)
    Unit cur, nxt; int ui = 0;
    if (!S.next(0, cur)) return;
    f32x4 acc[2][2][4][2];
#pragma unroll
    for (int a = 0; a < 2; ++a)
#pragma unroll
        for (int b = 0; b < 2; ++b)
#pragma unroll
            for (int m = 0; m < 4; ++m)
#pragma unroll
                for (int n = 0; n < 2; ++n) acc[a][b][m][n] = (f32x4){0.f, 0.f, 0.f, 0.f};
    bf16x8 At[4][2], B0[2][2], B1[2][2];
    const char* cA = (const char*)g.A + (size_t)cur.pm * tstep; const char* cB = (const char*)g.Bt + (size_t)cur.pn * tstep;
    S.a_ready(cur);
    if constexpr (SP2) {
        PG8_STAGE(PG8_SB(0, 0), cB, voffB); PG8_STAGE(PG8_SB(0, 1), cB + hstepB, voffB); PG8_STAGE(PG8_SA(0, 0), cA, voffA); PG8_STAGE(PG8_SA(0, 1), cA + hstep, voffA);
        if (wr == 1) PG8_BAR;
        PG8_WAIT_V(2); PG8_BAR;
        PG8_STAGE(PG8_SB(1, 0), cB + kstep, voffB); PG8_STAGE(PG8_SA(1, 0), cA + kstep, voffA); PG8_STAGE(PG8_SB(1, 1), cB + hstepB + kstep, voffB);
        PG8_WAIT_V(6); PG8_BAR;
    } else {
        PG8_STAGE(PG8_SB(0, 0), cB, voffB); PG8_STAGE(PG8_SA(0, 0), cA, voffA); PG8_STAGE(PG8_SB(0, 1), cB + hstepB, voffB); PG8_STAGE(PG8_SA(0, 1), cA + hstep, voffA);
        if (wr == 1) PG8_BAR;
        PG8_WAIT_V(4); PG8_BAR;
        PG8_STAGE(PG8_SB(1, 0), cB + kstep, voffB); PG8_STAGE(PG8_SA(1, 0), cA + kstep, voffA); PG8_STAGE(PG8_SB(1, 1), cB + hstepB + kstep, voffB);
        PG8_WAIT_V(6); PG8_BAR;
    }
    for (;;) {
        const bool has_next = S.next(ui + 1, nxt);
        const char* nA = has_next ? (const char*)g.A + (size_t)nxt.pm * tstep : cA; const char* nB = has_next ? (const char*)g.Bt + (size_t)nxt.pn * tstep : cB;
        for (int t = 0; t < nt; t += 2) {
            const bool last = (t == nt - 2);
            const char* a1 = cA + (size_t)(t + 1) * kstep;
            const char* a2 = last ? nA : cA + (size_t)(t + 2) * kstep; const char* b2 = last ? nB : cB + (size_t)(t + 2) * kstep;
            const char* a3 = a2 + kstep; const char* b3 = b2 + kstep;
            if (last && has_next) S.a_ready(nxt);
            if constexpr (SP2) {
            PG8_LDB(B0, 0, 0); PG8_LDB(B1, 0, 1); PG8_SCHED; PG8_LDA(At, 0, 0); PG8_STAGE(PG8_SA(1, 1), a1 + hstep, voffA);
            PG8_WAIT_V(8); PG8_WAIT_L(0); PG8_BAR; PG8_MMA(0, 0, At, B0); PG8_MMA(0, 1, At, B1); PG8_BAR; PG8_SCHED;
            PG8_LDA(At, 0, 1); PG8_STAGE(PG8_SB(0, 0), b2, voffB); PG8_STAGE(PG8_SB(0, 1), b2 + hstepB, voffB); PG8_STAGE(PG8_SA(0, 0), a2, voffA);
            PG8_WAIT_V(8); PG8_WAIT_L(0); PG8_BAR; PG8_MMA(1, 0, At, B0); PG8_MMA(1, 1, At, B1); PG8_BAR; PG8_SCHED;
            PG8_LDB(B0, 1, 0); PG8_LDB(B1, 1, 1); PG8_SCHED; PG8_LDA(At, 1, 0); PG8_STAGE(PG8_SA(0, 1), a2 + hstep, voffA);
            PG8_WAIT_V(8); PG8_WAIT_L(0); PG8_BAR; PG8_MMA(0, 0, At, B0); PG8_MMA(0, 1, At, B1); PG8_BAR; PG8_SCHED;
            PG8_LDA(At, 1, 1); PG8_STAGE(PG8_SB(1, 0), b3, voffB); PG8_STAGE(PG8_SB(1, 1), b3 + hstepB, voffB); PG8_STAGE(PG8_SA(1, 0), a3, voffA);
            PG8_WAIT_V(8); PG8_WAIT_L(0); PG8_BAR; PG8_MMA(1, 0, At, B0); PG8_MMA(1, 1, At, B1); PG8_BAR; PG8_SCHED;
            } else {
            PG8_LDB(B0, 0, 0); PG8_SCHED; PG8_LDA(At, 0, 0); PG8_STAGE(PG8_SA(1, 1), a1 + hstep, voffA);
            PG8_WAIT_L(8); PG8_BAR; PG8_WAIT_L(0); PG8_MMA(0, 0, At, B0); PG8_BAR; PG8_SCHED;
            PG8_LDB(B1, 0, 1); PG8_STAGE(PG8_SB(0, 0), b2, voffB);
            PG8_BAR; PG8_WAIT_L(0); PG8_MMA(0, 1, At, B1); PG8_BAR;
            PG8_LDA(At, 0, 1); PG8_STAGE(PG8_SA(0, 0), a2, voffA);
            PG8_BAR; PG8_WAIT_L(0); PG8_MMA(1, 0, At, B0); PG8_BAR; PG8_SCHED;
            PG8_STAGE(PG8_SB(0, 1), b2 + hstepB, voffB);
            PG8_WAIT_V(6); PG8_BAR; PG8_MMA(1, 1, At, B1); PG8_BAR;
            PG8_LDB(B0, 1, 0); PG8_SCHED; PG8_LDA(At, 1, 0); PG8_STAGE(PG8_SA(0, 1), a2 + hstep, voffA);
            PG8_WAIT_L(8); PG8_BAR; PG8_WAIT_L(0); PG8_MMA(0, 0, At, B0); PG8_BAR; PG8_SCHED;
            PG8_LDB(B1, 1, 1); PG8_STAGE(PG8_SB(1, 0), b3, voffB);
            PG8_BAR; PG8_WAIT_L(0); PG8_MMA(0, 1, At, B1); PG8_BAR;
            PG8_LDA(At, 1, 1); PG8_STAGE(PG8_SA(1, 0), a3, voffA);
            PG8_BAR; PG8_WAIT_L(0); PG8_MMA(1, 0, At, B0); PG8_BAR; PG8_SCHED;
            PG8_STAGE(PG8_SB(1, 1), b3 + hstepB, voffB);
            PG8_WAIT_V(6); PG8_BAR; PG8_MMA(1, 1, At, B1); PG8_BAR;
            }
        }
        if constexpr (ALIGN_EPI) { if (wr == 0) PG8_BAR; }
        if constexpr (!Epi::AFTER_DRAIN) { E(acc, cur, wr, wc, fr, fq); S.done(cur); }
        if (!has_next) break;
#pragma unroll
        for (int a = 0; a < 2; ++a)
#pragma unroll
            for (int b = 0; b < 2; ++b)
#pragma unroll
                for (int m = 0; m < 4; ++m)
#pragma unroll
                    for (int n = 0; n < 2; ++n) acc[a][b][m][n] = (f32x4){0.f, 0.f, 0.f, 0.f};
        cur = nxt; cA = nA; cB = nB; ++ui;
        if constexpr (ALIGN_EPI) { if (wr == 1) PG8_BAR; }
    }
    PG8_WAIT_V(0);
    if constexpr (!ALIGN_EPI) { if (wr == 0) PG8_BAR; }
    PG8_BAR;
    if constexpr (Epi::AFTER_DRAIN) { E.fused(acc, cur, wr, wc, fr, fq, lds, wid, lane); S.done(cur); }
#undef PG8_SA
#undef PG8_SB
#undef PG8_STAGE
#undef PG8_LDA
#undef PG8_LDB
#undef PG8_MMA
#undef PG8_WAIT_V
#undef PG8_WAIT_L
#undef PG8_BAR
#undef PG8_SCHED
}
}
namespace pg8 {
__device__ __forceinline__ float shx(float v, int m, int lane) { return __builtin_bit_cast(float, __builtin_amdgcn_ds_bpermute((lane ^ m) << 2, __builtin_bit_cast(int, v))); }
constexpr float QSCALE = 0.125f * 1.4426950408889634f;
struct EpiStore {
    static constexpr bool PERM = true, AFTER_DRAIN = false, WIDE = true;
    bf16_t* O; int ldc; int act; int rope_cols; int scale_cols; const float* cs;
    const float* st; const float* c1; const float* c2;
    int rowmask = -1;
    __device__ __forceinline__ void operator()(f32x4 (&acc)[2][2][4][2], const Unit& u, int wr, int wc, int fr, int fq) const {
        { int ln_; asm volatile("v_mbcnt_lo_u32_b32 %0, -1, 0\n\tv_mbcnt_hi_u32_b32 %0, -1, %0" : "=v"(ln_)); fr = ln_ & 15; fq = ln_ >> 4; }
        const int row0 = u.pm * BM + wr * 64 + fr; int colt = u.pn * BM; asm volatile("" : "+s"(colt));
        const int col0 = colt + wc * 64 + 8 * fq;
        if (colt < rope_cols) {
            const float sgn = fq == 0 ? -1.f : 1.f; const int lane = fq * 16 + fr;
#pragma unroll
            for (int ai = 0; ai < 2; ++ai)
#pragma unroll
                for (int m = 0; m < 4; ++m) {
                    const int pos = (row0 + ai * HALF + m * 16) & 8191;
                    const float* cp = cs + pos * 8;
#pragma unroll
                    for (int n = 0; n < 2; ++n) {
                        const f32x4 cv = *(const f32x4*)(cp + 4 * n), sv = *(const f32x4*)(cp + 65536 + 4 * n);
#pragma unroll
                        for (int e = 0; e < 4; ++e) {
                            const float v = acc[ai][0][m][n][e]; const float pv = shx(v, 16, lane);
                            const float nv = v * cv[e] + sgn * pv * sv[e];
                            acc[ai][0][m][n][e] = (fq < 2) ? nv : v;
                        }
                        asm volatile("" ::: "memory");
                    }
                }
        }
        if (st) {
            float muv[2][4], rsv[2][4];
#pragma unroll
            for (int ai = 0; ai < 2; ++ai)
#pragma unroll
                for (int m = 0; m < 4; ++m) { const int row = row0 + ai * HALF + m * 16; const f32x2 sv = *(const f32x2*)(st + 2 * row); muv[ai][m] = sv.x; rsv[ai][m] = sv.y; }
#pragma unroll
            for (int ai = 0; ai < 2; ++ai)
#pragma unroll
                for (int m = 0; m < 4; ++m) { const float mu = muv[ai][m] * (1.f / 1024.f); rsv[ai][m] = __builtin_amdgcn_rsqf(rsv[ai][m] * (1.f / 1024.f) - mu * mu + 1e-5f); muv[ai][m] = mu; }
#pragma unroll
            for (int bj = 0; bj < 2; ++bj) {
                const f32x4 c1a = *(const f32x4*)(c1 + col0 + bj * 32), c1b = *(const f32x4*)(c1 + col0 + bj * 32 + 4), c2a = *(const f32x4*)(c2 + col0 + bj * 32), c2b = *(const f32x4*)(c2 + col0 + bj * 32 + 4);
#pragma unroll
                for (int ai = 0; ai < 2; ++ai)
#pragma unroll
                    for (int m = 0; m < 4; ++m) { const float mu = muv[ai][m], rstd = rsv[ai][m];
                        acc[ai][bj][m][0] = (acc[ai][bj][m][0] - mu * c1a) * rstd + c2a; acc[ai][bj][m][1] = (acc[ai][bj][m][1] - mu * c1b) * rstd + c2b; }
            }
        }
        const float sc = (colt < scale_cols) ? QSCALE : 1.f;
        const bool hi = (fr & 8) != 0;
        const int colA = col0 + (hi ? 32 : 0);
        const int rbase = u.pm * BM + wr * 64 + (fr & 7);
#pragma unroll
        for (int ai = 0; ai < 2; ++ai)
#pragma unroll
            for (int m = 0; m < 4; ++m) {
                u32x4 w[2];
#pragma unroll
                for (int bj = 0; bj < 2; ++bj) { f32x4 v0 = acc[ai][bj][m][0], v1 = acc[ai][bj][m][1];
                    if (act == 1) {
#pragma unroll
                        for (int e = 0; e < 4; ++e) { float a = fmaxf(v0[e], 0.f), b = fmaxf(v1[e], 0.f); v0[e] = a * a; v1[e] = b * b; } }
                    v0 = v0 * sc; v1 = v1 * sc; w[bj].x = cvt_pk_bf16(v0[0], v0[1]); w[bj].y = cvt_pk_bf16(v0[2], v0[3]); w[bj].z = cvt_pk_bf16(v1[0], v1[1]); w[bj].w = cvt_pk_bf16(v1[2], v1[3]); }
                const u32x4 snd = hi ? w[0] : w[1]; u32x4 rcv;
                rcv.x = (unsigned)__builtin_amdgcn_update_dpp(0, (int)snd.x, 0x128, 0xF, 0xF, false); rcv.y = (unsigned)__builtin_amdgcn_update_dpp(0, (int)snd.y, 0x128, 0xF, 0xF, false);
                rcv.z = (unsigned)__builtin_amdgcn_update_dpp(0, (int)snd.z, 0x128, 0xF, 0xF, false); rcv.w = (unsigned)__builtin_amdgcn_update_dpp(0, (int)snd.w, 0x128, 0xF, 0xF, false);
                const u32x4 o1 = hi ? rcv : w[0], o2 = hi ? w[1] : rcv;
                const int r1 = rbase + ai * HALF + m * 16;
                bf16_t* p1 = O + (size_t)(r1 & rowmask) * ldc + colA; bf16_t* p2 = O + (size_t)((r1 + 8) & rowmask) * ldc + colA;
                if (O) { *(u32x4*)p1 = o1; *(u32x4*)p2 = o2; } else asm volatile("" :: "v"(o1), "v"(o2));
            }
    }
};
struct EpiResid {
    static constexpr bool PERM = true, AFTER_DRAIN = false, WIDE = false;
    const bf16_t* xinb; bf16_t* outb; const float* st_in; const float* g; const float* b; float* st_out;
    __device__ __forceinline__ void operator()(f32x4 (&acc)[2][2][4][2], const Unit& u, int wr, int wc, int fr, int fq) const {
        { int ln_; asm volatile("v_mbcnt_lo_u32_b32 %0, -1, 0\n\tv_mbcnt_hi_u32_b32 %0, -1, %0" : "=v"(ln_)); fr = ln_ & 15; fq = ln_ >> 4; }
        const int lane = fq * 16 + fr;
        const int col0 = u.pn * BM + wc * 32 + 8 * fq;
        f32x4 gv[2][2], bv[2][2];
        if (st_in) {
#pragma unroll
            for (int bj = 0; bj < 2; ++bj)
#pragma unroll
                for (int n = 0; n < 2; ++n) { gv[bj][n] = *(const f32x4*)(g + col0 + bj * HALF + n * 4); bv[bj][n] = *(const f32x4*)(b + col0 + bj * HALF + n * 4); } }
#pragma unroll
        for (int ai = 0; ai < 2; ++ai) {
            const int rowa = u.pm * BM + ai * HALF + wr * 64 + fr;
            float mu[4], rstd[4];
            u32x4 xw[4][2];
#pragma unroll
            for (int m = 0; m < 4; ++m)
#pragma unroll
                for (int bj = 0; bj < 2; ++bj) xw[m][bj] = *(const u32x4*)(xinb + (size_t)(rowa + m * 16) * 1024 + col0 + bj * HALF);
#pragma unroll
            for (int m = 0; m < 4; ++m) { mu[m] = 0.f; rstd[m] = 1.f;
                if (st_in) { const f32x2 sv = *(const f32x2*)(st_in + 2 * (rowa + m * 16)); mu[m] = sv.x * (1.f / 1024.f); rstd[m] = __builtin_amdgcn_rsqf(sv.y * (1.f / 1024.f) - mu[m] * mu[m] + 1e-5f); } }
#pragma unroll
            for (int m = 0; m < 4; ++m) { const int row = rowa + m * 16; const size_t off = (size_t)row * 1024 + col0;
                float s1 = 0.f, s2 = 0.f;
#pragma unroll
                for (int bj = 0; bj < 2; ++bj) { const u32x4 w0 = xw[m][bj];
                    f32x4 xa = {__uint_as_float(w0.x << 16), __uint_as_float(w0.x & 0xffff0000u), __uint_as_float(w0.y << 16), __uint_as_float(w0.y & 0xffff0000u)};
                    f32x4 xb2 = {__uint_as_float(w0.z << 16), __uint_as_float(w0.z & 0xffff0000u), __uint_as_float(w0.w << 16), __uint_as_float(w0.w & 0xffff0000u)};
                    if (st_in) { xa = (xa - mu[m]) * rstd[m] * gv[bj][0] + bv[bj][0]; xb2 = (xb2 - mu[m]) * rstd[m] * gv[bj][1] + bv[bj][1]; }
                    const f32x4 ya = xa * 1.4142135623730951f + acc[ai][bj][m][0], yb2 = xb2 * 1.4142135623730951f + acc[ai][bj][m][1];
                    u32x4 w; w.x = cvt_pk_bf16(ya[0], ya[1]); w.y = cvt_pk_bf16(ya[2], ya[3]); w.z = cvt_pk_bf16(yb2[0], yb2[1]); w.w = cvt_pk_bf16(yb2[2], yb2[3]);
                    *(u32x4*)(outb + off + bj * HALF) = w;
                    s1 += ((ya[0] + ya[1]) + (ya[2] + ya[3])) + ((yb2[0] + yb2[1]) + (yb2[2] + yb2[3]));
                    s2 += ((ya[0] * ya[0] + ya[1] * ya[1]) + (ya[2] * ya[2] + ya[3] * ya[3])) + ((yb2[0] * yb2[0] + yb2[1] * yb2[1]) + (yb2[2] * yb2[2] + yb2[3] * yb2[3])); }
                s1 += shx(s1, 16, lane); s1 += shx(s1, 32, lane); s2 += shx(s2, 16, lane); s2 += shx(s2, 32, lane);
                if (fq == 0 && st_out) { atomicAdd(st_out + 2 * row, s1); atomicAdd(st_out + 2 * row + 1, s2); } }
            asm volatile("" ::: "memory");
        }
    }
};
struct EpiE {
    static constexpr bool PERM = true, AFTER_DRAIN = false, WIDE = false;
    bf16_t* O; float* rowss;
    __device__ __forceinline__ void operator()(f32x4 (&acc)[2][2][4][2], const Unit& u, int wr, int wc, int fr, int fq) const {
        { int ln_; asm volatile("v_mbcnt_lo_u32_b32 %0, -1, 0\n\tv_mbcnt_hi_u32_b32 %0, -1, %0" : "=v"(ln_)); fr = ln_ & 15; fq = ln_ >> 4; }
        const int row0 = u.pm * BM + wr * 64 + fr; const int col0 = u.pn * BM + wc * 32 + 8 * fq; const int lane = fq * 16 + fr;
#pragma unroll
        for (int ai = 0; ai < 2; ++ai)
#pragma unroll
            for (int m = 0; m < 4; ++m) { const int row = row0 + ai * HALF + m * 16; bf16_t* rowp = O + (size_t)row * 1024 + col0; float ss = 0.f;
#pragma unroll
                for (int bj = 0; bj < 2; ++bj) { const f32x4 v0 = acc[ai][bj][m][0], v1 = acc[ai][bj][m][1];
                    ss += (v0[0] * v0[0] + v0[1] * v0[1]) + (v0[2] * v0[2] + v0[3] * v0[3]) + (v1[0] * v1[0] + v1[1] * v1[1]) + (v1[2] * v1[2] + v1[3] * v1[3]);
                    u32x4 w; w.x = cvt_pk_bf16(v0[0], v0[1]); w.y = cvt_pk_bf16(v0[2], v0[3]); w.z = cvt_pk_bf16(v1[0], v1[1]); w.w = cvt_pk_bf16(v1[2], v1[3]);
                    *(u32x4*)(rowp + bj * HALF) = w; }
                ss += shx(ss, 16, lane); ss += shx(ss, 32, lane);
                if (fq == 0) atomicAdd(rowss + row, ss); }
    }
};
struct EpiGate {
    static constexpr bool PERM = true, AFTER_DRAIN = false, WIDE = false;
    float* x; const bf16_t* yb; const float* st; const float* g2; const float* b2; const float* c1; const float* c2; const bf16_t* E; const float* rowss; const float* gp; bf16_t* xb;
    __device__ __forceinline__ void operator()(f32x4 (&acc)[2][2][4][2], const Unit& u, int wr, int wc, int fr, int fq) const {
        { int ln_; asm volatile("v_mbcnt_lo_u32_b32 %0, -1, 0\n\tv_mbcnt_hi_u32_b32 %0, -1, %0" : "=v"(ln_)); fr = ln_ & 15; fq = ln_ >> 4; }
        const int col0 = u.pn * BM + wc * 32 + 8 * fq;
#pragma unroll
        for (int ai = 0; ai < 2; ++ai)
#pragma unroll
        for (int mp = 0; mp < 2; ++mp) {
            const int rowa = u.pm * BM + ai * HALF + wr * 64 + mp * 32 + fr;
            u32x4 yw[2][2], ew[2][2]; float mu[2], rstd[2], rs[2];
#pragma unroll
            for (int m = 0; m < 2; ++m)
#pragma unroll
                for (int bj = 0; bj < 2; ++bj) { const size_t o2 = (size_t)(rowa + m * 16) * 1024 + col0 + bj * HALF; yw[m][bj] = *(const u32x4*)(yb + o2); ew[m][bj] = *(const u32x4*)(E + o2); }
#pragma unroll
            for (int m = 0; m < 2; ++m) { const int row = rowa + m * 16; const f32x2 sv = *(const f32x2*)(st + 2 * row); rs[m] = rowss[row]; mu[m] = sv.x; rstd[m] = sv.y; }
#pragma unroll
            for (int m = 0; m < 2; ++m) { rs[m] = __builtin_amdgcn_rsqf(rs[m] * (1.0f / 1024.0f) + 1e-5f); mu[m] *= (1.f / 1024.f); rstd[m] = __builtin_amdgcn_rsqf(rstd[m] * (1.f / 1024.f) - mu[m] * mu[m] + 1e-5f); }
#pragma unroll
            for (int bj = 0; bj < 2; ++bj) { const int c = col0 + bj * HALF;
                f32x4 gv[2], g2v[2], b2v[2], c1v[2], c2v[2];
#pragma unroll
                for (int n = 0; n < 2; ++n) { gv[n] = *(const f32x4*)(gp + c + 4 * n); g2v[n] = *(const f32x4*)(g2 + c + 4 * n); b2v[n] = *(const f32x4*)(b2 + c + 4 * n); c1v[n] = *(const f32x4*)(c1 + c + 4 * n); c2v[n] = *(const f32x4*)(c2 + c + 4 * n); }
#pragma unroll
                for (int m = 0; m < 2; ++m) { const size_t o2 = (size_t)(rowa + m * 16) * 1024 + c; f32x4 o[2];
#pragma unroll
                    for (int n = 0; n < 2; ++n) {
                        const unsigned y0 = n ? yw[m][bj].z : yw[m][bj].x, y1 = n ? yw[m][bj].w : yw[m][bj].y, e0 = n ? ew[m][bj].z : ew[m][bj].x, e1 = n ? ew[m][bj].w : ew[m][bj].y;
                        const f32x4 yv = {__uint_as_float(y0 << 16), __uint_as_float(y0 & 0xffff0000u), __uint_as_float(y1 << 16), __uint_as_float(y1 & 0xffff0000u)};
                        const f32x4 ef = {__uint_as_float(e0 << 16), __uint_as_float(e0 & 0xffff0000u), __uint_as_float(e1 << 16), __uint_as_float(e1 & 0xffff0000u)};
                        const f32x4 xv = (yv - mu[m]) * rstd[m] * g2v[n] + b2v[n];
                        const f32x4 a = (acc[ai][bj][2 * mp + m][n] - mu[m] * c1v[n]) * rstd[m] + c2v[n];
#pragma unroll
                        for (int e = 0; e < 4; ++e) o[n][e] = xv[e] + ef[e] * rs[m] * gv[n][e] * __builtin_amdgcn_rcpf(1.f + __expf(-a[e])); }
                    if (x) { *(f32x4*)(x + o2) = o[0]; *(f32x4*)(x + o2 + 4) = o[1]; }
                    if (xb) { u32x4 w; w.x = cvt_pk_bf16(o[0][0], o[0][1]); w.y = cvt_pk_bf16(o[0][2], o[0][3]); w.z = cvt_pk_bf16(o[1][0], o[1][1]); w.w = cvt_pk_bf16(o[1][2], o[1][3]); *(u32x4*)(xb + o2) = w; } } }
            asm volatile("" ::: "memory");
        }
    }
};
}
#define PG8_SP2 true
#define PG8_ALIGN true
#include <hip/hip_bf16.h>
#include <cmath>
namespace attn_body {
using bf16=__hip_bfloat16;
using bf16x8=__attribute__((ext_vector_type(8)))short;
using s16x4=__attribute__((ext_vector_type(4)))short;
using f32x16=__attribute__((ext_vector_type(16)))float;
using u32x4=__attribute__((ext_vector_type(4)))unsigned;
constexpr int SEQ=8192,D=64,DM=3584,DMO=1024;
constexpr int NW=8,QBLK=32,QB=QBLK*NW,KVBLK=64,NQB=SEQ/QB;
constexpr int ATTN_PITCH=DM, ATTN_UNIT_ROWS=QB;
__device__ __forceinline__ int crow(int r,int hi){return (r&3)+8*(r>>2)+4*hi;}
#define SBAR() __builtin_amdgcn_sched_barrier(0)
__device__ __forceinline__ void cmask(f32x16&p0,f32x16&p1,int jb,int qrel,int hi){
  const float NEG=-INFINITY; int kb=64*jb+4*hi;
  #pragma unroll
  for(int r=0;r<16;++r){int kv=kb+(r&3)+8*(r>>2); if(kv>qrel)p0[r]=NEG; if(kv+32>qrel)p1[r]=NEG;}
}

constexpr int NSLOT=3, SLOTB=8192;
constexpr int LDS_K=0, LDS_V=NSLOT*SLOTB, LDS_WS=2*NSLOT*SLOTB, LDS_OST=LDS_WS+NW*64*4, LDS_BYTES=LDS_OST+NW*4096;
constexpr float C2=0.125f*1.4426950408889634f;
__device__ __forceinline__ void glds16(const void*gsrc,unsigned lds_dst){unsigned keep;
  asm volatile("s_mov_b32 %0, m0\n\ts_mov_b32 m0, %2\n\ts_nop 0\n\tglobal_load_lds_dwordx4 %1, off\n\ts_mov_b32 m0, %0":"=&s"(keep):"v"(gsrc),"s"(lds_dst):"memory");}
__device__ __forceinline__ float max3f(float a,float b,float c){float r;asm("v_max3_f32 %0, %1, %2, %3":"=v"(r):"v"(a),"v"(b),"v"(c));return r;}
__device__ __forceinline__ float max2f(float a,float b){float r;asm("v_max_f32_e32 %0, %1, %2":"=v"(r):"v"(a),"v"(b));return r;}
__device__ __forceinline__ float fadd_s(float a,float b){float r;asm("v_add_f32_e32 %0, %1, %2":"=v"(r):"v"(a),"v"(b));return r;}
__device__ __forceinline__ float fsub_s(float a,float b){float r;asm("v_sub_f32_e32 %0, %1, %2":"=v"(r):"v"(a),"v"(b));return r;}
typedef float f32x2_t __attribute__((ext_vector_type(2))); typedef __bf16 bf16x2_t __attribute__((ext_vector_type(2)));
__device__ __forceinline__ unsigned cvtpk_s(float lo,float hi){f32x2_t v={lo,hi};bf16x2_t b=__builtin_convertvector(v,bf16x2_t);return __builtin_bit_cast(unsigned,b);}
#define WAIT_BAR(N) asm volatile("s_waitcnt vmcnt(" #N ") lgkmcnt(0)\n\ts_barrier":::"memory")

__device__ __forceinline__ void qkt(f32x16&p0,f32x16&p1,const char*Kslot,const bf16x8*qr,const f32x16&negm,int r32,int hi){
  const char*kb=Kslot+hi*1024+r32*16;
  #pragma unroll
  for(int d0=0;d0<4;++d0){
    const bf16x8 b0=*reinterpret_cast<const bf16x8*>(kb+d0*2048);
    const bf16x8 b1=*reinterpret_cast<const bf16x8*>(kb+d0*2048+512);
    if(d0==0){p0=__builtin_amdgcn_mfma_f32_32x32x16_bf16(b0,qr[0],negm,0,0,0);p1=__builtin_amdgcn_mfma_f32_32x32x16_bf16(b1,qr[0],negm,0,0,0);}
    else{p0=__builtin_amdgcn_mfma_f32_32x32x16_bf16(b0,qr[d0],p0,0,0,0);p1=__builtin_amdgcn_mfma_f32_32x32x16_bf16(b1,qr[d0],p1,0,0,0);}}
}
typedef __attribute__((address_space(3))) const char* lds_cptr;
typedef short v4i16_t __attribute__((ext_vector_type(4)));
__device__ __forceinline__ void kload8(bf16x8*kf,lds_cptr kp){
  kf[0]=*(const __attribute__((address_space(3))) bf16x8*)(kp);      kf[1]=*(const __attribute__((address_space(3))) bf16x8*)(kp+512);
  kf[2]=*(const __attribute__((address_space(3))) bf16x8*)(kp+2048); kf[3]=*(const __attribute__((address_space(3))) bf16x8*)(kp+2560);
  kf[4]=*(const __attribute__((address_space(3))) bf16x8*)(kp+4096); kf[5]=*(const __attribute__((address_space(3))) bf16x8*)(kp+4608);
  kf[6]=*(const __attribute__((address_space(3))) bf16x8*)(kp+6144); kf[7]=*(const __attribute__((address_space(3))) bf16x8*)(kp+6656);
}
__device__ __forceinline__ void kload2(bf16x8*kf,lds_cptr kp,int j){ kf[2*j]=*(const __attribute__((address_space(3))) bf16x8*)(kp+j*2048); kf[2*j+1]=*(const __attribute__((address_space(3))) bf16x8*)(kp+j*2048+512); }
__device__ __forceinline__ s16x4 vtr(lds_cptr p){ return __builtin_bit_cast(s16x4,__builtin_amdgcn_ds_read_tr16_b64_v4i16((__attribute__((address_space(3))) v4i16_t*)p)); }
__device__ __forceinline__ float rowmax(const f32x16&p0,const f32x16&p1){
  float a=max3f(p0[0],p0[1],p1[0]),b=max3f(p0[2],p0[3],p1[1]);a=max3f(a,p1[2],p1[3]);
  #pragma unroll
  for(int r=4;r<16;r+=4){a=max3f(a,p0[r],p0[r+1]);b=max3f(b,p0[r+2],p0[r+3]);a=max3f(a,p1[r],p1[r+1]);b=max3f(b,p1[r+2],p1[r+3]);}
  const float m=max2f(a,b);
  auto rr=__builtin_amdgcn_permlane32_swap(__float_as_uint(m),__float_as_uint(m),false,false);
  return max2f(__uint_as_float(rr[0]),__uint_as_float(rr[1]));
}
__device__ __forceinline__ void pv(f32x16*o,int vb,bf16x8 pa0,bf16x8 pa1,bf16x8 pa2,bf16x8 pa3){
  #pragma unroll
  for(int d0=0;d0<2;++d0){s16x4 lo[4],hi[4];
    #pragma unroll
    for(int ks=0;ks<4;++ks){
      asm volatile("ds_read_b64_tr_b16 %0,%1 offset:%c2":"=&v"(lo[ks]):"v"(vb),"i"(d0*4096+ks*1024):"memory");
      asm volatile("ds_read_b64_tr_b16 %0,%1 offset:%c2":"=&v"(hi[ks]):"v"(vb),"i"(d0*4096+ks*1024+512):"memory");}
    asm volatile("s_waitcnt lgkmcnt(0)":::"memory");SBAR();
    #define PK(k) (bf16x8){lo[k][0],lo[k][1],lo[k][2],lo[k][3],hi[k][0],hi[k][1],hi[k][2],hi[k][3]}
    o[d0]=__builtin_amdgcn_mfma_f32_32x32x16_bf16(pa0,PK(0),o[d0],0,0,0);
    o[d0]=__builtin_amdgcn_mfma_f32_32x32x16_bf16(pa1,PK(1),o[d0],0,0,0);
    o[d0]=__builtin_amdgcn_mfma_f32_32x32x16_bf16(pa2,PK(2),o[d0],0,0,0);
    o[d0]=__builtin_amdgcn_mfma_f32_32x32x16_bf16(pa3,PK(3),o[d0],0,0,0);
    #undef PK
  }
}

#ifndef ATTN_STORE16
#define ATTN_STORE16(p,v) (*(u32x4*)(p)=(v))
#endif
template<int THRL> __device__ __forceinline__ void attn_unit(int b,int colq,int colk,int colv,int colo,int qb,const bf16*Q,const bf16*__restrict__ K,const bf16*__restrict__ V,bf16*O,char*shm,const int tid_in){
  const int tid=tid_in,lane=tid&63,r32=lane&31,hi=lane>>5; const int wid=__builtin_amdgcn_readfirstlane(tid>>6);
  const long rowbase=(long)b*SEQ; const int q0=qb*QB;
  const bf16*Qw=Q+(rowbase+q0+wid*QBLK)*DM+colq;
  const bf16*Kh=K+rowbase*DM+colk,*Vh=V+rowbase*DM+colv;
  const unsigned lds0=(unsigned)(uintptr_t)shm;
  float*wsf=(float*)(shm+LDS_WS)+wid*64;
  const bf16*ksrc=Kh+(long)lane*DM+wid*8;
  const bf16*vsrc=Vh+(long)(16*(wid&3)+(lane>>2))*DM+(wid>>2)*32+(lane&3)*8;
  const unsigned kdst=lds0+LDS_K+wid*1024, vdst=lds0+LDS_V+wid*1024;
  #define DMA_K(t,slot) glds16(ksrc+(long)(t)*KVBLK*DM,(unsigned)__builtin_amdgcn_readfirstlane(kdst+(slot)))
  #define DMA_V(t,slot) glds16(vsrc+(long)(t)*KVBLK*DM,(unsigned)__builtin_amdgcn_readfirstlane(vdst+(slot)))
  const int vb0=(int)(lds0+LDS_V)+((lane>>4)&1)*32+(lane&3)*8+(4*hi+((lane&15)>>2))*64;
  const char*Kbase=shm+LDS_K; bf16x8 kf[8];
  const lds_cptr shm3=(lds_cptr)shm; const lds_cptr kp0=shm3+LDS_K+hi*1024+r32*16; const lds_cptr vp0=shm3+LDS_V+((lane>>4)&1)*32+(lane&3)*8+(4*hi+((lane&15)>>2))*64;
  const int NT=(q0+QB)/KVBLK;
  DMA_K(0,0);DMA_V(0,0);DMA_K(1,SLOTB);
  bf16x8 qr[4];
  #pragma unroll
  for(int d0=0;d0<4;++d0)qr[d0]=*reinterpret_cast<const bf16x8*>(&Qw[(long)r32*DM+d0*16+hi*8]);
  float mhat=0.f,l_reg=0.f;f32x16 o[2];o[0]=f32x16{};o[1]=f32x16{};f32x16 negm=f32x16{};asm volatile("":"+v"(negm));
  const int qrel=wid*QBLK+r32;
  #define CMASK(P0,P1,t) do{int jb_=(t)-(NT-4); if(jb_>=0)cmask(P0,P1,jb_,qrel,hi);}while(0)
  bool resc=false;
  #define START(P0,P1) do{ const float rm=rowmax(P0,P1); resc=false; \
    { const float dl=rm; mhat=fadd_s(mhat,dl); \
      _Pragma("unroll") for(int r=0;r<16;++r){P0[r]=fsub_s(P0[r],dl);P1[r]=fsub_s(P1[r],dl);} \
      _Pragma("unroll") for(int r=0;r<16;++r)negm[r]=-mhat; asm volatile("":"+v"(negm)); } \
    _Pragma("unroll") for(int r=0;r<16;++r)P0[r]=__builtin_amdgcn_exp2f(P0[r]); }while(0)
  #define RESC() do{ if(resc){ asm volatile("s_waitcnt lgkmcnt(0)":::"memory"); \
      _Pragma("unroll") for(int d_=0;d_<2;++d_) _Pragma("unroll") for(int r=0;r<16;++r)o[d_][r]*=wsf[crow(r,hi)]; } }while(0)
  f32x16 pA0,pA1,pB0,pB1;
  int sl_prev=0,sl_cur=0,sl_next=SLOTB;
  #define ROT() do{sl_prev=sl_cur;sl_cur=sl_next;sl_next=(sl_next==(NSLOT-1)*SLOTB)?0:sl_next+SLOTB;}while(0)
  DMA_K(2,2*SLOTB);
  WAIT_BAR(3);
  qkt(pA0,pA1,Kbase,qr,negm,r32,hi);asm volatile("s_nop 15\n\ts_nop 7":"+v"(pA0),"+v"(pA1));CMASK(pA0,pA1,0);
  START(pA0,pA1);
  _Pragma("unroll") for(int r=0;r<16;++r)pA1[r]=__builtin_amdgcn_exp2f(pA1[r]);
  WAIT_BAR(0);
  DMA_K(3,0);DMA_V(1,SLOTB);
  ROT();
  kload8(kf,kp0+sl_cur);
  WAIT_BAR(2);
  s16x4 vlo[8],vhi[8]; u32x4 pw0,pw1,pw2,pw3;
  #define PKW(P,B) cvtpk_s(P[B],P[B+1])
  #define PAF(k) __builtin_bit_cast(bf16x8,pw##k)
  #define VFR(i) (bf16x8){vlo[i][0],vlo[i][1],vlo[i][2],vlo[i][3],vhi[i][0],vhi[i][1],vhi[i][2],vhi[i][3]}
  #define PIN(x) asm volatile("":"+v"(x))
  #define MX3(a,b,c) __builtin_fmaxf(__builtin_fmaxf((a),(b)),(c))
  #define GAPA(MF,A0,A1,A2,A3,W0,W1,PW) do{ MF; sacc+=A0; sacc+=A1; sacc+=A2; sacc+=A3; PIN(sacc); W0; W1; PIN(PW); SBAR(); }while(0)
  #define EX(v) __builtin_amdgcn_exp2f(v)
  #define GAPB(MF,X,B) do{ MF; X[B]=EX(X[B]); X[B+1]=EX(X[B+1]); X[B+2]=EX(X[B+2]); X[B+3]=EX(X[B+3]); PIN(X); SBAR(); }while(0)
  #define VRD(i) do{ vlo[i]=vtr(vp_+(((i)>>2)*4096+((i)&3)*1024)); vhi[i]=vtr(vp_+(((i)>>2)*4096+((i)&3)*1024+512)); }while(0)
  #define KRD(G,j) do{ if(G){ kload2(kf,kp0+sl_next,j); SBAR(); } }while(0)
  #define STEP(C0,C1,P0,P1,t,GK,GV,GL) do{ SBAR(); \
    const lds_cptr vp_=vp0+sl_prev; \
    VRD(0); SBAR(); float sacc=(P0[0]+P0[1]); \
    GAPA(C0=__builtin_amdgcn_mfma_f32_32x32x16_bf16(kf[0],qr[0],negm,0,0,0), P0[2],P0[3],P0[4],P0[5],     pw0[0]=PKW(P0,0), pw0[1]=PKW(P0,2), pw0); \
    VRD(4); SBAR(); GAPA(C1=__builtin_amdgcn_mfma_f32_32x32x16_bf16(kf[1],qr[0],negm,0,0,0), P0[6],P0[7],P0[8],P0[9],     pw0[2]=PKW(P0,4), pw0[3]=PKW(P0,6), pw0); \
    VRD(1); SBAR(); GAPA(C0=__builtin_amdgcn_mfma_f32_32x32x16_bf16(kf[2],qr[1],C0,0,0,0),   P0[10],P0[11],P0[12],P0[13], pw1[0]=PKW(P0,8), pw1[1]=PKW(P0,10), pw1); \
    VRD(5); SBAR(); GAPA(C1=__builtin_amdgcn_mfma_f32_32x32x16_bf16(kf[3],qr[1],C1,0,0,0),   P0[14],P0[15],P1[0],P1[1],   pw1[2]=PKW(P0,12),pw1[3]=PKW(P0,14), pw1); \
    VRD(2); SBAR(); GAPA(C0=__builtin_amdgcn_mfma_f32_32x32x16_bf16(kf[4],qr[2],C0,0,0,0),   P1[2],P1[3],P1[4],P1[5],     pw2[0]=PKW(P1,0), pw2[1]=PKW(P1,2), pw2); \
    VRD(6); SBAR(); GAPA(C1=__builtin_amdgcn_mfma_f32_32x32x16_bf16(kf[5],qr[2],C1,0,0,0),   P1[6],P1[7],P1[8],P1[9],     pw2[2]=PKW(P1,4), pw2[3]=PKW(P1,6), pw2); \
    VRD(3); SBAR(); GAPA(C0=__builtin_amdgcn_mfma_f32_32x32x16_bf16(kf[6],qr[3],C0,0,0,0),   P1[10],P1[11],P1[12],P1[13], pw3[0]=PKW(P1,8), pw3[1]=PKW(P1,10), pw3); \
    VRD(7); SBAR(); GAPA(C1=__builtin_amdgcn_mfma_f32_32x32x16_bf16(kf[7],qr[3],C1,0,0,0),   P1[14],P1[15],0.f,0.f,       pw3[2]=PKW(P1,12),pw3[3]=PKW(P1,14), pw3); \
    l_reg+=sacc; \
    if(GK){DMA_K((t)+3,sl_cur);} if(GV){DMA_V((t)+1,sl_next);} \
    CMASK(C0,C1,t); \
    { float a=MX3(C0[0],C0[1],C1[0]),b=MX3(C0[2],C0[3],C1[1]); a=MX3(a,C1[2],C1[3]); \
      _Pragma("unroll") for(int r=4;r<16;r+=4){a=MX3(a,C0[r],C0[r+1]);b=MX3(b,C0[r+2],C0[r+3]);a=MX3(a,C1[r],C1[r+1]);b=MX3(b,C1[r+2],C1[r+3]);} \
      float rm=__builtin_fmaxf(a,b); { auto rr=__builtin_amdgcn_permlane32_swap(__float_as_uint(rm),__float_as_uint(rm),false,false); rm=__builtin_fmaxf(__uint_as_float(rr[0]),__uint_as_float(rr[1])); } \
      resc=false; \
      if(__builtin_expect(__any(rm>(float)THRL),0)){ const float dl=__builtin_fmaxf(rm,0.f); mhat+=dl; \
        _Pragma("unroll") for(int r=0;r<16;++r){C0[r]-=dl;C1[r]-=dl;} \
        _Pragma("unroll") for(int r=0;r<16;++r)negm[r]=-mhat; asm volatile("":"+v"(negm)); \
        const float f=__builtin_amdgcn_exp2f(-dl); l_reg*=f; if(hi==0)wsf[r32]=f; resc=true; } } \
    SBAR(); \
    GAPB(o[0]=__builtin_amdgcn_mfma_f32_32x32x16_bf16(PAF(0),VFR(0),o[0],0,0,0), C0,0); \
    GAPB(o[1]=__builtin_amdgcn_mfma_f32_32x32x16_bf16(PAF(0),VFR(4),o[1],0,0,0), C0,4); \
    KRD(GL,0); GAPB(o[0]=__builtin_amdgcn_mfma_f32_32x32x16_bf16(PAF(1),VFR(1),o[0],0,0,0), C0,8); \
    KRD(GL,1); GAPB(o[1]=__builtin_amdgcn_mfma_f32_32x32x16_bf16(PAF(1),VFR(5),o[1],0,0,0), C0,12); \
    KRD(GL,2); GAPB(o[0]=__builtin_amdgcn_mfma_f32_32x32x16_bf16(PAF(2),VFR(2),o[0],0,0,0), C1,0); \
    KRD(GL,3); GAPB(o[1]=__builtin_amdgcn_mfma_f32_32x32x16_bf16(PAF(2),VFR(6),o[1],0,0,0), C1,4); \
    GAPB(o[0]=__builtin_amdgcn_mfma_f32_32x32x16_bf16(PAF(3),VFR(3),o[0],0,0,0), C1,8); \
    GAPB(o[1]=__builtin_amdgcn_mfma_f32_32x32x16_bf16(PAF(3),VFR(7),o[1],0,0,0), C1,12); \
    }while(0)
  int t=1;
  #undef CMASK
  #define CMASK(P0,P1,t) do{}while(0)
  for(;t+5<NT;t+=2){
    STEP(pB0,pB1,pA0,pA1,t,true,true,true);     WAIT_BAR(2); RESC(); ROT();
    STEP(pA0,pA1,pB0,pB1,t+1,true,true,true);   WAIT_BAR(2); RESC(); ROT();
  }
  #undef CMASK
  #define CMASK(P0,P1,t) do{int jb_=(t)-(NT-4); if(jb_>=0)cmask(P0,P1,jb_,qrel,hi);}while(0)
  #define ENDW(tt) do{ if((tt)+3<NT){WAIT_BAR(2);} else if((tt)+2<NT){WAIT_BAR(1);} else {WAIT_BAR(0);} }while(0)
  for(;t+1<NT;t+=2){
    STEP(pB0,pB1,pA0,pA1,t,(t+3<NT),(t+1<NT),(t+1<NT));       ENDW(t);   RESC(); ROT();
    STEP(pA0,pA1,pB0,pB1,t+1,(t+4<NT),(t+2<NT),(t+2<NT));     ENDW(t+1); RESC(); ROT();
  }
  STEP(pB0,pB1,pA0,pA1,NT-1,false,false,false); RESC();
  { float sacc=pB0[0]+pB0[1]; _Pragma("unroll") for(int r=2;r<16;++r)sacc+=pB0[r]; _Pragma("unroll") for(int r=0;r<16;++r)sacc+=pB1[r]; l_reg+=sacc;
    pw0=(u32x4){PKW(pB0,0),PKW(pB0,2),PKW(pB0,4),PKW(pB0,6)};pw1=(u32x4){PKW(pB0,8),PKW(pB0,10),PKW(pB0,12),PKW(pB0,14)};pw2=(u32x4){PKW(pB1,0),PKW(pB1,2),PKW(pB1,4),PKW(pB1,6)};pw3=(u32x4){PKW(pB1,8),PKW(pB1,10),PKW(pB1,12),PKW(pB1,14)};
    SBAR(); pv(o,vb0+sl_cur,PAF(0),PAF(1),PAF(2),PAF(3)); }
  #undef PKW
  #undef PAF
  #undef VFR
  #undef PIN
  #undef MX3
  #undef GAPA
  #undef GAPB
  #undef EX
  #undef VRD
  #undef KRD
  #undef STEP
  #undef ENDW
  {auto rr=__builtin_amdgcn_permlane32_swap(__float_as_uint(l_reg),__float_as_uint(l_reg),false,false);l_reg=__uint_as_float(rr[0])+__uint_as_float(rr[1]);}
  if(hi==0)wsf[32+r32]=l_reg;asm volatile("s_waitcnt lgkmcnt(0)":::"memory");
  float rli[16];
  #pragma unroll
  for(int r=0;r<16;++r)rli[r]=__builtin_amdgcn_rcpf(wsf[32+crow(r,hi)]);
  bf16*Ow=O+(rowbase+q0+wid*QBLK)*DMO+colo;
  { bf16*stg=(bf16*)(shm+LDS_OST)+wid*2048;
    #pragma unroll
    for(int r=0;r<16;++r){const int orow=crow(r,hi);
      #pragma unroll
      for(int d0=0;d0<2;++d0)stg[orow*64+d0*32+r32]=__float2bfloat16(o[d0][r]*rli[r]);}
    asm volatile("s_waitcnt lgkmcnt(0)":::"memory");
    #pragma unroll
    for(int i=0;i<4;++i){const int row=i*8+(lane>>3),ch=lane&7; const u32x4 v=*(const u32x4*)(stg+row*64+ch*8); ATTN_STORE16(Ow+(long)row*DMO+ch*8,v);} }
  asm volatile("s_waitcnt lgkmcnt(0)\n\ts_barrier":::"memory");
  #undef DMA_K
  #undef DMA_V
  #undef CMASK
  #undef START
  #undef RESC
  #undef ROT
}
constexpr int ATTN_LDS_BYTES=LDS_BYTES;
#undef SBAR
#undef WAIT_BAR
}
#define LAS __attribute__((address_space(3)))
typedef unsigned short u16;
typedef unsigned v4u __attribute__((ext_vector_type(4)));
typedef unsigned v2u __attribute__((ext_vector_type(2)));
typedef float f32x4 __attribute__((ext_vector_type(4)));
typedef short bf16x8 __attribute__((ext_vector_type(8)));
typedef short s16x4 __attribute__((ext_vector_type(4)));
typedef float f32x16 __attribute__((ext_vector_type(16)));
typedef float f32x2_t __attribute__((ext_vector_type(2)));
typedef __bf16 bf16x2_t __attribute__((ext_vector_type(2)));

constexpr int MTOK = 32768, SEQL = 8192, DMODEL = 1024, FFD = 4096, NIN0 = 3584, NIN1 = 3072, PLE = 256;
constexpr float LN_EPS = 1e-5f;
constexpr float ALPHA = 1.4142135623730951f;
constexpr size_t MiB = 1u << 20;
constexpr size_t WS_CVEC = 0;
constexpr size_t WS_STATS = 62 * MiB;
constexpr size_t WS_ROWSS = 63 * MiB;
constexpr size_t WS_BAR = 256 * 1024;
constexpr size_t WS_MISC = 512 * 1024;
constexpr size_t WS_CS = 1 * MiB;
constexpr size_t WS_WIN0 = 2 * MiB, WS_WOUT0 = 9 * MiB, WS_WIN1 = 11 * MiB, WS_WOUT1 = 17 * MiB, WS_W1 = 19 * MiB  , WS_W2 = 35 * MiB  , WS_WP = 51 * MiB  , WS_WG = 52 * MiB  ;
constexpr size_t WS_LSE = 56 * MiB;
constexpr size_t WS_XB = 64 * MiB, WS_MIX = 128 * MiB, WS_HB = 192 * MiB, WS_AUX = 448 * MiB, WS_END = 512 * MiB;
constexpr size_t WS_HGS = 416 * MiB, WS_HGD = 432 * MiB;
constexpr size_t WS_OB1 = 384 * MiB;
constexpr int LDS_BYTES = 147456;

__device__ __forceinline__ unsigned f2bf(float f) { unsigned u = __builtin_bit_cast(unsigned, f); return (u + 0x7fffu + ((u >> 16) & 1u)) >> 16; }
__device__ __forceinline__ unsigned pk2(float lo, float hi) { f32x2_t v = {lo, hi}; bf16x2_t b = __builtin_convertvector(v, bf16x2_t); return __builtin_bit_cast(unsigned, b); }
__device__ __forceinline__ float bf2f(unsigned v) { return __uint_as_float(v << 16); }
__device__ __forceinline__ float bflo(unsigned w) { return __uint_as_float(w << 16); }
__device__ __forceinline__ float bfhi(unsigned w) { return __uint_as_float(w & 0xffff0000u); }
__device__ __forceinline__ float shx(float v, int m, int lane) { return __builtin_bit_cast(float, __builtin_amdgcn_ds_bpermute((lane ^ m) << 2, __builtin_bit_cast(int, v))); }
__device__ __forceinline__ float wave_sum(float v, int lane) {
#pragma unroll
    for (int o = 1; o < 64; o <<= 1) v += shx(v, o, lane);
    return v;
}
__device__ __forceinline__ int crow(int reg, int h) { return (reg & 3) + 8 * (reg >> 2) + 4 * h; }
#define MFMA32(a, b, c) __builtin_amdgcn_mfma_f32_32x32x16_bf16((a), (b), (c), 0, 0, 0)
__device__ __forceinline__ bf16x8 pack8(const f32x16& x, int base) {
    v4u p; p.x = pk2(x[base], x[base + 1]); p.y = pk2(x[base + 2], x[base + 3]); p.z = pk2(x[base + 4], x[base + 5]); p.w = pk2(x[base + 6], x[base + 7]);
    return __builtin_bit_cast(bf16x8, p);
}
typedef short v4i16_t __attribute__((ext_vector_type(4)));
__device__ __forceinline__ s16x4 trrd(LAS unsigned char* p) { return __builtin_bit_cast(s16x4, __builtin_amdgcn_ds_read_tr16_b64_v4i16((LAS v4i16_t*)p)); }
__device__ __forceinline__ bf16x8 trfrag(LAS unsigned char* img, int pitch, int row_lo, int hi_delta, int col0, int lane) {
    const int i16 = lane & 15, q = i16 >> 2, p = i16 & 3, g16 = (lane >> 4) & 1;
    LAS unsigned char* a = img + (row_lo + q) * pitch + (col0 + 16 * g16 + 4 * p) * 2;
    const s16x4 lo = trrd(a), hi = trrd(a + hi_delta * pitch);
    return (bf16x8){lo[0], lo[1], lo[2], lo[3], hi[0], hi[1], hi[2], hi[3]};
}

struct Args {
    const float *x, *p, *ev_w_in, *ev_w_out, *da_lambda, *da_subln_g, *hg_lb_logits, *hg_norm_g, *od_w_in, *od_w_out, *ln1_g, *ln1_b, *ffn_w1, *ffn_w2, *ln2_g, *ln2_b, *ple_w_proj, *ple_w_gate, *ple_norm_g;
    float* out; unsigned char* ws;
};

__device__ __forceinline__ void p0_transpose_item(const float* W, int K, int N, u16* WT, LAS float* scr, int item, int lane, const float* gk = nullptr, const float* bk = nullptr, float* c1 = nullptr, float* c2 = nullptr) {
    const int nblk = N / 32, kb = item / nblk, nb = item % nblk, k0 = 64 * kb, n0 = 32 * nb;
#pragma unroll 8
    for (int i = 0; i < 32; ++i) { const int kk = 2 * i + (lane >> 5); scr[kk * 33 + (lane & 31)] = W[(size_t)(k0 + kk) * N + n0 + (lane & 31)]; }
    asm volatile("s_waitcnt lgkmcnt(0)" ::: "memory");
    const int c = lane & 7;
    float gs[8];
#pragma unroll
    for (int e = 0; e < 8; ++e) gs[e] = gk ? gk[k0 + 8 * c + e] : 1.f;
    if (gk) {
        const int n = lane & 31, kh = (lane >> 5) * 32; float s1 = 0.f, s2 = 0.f;
#pragma unroll 8
        for (int kk = 0; kk < 32; ++kk) { const float wv = scr[(kh + kk) * 33 + n]; s1 += gk[k0 + kh + kk] * wv; s2 += bk[k0 + kh + kk] * wv; }
        s1 += shx(s1, 32, lane); s2 += shx(s2, 32, lane);
        if (lane < 32) { atomicAdd(c1 + n0 + n, s1); atomicAdd(c2 + n0 + n, s2); }
    }
#pragma unroll
    for (int j = 0; j < 4; ++j) { const int n = (lane >> 3) + 8 * j; const LAS float* sp = scr + (8 * c) * 33 + n;
        v4u o; o.x = pk2(sp[0 * 33] * gs[0], sp[1 * 33] * gs[1]); o.y = pk2(sp[2 * 33] * gs[2], sp[3 * 33] * gs[3]); o.z = pk2(sp[4 * 33] * gs[4], sp[5 * 33] * gs[5]); o.w = pk2(sp[6 * 33] * gs[6], sp[7 * 33] * gs[7]);
        *(v4u*)(WT + (size_t)(n0 + n) * K + k0 + 8 * c) = o; }
    asm volatile("s_waitcnt lgkmcnt(0)" ::: "memory");
}
__device__ __forceinline__ void prologue(const Args& A, LAS unsigned char* lds, int gw, int NGW, int wave, int lane) {
    unsigned char* ws = A.ws;
    LAS float* scr = (LAS float*)(lds + wave * 16384);
    const int cnt[12] = {(1024 / 64) * (NIN0 / 32), 512, (1024 / 64) * (NIN1 / 32), 512, 2048, 2048, 2048, 2048, 128, 128, 512, 512};
    int total = 0;
#pragma unroll
    for (int i = 0; i < 12; ++i) total += cnt[i];
    for (int it = gw; it < total; it += NGW) {
        int r = it;
        if (r < cnt[0]) { p0_transpose_item(A.ev_w_in, 1024, NIN0, (u16*)(ws + WS_WIN0), scr, r, lane); continue; } r -= cnt[0];
        if (r < cnt[1]) { p0_transpose_item(A.ev_w_out, 1024, 1024, (u16*)(ws + WS_WOUT0), scr, r, lane); continue; } r -= cnt[1];
        if (r < cnt[2]) { p0_transpose_item(A.od_w_in, 1024, NIN1, (u16*)(ws + WS_WIN1), scr, r, lane); continue; } r -= cnt[2];
        if (r < cnt[3]) { p0_transpose_item(A.od_w_out, 1024, 1024, (u16*)(ws + WS_WOUT1), scr, r, lane); continue; } r -= cnt[3];
        if (r < 4096) { const int l = r >> 11; float* cv = (float*)(ws + WS_CVEC) + l * 10240; p0_transpose_item(A.ffn_w1 + (size_t)l * 1024 * 4096, 1024, 4096, (u16*)(ws + WS_W1 + l * 8 * MiB), scr, r & 2047, lane, A.ln1_g + l * 1024, A.ln1_b + l * 1024, cv, cv + 4096); continue; } r -= 4096;
        if (r < 4096) { const int l = r >> 11; p0_transpose_item(A.ffn_w2 + (size_t)l * 1024 * 4096, 4096, 1024, (u16*)(ws + WS_W2 + l * 8 * MiB), scr, r & 2047, lane); continue; } r -= 4096;
        if (r < 256) { const int l = r >> 7; p0_transpose_item(A.ple_w_proj + (size_t)l * 256 * 1024, 256, 1024, (u16*)(ws + WS_WP + l * (MiB / 2)), scr, r & 127, lane); continue; } r -= 256;
        { const int l = r >> 9; float* cv = (float*)(ws + WS_CVEC) + l * 10240 + 8192; p0_transpose_item(A.ple_w_gate + (size_t)l * 1024 * 1024, 1024, 1024, (u16*)(ws + WS_WG + l * 2 * MiB), scr, r & 511, lane, A.ln2_g + l * 1024, A.ln2_b + l * 1024, cv, cv + 1024); }
    }
    u16* XB = (u16*)(ws + WS_XB);
    for (int m = gw; m < MTOK; m += NGW) {
        const f32x4* xr = (const f32x4*)(A.x + (size_t)m * 1024) + 2 * lane; v4u* o = (v4u*)(XB + (size_t)m * 1024) + lane;
#pragma unroll
        for (int j = 0; j < 2; ++j) { const f32x4 v = xr[128 * j], v2 = xr[128 * j + 1]; v4u w; w.x = pk2(v[0], v[1]); w.y = pk2(v[2], v[3]); w.z = pk2(v2[0], v2[1]); w.w = pk2(v2[2], v2[3]); o[64 * j] = w; }
    }
    { v4u* z = (v4u*)(ws + WS_STATS); for (int i = gw * 64 + lane; i < (int)((MiB + 256 * 1024) / 16); i += NGW * 64) z[i] = (v4u){0u, 0u, 0u, 0u}; }
    float* cs = (float*)(ws + WS_CS);
    for (int idx = gw * 64 + lane; idx < 65536; idx += NGW * 64) {
        const int pos = idx >> 3, e = idx & 7;
        double iv = 1.0;
#pragma unroll 1
        for (int k = 0; k < e; ++k) iv *= 0.19392274474868576;
        const float inv = (float)iv;
        const float angf = (float)pos * inv;
        double a = (double)angf; const double twopi = 6.283185307179586476925;
        const double kq = __builtin_rint(a / twopi); a -= kq * twopi;
        const double a2 = a * a; double sn = 0.0, cn = 0.0;
        double ts = a, tc = 1.0;
#pragma unroll 1
        for (int n = 0; n < 16; ++n) { cn += tc; sn += ts; tc *= -a2 / (double)((2 * n + 1) * (2 * n + 2)); ts *= -a2 / (double)((2 * n + 2) * (2 * n + 3)); }
        cs[idx] = (float)cn; cs[65536 + idx] = (float)sn;
    }
    float* misc = (float*)(ws + WS_MISC);
    for (int i = gw * 64 + lane; i < 512; i += NGW * 64) { const float l0 = A.hg_lb_logits[i], l1 = A.hg_lb_logits[512 + i]; misc[i] = 1.f / (1.f + __expf(l1 - l0)); }
}

__device__ __forceinline__ void ln_rows(float* X, u16* XBo, const float* g, const float* bta, float* rowss, const float* prow, u16* PBo, int gw, int NGW, int lane) {
    for (int m = gw; m < MTOK; m += NGW) {
        f32x4* xr = (f32x4*)(X + (size_t)m * 1024) + lane;
        f32x4 v[4]; float s = 0.f;
#pragma unroll
        for (int j = 0; j < 4; ++j) { v[j] = xr[64 * j]; s += (v[j][0] + v[j][1]) + (v[j][2] + v[j][3]); }
        const float mean = wave_sum(s, lane) * (1.f / 1024.f); float s2 = 0.f;
#pragma unroll
        for (int j = 0; j < 4; ++j) { v[j] = v[j] - mean; s2 += (v[j][0] * v[j][0] + v[j][1] * v[j][1]) + (v[j][2] * v[j][2] + v[j][3] * v[j][3]); }
        const float rstd = 1.f / sqrtf(wave_sum(s2, lane) * (1.f / 1024.f) + LN_EPS);
        v2u* o8 = (v2u*)(XBo + (size_t)m * 1024) + lane;
#pragma unroll
        for (int j = 0; j < 4; ++j) { const f32x4 gv = ((const f32x4*)g)[lane + 64 * j], bv = ((const f32x4*)bta)[lane + 64 * j];
            const f32x4 o = v[j] * rstd * gv + bv; xr[64 * j] = o; v2u w; w.x = pk2(o[0], o[1]); w.y = pk2(o[2], o[3]); o8[64 * j] = w; }
        if (rowss && lane == 0) rowss[m] = 0.f;
        if (prow) { const f32x4 pv = ((const f32x4*)(prow + (size_t)m * 256))[lane]; v2u w; w.x = pk2(pv[0], pv[1]); w.y = pk2(pv[2], pv[3]); ((v2u*)(PBo + (size_t)m * 256))[lane] = w; }
    }
}
__device__ __forceinline__ void p_rows(const float* prow, u16* PBo, int gw, int NGW, int lane) {
    for (int m = gw; m < MTOK; m += NGW) { const f32x4 pv = ((const f32x4*)(prow + (size_t)m * 256))[lane]; v2u w; w.x = pk2(pv[0], pv[1]); w.y = pk2(pv[2], pv[3]); ((v2u*)(PBo + (size_t)m * 256))[lane] = w; }
}
__device__ __forceinline__ void p_rows2(const float* prow, u16* PBo, int gw, int NGW, int lane) {
    for (int m = gw; m < 2 * MTOK; m += NGW) {
        if (lane < 32) { const f32x4 a = ((const f32x4*)(prow + (size_t)m * 256))[2 * lane], b = ((const f32x4*)(prow + (size_t)m * 256))[2 * lane + 1];
            v4u w; w.x = pk2(a[0], a[1]); w.y = pk2(a[2], a[3]); w.z = pk2(b[0], b[1]); w.w = pk2(b[2], b[3]); ((v4u*)(PBo + (size_t)m * 256))[lane] = w; }
    }
}
__device__ __forceinline__ void diff_combine_block(const u16* AUX, u16* MIX, const float* lam_p, const float* subg, size_t row0, int h, int tid) {
    const int lane = tid & 63;
    const float s01 = wave_sum(lam_p[lane] * lam_p[64 + lane], lane), s23 = wave_sum(lam_p[128 + lane] * lam_p[192 + lane], lane);
    const float lam = __expf(s01) - __expf(s23) + 0.2f;
    const int d0 = (tid & 15) * 8;
    float gv[8];
#pragma unroll
    for (int e = 0; e < 8; ++e) gv[e] = subg[d0 + e] * 0.8f;
#pragma unroll
    for (int it = 0; it < 8; ++it) {
        const size_t m = row0 + (tid >> 4) + 32 * it;
        const v4u a0 = *(const v4u*)(AUX + m * 1024 + h * 256 + d0), a1 = *(const v4u*)(AUX + m * 1024 + h * 256 + 128 + d0);
        float o[8];
        o[0] = bflo(a0.x) - lam * bflo(a1.x); o[1] = bfhi(a0.x) - lam * bfhi(a1.x); o[2] = bflo(a0.y) - lam * bflo(a1.y); o[3] = bfhi(a0.y) - lam * bfhi(a1.y);
        o[4] = bflo(a0.z) - lam * bflo(a1.z); o[5] = bfhi(a0.z) - lam * bfhi(a1.z); o[6] = bflo(a0.w) - lam * bflo(a1.w); o[7] = bfhi(a0.w) - lam * bfhi(a1.w);
        float ss = 0.f;
#pragma unroll
        for (int e = 0; e < 8; ++e) ss += o[e] * o[e];
        ss += shx(ss, 1, lane); ss += shx(ss, 2, lane); ss += shx(ss, 4, lane); ss += shx(ss, 8, lane);
        const float rs = __builtin_amdgcn_rsqf(ss * (1.f / 128.f) + LN_EPS);
        v4u w; w.x = pk2(o[0] * rs * gv[0], o[1] * rs * gv[1]); w.y = pk2(o[2] * rs * gv[2], o[3] * rs * gv[3]); w.z = pk2(o[4] * rs * gv[4], o[5] * rs * gv[5]); w.w = pk2(o[6] * rs * gv[6], o[7] * rs * gv[7]);
        *(v4u*)(MIX + m * 1024 + h * 128 + d0) = w;
    }
}
__device__ __forceinline__ void diff_combine(const u16* AUX, u16* MIX, const float* lam_p, const float* subg, int gw, int NGW, int lane) {
    const float s01 = wave_sum(lam_p[lane] * lam_p[64 + lane], lane), s23 = wave_sum(lam_p[128 + lane] * lam_p[192 + lane], lane);
    const float lam = __expf(s01) - __expf(s23) + 0.2f;
    const int h = lane >> 4, d0 = (lane & 15) * 8;
    float gv[8];
#pragma unroll
    for (int e = 0; e < 8; ++e) gv[e] = subg[d0 + e] * 0.8f;
    for (int m = gw; m < MTOK; m += NGW) {
        const v4u a0 = *(const v4u*)(AUX + (size_t)m * 1024 + h * 256 + d0), a1 = *(const v4u*)(AUX + (size_t)m * 1024 + h * 256 + 128 + d0);
        float o[8];
        o[0] = bflo(a0.x) - lam * bflo(a1.x); o[1] = bfhi(a0.x) - lam * bfhi(a1.x); o[2] = bflo(a0.y) - lam * bflo(a1.y); o[3] = bfhi(a0.y) - lam * bfhi(a1.y);
        o[4] = bflo(a0.z) - lam * bflo(a1.z); o[5] = bfhi(a0.z) - lam * bfhi(a1.z); o[6] = bflo(a0.w) - lam * bflo(a1.w); o[7] = bfhi(a0.w) - lam * bfhi(a1.w);
        float ss = 0.f;
#pragma unroll
        for (int e = 0; e < 8; ++e) ss += o[e] * o[e];
        ss += shx(ss, 1, lane); ss += shx(ss, 2, lane); ss += shx(ss, 4, lane); ss += shx(ss, 8, lane);
        const float rs = 1.f / sqrtf(ss * (1.f / 128.f) + LN_EPS);
        v4u w; w.x = pk2(o[0] * rs * gv[0], o[1] * rs * gv[1]); w.y = pk2(o[2] * rs * gv[2], o[3] * rs * gv[3]); w.z = pk2(o[4] * rs * gv[4], o[5] * rs * gv[5]); w.w = pk2(o[6] * rs * gv[6], o[7] * rs * gv[7]);
        *(v4u*)(MIX + (size_t)m * 1024 + h * 128 + d0) = w;
    }
}
namespace hg {
constexpr int P_QA = 272, P_QO = 264, P_TR = 320;
constexpr int O_QA = 0, O_KA = O_QA + 64 * P_QA, O_QO = O_KA + 64 * P_QA, O_KST = O_QO + 64 * P_QO, O_V = O_KST + 64 * P_TR, O_OST = O_V + 64 * P_TR, O_TOT = O_OST + 64 * 132 * 4, O_DEC = O_TOT + 2048, O_END = O_DEC + 512;
static_assert(O_END <= 131072, "hgrn lds");
template <bool OUT>
__device__ __forceinline__ void item(LAS unsigned char* L, const u16* __restrict__ H, int it, const float* __restrict__ lbv, float* Send, float* Drun, const float* __restrict__ outg, u16* MIX, const int tid, const float* Sst = nullptr) {
    const int  lane = tid & 63, w = __builtin_amdgcn_readfirstlane(tid >> 6), r = lane & 31, h = lane >> 5;
    const int tt = w & 1, vt = w >> 1;
    const int bh = it >> 4, run = it & 15, b = bh >> 2, hh = bh & 3;
    const int kd = tid & 127, seg = tid >> 7;
    const size_t row0 = (size_t)b * 8192 + (size_t)run * 512;
    const float lb = lbv[hh * 128 + kd];
    LAS float* TOT = (LAS float*)(L + O_TOT); LAS float* DEC = (LAS float*)(L + O_DEC); LAS float* OST = (LAS float*)(L + O_OST);
    f32x16 S[4];
#pragma unroll
    for (int k = 0; k < 4; ++k) S[k] = f32x16{};
    if (OUT && run > 0) {
        if (Sst) {
#pragma unroll
            for (int k = 0; k < 4; ++k)
#pragma unroll
                for (int i = 0; i < 16; ++i) S[k][i] = Sst[((((size_t)it * 4 + vt) * 4 + k) * 16 + i) * 64 + lane];
        } else {
            for (int rp = 0; rp < run; ++rp) { const int ip = bh * 16 + rp;
#pragma unroll
                for (int k = 0; k < 4; ++k)
#pragma unroll
                    for (int i = 0; i < 16; ++i) S[k][i] = Drun[ip * 128 + 32 * k + crow(i, h)] * S[k][i] + Send[((((size_t)ip * 4 + vt) * 4 + k) * 16 + i) * 64 + lane];
            }
        }
    }
    float bsum = 0.f;
    u16 nf[16], nq[16]; v4u nv[2]; v4u ng[2] = {{0u, 0u, 0u, 0u}, {0u, 0u, 0u, 0u}};
#define HG_ISSUE(rowc_) do { _Pragma("unroll") for (int i = 0; i < 16; ++i) { const u16* p = H + ((rowc_) + seg * 16 + i) * NIN0 + hh * 128 + kd; nf[i] = p[2048]; if (OUT) nq[i] = p[1536]; } \
        _Pragma("unroll") for (int n = 0; n < 2; ++n) { const int id = tid + 512 * n, t = id >> 4, c = id & 15; nv[n] = *(const v4u*)(H + ((rowc_) + t) * NIN0 + 2560 + hh * 128 + c * 8); } \
        if (OUT) { const u16* gp_ = H + ((rowc_) + (tid >> 3)) * NIN0 + 3072 + hh * 128 + (tid & 7) * 16; ng[0] = *(const v4u*)gp_; ng[1] = *(const v4u*)(gp_ + 8); } } while (0)
    HG_ISSUE(row0);
    for (int ch = 0; ch < 8; ++ch) {
        const size_t rowc = row0 + ch * 64;
        float fg[16], cs[16], hq[16];
#pragma unroll
        for (int i = 0; i < 16; ++i) { fg[i] = bf2f(nf[i]); if (OUT) hq[i] = bf2f(nq[i]); }
#pragma unroll
        for (int n = 0; n < 2; ++n) { const int id = tid + 512 * n, t = id >> 4, c = id & 15; *(LAS v4u*)(L + O_V + t * P_TR + c * 16) = nv[n]; }
        const v4u gc0 = ng[0], gc1 = ng[1];
        if (ch + 1 < 8) HG_ISSUE(rowc + 64);
        float runs = 0.f;
#pragma unroll
        for (int i = 0; i < 16; ++i) { const float sg = __builtin_amdgcn_rcpf(1.f + __expf(-fg[i])); const float f = lb + (1.f - lb) * sg; fg[i] = (1.f - lb) * (1.f - sg); runs += __logf(f); cs[i] = runs; }
        TOT[seg * 128 + kd] = runs;
        __syncthreads();
        const float t0 = TOT[kd], t1 = TOT[128 + kd], t2 = TOT[256 + kd], t3 = TOT[384 + kd];
        const float off = (seg > 0 ? t0 : 0.f) + (seg > 1 ? t1 : 0.f) + (seg > 2 ? t2 : 0.f);
        const float bmid = t0 + t1, blast = (t0 + t1) + (t2 + t3);
        const float elm = __expf(blast - bmid), em = __expf(bmid);
#pragma unroll
        for (int i = 0; i < 16; i += 2) {
            const int t = seg * 16 + i; float kst[2], qa[2], ka[2], qo[2];
#pragma unroll
            for (int u = 0; u < 2; ++u) { const float bi = off + cs[i + u];
                const float e1 = __expf(bi - bmid), e2 = __builtin_amdgcn_rcpf(e1); const float kk = fg[i + u];
                ka[u] = kk * e2; kst[u] = ka[u] * elm;
                if (OUT) { const float q = hq[i + u] * __builtin_amdgcn_rcpf(1.f + __expf(-hq[i + u])); qa[u] = q * e1; qo[u] = qa[u] * em; } }
            { const unsigned w = pk2(kst[0], kst[1]); *(LAS u16*)(L + O_KST + t * P_TR + kd * 2) = (u16)w; *(LAS u16*)(L + O_KST + (t + 1) * P_TR + kd * 2) = (u16)(w >> 16); }
            if (OUT) {
                { const unsigned w = pk2(qa[0], qa[1]); *(LAS u16*)(L + O_QA + t * P_QA + kd * 2) = (u16)w; *(LAS u16*)(L + O_QA + (t + 1) * P_QA + kd * 2) = (u16)(w >> 16); }
                { const unsigned w = pk2(ka[0], ka[1]); *(LAS u16*)(L + O_KA + t * P_QA + kd * 2) = (u16)w; *(LAS u16*)(L + O_KA + (t + 1) * P_QA + kd * 2) = (u16)(w >> 16); }
                { const unsigned w = pk2(qo[0], qo[1]); *(LAS u16*)(L + O_QO + t * P_QO + kd * 2) = (u16)w; *(LAS u16*)(L + O_QO + (t + 1) * P_QO + kd * 2) = (u16)(w >> 16); } }
        }
        if (seg == 0) { DEC[kd] = __expf(blast); bsum += blast; }
        __syncthreads();
        if (OUT) {
            f32x16 acc = f32x16{};
            for (int st = 0; st <= tt; ++st) {
                f32x16 X = f32x16{};
#pragma unroll
                for (int ks = 0; ks < 8; ++ks) { const bf16x8 a = *(LAS bf16x8*)(L + O_KA + (32 * st + r) * P_QA + (16 * ks + 8 * h) * 2); const bf16x8 bq = *(LAS bf16x8*)(L + O_QA + (32 * tt + r) * P_QA + (16 * ks + 8 * h) * 2); X = MFMA32(a, bq, X); }
                if (st == tt) {
#pragma unroll
                    for (int i = 0; i < 16; ++i) if (crow(i, h) > r) X[i] = 0.f; }
#pragma unroll
                for (int s2 = 0; s2 < 2; ++s2) { const bf16x8 pa = pack8(X, 8 * s2); const bf16x8 vf = trfrag(L + O_V, P_TR, 32 * st + 16 * s2 + 4 * h, 8, 32 * vt, lane); acc = MFMA32(pa, vf, acc); }
            }
#pragma unroll
            for (int k = 0; k < 4; ++k)
#pragma unroll
                for (int s2 = 0; s2 < 2; ++s2) {
                    LAS unsigned char* qp = L + O_QO + (32 * tt + r) * P_QO + (32 * k + 16 * s2 + 4 * h) * 2;
                    const s16x4 lo = *(LAS s16x4*)qp, hi = *(LAS s16x4*)(qp + 16);
                    const bf16x8 a2 = (bf16x8){lo[0], lo[1], lo[2], lo[3], hi[0], hi[1], hi[2], hi[3]};
                    acc = MFMA32(a2, pack8(S[k], 8 * s2), acc); }
#pragma unroll
            for (int i = 0; i < 16; ++i) OST[(32 * tt + crow(i, h)) * 132 + 32 * vt + r] = acc[i];
        }
#pragma unroll
        for (int k = 0; k < 4; ++k) {
#pragma unroll
            for (int i = 0; i < 16; ++i) S[k][i] *= DEC[32 * k + crow(i, h)];
#pragma unroll
            for (int ks = 0; ks < 4; ++ks) { const bf16x8 a = trfrag(L + O_KST, P_TR, 16 * ks + 8 * h, 4, 32 * k, lane); const bf16x8 bv = trfrag(L + O_V, P_TR, 16 * ks + 8 * h, 4, 32 * vt, lane); S[k] = MFMA32(a, bv, S[k]); }
        }
        __syncthreads();
        if (OUT) {
            const int t = tid >> 3, c8 = tid & 7; float o[16]; float ss = 0.f;
#pragma unroll
            for (int j = 0; j < 4; ++j) { const f32x4 v = *(LAS f32x4*)(OST + t * 132 + c8 * 16 + 4 * j); o[4 * j] = v[0]; o[4 * j + 1] = v[1]; o[4 * j + 2] = v[2]; o[4 * j + 3] = v[3]; ss += (v[0] * v[0] + v[1] * v[1]) + (v[2] * v[2] + v[3] * v[3]); }
            ss += shx(ss, 1, lane); ss += shx(ss, 2, lane); ss += shx(ss, 4, lane);
            const float rs = __builtin_amdgcn_rsqf(ss * (1.f / 128.f) + LN_EPS);
            u16* op = MIX + (rowc + t) * 1024 + 512 + hh * 128 + c8 * 16;
#pragma unroll
            for (int j = 0; j < 2; ++j) { const v4u gvv = j ? gc1 : gc0; const unsigned gw_[4] = {gvv.x, gvv.y, gvv.z, gvv.w}; unsigned ow[4];
#pragma unroll
                for (int e = 0; e < 4; ++e) { const float g0 = bflo(gw_[e]), g1 = bfhi(gw_[e]); const int c = 8 * j + 2 * e;
                    const float y0 = o[c] * rs * outg[c8 * 16 + c] * (g0 * __builtin_amdgcn_rcpf(1.f + __expf(-g0))), y1 = o[c + 1] * rs * outg[c8 * 16 + c + 1] * (g1 * __builtin_amdgcn_rcpf(1.f + __expf(-g1)));
                    ow[e] = pk2(y0, y1); }
                *(v4u*)(op + 8 * j) = (v4u){ow[0], ow[1], ow[2], ow[3]}; }
        }
    }
    if (!OUT) {
        if (tt == 0) {
#pragma unroll
            for (int k = 0; k < 4; ++k)
#pragma unroll
                for (int i = 0; i < 16; ++i) Send[((((size_t)it * 4 + vt) * 4 + k) * 16 + i) * 64 + lane] = S[k][i]; }
        if (seg == 0) Drun[it * 128 + kd] = __expf(bsum);
    }
}
__device__ __forceinline__ void scan(const float* __restrict__ Send, const float* __restrict__ Drun, float* Sst, int gtid, int nthreads) {
    for (int idx = gtid; idx < 16 * 16384; idx += nthreads) {
        const int bh = idx >> 14, e = idx & 16383, lane = e & 63, i = (e >> 6) & 15, k = (e >> 10) & 3;
        const int kd = 32 * k + crow(i, lane >> 5);
        float sv[15], dv[15];
#pragma unroll
        for (int r = 0; r < 15; ++r) { sv[r] = Send[(size_t)(bh * 16 + r) * 16384 + e]; dv[r] = Drun[(bh * 16 + r) * 128 + kd]; }
        float st = 0.f;
#pragma unroll
        for (int r = 0; r < 15; ++r) { st = dv[r] * st + sv[r]; Sst[(size_t)(bh * 16 + r + 1) * 16384 + e] = st; }
    }
}
}

__device__ __forceinline__ void dil_task(LAS unsigned char* Lw, const u16* __restrict__ QKV, int task, u16* OBg0, u16* OBg1, u16* OBg2, float* LSE, int lane) {
    const int r = lane & 31, h = lane >> 5;
    const int bh = task / 768, rem = task - bh * 768, g = rem >> 8, j = rem & 255;
    const int sh = 2 * g, res = j >> (8 - sh), qt = j & ((256 >> sh) - 1);
    const int b = bh >> 4, hd = bh & 15;
    const size_t rowb = (size_t)b * 8192;
    const int qpos = res + ((32 * qt + r) << sh);
    const u16* qp = QKV + (rowb + qpos) * NIN1 + hd * 64;
    bf16x8 qf[4];
#pragma unroll
    for (int ks = 0; ks < 4; ++ks) qf[ks] = *(const bf16x8*)(qp + 16 * ks + 8 * h);
    f32x16 X[5];
#pragma unroll
    for (int kb = 0; kb < 5; ++kb) {
        int ki = 32 * qt - 128 + 32 * kb + r; ki = ki < 0 ? 0 : ki;
        const u16* kp = QKV + (rowb + res + (ki << sh)) * NIN1 + 1024 + hd * 64;
        X[kb] = f32x16{};
#pragma unroll
        for (int ks = 0; ks < 4; ++ks) { const bf16x8 kf = *(const bf16x8*)(kp + 16 * ks + 8 * h); X[kb] = MFMA32(kf, qf[ks], X[kb]); }
    }
    float m = -INFINITY;
#pragma unroll
    for (int kb = 0; kb < 5; ++kb)
#pragma unroll
        for (int i = 0; i < 16; ++i) { const int c = crow(i, h); bool valid = (32 * qt - 128 + 32 * kb + c) >= 0;
            if (kb == 0) valid = valid && (c >= r);
            if (kb == 4) valid = valid && (c <= r);
            X[kb][i] = valid ? X[kb][i] : -INFINITY; m = fmaxf(m, X[kb][i]); }
    m = fmaxf(m, shx(m, 32, lane));
    float l = 0.f;
#pragma unroll
    for (int kb = 0; kb < 5; ++kb)
#pragma unroll
        for (int i = 0; i < 16; ++i) { X[kb][i] = __builtin_amdgcn_exp2f(X[kb][i] - m); l += X[kb][i]; }
    l += shx(l, 32, lane);
    f32x16 y[2]; y[0] = f32x16{}; y[1] = f32x16{};
#pragma unroll
    for (int kb = 0; kb < 5; ++kb) {
#pragma unroll
        for (int n = 0; n < 4; ++n) { const int id = lane + 64 * n, key = id >> 3, c = id & 7; int ki = 32 * qt - 128 + 32 * kb + key; ki = ki < 0 ? 0 : ki;
            const v4u v = *(const v4u*)(QKV + (rowb + res + (ki << sh)) * NIN1 + 2048 + hd * 64 + c * 8); *(LAS v4u*)(Lw + key * 192 + c * 16) = v; }
#pragma unroll
        for (int s2 = 0; s2 < 2; ++s2) { const bf16x8 pb = pack8(X[kb], 8 * s2);
#pragma unroll
            for (int dt = 0; dt < 2; ++dt) { const bf16x8 a = trfrag(Lw, 192, 16 * s2 + 4 * h, 8, 32 * dt, lane); y[dt] = MFMA32(a, pb, y[dt]); } }
    }
    const float inv = 1.f / l;
    u16* ob = (g == 0 ? OBg0 : g == 1 ? OBg1 : OBg2) + (rowb + qpos) * 1024 + hd * 64;
#pragma unroll
    for (int dt = 0; dt < 2; ++dt)
#pragma unroll
        for (int gq = 0; gq < 4; ++gq) { v2u w; w.x = pk2(y[dt][4 * gq] * inv, y[dt][4 * gq + 1] * inv); w.y = pk2(y[dt][4 * gq + 2] * inv, y[dt][4 * gq + 3] * inv); *(v2u*)(ob + 32 * dt + 8 * gq + 4 * h) = w; }
    if (h == 0) LSE[((size_t)g * MTOK + rowb + qpos) * 16 + hd] = (m + __log2f(l)) * 0.6931471805599453f;
}
namespace dl {
constexpr int KP = 144, VP = 192, O_K = 0, O_V = 384 * KP, O_END = O_V + 384 * VP;
static_assert(O_END <= 131072, "dilated lds");
struct Dec { int g, sh, res, i0, hd; size_t rowb; };
__device__ __forceinline__ Dec decode(int task) {
    Dec d; const int bh = task / 96, rem = task - bh * 96; d.g = rem >> 5; const int j = rem & 31;
    d.sh = 2 * d.g; d.res = j >> (5 - d.sh); d.i0 = 256 * (j & ((32 >> d.sh) - 1)); d.hd = bh & 15; d.rowb = (size_t)(bh >> 4) * 8192; return d;
}
__device__ __forceinline__ void issue(const u16* __restrict__ QKV, int task, int tid, v4u (&pk)[6], v4u (&pv)[6], bf16x8 (&qn)[4]) {
    const Dec d = decode(task); const int lane = tid & 63, w = tid >> 6, r = lane & 31, h = lane >> 5;
#pragma unroll
    for (int n = 0; n < 6; ++n) { const int id = tid + 512 * n, c = id >> 3, ch = id & 7; int ki = d.i0 - 128 + c; ki = ki < 0 ? 0 : ki;
        const u16* src = QKV + (d.rowb + d.res + (ki << d.sh)) * NIN1 + d.hd * 64 + ch * 8;
        pk[n] = *(const v4u*)(src + 1024); pv[n] = *(const v4u*)(src + 2048); }
    const u16* qp = QKV + (d.rowb + d.res + ((d.i0 + 32 * w + r) << d.sh)) * NIN1 + d.hd * 64;
#pragma unroll
    for (int ks = 0; ks < 4; ++ks) qn[ks] = *(const bf16x8*)(qp + 16 * ks + 8 * h);
}
__device__ __forceinline__ void phase(LAS unsigned char* L, const u16* __restrict__ QKV, u16* OBg0, u16* OBg1, u16* OBg2, float* LSE, int first, int stride, const int tid) {
    const int lane = tid & 63, w = __builtin_amdgcn_readfirstlane(tid >> 6), r = lane & 31, h = lane >> 5;
    const bool xl = (stride == 256); const int nround = xl ? 24 : (6144 - first + stride - 1) / stride;
    if (first >= 6144) return;
#define DL_TASK(k) (xl ? (((first >> 5) * 8 + (k) / 3) * 96 + ((k) % 3) * 32 + (first & 31)) : (first + (k) * stride))
    v4u pk[6], pv[6]; bf16x8 qn[4];
    issue(QKV, DL_TASK(0), tid, pk, pv, qn);
    for (int kr = 0; kr < nround; ++kr) {
        const int task = DL_TASK(kr);
        const Dec d = decode(task);
#pragma unroll
        for (int n = 0; n < 6; ++n) { const int id = tid + 512 * n, c = id >> 3, ch = id & 7; *(LAS v4u*)(L + O_K + c * KP + ch * 16) = pk[n]; *(LAS v4u*)(L + O_V + c * VP + ch * 16) = pv[n]; }
        bf16x8 qf[4];
#pragma unroll
        for (int ks = 0; ks < 4; ++ks) qf[ks] = qn[ks];
        __syncthreads();
        if (kr + 1 < nround) issue(QKV, DL_TASK(kr + 1), tid, pk, pv, qn);
        const int i0 = d.i0, g = d.g, sh = d.sh;
        const int qpos = d.res + ((i0 + 32 * w + r) << sh);
        f32x16 X[5];
#pragma unroll
        for (int kb = 0; kb < 5; ++kb) X[kb] = f32x16{};
        {
            LAS unsigned char* kbase = L + O_K + (32 * w + r) * KP + 8 * h * 2;
#pragma unroll
            for (int ks = 0; ks < 4; ++ks) {
                bf16x8 kf[5];
#pragma unroll
                for (int kb = 0; kb < 5; ++kb) kf[kb] = *(LAS bf16x8*)(kbase + 32 * kb * KP + 16 * ks * 2);
#pragma unroll
                for (int kb = 0; kb < 5; ++kb) X[kb] = MFMA32(kf[kb], qf[ks], X[kb]);
            }
        }
        float m = -INFINITY;
        const int kneg = 128 - i0 - 32 * w;
#pragma unroll
        for (int i = 0; i < 16; ++i) { const int c = crow(i, h);
            X[0][i] = (c >= r && c >= kneg) ? X[0][i] : -INFINITY; X[4][i] = (c <= r) ? X[4][i] : -INFINITY; }
        if (kneg > 32) {
#pragma unroll
            for (int kb = 1; kb < 4; ++kb)
#pragma unroll
                for (int i = 0; i < 16; ++i) X[kb][i] = (32 * kb + crow(i, h) >= kneg) ? X[kb][i] : -INFINITY;
        }
#pragma unroll
        for (int kb = 0; kb < 5; ++kb)
#pragma unroll
            for (int i = 0; i < 16; i += 2) m = fmaxf(m, fmaxf(X[kb][i], X[kb][i + 1]));
        m = fmaxf(m, shx(m, 32, lane));
        float l = 0.f;
#pragma unroll
        for (int kb = 0; kb < 5; ++kb)
#pragma unroll
            for (int i = 0; i < 16; ++i) { X[kb][i] = __builtin_amdgcn_exp2f(X[kb][i] - m); l += X[kb][i]; }
        l += shx(l, 32, lane);
        f32x16 y[2]; y[0] = f32x16{}; y[1] = f32x16{};
#pragma unroll
        for (int kb = 0; kb < 5; ++kb) {
            bf16x8 vf[2][2];
#pragma unroll
            for (int s2 = 0; s2 < 2; ++s2)
#pragma unroll
                for (int dt = 0; dt < 2; ++dt) vf[s2][dt] = trfrag(L + O_V, VP, 32 * w + 32 * kb + 16 * s2 + 4 * h, 8, 32 * dt, lane);
            const bf16x8 pb0 = pack8(X[kb], 0), pb1 = pack8(X[kb], 8);
            y[0] = MFMA32(vf[0][0], pb0, y[0]); y[1] = MFMA32(vf[0][1], pb0, y[1]); y[0] = MFMA32(vf[1][0], pb1, y[0]); y[1] = MFMA32(vf[1][1], pb1, y[1]);
        }
        const float inv = __builtin_amdgcn_rcpf(l);
        u16* ob = (g == 0 ? OBg0 : g == 1 ? OBg1 : OBg2) + (d.rowb + qpos) * 1024 + d.hd * 64;
#pragma unroll
        for (int dt = 0; dt < 2; ++dt)
#pragma unroll
            for (int gp = 0; gp < 2; ++gp) {
                const int ge = 2 * gp, go = 2 * gp + 1;
                unsigned e0 = pk2(y[dt][4 * ge] * inv, y[dt][4 * ge + 1] * inv), e1 = pk2(y[dt][4 * ge + 2] * inv, y[dt][4 * ge + 3] * inv);
                unsigned o0 = pk2(y[dt][4 * go] * inv, y[dt][4 * go + 1] * inv), o1 = pk2(y[dt][4 * go + 2] * inv, y[dt][4 * go + 3] * inv);
                const auto s0 = __builtin_amdgcn_permlane32_swap(e0, o0, false, false); const auto s1 = __builtin_amdgcn_permlane32_swap(e1, o1, false, false);
                const v4u wv = {s0[0], s1[0], s0[1], s1[1]};
                *(v4u*)(ob + 32 * dt + 8 * (2 * gp + h)) = wv; }
        if (h == 0) LSE[((size_t)g * MTOK + d.rowb + qpos) * 16 + d.hd] = (m + __log2f(l)) * 0.6931471805599453f;
        __syncthreads();
    }
}
}
__device__ __forceinline__ void dil_merge(const u16* OB0, const u16* OB1, const u16* OB2, const float* LSE, u16* MIX, int gw, int NGW, int lane) {
    const int hd = lane >> 2, dq = (lane & 3) * 16;
    for (int m = gw; m < MTOK; m += NGW) {
        const float l0 = LSE[((size_t)m) * 16 + hd], l1 = LSE[((size_t)MTOK + m) * 16 + hd], l2 = LSE[((size_t)2 * MTOK + m) * 16 + hd];
        const float mx = fmaxf(l0, fmaxf(l1, l2)); float w0 = __expf(l0 - mx), w1 = __expf(l1 - mx), w2 = __expf(l2 - mx); const float iz = 1.f / (w0 + w1 + w2); w0 *= iz; w1 *= iz; w2 *= iz;
        const size_t off = (size_t)m * 1024 + hd * 64 + dq;
#pragma unroll
        for (int j = 0; j < 2; ++j) { const v4u a = *(const v4u*)(OB0 + off + 8 * j), bq = *(const v4u*)(OB1 + off + 8 * j), c = *(const v4u*)(OB2 + off + 8 * j);
            const unsigned aw[4] = {a.x, a.y, a.z, a.w}, bw[4] = {bq.x, bq.y, bq.z, bq.w}, cw[4] = {c.x, c.y, c.z, c.w}; unsigned ow[4];
#pragma unroll
            for (int e = 0; e < 4; ++e) ow[e] = pk2(w0 * bflo(aw[e]) + w1 * bflo(bw[e]) + w2 * bflo(cw[e]), w0 * bfhi(aw[e]) + w1 * bfhi(bw[e]) + w2 * bfhi(cw[e]));
            *(v4u*)(MIX + off + 8 * j) = (v4u){ow[0], ow[1], ow[2], ow[3]}; }
    }
}
#ifndef PROBE_NOSTORE
#define PROBE_NOSTORE 0
#endif
#ifndef PROBE_SP2
#define PROBE_SP2 true
#endif
#ifndef LIGHT_ALIGN
#define LIGHT_ALIGN true
#endif
#ifndef PROBE_PAIR
#define PROBE_PAIR 0
#endif
#ifndef ATT_ORDER
#define ATT_ORDER 2
#endif
#ifndef PROBE_A
#define PROBE_A MIX
#endif
#ifndef PROBE_B
#define PROBE_B WS_WOUT0
#endif
#ifndef PROBE_M
#define PROBE_M MTOK
#endif
#ifndef HEAVY_ALIGN
#define HEAVY_ALIGN true
#endif
#ifndef REP_PRO
#define REP_PRO 1
#endif
#ifndef REP_P1
#define REP_P1 1
#endif
#ifndef REP_HGA
#define REP_HGA 1
#endif
#ifndef REP_HGC
#define REP_HGC 1
#endif
#ifndef REP_CMB
#define REP_CMB 1
#endif
#ifndef REP_DIL
#define REP_DIL 1
#endif
#ifndef REP_MRG
#define REP_MRG 1
#endif
#ifndef REP_P6
#define REP_P6 1
#endif
#ifndef REP_ATT
#define REP_ATT 1
#endif
#ifndef PH_LO
#define PH_LO 0
#endif
#ifndef PH_HI
#define PH_HI 100
#endif
__device__ __forceinline__ int fresh_lane() { int l; asm volatile("v_mbcnt_lo_u32_b32 %0, -1, 0\n\tv_mbcnt_hi_u32_b32 %0, -1, %0" : "=v"(l)); return l; }
__device__ __forceinline__ unsigned xcc_id() { return (unsigned)__builtin_amdgcn_s_getreg((3 << 11) | 20) & 0xFu; }
__device__ __forceinline__ unsigned bar_ld(unsigned* p) { return __hip_atomic_load(p, __ATOMIC_RELAXED, __HIP_MEMORY_SCOPE_AGENT); }
__device__ __forceinline__ unsigned bar_add(unsigned* p) { return __hip_atomic_fetch_add(p, 1u, __ATOMIC_RELAXED, __HIP_MEMORY_SCOPE_AGENT); }
__device__ __forceinline__ void grid_bar(unsigned* bar, unsigned k, unsigned x, unsigned nloc, unsigned nx, int wave0) {
    asm volatile("s_waitcnt vmcnt(0) lgkmcnt(0)" ::: "memory");
    __syncthreads();
    if (wave0 == 0) {
        const int ln = fresh_lane();
        if (ln == 0) {
            const unsigned old = bar_add(&bar[1024 + 64 * x]);
            if (old + 1u == k * nloc) {
                __builtin_amdgcn_fence(__ATOMIC_RELEASE, "agent");
                asm volatile("s_waitcnt vmcnt(0)" ::: "memory");
                const unsigned og = bar_add(&bar[3072]);
                if (og + 1u == k * nx) bar_add(&bar[3136]);
                else while (bar_ld(&bar[3136]) < k) __builtin_amdgcn_s_sleep(1);
                __builtin_amdgcn_fence(__ATOMIC_ACQUIRE, "agent");
                bar_add(&bar[2048 + 64 * x]);
                asm volatile("s_waitcnt vmcnt(0)" ::: "memory");
            } else {
                while (bar_ld(&bar[2048 + 64 * x]) < k) __builtin_amdgcn_s_sleep(1);
                __builtin_amdgcn_fence(__ATOMIC_ACQUIRE, "agent");
                asm volatile("s_waitcnt vmcnt(0)" ::: "memory");
            }
        }
    }
    __syncthreads();
}
struct PairOrder {
    int v;
    __device__ __forceinline__ bool next(int i, pg8::Unit& u) const { if (i >= 2) return false; u.pm = v >> 1; u.pn = 2 * (v & 1) + i; return true; }
    __device__ __forceinline__ void a_ready(const pg8::Unit&) const {}
    __device__ __forceinline__ void done(const pg8::Unit&) const {}
};
template <bool ALIGN = true, class Epi>
__device__ __forceinline__ void run_gemm_pair(LAS unsigned char* lds, const u16* A, const u16* Bt, int K, const Epi& E, int tid, int vcu) {
    asm volatile("" : "+v"(tid));
    int vl = vcu; asm volatile("" : "+s"(vl));
    pg8::Gemm g{A, Bt, MTOK, 1024, K}; PairOrder S{vl};
    pg8::gemm_phase<Epi, PairOrder, ALIGN, PG8_SP2>(lds, g, S, E, tid);
}
struct RangeOrder : pg8::StaticOrder {
    int i0, i1;
    __device__ __forceinline__ bool next(int i, pg8::Unit& u) const { return (i + i0 < i1) && pg8::StaticOrder::next(i + i0, u); }
};
template <class Epi>
__device__ __forceinline__ void run_gemm_range(LAS unsigned char* lds, const u16* A, const u16* Bt, int N, int K, const Epi& E, int tid, int i0, int i1) {
    asm volatile("" : "+v"(tid));
    int Gl = (int)gridDim.x, bxl = (int)blockIdx.x; asm volatile("" : "+s"(Gl), "+s"(bxl));
    pg8::Gemm g{A, Bt, MTOK, N, K}; RangeOrder S; S.init(MTOK, N, Gl, bxl); S.i0 = i0; S.i1 = i1;
    pg8::gemm_phase<Epi, RangeOrder, true, true>(lds, g, S, E, tid);
}
template <bool ALIGN = true, bool SP2 = true, class Epi>
__device__ __forceinline__ void run_gemm(LAS unsigned char* lds, const u16* A, const u16* Bt, int N, int K, const Epi& E, int tid, int Mrows = MTOK) {
    asm volatile("" : "+v"(tid));
    pg8::Gemm g{A, Bt, Mrows, N, K}; int Gl = (int)gridDim.x, bxl = (int)blockIdx.x; asm volatile("" : "+s"(Gl), "+s"(bxl)); pg8::StaticOrder S; S.init(Mrows, N, Gl, bxl);
    pg8::gemm_phase<Epi, pg8::StaticOrder, ALIGN, SP2>(lds, g, S, E, tid);
}
__global__ void __launch_bounds__(512, 2) fwd_kernel(Args A) {
    extern __shared__ __attribute__((aligned(16))) unsigned char lds_raw[];
    LAS unsigned char* lds = (LAS unsigned char*)lds_raw;
    cg::grid_group grid = cg::this_grid();
    const int wave0 = __builtin_amdgcn_readfirstlane((int)threadIdx.x >> 6);
#define tid0 (wave0 * 64 + fresh_lane())
    const int G = gridDim.x, bx = blockIdx.x;
    const int vcu = (G % 8 == 0) ? (bx % 8) * (G / 8) + bx / 8 : bx;
    const int NGW = G * 8;
#define PHASE_IDS() int tid = tid0; asm volatile("" : "+v"(tid)); const int lane = tid & 63, wave = __builtin_amdgcn_readfirstlane(tid >> 6), gw = bx * 8 + wave; (void)lane; (void)gw;
    unsigned char* ws = A.ws;
    float* rowss0 = (float*)(ws + WS_ROWSS); float* stats0 = (float*)(ws + WS_STATS); const float* cvec0 = (const float*)(ws + WS_CVEC); const float* lbv = (const float*)(ws + WS_MISC); const float* cs = (const float*)(ws + WS_CS);
    u16* XB = (u16*)(ws + WS_XB); u16* MIX = (u16*)(ws + WS_MIX); u16* HB = (u16*)(ws + WS_HB); u16* AUX = (u16*)(ws + WS_AUX);
    float* HGS = (float*)(ws + WS_HGS); float* HGD = (float*)(ws + WS_HGD); float* LSE = (float*)(ws + WS_LSE); u16* OB1 = (u16*)(ws + WS_OB1);
    float* X = A.out;
    u16* PBall = (u16*)((unsigned char*)A.out + 64 * MiB);
    unsigned* barw = (unsigned*)(ws + WS_BAR); unsigned nbar = 0;
    const unsigned myx = xcc_id();
    if (threadIdx.x == 0) bar_add(&barw[64 * myx]);
    unsigned nloc = 1, nxc = 1;
#define GSYNC() do { ++nbar; grid_bar(barw, nbar, myx, nloc, nxc, wave0); } while (0)

    for (int rep_ = 0; rep_ < REP_PRO; ++rep_) { { PHASE_IDS(); prologue(A, lds, gw, NGW, wave, lane); p_rows2(A.p, PBall, gw, NGW, lane); } }
    grid.sync();
    { unsigned cnt = 0, mine = 0;
#pragma unroll
      for (unsigned jx = 0; jx < 16; ++jx) { const unsigned c = bar_ld(&barw[64 * jx]); cnt += (c > 0u) ? 1u : 0u; mine = (jx == myx) ? c : mine; }
      nloc = (unsigned)__builtin_amdgcn_readfirstlane((int)mine); nxc = (unsigned)__builtin_amdgcn_readfirstlane((int)cnt); }

    for (int l = 0; l < 2; ++l) {
        const u16* Ain = (l == 0) ? XB : (const u16*)X;
        if (l == 0) {
            for (int rep_ = 0; rep_ < REP_P1; ++rep_) { { pg8::EpiStore E{HB, NIN0, 0, 1024, 512, cs, nullptr, nullptr, nullptr}; run_gemm(lds, Ain, (const u16*)(ws + WS_WIN0), NIN0, 1024, E, tid0); } }
            GSYNC();
#ifndef NO_HGA
            for (int rep_ = 0; rep_ < REP_HGA; ++rep_) { for (int it = vcu; it < 256; it += G) { PHASE_IDS(); hg::item<false>(lds, HB, it, lbv, HGS, HGD, nullptr, nullptr, tid); } }
#endif
            GSYNC();
#ifndef NO_HGC
            for (int rep_ = 0; rep_ < REP_HGC; ++rep_) { for (int it = vcu; it < 256; it += G) { PHASE_IDS(); hg::item<true>(lds, HB, it, lbv, HGS, HGD, A.hg_norm_g, MIX, tid); } }
#endif
            __syncthreads();
            int Ga = G; asm volatile("" : "+s"(Ga));
#if ATT_ORDER == 2
            for (int rep_ = 0; rep_ < REP_ATT; ++rep_) {
                const int bhd = (Ga == 256) ? (vcu >> 4) : 0, jq = vcu & 15; const int b = bhd >> 2, hh = bhd & 3;
                if (Ga == 256) {
                    for (int sub = 0; sub < 4; ++sub)
                        for (int grp = 0; grp < 2; ++grp) {
                            int tidA = tid0; asm volatile("" : "+v"(tidA));
                            const int c = sub >> 1, half = sub & 1, vh = hh * 4 + sub, qb = grp ? jq : 31 - jq;
                            attn_body::attn_unit<8>(b, (2 * hh + c) * 64, 512 + (2 * hh + c) * 64, 1024 + hh * 128 + half * 64, vh * 64, qb,
                                                    (const attn_body::bf16*)HB, (const attn_body::bf16*)HB, (const attn_body::bf16*)HB, (attn_body::bf16*)AUX, (char*)lds_raw, tidA);
                        }
                    asm volatile("s_waitcnt vmcnt(0)" ::: "memory");
                    __syncthreads();
                    for (int grp = 0; grp < 2; ++grp) { PHASE_IDS(); diff_combine_block(AUX, MIX, A.da_lambda, A.da_subln_g, (size_t)b * 8192 + (size_t)(grp ? jq : 31 - jq) * 256, hh, tid); }
                }
            }
            if (Ga != 256)
#endif
            for (int rep_ = 0; rep_ < REP_ATT; ++rep_)
            for (int gi = vcu; gi < 512; gi += Ga) {
                int bhd, qb;
#if ATT_ORDER == 1
                if (Ga == 256) { const int j = vcu & 31; if (gi < 256) { bhd = 2 * (vcu >> 5); qb = 31 - j; } else { bhd = 2 * (vcu >> 5) + 1; qb = j; } }
#else
                if (Ga == 256) { bhd = vcu >> 4; const int j = vcu & 15; qb = (gi < 256) ? 31 - j : j; }
#endif
                else { bhd = gi >> 5; qb = 31 - (gi & 31); }
                const int b = bhd >> 2, hh = bhd & 3;
                for (int sub = 0; sub < 4; ++sub) {
                    int tidA = tid0; asm volatile("" : "+v"(tidA));
                    const int c = sub >> 1, half = sub & 1, vh = hh * 4 + sub;
#ifndef NO_ATTN
                    attn_body::attn_unit<8>(b, (2 * hh + c) * 64, 512 + (2 * hh + c) * 64, 1024 + hh * 128 + half * 64, vh * 64, qb,
                                            (const attn_body::bf16*)HB, (const attn_body::bf16*)HB, (const attn_body::bf16*)HB, (attn_body::bf16*)AUX, (char*)lds_raw, tidA);
#endif
                }
                asm volatile("s_waitcnt vmcnt(0)" ::: "memory");
                __syncthreads();
                { PHASE_IDS(); diff_combine_block(AUX, MIX, A.da_lambda, A.da_subln_g, (size_t)b * 8192 + (size_t)qb * 256, hh, tid); }
            }
            GSYNC();
        } else {
            { pg8::EpiStore E{HB, NIN1, 0, 2048, 1024, cs, nullptr, nullptr, nullptr}; run_gemm(lds, Ain, (const u16*)(ws + WS_WIN1), NIN1, 1024, E, tid0); }
            GSYNC();
#ifndef NO_DIL
            for (int rep_ = 0; rep_ < REP_DIL; ++rep_) { { PHASE_IDS(); dl::phase(lds, HB, AUX, OB1, XB, LSE, vcu, G, tid); } }
#endif
            GSYNC();
            for (int rep_ = 0; rep_ < REP_MRG; ++rep_) { { PHASE_IDS(); dil_merge(AUX, OB1, XB, LSE, MIX, gw, NGW, lane); } }
            GSYNC();
        }
        float* rowss = rowss0 + (size_t)l * MTOK; float* st1 = stats0 + (size_t)(2 * l) * MTOK * 2; float* st2 = stats0 + (size_t)(2 * l + 1) * MTOK * 2; const float* cv = cvec0 + l * 10240;
        { pg8::EpiResid E{Ain, XB, nullptr, nullptr, nullptr, st1}; run_gemm<HEAVY_ALIGN>(lds, MIX, (const u16*)(ws + (l == 0 ? WS_WOUT0 : WS_WOUT1)), 1024, 1024, E, tid0); }
#ifdef PROBE_OUTP
        for (int q_ = 0; q_ < PROBE_OUTP; ++q_) { pg8::EpiStore E{PROBE_NOSTORE == 1 ? (u16*)nullptr : HB + (size_t)64 * MiB, 1024, 0, 0, 0, cs, nullptr, nullptr, nullptr, PROBE_NOSTORE == 2 ? 255 : -1}; if (PROBE_PAIR && G == 256) run_gemm_pair(lds, PROBE_A, (const u16*)(ws + PROBE_B), 1024, E, tid0, vcu); else run_gemm<true, PROBE_SP2>(lds, PROBE_A, (const u16*)(ws + PROBE_B), 1024, 1024, E, tid0, PROBE_M); }
#endif
#ifdef PROBE_RESID
        { pg8::EpiResid E{XB, HB + (size_t)64 * MiB, st1, A.ln1_g, A.ln1_b, PROBE_RESID == 2 ? (float*)nullptr : (float*)(HB + (size_t)96 * MiB)}; run_gemm(lds, MIX, (const u16*)(ws + WS_WOUT0), 1024, 1024, E, tid0); }
#endif
        GSYNC();
        { int ksp = (G == 256) ? ((vcu & 7) % 3) : 0;
          asm volatile("" : "+s"(ksp));
          for (int sgm = 0; sgm < 3; ++sgm) {
            if (sgm == 1) { for (int rep_ = 0; rep_ < REP_P6; ++rep_) { pg8::EpiStore E{HB, FFD, 1, 0, 0, cs, st1, cv, cv + 4096}; run_gemm<LIGHT_ALIGN>(lds, XB, (const u16*)(ws + WS_W1 + l * 8 * MiB), FFD, 1024, E, tid0); } }
            else { pg8::EpiE E{MIX, rowss}; run_gemm_range(lds, PBall + (size_t)l * MTOK * PLE, (const u16*)(ws + WS_WP + l * (MiB / 2)), 1024, PLE, E, tid0, sgm == 0 ? 0 : ksp, sgm == 0 ? ksp : 1 << 20); }
          } }
        GSYNC();
#ifdef PROBE_EGEMM
        for (int q_ = 0; q_ < PROBE_EGEMM; ++q_) { pg8::EpiE E{AUX, (float*)(ws + WS_LSE)}; run_gemm(lds, AUX, (const u16*)(ws + WS_WP + l * (MiB / 2)), 1024, PLE, E, tid0); }
#endif
#ifdef PROBE_FFN2
        { pg8::EpiStore E{AUX, 1024, 0, 0, 0, cs, nullptr, nullptr, nullptr}; run_gemm(lds, HB, (const u16*)(ws + WS_W2 + l * 8 * MiB), 1024, FFD, E, tid0); }
#endif
        { pg8::EpiResid E{XB, XB, st1, A.ln1_g + l * 1024, A.ln1_b + l * 1024, st2}; run_gemm<HEAVY_ALIGN>(lds, HB, (const u16*)(ws + WS_W2 + l * 8 * MiB), 1024, FFD, E, tid0); }
        GSYNC();
        { pg8::EpiGate E{l == 0 ? (float*)nullptr : X, XB, st2, A.ln2_g + l * 1024, A.ln2_b + l * 1024, cv + 8192, cv + 9216, MIX, rowss, A.ple_norm_g + l * 1024, l == 0 ? (u16*)X : (u16*)nullptr}; run_gemm<HEAVY_ALIGN>(lds, XB, (const u16*)(ws + WS_WG + l * 2 * MiB), 1024, 1024, E, tid0); }
        if (l == 0) GSYNC();
    }
#ifdef PROBE_BARS
    for (int i = 0; i < PROBE_BARS; ++i) GSYNC();
#endif
}

extern "C" void kernel_launch(void* const* d_in, const int* in_sizes, int n_in, void* d_out, int out_size, void* d_ws, size_t ws_size, hipStream_t stream) {
    static int grid = 0;
    if (grid == 0) {
        if (n_in != 19 || out_size != MTOK * DMODEL || ws_size < WS_END) { fprintf(stderr, "kernel_launch: unexpected shapes (n_in %d, out %d, ws %zu)\n", n_in, out_size, ws_size); grid = -1; return; }
        int dev = 0, cus = 0, per_cu = 0;
        if (hipGetDevice(&dev) != hipSuccess || hipDeviceGetAttribute(&cus, hipDeviceAttributeMultiprocessorCount, dev) != hipSuccess) { grid = -1; return; }
        if (hipFuncSetAttribute((const void*)fwd_kernel, hipFuncAttributeMaxDynamicSharedMemorySize, LDS_BYTES) != hipSuccess) { fprintf(stderr, "kernel_launch: hipFuncSetAttribute failed\n"); grid = -1; return; }
        if (hipOccupancyMaxActiveBlocksPerMultiprocessor(&per_cu, (const void*)fwd_kernel, 512, LDS_BYTES) != hipSuccess || per_cu < 1) { fprintf(stderr, "kernel_launch: occupancy query says %d\n", per_cu); per_cu = 1; }
        (void)hipGetLastError();
        grid = cus * per_cu;
    }
    if (grid < 0) return;
    if (hipMemsetAsync((char*)d_ws, 0, WS_BAR + 16384, stream) != hipSuccess) { fprintf(stderr, "kernel_launch: memset failed\n"); return; }
    Args a{};
    const float** f = (const float**)&a;
    for (int i = 0; i < 19; ++i) f[i] = (const float*)d_in[i];
    a.out = (float*)d_out; a.ws = (unsigned char*)d_ws;
    void* args[] = {&a};
    hipError_t e = hipLaunchCooperativeKernel((const void*)fwd_kernel, dim3(grid), dim3(512), args, LDS_BYTES, stream);
    if (e != hipSuccess) fprintf(stderr, "cooperative launch failed: %s (grid %d)\n", hipGetErrorString(e), grid);
}
```
